# Optimizing an MI355X kernel written in HIP

```python
import jax, jax.numpy as jnp
from jax import lax
import numpy as np

D_MODEL = 1024
BATCH = 8
SEQ = 2048
DEPTH = 2

SG_WIDTH = D_MODEL // 2
SG_CHUNK = 128
SG_GROUPS = 4
CV_WIDTH = D_MODEL // 2
CV_KERNEL = 31
HEAD_DIM = 64
N_Q_HEADS = D_MODEL // 2 // HEAD_DIM
N_KV_HEADS = N_Q_HEADS // 4
Q_WIDTH = N_Q_HEADS * HEAD_DIM
KV_WIDTH = N_KV_HEADS * HEAD_DIM
WINDOW = 128
ROPE_THETA = 10000.0
SC_WIDTH = D_MODEL // 2
SC_KERNEL = 3
N_BRANCH = 4
BRANCH_WIDTH = D_MODEL // 2
D_FF = -(-8 * D_MODEL // (3 * 256)) * 256
EPS = 1e-6

_PROJ_WIDTHS = (2 * SG_WIDTH, 2 * CV_WIDTH, Q_WIDTH, KV_WIDTH, KV_WIDTH, 3 * SC_WIDTH, N_BRANCH * D_MODEL)
PROJ_WIDTH = sum(_PROJ_WIDTHS)
PROJ_SPLITS = tuple(sum(_PROJ_WIDTHS[:i + 1]) for i in range(len(_PROJ_WIDTHS) - 1))

kernel_name = "hybrid_gated_four_mixer_block"


def rmsnorm(x, g):
    xf = x.astype(jnp.float32)
    y = xf * lax.rsqrt(jnp.mean(xf * xf, axis=-1, keepdims=True) + EPS)
    return (y * g.astype(jnp.float32)).astype(x.dtype)


def layernorm(x, g, b):
    xf = x.astype(jnp.float32)
    mu = jnp.mean(xf, axis=-1, keepdims=True)
    var = jnp.mean(jnp.square(xf - mu), axis=-1, keepdims=True)
    y = (xf - mu) * lax.rsqrt(var + EPS)
    return (y * g.astype(jnp.float32) + b.astype(jnp.float32)).astype(x.dtype)


def causal_depthwise_conv(x, w):
    k = w.shape[0]
    return lax.conv_general_dilated(
        x, w[:, None, :].astype(x.dtype), window_strides=(1,), padding=[(k - 1, 0)],
        dimension_numbers=('NWC', 'WIO', 'NWC'), feature_group_count=x.shape[-1])


def rotary(t, cos, sin):
    t1, t2 = jnp.split(t, 2, axis=-1)
    c = cos[None, :, None, :]
    s = sin[None, :, None, :]
    return jnp.concatenate([t1 * c - t2 * s, t2 * c + t1 * s], axis=-1)


def spatial_gating(z, ln_g, ln_b, w_s, b_s):
    u, v = jnp.split(z, 2, axis=-1)
    v = layernorm(v, ln_g, ln_b)
    b, s, _ = v.shape
    nc = s // SG_CHUNK
    vc = v.reshape(b, nc, SG_CHUNK, SG_GROUPS, SG_WIDTH // SG_GROUPS)
    tril = jnp.tril(jnp.ones((SG_CHUNK, SG_CHUNK), dtype=bool))
    w = jnp.where(tril[None], w_s, jnp.zeros((), w_s.dtype))
    mixed = jnp.einsum('gts,bnsgc->bntgc', w, vc) + b_s.T[None, None, :, :, None]
    return u * mixed.reshape(b, s, SG_WIDTH)


def conformer_conv(z, w_dw, b_dw, ln_g, ln_b):
    a, gate = jnp.split(z, 2, axis=-1)
    y = a * jax.nn.sigmoid(gate)
    y = causal_depthwise_conv(y, w_dw) + b_dw
    y = layernorm(y, ln_g, ln_b)
    return jax.nn.silu(y)


def short_gated_conv(z, w_sc):
    bg, cg, h = jnp.split(z, 3, axis=-1)
    return bg * causal_depthwise_conv(cg * h, w_sc)


def sliding_window_attention(q, k, v, sinks):
    b, s, _, _ = q.shape
    nb = s // WINDOW
    g = N_Q_HEADS // N_KV_HEADS
    qb = q.reshape(b, nb, WINDOW, N_KV_HEADS, g, HEAD_DIM)

    def band(t):
        tp = jnp.pad(t, ((0, 0), (WINDOW, 0), (0, 0), (0, 0)))
        prev = tp[:, :s].reshape(b, nb, WINDOW, N_KV_HEADS, HEAD_DIM)
        cur = t.reshape(b, nb, WINDOW, N_KV_HEADS, HEAD_DIM)
        return jnp.concatenate([prev, cur], axis=2)

    kb, vb = band(k), band(v)
    scores = jnp.einsum('bnqhgd,bnkhd->bnhgqk', qb, kb).astype(jnp.float32) * (HEAD_DIM ** -0.5)
    qi = jnp.arange(WINDOW)[None, :, None]
    kj = jnp.arange(2 * WINDOW)[None, None, :]
    blk = jnp.arange(nb)[:, None, None]
    delta = qi + WINDOW - kj
    valid = (delta >= 0) & (delta < WINDOW) & (blk * WINDOW + kj - WINDOW >= 0)
    scores = jnp.where(valid[None, :, None, None], scores, -jnp.inf)
    sink = sinks.astype(jnp.float32).reshape(N_KV_HEADS, g)[None, None, :, :, None, None]
    m = jnp.maximum(jnp.max(scores, axis=-1, keepdims=True), sink)
    p = jnp.exp(scores - m)
    probs = (p / (jnp.sum(p, axis=-1, keepdims=True) + jnp.exp(sink - m))).astype(v.dtype)
    out = jnp.einsum('bnhgqk,bnkhd->bnqhgd', probs, vb)
    return out.reshape(b, s, Q_WIDTH)


def setup_inputs(seed: int = 0) -> dict:
    key = jax.random.key(seed)
    ks = jax.random.split(key, 24)
    f32 = jnp.float32
    nrm = lambda k, shape, scale: jax.random.normal(k, shape, f32) * scale
    gain = lambda k, shape: 1.0 + 0.02 * jax.random.normal(k, shape, f32)
    return {
        "x": nrm(ks[0], (BATCH, SEQ, D_MODEL), 1.0),
        "norm_mix": gain(ks[1], (DEPTH, D_MODEL)),
        "w_in": nrm(ks[2], (DEPTH, D_MODEL, PROJ_WIDTH), D_MODEL ** -0.5),
        "sg_ln_g": gain(ks[3], (DEPTH, SG_WIDTH)),
        "sg_ln_b": nrm(ks[4], (DEPTH, SG_WIDTH), 0.02),
        "sg_w": nrm(ks[5], (DEPTH, SG_GROUPS, SG_CHUNK, SG_CHUNK), SG_CHUNK ** -0.5),
        "sg_b": 1.0 + nrm(ks[6], (DEPTH, SG_GROUPS, SG_CHUNK), 0.1),
        "cv_w": nrm(ks[7], (DEPTH, CV_KERNEL, CV_WIDTH), CV_KERNEL ** -0.5),
        "cv_b": nrm(ks[8], (DEPTH, CV_WIDTH), 0.02),
        "cv_ln_g": gain(ks[9], (DEPTH, CV_WIDTH)),
        "cv_ln_b": nrm(ks[10], (DEPTH, CV_WIDTH), 0.02),
        "attn_sinks": nrm(ks[11], (DEPTH, N_Q_HEADS), 1.0),
        "sc_w": nrm(ks[12], (DEPTH, SC_KERNEL, SC_WIDTH), SC_KERNEL ** -0.5),
        "w_branch": nrm(ks[13], (DEPTH, N_BRANCH, BRANCH_WIDTH, D_MODEL), BRANCH_WIDTH ** -0.5),
        "w_out": nrm(ks[14], (DEPTH, D_MODEL, D_MODEL), 0.5 * D_MODEL ** -0.5),
        "norm_ffn": gain(ks[15], (DEPTH, D_MODEL)),
        "w_gate_up": nrm(ks[16], (DEPTH, D_MODEL, 2 * D_FF), D_MODEL ** -0.5),
        "w_down": nrm(ks[17], (DEPTH, D_FF, D_MODEL), D_FF ** -0.5),
        "norm_final": gain(ks[18], (D_MODEL,)),
    }


def reference(x, norm_mix, w_in, sg_ln_g, sg_ln_b, sg_w, sg_b, cv_w, cv_b, cv_ln_g, cv_ln_b,
              attn_sinks, sc_w, w_branch, w_out, norm_ffn, w_gate_up, w_down, norm_final):
    b, s, _ = x.shape
    pos = jnp.arange(s, dtype=jnp.float32)
    inv_freq = 1.0 / (ROPE_THETA ** (jnp.arange(0, HEAD_DIM, 2, dtype=jnp.float32) / HEAD_DIM))
    ang = pos[:, None] * inv_freq[None, :]
    cos = jnp.cos(ang).astype(x.dtype)
    sin = jnp.sin(ang).astype(x.dtype)

    for l in range(DEPTH):
        xn = rmsnorm(x, norm_mix[l])
        proj = xn @ w_in[l]
        z_a, z_b, q, k, v, z_d, z_g = jnp.split(proj, PROJ_SPLITS, axis=-1)

        y_a = spatial_gating(jax.nn.gelu(z_a, approximate=False), sg_ln_g[l], sg_ln_b[l], sg_w[l], sg_b[l])
        y_b = conformer_conv(z_b, cv_w[l], cv_b[l], cv_ln_g[l], cv_ln_b[l])
        q = rotary(q.reshape(b, s, N_Q_HEADS, HEAD_DIM), cos, sin)
        k = rotary(k.reshape(b, s, N_KV_HEADS, HEAD_DIM), cos, sin)
        v = v.reshape(b, s, N_KV_HEADS, HEAD_DIM)
        y_c = sliding_window_attention(q, k, v, attn_sinks[l])
        y_d = short_gated_conv(z_d, sc_w[l])

        ys = jnp.stack([y_a, y_b, y_c, y_d], axis=0)
        branch = jnp.einsum('nbsc,ncd->nbsd', ys, w_branch[l])
        gates = jax.nn.sigmoid(z_g.reshape(b, s, N_BRANCH, D_MODEL))
        merged = jnp.einsum('bsnd,nbsd->bsd', gates, branch)
        x = x + merged @ w_out[l]

        hn = rmsnorm(x, norm_ffn[l])
        gate, up = jnp.split(hn @ w_gate_up[l], 2, axis=-1)
        x = x + (jax.nn.silu(gate) * up) @ w_down[l]

    return rmsnorm(x, norm_final)
```

```cpp
#include <hip/hip_runtime.h>
#include <hip/hip_cooperative_groups.h>
#include <cstdio>
#include <cstdint>
namespace cg = cooperative_groups;

#define LAS __attribute__((address_space(3)))
typedef unsigned short bf16_t;
typedef short bf16x8 __attribute__((ext_vector_type(8)));
typedef float f32x4 __attribute__((ext_vector_type(4)));
typedef float f32x2 __attribute__((ext_vector_type(2)));
typedef unsigned u32x4 __attribute__((ext_vector_type(4)));
typedef unsigned u32x2 __attribute__((ext_vector_type(2)));

constexpr int M = 16384, D = 1024, SEQ = 2048, NBATCH = 8, DFF = 2816, PROJ = 8448, NLOG1 = 4352  ;
constexpr float EPS = 1e-6f;
constexpr int NTHREADS = 512, NWAVES = 8;
constexpr int LDS_BYTES = 147456;

constexpr size_t MiB = 1u << 20;
constexpr size_t WS_SSQ = 0;
constexpr size_t WS_PAR = 512 * 1024;
constexpr int PAR_L = 24576, P_SGLNG = 0, P_SGLNB = 512, P_SGB = 1024, P_CVB = 1536, P_CVLNG = 2048, P_CVLNB = 2560, P_SCW = 3072, P_SINK = 4608, P_CVW = 4672, P_FINAL = 2 * PAR_L;
constexpr size_t WS_BAR = 768 * 1024;
constexpr int MISC_OFF = 147200;
constexpr size_t WS_ROPEC = 1 * MiB, WS_ROPES = 1 * MiB + 256 * 1024;
constexpr size_t WS_SGWT = 1 * MiB + 512 * 1024;
constexpr size_t WS_WIN = 2 * MiB, WIN_L = (size_t)PROJ * D * 2;
constexpr size_t WS_WBR = 35 * MiB, WBR_L = 4 * MiB;
constexpr size_t WS_WOUT = 43 * MiB, WOUT_L = 2 * MiB;
constexpr size_t WS_WGU = 47 * MiB, WGU_L = 11 * MiB;
constexpr size_t WS_WDN = 69 * MiB, WDN_L = (size_t)D * DFF * 2;
constexpr size_t WS_XB = 80 * MiB;
constexpr size_t WS_ZA = 112 * MiB;
constexpr size_t WS_MG = WS_ZA;
constexpr size_t WS_GLU = 144 * MiB;
constexpr size_t WS_CH = 160 * MiB;
constexpr size_t WS_TMP = WS_GLU;
constexpr size_t WS_Q = 176 * MiB;
constexpr size_t WS_BG = 192 * MiB;
constexpr size_t WS_K = 208 * MiB, WS_V = 212 * MiB;
constexpr size_t WS_YA = 216 * MiB, WS_YB = 232 * MiB;
constexpr size_t WS_ACT = 112 * MiB;
constexpr size_t WS_END = 248 * MiB;

__device__ const double INVF_REV[32] = {0.15915494309189535, 0.11934937021124886, 0.08949940160889101, 0.06711508300522726, 0.050329212104487035, 0.03774158471741977, 0.0283021958306234, 0.02122365276477766, 0.015915494309189534, 0.011934937021124886, 0.008949940160889102, 0.006711508300522725, 0.005032921210448704, 0.003774158471741977, 0.00283021958306234, 0.0021223652764777662, 0.0015915494309189536, 0.0011934937021124885, 0.0008949940160889102, 0.0006711508300522726, 0.0005032921210448703, 0.00037741584717419774, 0.00028302195830623395, 0.0002122365276477766, 0.00015915494309189535, 0.00011934937021124886, 8.949940160889102e-05, 6.711508300522725e-05, 5.0329212104487035e-05, 3.774158471741978e-05, 2.8302195830623396e-05, 2.122365276477766e-05};

__device__ __forceinline__ unsigned cvt_pk_bf16(float lo, float hi) { unsigned r; asm volatile("v_cvt_pk_bf16_f32 %0, %1, %2" : "=v"(r) : "v"(lo), "v"(hi)); return r; }
__device__ __forceinline__ float bf_lo(unsigned u) { return __builtin_bit_cast(float, u << 16); }
__device__ __forceinline__ float bf_hi(unsigned u) { return __builtin_bit_cast(float, u & 0xffff0000u); }
__device__ __forceinline__ float bf1(bf16_t h) { return __builtin_bit_cast(float, ((unsigned)h) << 16); }
__device__ __forceinline__ float sigmoidf_(float x) { return __builtin_amdgcn_rcpf(1.0f + __expf(-x)); }
__device__ __forceinline__ float wave_sum(float v) {
#pragma unroll
    for (int o = 1; o < 64; o <<= 1) v += __shfl_xor(v, o);
    return v;
}
__device__ __forceinline__ f32x2 gelu_pk(f32x2 v) {
    const f32x2 av = __builtin_elementwise_abs(v), d = av * 0.2316418882f + 1.0f;
    f32x2 t; t.x = __builtin_amdgcn_rcpf(d.x); t.y = __builtin_amdgcn_rcpf(d.y);
    f32x2 q = t * 0.5307027145f + (-0.7265760135f); q = q * t + 0.7107068705f; q = q * t + (-0.142248368f); q = q * t + 0.127414796f; q = q * t;
    const f32x2 s = (v * v) * (-0.72134752044f);
    f32x2 e; e.x = __builtin_amdgcn_exp2f(s.x); e.y = __builtin_amdgcn_exp2f(s.y);
    const f32x2 m = v * (q * e), r = v - m;
    f32x2 o; o.x = v.x < 0.f ? m.x : r.x; o.y = v.y < 0.f ? m.y : r.y; return o;
}
__device__ __forceinline__ u32x4 pack8(f32x4 a, f32x4 b) { u32x4 w; w.x = cvt_pk_bf16(a[0], a[1]); w.y = cvt_pk_bf16(a[2], a[3]); w.z = cvt_pk_bf16(b[0], b[1]); w.w = cvt_pk_bf16(b[2], b[3]); return w; }
__device__ __forceinline__ void unpack8(u32x4 w, f32x4& a, f32x4& b) { a = (f32x4){bf_lo(w.x), bf_hi(w.x), bf_lo(w.y), bf_hi(w.y)}; b = (f32x4){bf_lo(w.z), bf_hi(w.z), bf_lo(w.w), bf_hi(w.w)}; }

namespace pg8 {
constexpr int BM = 256, BK = 64, HALF = 128, HTB = HALF * BK * 2, STAGE_BYTES = 8 * HTB, NXCD = 8, WGM = 8;
__host__ __device__ __forceinline__ int lds_byte(int r, int c) { const int st = (r >> 4) * 2 + (c >> 5), rr = r & 15, cc = c & 31, ob = rr * 64 + cc * 2; return st * 1024 + (ob ^ (((ob >> 9) & 1) << 5)); }
__host__ __device__ __forceinline__ void stage_rc(int b, int& R, int& C) { const int st = b / 1024, sb = b % 1024, swz = sb ^ (((sb >> 9) & 1) << 5); R = (st >> 1) * 16 + swz / 64; C = (st & 1) * 32 + (swz % 64) / 2; }
__host__ __device__ __forceinline__ int perm32(int rho) { const int n = rho >> 4, i = rho & 15; return 8 * (i >> 2) + 4 * n + (i & 3); }

struct Unit { const char* A; const char* B; int lda2, ldb2, nt, pm, pn, z; };

__device__ __forceinline__ void tile_of(int L, int nM, int nN, int& pm, int& pn) {
    const int nwg = nM * nN; int wgid = L; { const int q = nwg / NXCD, r = nwg % NXCD, xcd = wgid % NXCD, off = wgid / NXCD; wgid = (xcd < r ? xcd * (q + 1) : r * (q + 1) + (xcd - r) * q) + off; }
    const int nig = WGM * nN, gid = wgid / nig, fm = gid * WGM, gsz = (nM - fm) < WGM ? (nM - fm) : WGM;
    pm = fm + ((wgid % nig) % gsz); pn = (wgid % nig) / gsz;
}
struct SchedGrid {
    static constexpr bool VARLD = false;
    int nM, nN, nwg, G, c; const char* A; const char* B; int lda2, ldb2, nt;
    __device__ __forceinline__ bool next(int i, Unit& u) const {
        const long L = (long)i * G + c; if (L >= nwg) return false;
        tile_of((int)L, nM, nN, u.pm, u.pn); u.z = 0;
        u.A = A + (size_t)u.pm * 256 * lda2; u.B = B + (size_t)u.pn * 256 * ldb2; u.lda2 = lda2; u.ldb2 = ldb2; u.nt = nt; return true;
    }
};
struct SchedMerge {
    static constexpr bool VARLD = true;
    int G, c; const char* ws; const char* WG  ; const char* WBR;
    __device__ __forceinline__ bool next(int i, Unit& u) const {
        const int ti = i >> 3, sub = i & 7; const long L = (long)ti * G + c; if (L >= 256) return false;
        tile_of((int)L, 64, 4, u.pm, u.pn); u.z = sub; const int br = sub >> 1;
        if ((sub & 1) == 0) { u.A = ws + WS_XB + (size_t)u.pm * 256 * 2048; u.lda2 = 2048; u.B = WG + (size_t)(br * 1024 + u.pn * 256) * 2048; u.ldb2 = 2048; u.nt = 16; }
        else { const size_t yo = br == 0 ? WS_YA : br == 1 ? WS_YB : br == 2 ? WS_Q : WS_BG;
               u.A = ws + yo + (size_t)u.pm * 256 * 1024; u.lda2 = 1024; u.B = WBR + (size_t)br * (1024 * 512 * 2) + (size_t)u.pn * 256 * 1024; u.ldb2 = 1024; u.nt = 8; }
        return true;
    }
};

struct SchedOne {
    static constexpr bool VARLD = false;
    SchedMerge M; int i0;
    __device__ __forceinline__ bool next(int i, Unit& u) const { if (i != 0) return false; return M.next(i0, u); }
};
struct SchedOneG {
    static constexpr bool VARLD = false;
    SchedGrid S; int i0;
    __device__ __forceinline__ bool next(int i, Unit& u) const { if (i != 0) return false; return S.next(i0, u); }
};
template <class Epi, class Sched, bool ALIGN_EPI>
__device__ __forceinline__ void gemm_phase(LAS unsigned char* lds, const Sched& S, const Epi& E) {
    int tid_ = threadIdx.x; asm volatile("" : "+v"(tid_));
    const int tid = tid_, wid = __builtin_amdgcn_readfirstlane(tid >> 6), lane = tid & 63, wr = wid >> 2, wc = wid & 3, fr = lane & 15, fq = lane >> 4;
    unsigned rA[2], rB[2], cc2[2];
#pragma unroll
    for (int i = 0; i < 2; ++i) { int R, C; stage_rc(tid * 16 + i * 8192, R, C); rA[i] = (unsigned)R; rB[i] = (unsigned)((R & ~31) + perm32(R & 31)); cc2[i] = (unsigned)C * 2u; }
    const size_t kstep = (size_t)(BK * 2);
    const unsigned ldsw = (unsigned)wid * 1024u;
    const int aoff = lds_byte(wr * 64 + fr, fq * 8), boff = lds_byte(wc * 32 + fr, fq * 8);
#define PG8_SA(b, h) (((b) * 2 + (h)) * HTB)
#define PG8_SB(b, h) ((4 + (b) * 2 + (h)) * HTB)
#define PG8_STAGE(bufoff, gbase, voff) do { _Pragma("unroll") for (int _i = 0; _i < 2; ++_i) \
        __builtin_amdgcn_global_load_lds((const unsigned*)((const char*)(gbase) + (voff)[_i]), (LAS unsigned*)(lds + (bufoff) + ldsw + _i * 8192), 16, 0, 0); } while (0)
#define PG8_LDA(dst, b, h) do { _Pragma("unroll") for (int m = 0; m < 4; ++m) _Pragma("unroll") for (int k = 0; k < 2; ++k) dst[m][k] = *(const LAS bf16x8*)(lds + PG8_SA(b, h) + aoff + m * 2048 + k * 1024); } while (0)
#define PG8_LDB(dst, b, h) do { _Pragma("unroll") for (int n = 0; n < 2; ++n) _Pragma("unroll") for (int k = 0; k < 2; ++k) dst[n][k] = *(const LAS bf16x8*)(lds + PG8_SB(b, h) + boff + n * 2048 + k * 1024); } while (0)
#define PG8_MMA(ai, bj, At, Bt) do { __builtin_amdgcn_s_setprio(1); _Pragma("unroll") for (int m = 0; m < 4; ++m) _Pragma("unroll") for (int n = 0; n < 2; ++n) _Pragma("unroll") for (int k = 0; k < 2; ++k) \
        acc[ai][bj][m][n] = __builtin_amdgcn_mfma_f32_16x16x32_bf16(Bt[n][k], At[m][k], acc[ai][bj][m][n], 0, 0, 0); __builtin_amdgcn_s_setprio(0); } while (0)
#define PG8_WAIT_V(n) asm volatile("s_waitcnt vmcnt(" #n ")" ::: "memory")
#define PG8_WAIT_L(n) asm volatile("s_waitcnt lgkmcnt(" #n ")" ::: "memory")
#define PG8_BAR __builtin_amdgcn_s_barrier()
#define PG8_SCHED __builtin_amdgcn_sched_barrier(0)
    Unit cur, nxt; int ui = 0;
    if (!S.next(0, cur)) return;
    f32x4 acc[2][2][4][2];
#pragma unroll
    for (int a = 0; a < 2; ++a)
#pragma unroll
        for (int b = 0; b < 2; ++b)
#pragma unroll
            for (int m = 0; m < 4; ++m)
#pragma unroll
                for (int n = 0; n < 2; ++n) acc[a][b][m][n] = (f32x4){0.f, 0.f, 0.f, 0.f};
    bf16x8 At[4][2], B0[2][2], B1[2][2];
    unsigned voffA[2], voffB[2];
#pragma unroll
    for (int i = 0; i < 2; ++i) { voffA[i] = rA[i] * (unsigned)cur.lda2 + cc2[i]; voffB[i] = rB[i] * (unsigned)cur.ldb2 + cc2[i]; }
    const char* cA = cur.A; const char* cB = cur.B;
    unsigned hA = (unsigned)HALF * cur.lda2, hB = (unsigned)HALF * cur.ldb2;
    PG8_STAGE(PG8_SB(0, 0), cB, voffB); PG8_STAGE(PG8_SB(0, 1), cB + hB, voffB); PG8_STAGE(PG8_SA(0, 0), cA, voffA); PG8_STAGE(PG8_SA(0, 1), cA + hA, voffA);
    if (wr == 1) PG8_BAR;
    PG8_WAIT_V(2); PG8_BAR;
    PG8_STAGE(PG8_SB(1, 0), cB + kstep, voffB); PG8_STAGE(PG8_SA(1, 0), cA + kstep, voffA); PG8_STAGE(PG8_SB(1, 1), cB + hB + kstep, voffB);
    PG8_WAIT_V(6); PG8_BAR;
    for (;;) {
        const bool has_next = S.next(ui + 1, nxt);
        if (!has_next) nxt = cur;
        unsigned voffAn[2], voffBn[2];
#pragma unroll
        for (int i = 0; i < 2; ++i) { if constexpr (Sched::VARLD) { voffAn[i] = rA[i] * (unsigned)nxt.lda2 + cc2[i]; voffBn[i] = rB[i] * (unsigned)nxt.ldb2 + cc2[i]; } else { voffAn[i] = voffA[i]; voffBn[i] = voffB[i]; } }
        const char* nA = nxt.A; const char* nB = nxt.B;
        const unsigned hAn = Sched::VARLD ? (unsigned)HALF * nxt.lda2 : hA, hBn = Sched::VARLD ? (unsigned)HALF * nxt.ldb2 : hB;
        const int nt = cur.nt;
        for (int t = 0; t < nt; t += 2) {
            const bool last = (t == nt - 2);
            const char* a1 = cA + (size_t)(t + 1) * kstep;
            const char* a2 = last ? nA : cA + (size_t)(t + 2) * kstep; const char* b2 = last ? nB : cB + (size_t)(t + 2) * kstep;
            const char* a3 = a2 + kstep; const char* b3 = b2 + kstep;
            const unsigned hA2 = last ? hAn : hA, hB2 = last ? hBn : hB;
            unsigned vA2[2], vB2[2];
#pragma unroll
            for (int i = 0; i < 2; ++i) { vA2[i] = last ? voffAn[i] : voffA[i]; vB2[i] = last ? voffBn[i] : voffB[i]; }
            PG8_LDB(B0, 0, 0); PG8_LDB(B1, 0, 1); PG8_SCHED; PG8_LDA(At, 0, 0); PG8_STAGE(PG8_SA(1, 1), a1 + hA, voffA);
            PG8_WAIT_V(8); PG8_WAIT_L(0); PG8_BAR; PG8_MMA(0, 0, At, B0); PG8_MMA(0, 1, At, B1); PG8_BAR; PG8_SCHED;
            PG8_LDA(At, 0, 1); PG8_STAGE(PG8_SB(0, 0), b2, vB2); PG8_STAGE(PG8_SB(0, 1), b2 + hB2, vB2); PG8_STAGE(PG8_SA(0, 0), a2, vA2);
            PG8_WAIT_V(8); PG8_WAIT_L(0); PG8_BAR; PG8_MMA(1, 0, At, B0); PG8_MMA(1, 1, At, B1); PG8_BAR; PG8_SCHED;
            PG8_LDB(B0, 1, 0); PG8_LDB(B1, 1, 1); PG8_SCHED; PG8_LDA(At, 1, 0); PG8_STAGE(PG8_SA(0, 1), a2 + hA2, vA2);
            PG8_WAIT_V(8); PG8_WAIT_L(0); PG8_BAR; PG8_MMA(0, 0, At, B0); PG8_MMA(0, 1, At, B1); PG8_BAR; PG8_SCHED;
            PG8_LDA(At, 1, 1); PG8_STAGE(PG8_SB(1, 0), b3, vB2); PG8_STAGE(PG8_SB(1, 1), b3 + hB2, vB2); PG8_STAGE(PG8_SA(1, 0), a3, vA2);
            PG8_WAIT_V(8); PG8_WAIT_L(0); PG8_BAR; PG8_MMA(1, 0, At, B0); PG8_MMA(1, 1, At, B1); PG8_BAR; PG8_SCHED;
        }
        if constexpr (ALIGN_EPI) { if (wr == 0) PG8_BAR; }
        E(acc, cur, wr, wc, fr, fq);
        if (!has_next) break;
#pragma unroll
        for (int a = 0; a < 2; ++a)
#pragma unroll
            for (int b = 0; b < 2; ++b)
#pragma unroll
                for (int m = 0; m < 4; ++m)
#pragma unroll
                    for (int n = 0; n < 2; ++n) acc[a][b][m][n] = (f32x4){0.f, 0.f, 0.f, 0.f};
        cur = nxt; cA = nA; cB = nB; hA = hAn; hB = hBn; ++ui;
#pragma unroll
        for (int i = 0; i < 2; ++i) { voffA[i] = voffAn[i]; voffB[i] = voffBn[i]; }
        if constexpr (ALIGN_EPI) { if (wr == 1) PG8_BAR; }
    }
    PG8_WAIT_V(0);
    if constexpr (!ALIGN_EPI) { if (wr == 0) PG8_BAR; }
    PG8_BAR;
#undef PG8_SA
#undef PG8_SB
#undef PG8_STAGE
#undef PG8_LDA
#undef PG8_LDB
#undef PG8_MMA
#undef PG8_WAIT_V
#undef PG8_WAIT_L
#undef PG8_BAR
#undef PG8_SCHED
}
}

#define EPI_ROWLOOP _Pragma("unroll") for (int ai = 0; ai < 2; ++ai) _Pragma("unroll") for (int m = 0; m < 4; ++m)
__device__ __forceinline__ float row_rs(const float* ssq, int row) { return __builtin_amdgcn_rsqf(ssq[row] * (1.0f / D) + EPS); }

struct EpiInProj {
    const float* ssq; unsigned char* ws;
    __device__ __forceinline__ void operator()(const f32x4 (&acc)[2][2][4][2], const pg8::Unit& u, int wr, int wc, int fr, int fq) const {
        bf16_t* const ZA = (bf16_t*)(ws + WS_ZA); bf16_t* const GLU = (bf16_t*)(ws + WS_GLU); bf16_t* const BG = (bf16_t*)(ws + WS_BG); bf16_t* const CH = (bf16_t*)(ws + WS_CH);
        const float* const ropeC = (const float*)(ws + WS_ROPEC); const float* const ropeS = (const float*)(ws + WS_ROPES);
        const int T = u.pn, row0 = u.pm * 256 + wr * 64 + fr, jcol = wc * 32 + 8 * fq;
        if (T < 4) {
            EPI_ROWLOOP { const int row = row0 + ai * 128 + m * 16; const float rs = row_rs(ssq, row);
#pragma unroll
                for (int bj = 0; bj < 2; ++bj) { f32x4 v0 = acc[ai][bj][m][0] * rs, v1 = acc[ai][bj][m][1] * rs;
                    f32x2 a = gelu_pk((f32x2){v0[0], v0[1]}), b = gelu_pk((f32x2){v0[2], v0[3]}), c = gelu_pk((f32x2){v1[0], v1[1]}), d = gelu_pk((f32x2){v1[2], v1[3]});
                    *(u32x4*)(ZA + (size_t)row * 1024 + 256 * T + 128 * bj + jcol) = pack8((f32x4){a.x, a.y, b.x, b.y}, (f32x4){c.x, c.y, d.x, d.y}); } }
        } else if (T < 8) {
            EPI_ROWLOOP { const int row = row0 + ai * 128 + m * 16; const float rs = row_rs(ssq, row); f32x4 o[2];
#pragma unroll
                for (int n = 0; n < 2; ++n) { const f32x4 a = acc[ai][0][m][n] * rs, g = acc[ai][1][m][n] * rs;
#pragma unroll
                    for (int j = 0; j < 4; ++j) o[n][j] = a[j] * sigmoidf_(g[j]); }
                *(u32x4*)(GLU + (size_t)row * 512 + 128 * (T - 4) + jcol) = pack8(o[0], o[1]); }
        } else if (T < 11) {
            const bool isq = T < 10; const bool rope = isq || wc < 2; const float sc = isq ? 0.125f : 1.0f;
            const size_t boff = isq ? WS_Q : (wc < 2 ? WS_K : WS_V); bf16_t* const base = (bf16_t*)(ws + boff);
            const int ld = isq ? 512 : 128, hcol = isq ? (4 * (T - 8) + wc) * 64 : (wc & 1) * 64;
            EPI_ROWLOOP { const int row = row0 + ai * 128 + m * 16; const float rs = row_rs(ssq, row) * sc; const int pos = row & (SEQ - 1); f32x4 o1[2], o2[2];
#pragma unroll
                for (int n = 0; n < 2; ++n) { const f32x4 x1 = acc[ai][0][m][n] * rs, x2 = acc[ai][1][m][n] * rs;
                    if (rope) { const f32x4 c = *(const f32x4*)(ropeC + pos * 32 + 8 * fq + 4 * n), s = *(const f32x4*)(ropeS + pos * 32 + 8 * fq + 4 * n);
                        o1[n] = x1 * c - x2 * s; o2[n] = x2 * c + x1 * s; } else { o1[n] = x1; o2[n] = x2; } }
                bf16_t* p = base + (size_t)row * ld + hcol + 8 * fq;
                *(u32x4*)p = pack8(o1[0], o1[1]); *(u32x4*)(p + 32) = pack8(o2[0], o2[1]); }
        } else if (T < 13) {
            EPI_ROWLOOP { const int row = row0 + ai * 128 + m * 16; const float rs = row_rs(ssq, row);
#pragma unroll
                for (int bj = 0; bj < 2; ++bj) *(u32x4*)(BG + (size_t)row * 512 + 256 * (T - 11) + 128 * bj + jcol) = pack8(acc[ai][bj][m][0] * rs, acc[ai][bj][m][1] * rs); }
        } else {
            EPI_ROWLOOP { const int row = row0 + ai * 128 + m * 16; const float rs = row_rs(ssq, row); const float rs2 = rs * rs;
                *(u32x4*)(CH + (size_t)row * 512 + 128 * (T - 13) + jcol) = pack8(acc[ai][0][m][0] * acc[ai][1][m][0] * rs2, acc[ai][0][m][1] * acc[ai][1][m][1] * rs2); }
        }
    }
};
struct EpiGate {
    const float* ssq; bf16_t* MG;
    __device__ __forceinline__ void operator()(const f32x4 (&acc)[2][2][4][2], const pg8::Unit& u, int wr, int wc, int fr, int fq) const {
        const int row0 = u.pm * 256 + wr * 64 + fr, col0 = u.pn * 256 + wc * 32 + 8 * fq;
        EPI_ROWLOOP { const int row = row0 + ai * 128 + m * 16; const float rs = row_rs(ssq, row);
#pragma unroll
            for (int bj = 0; bj < 2; ++bj) { f32x4 v0 = acc[ai][bj][m][0] * rs, v1 = acc[ai][bj][m][1] * rs;
#pragma unroll
                for (int j = 0; j < 4; ++j) { v0[j] = sigmoidf_(v0[j]); v1[j] = sigmoidf_(v1[j]); }
#ifdef ABL_GATE
                if ((u.z >> 1) == ABL_GATE) { v0 = v0 * 0.f + 0.5f; v1 = v1 * 0.f + 0.5f; }
#endif
                *(u32x4*)(MG + (size_t)row * 1024 + col0 + 128 * bj) = pack8(v0, v1); } }
    }
};
struct EpiBranch {
    bf16_t* MG; bf16_t* TMP;
    __device__ __forceinline__ void operator()(const f32x4 (&acc)[2][2][4][2], const pg8::Unit& u, int wr, int wc, int fr, int fq) const {
        const int row0 = u.pm * 256 + wr * 64 + fr, col0 = u.pn * 256 + wc * 32 + 8 * fq, br = u.z >> 1;
        EPI_ROWLOOP { const int row = row0 + ai * 128 + m * 16;
#pragma unroll
            for (int bj = 0; bj < 2; ++bj) { const size_t off = (size_t)row * 1024 + col0 + 128 * bj;
                f32x4 g0, g1; unpack8(*(const u32x4*)(MG + off), g0, g1);
                f32x4 v0 = acc[ai][bj][m][0] * g0, v1 = acc[ai][bj][m][1] * g1;
                if (br > 0) { f32x4 t0, t1; unpack8(*(const u32x4*)(TMP + off), t0, t1); v0 += t0; v1 += t1; }
                if (br < 3) *(u32x4*)(TMP + off) = pack8(v0, v1); else *(u32x4*)(MG + off) = pack8(v0, v1); } }
    }
};
struct EpiStashB {
    bf16_t* MG;
    __device__ __forceinline__ void operator()(const f32x4 (&acc)[2][2][4][2], const pg8::Unit& u, int wr, int wc, int fr, int fq) const {
        const int row0 = u.pm * 256 + wr * 64 + fr, col0 = u.pn * 256 + wc * 32 + 8 * fq;
        EPI_ROWLOOP { const int row = row0 + ai * 128 + m * 16;
#pragma unroll
            for (int bj = 0; bj < 2; ++bj) *(u32x4*)(MG + (size_t)row * 1024 + col0 + 128 * bj) = pack8(acc[ai][bj][m][0], acc[ai][bj][m][1]); }
    }
};
struct EpiGateAcc {
    const float* ssq; bf16_t* MG; bf16_t* TMP;
    __device__ __forceinline__ void operator()(const f32x4 (&acc)[2][2][4][2], const pg8::Unit& u, int wr, int wc, int fr, int fq) const {
        const int row0 = u.pm * 256 + wr * 64 + fr, col0 = u.pn * 256 + wc * 32 + 8 * fq, br = u.z >> 1;
        EPI_ROWLOOP { const int row = row0 + ai * 128 + m * 16; const float rs = row_rs(ssq, row);
#pragma unroll
            for (int bj = 0; bj < 2; ++bj) { const size_t off = (size_t)row * 1024 + col0 + 128 * bj;
                f32x4 b0, b1; unpack8(*(const u32x4*)(MG + off), b0, b1);
                f32x4 v0 = acc[ai][bj][m][0] * rs, v1 = acc[ai][bj][m][1] * rs;
#pragma unroll
                for (int j = 0; j < 4; ++j) { v0[j] = sigmoidf_(v0[j]) * b0[j]; v1[j] = sigmoidf_(v1[j]) * b1[j]; }
                if (br > 0) { f32x4 t0, t1; unpack8(*(const u32x4*)(TMP + off), t0, t1); v0 += t0; v1 += t1; }
                if (br < 3) *(u32x4*)(TMP + off) = pack8(v0, v1); else *(u32x4*)(MG + off) = pack8(v0, v1); } }
    }
};
struct EpiResid {
    const float* SRC; float* DST; bf16_t* XB; float* ssq_out;
    __device__ __forceinline__ void operator()(const f32x4 (&acc)[2][2][4][2], const pg8::Unit& u, int wr, int wc, int fr, int fq) const {
        const int row0 = u.pm * 256 + wr * 64 + fr, col0 = u.pn * 256 + wc * 32 + 8 * fq;
        EPI_ROWLOOP { const int row = row0 + ai * 128 + m * 16; float ss = 0.f;
#pragma unroll
            for (int bj = 0; bj < 2; ++bj) { const size_t off = (size_t)row * 1024 + col0 + 128 * bj;
                const f32x4 v0 = *(const f32x4*)(SRC + off) + acc[ai][bj][m][0], v1 = *(const f32x4*)(SRC + off + 4) + acc[ai][bj][m][1];
                *(f32x4*)(DST + off) = v0; *(f32x4*)(DST + off + 4) = v1; *(u32x4*)(XB + off) = pack8(v0, v1);
                ss += (v0[0] * v0[0] + v0[1] * v0[1]) + (v0[2] * v0[2] + v0[3] * v0[3]) + (v1[0] * v1[0] + v1[1] * v1[1]) + (v1[2] * v1[2] + v1[3] * v1[3]); }
            ss += __shfl_xor(ss, 16); ss += __shfl_xor(ss, 32);
            if (fq == 0) atomicAdd(ssq_out + row, ss); }
    }
};
struct EpiSwiGLU {
    const float* ssq; bf16_t* ACT; float zero_scale;
    __device__ __forceinline__ void operator()(const f32x4 (&acc)[2][2][4][2], const pg8::Unit& u, int wr, int wc, int fr, int fq) const {
        const int row0 = u.pm * 256 + wr * 64 + fr, col0 = u.pn * 128 + wc * 32 + 8 * fq;
        EPI_ROWLOOP { const int row = row0 + ai * 128 + m * 16; const float rs = row_rs(ssq, row); f32x4 o[2];
#pragma unroll
            for (int n = 0; n < 2; ++n) { const f32x4 g = acc[ai][0][m][n] * rs, up = acc[ai][1][m][n] * rs;
#pragma unroll
                for (int j = 0; j < 4; ++j) o[n][j] = g[j] * sigmoidf_(g[j]) * up[j] * zero_scale; }
            *(u32x4*)(ACT + (size_t)row * DFF + col0) = pack8(o[0], o[1]); }
    }
};

#ifndef ABL_FFN
#define ABL_FFN_SCALE(l) 1.0f
#else
#define ABL_FFN_SCALE(l) ((l) == ABL_FFN ? 0.0f : 1.0f)
#endif
struct Args { const float* in[19]; float* out; unsigned char* ws; };

__device__ __forceinline__ int win_src_col(int nlog) {
    const int T = nlog >> 8, o = nlog & 255, bj = o >> 7, j = o & 127;
    if (T < 4) return nlog;
    if (T < 8) return 1024 + bj * 512 + 128 * (T - 4) + j;
    if (T < 10) return 2048 + (4 * (T - 8) + (j >> 5)) * 64 + 32 * bj + (j & 31);
    if (T == 10) { const int h = j >> 5; return (h < 2 ? 2560 + h * 64 : 2688 + (h - 2) * 64) + 32 * bj + (j & 31); }
    if (T < 13) return 2816 + 256 * (T - 11) + o;
    if (T < 17) return 3328 + bj * 512 + 128 * (T - 13) + j;
    return nlog;
}
__device__ __forceinline__ void tr_item(const float* W, int Nsrc, int k0, int scolA, int scolB, const float* gain, bf16_t* WT, int K, int drow, LAS float* scr, int lane) {
    const int c4 = lane & 15; const int sc = ((c4 >> 3) ? scolB : scolA) + 4 * (c4 & 7);
#pragma unroll 4
    for (int i = 0; i < 16; ++i) { const int row = 4 * i + (lane >> 4); f32x4 v = *(const f32x4*)(W + (size_t)(k0 + row) * Nsrc + sc);
        if (gain) v = v * gain[k0 + row];
        LAS float* d = scr + row * 65 + 4 * c4; d[0] = v[0]; d[1] = v[1]; d[2] = v[2]; d[3] = v[3]; }
    asm volatile("s_waitcnt lgkmcnt(0)" ::: "memory");
    const int c = lane & 7;
#pragma unroll
    for (int jj = 0; jj < 8; ++jj) { const int n = (lane >> 3) + 8 * jj; const LAS float* s = scr + (8 * c) * 65 + n;
        u32x4 o; o.x = cvt_pk_bf16(s[0], s[65]); o.y = cvt_pk_bf16(s[2 * 65], s[3 * 65]); o.z = cvt_pk_bf16(s[4 * 65], s[5 * 65]); o.w = cvt_pk_bf16(s[6 * 65], s[7 * 65]);
        *(u32x4*)(WT + (size_t)(drow + n) * K + k0 + 8 * c) = o; }
    asm volatile("s_waitcnt lgkmcnt(0)" ::: "memory");
}
__device__ __forceinline__ void prologue(const Args& a, LAS unsigned char* lds, int G) {
    int tid_ = threadIdx.x; asm volatile("" : "+v"(tid_));
    const int tid = tid_, lane = tid & 63, wave = __builtin_amdgcn_readfirstlane(tid >> 6);
    const int gw = blockIdx.x * NWAVES + wave, NGW = G * NWAVES;
    unsigned char* ws = a.ws;
    LAS float* scr = (LAS float*)(lds + wave * 16640);
    constexpr int I_IN = 16 * 132, I_BR = 512, I_OUT = 256, I_GU = 16 * 88, I_DN = 44 * 16, I_L = I_IN + I_BR + I_OUT + I_GU + I_DN;
    for (int it = gw; it < 2 * I_L; it += NGW) {
        const int l = it / I_L; int r = it % I_L;
        if (r < I_IN) { const int kb = r / 132, nb = r % 132, n0 = 64 * nb;
            tr_item(a.in[2] + (size_t)l * D * PROJ, PROJ, 64 * kb, win_src_col(n0), win_src_col(n0 + 32), a.in[1] + l * D, (bf16_t*)(ws + WS_WIN + l * WIN_L), D, n0, scr, lane); continue; } r -= I_IN;
        if (r < I_BR) { const int br = r >> 7, q = r & 127, kb = q >> 4, nb = q & 15;
            tr_item(a.in[13] + (size_t)(l * 4 + br) * 512 * D, D, 64 * kb, 64 * nb, 64 * nb + 32, nullptr, (bf16_t*)(ws + WS_WBR + l * WBR_L) + (size_t)br * 1024 * 512, 512, 64 * nb, scr, lane); continue; } r -= I_BR;
        if (r < I_OUT) { const int kb = r >> 4, nb = r & 15;
            tr_item(a.in[14] + (size_t)l * D * D, D, 64 * kb, 64 * nb, 64 * nb + 32, nullptr, (bf16_t*)(ws + WS_WOUT + l * WOUT_L), D, 64 * nb, scr, lane); continue; } r -= I_OUT;
        if (r < I_GU) { const int kb = r / 88, nb = r % 88, n0 = 64 * nb, T = n0 >> 8, o = n0 & 255, sc = (o >> 7) * DFF + 128 * T + (o & 127);
            tr_item(a.in[16] + (size_t)l * D * 2 * DFF, 2 * DFF, 64 * kb, sc, sc + 32, a.in[15] + l * D, (bf16_t*)(ws + WS_WGU + l * WGU_L), D, n0, scr, lane); continue; } r -= I_GU;
        { const int kb = r >> 4, nb = r & 15;
            tr_item(a.in[17] + (size_t)l * DFF * D, D, 64 * kb, 64 * nb, 64 * nb + 32, nullptr, (bf16_t*)(ws + WS_WDN + l * WDN_L), DFF, 64 * nb, scr, lane); }
    }
    float* ssq = (float*)(ws + WS_SSQ);
    for (int row = gw; row < M; row += NGW) {
        const f32x4* xr = (const f32x4*)(a.in[0] + (size_t)row * D) + lane; float s = 0.f; f32x4 v[4];
#pragma unroll
        for (int j = 0; j < 4; ++j) { v[j] = xr[64 * j]; s += (v[j][0] * v[j][0] + v[j][1] * v[j][1]) + (v[j][2] * v[j][2] + v[j][3] * v[j][3]); }
        s = wave_sum(s);
        u32x2* o = (u32x2*)((bf16_t*)(ws + WS_XB) + (size_t)row * D) + lane;
#pragma unroll
        for (int j = 0; j < 4; ++j) o[64 * j] = (u32x2){cvt_pk_bf16(v[j][0], v[j][1]), cvt_pk_bf16(v[j][2], v[j][3])};
        if (lane == 0) ssq[row] = s;
    }
    for (int i = blockIdx.x * NTHREADS + tid; i < 4 * M; i += G * NTHREADS) ssq[M + i] = 0.f;
    { float* par = (float*)(ws + WS_PAR); const int gt = blockIdx.x * NTHREADS + tid, GT = G * NTHREADS;
#define CPY(dstoff, srcp, n) for (int i = gt; i < (n); i += GT) par[(dstoff) + i] = (srcp)[i]
      for (int l = 0; l < 2; ++l) { const int o = l * PAR_L;
          CPY(o + P_SGLNG, a.in[3] + l * 512, 512); CPY(o + P_SGLNB, a.in[4] + l * 512, 512); CPY(o + P_SGB, a.in[6] + l * 512, 512);
          CPY(o + P_CVB, a.in[8] + l * 512, 512); CPY(o + P_CVLNG, a.in[9] + l * 512, 512); CPY(o + P_CVLNB, a.in[10] + l * 512, 512);
          CPY(o + P_SCW, a.in[12] + l * 1536, 1536); CPY(o + P_SINK, a.in[11] + l * 8, 8); CPY(o + P_CVW, a.in[7] + l * 31 * 512, 31 * 512); }
      CPY(P_FINAL, a.in[18], 1024);
#undef CPY
    }
    for (int i = blockIdx.x * NTHREADS + tid; i < SEQ * 32; i += G * NTHREADS) { const int pos = i >> 5, f = i & 31;
        const double rev = (double)pos * INVF_REV[f]; const float fr = (float)(rev - floor(rev));
        ((float*)(ws + WS_ROPEC))[i] = __builtin_amdgcn_cosf(fr); ((float*)(ws + WS_ROPES))[i] = __builtin_amdgcn_sinf(fr); }
    for (int i = blockIdx.x * NTHREADS + tid; i < 2 * 4 * 128 * 128; i += G * NTHREADS) { const int t = i & 127, s = (i >> 7) & 127, lg = i >> 14;
        ((float*)(ws + WS_SGWT))[i] = s <= t ? a.in[5][(size_t)lg * 16384 + t * 128 + s] : 0.f; }
}

__device__ __forceinline__ void mixer_sg(unsigned char* ws, int l, LAS unsigned char* lds, int unit) {
    asm volatile("" : "+s"(ws)); int tid_ = threadIdx.x; asm volatile("" : "+v"(tid_));
    const float* par = (const float*)(ws + WS_PAR) + l * PAR_L;
    const int tid = tid_, lane = tid & 63, wave = tid >> 6;
    const int ck = unit >> 2, g = unit & 3, r0 = ck * 128;
    const bf16_t* ZA = (const bf16_t*)(ws + WS_ZA); bf16_t* YA = (bf16_t*)(ws + WS_YA);
    LAS float* vn = (LAS float*)lds;
    LAS float* wT = (LAS float*)(lds + 65536);
    const float* lng = par + P_SGLNG; const float* lnb = par + P_SGLNB;
    f32x4 g0 = *(const f32x4*)(lng + 8 * lane), g1 = *(const f32x4*)(lng + 8 * lane + 4), b0 = *(const f32x4*)(lnb + 8 * lane), b1 = *(const f32x4*)(lnb + 8 * lane + 4);
    for (int s = wave; s < 128; s += NWAVES) {
        f32x4 x0, x1; unpack8(*(const u32x4*)(ZA + (size_t)(r0 + s) * 1024 + 512 + 8 * lane), x0, x1);
        const float mean = wave_sum((x0[0] + x0[1]) + (x0[2] + x0[3]) + (x1[0] + x1[1]) + (x1[2] + x1[3])) * (1.0f / 512.0f);
        x0 -= mean; x1 -= mean;
        const float var = wave_sum((x0[0] * x0[0] + x0[1] * x0[1]) + (x0[2] * x0[2] + x0[3] * x0[3]) + (x1[0] * x1[0] + x1[1] * x1[1]) + (x1[2] * x1[2] + x1[3] * x1[3])) * (1.0f / 512.0f);
        const float rstd = __builtin_amdgcn_rsqf(var + EPS);
        if ((lane >> 4) == g) { const int c = 8 * (lane & 15); *(LAS f32x4*)(vn + s * 128 + c) = x0 * rstd * g0 + b0; *(LAS f32x4*)(vn + s * 128 + c + 4) = x1 * rstd * g1 + b1; }
    }
    const f32x4* wsrc = (const f32x4*)((const float*)(ws + WS_SGWT) + (size_t)(l * 4 + g) * 16384);
    for (int i = tid; i < 4096; i += NTHREADS) *(LAS f32x4*)(wT + 4 * i) = wsrc[i];
    __syncthreads();
    const int c = tid & 127, q = tid >> 7;
    const float* bs = par + P_SGB + g * 128;
    for (int tbi = 0; tbi < 8; ++tbi) {
        const int t0 = 4 * (q + 4 * tbi); f32x4 acc = {0.f, 0.f, 0.f, 0.f};
        for (int s = 0; s < t0 + 4; ++s) { const float x = vn[s * 128 + c]; const f32x4 w = *(const LAS f32x4*)(wT + s * 128 + t0); acc += w * x; }
#pragma unroll
        for (int j = 0; j < 4; ++j) { const int t = t0 + j; const size_t row = r0 + t;
            const float u = bf1(ZA[row * 1024 + 128 * g + c]);
            const float o = u * (acc[j] + bs[t]);
            YA[row * 512 + 128 * g + c] = (bf16_t)(cvt_pk_bf16(o, 0.f) & 0xffffu); }
    }
    __syncthreads();
}
__device__ __forceinline__ void mixer_conv(unsigned char* ws, int l, LAS unsigned char* lds, int unit) {
    asm volatile("" : "+s"(ws)); int tid_ = threadIdx.x; asm volatile("" : "+v"(tid_));
    const float* par = (const float*)(ws + WS_PAR) + l * PAR_L;
    const int tid = tid_, lane = tid & 63, wave = tid >> 6;
    const int b = unit >> 6, tb = unit & 63, t0 = tb * 32; const size_t rbase = (size_t)b * SEQ;
    const bf16_t* GLU = (const bf16_t*)(ws + WS_GLU); bf16_t* YB = (bf16_t*)(ws + WS_YB);
    LAS bf16_t* in = (LAS bf16_t*)lds;
    LAS float* cv = (LAS float*)(lds + 65536);
    for (int i = tid; i < 62 * 64; i += NTHREADS) { const int r = i >> 6, ch = i & 63; const int t = t0 - 30 + r;
        u32x4 v = {0u, 0u, 0u, 0u}; if (t >= 0) v = *(const u32x4*)(GLU + (rbase + t) * 512 + 8 * ch);
        *(LAS u32x4*)(in + r * 512 + 8 * ch) = v; }
    __syncthreads();
    { const int c = tid; float w[31];
#pragma unroll
      for (int k = 0; k < 31; ++k) w[k] = par[P_CVW + k * 512 + c];
      const float bias = par[P_CVB + c];
      for (int t = 0; t < 32; ++t) { float s = bias;
#pragma unroll
          for (int k = 0; k < 31; ++k) s += w[k] * bf1(in[(t + k) * 512 + c]);
          cv[t * 512 + c] = s; } }
    __syncthreads();
    { const float* lng = par + P_CVLNG; const float* lnb = par + P_CVLNB;
      const f32x4 g0 = *(const f32x4*)(lng + 8 * lane), g1 = *(const f32x4*)(lng + 8 * lane + 4), b0 = *(const f32x4*)(lnb + 8 * lane), b1 = *(const f32x4*)(lnb + 8 * lane + 4);
      for (int t = wave; t < 32; t += NWAVES) {
          f32x4 x0 = *(const LAS f32x4*)(cv + t * 512 + 8 * lane), x1 = *(const LAS f32x4*)(cv + t * 512 + 8 * lane + 4);
          const float mean = wave_sum((x0[0] + x0[1]) + (x0[2] + x0[3]) + (x1[0] + x1[1]) + (x1[2] + x1[3])) * (1.0f / 512.0f);
          x0 -= mean; x1 -= mean;
          const float var = wave_sum((x0[0] * x0[0] + x0[1] * x0[1]) + (x0[2] * x0[2] + x0[3] * x0[3]) + (x1[0] * x1[0] + x1[1] * x1[1]) + (x1[2] * x1[2] + x1[3] * x1[3])) * (1.0f / 512.0f);
          const float rstd = __builtin_amdgcn_rsqf(var + EPS);
          x0 = x0 * rstd * g0 + b0; x1 = x1 * rstd * g1 + b1;
#pragma unroll
          for (int j = 0; j < 4; ++j) { x0[j] = x0[j] * sigmoidf_(x0[j]); x1[j] = x1[j] * sigmoidf_(x1[j]); }
          *(u32x4*)(YB + (rbase + t0 + t) * 512 + 8 * lane) = pack8(x0, x1); } }
    __syncthreads();
}
__device__ __forceinline__ void mixer_attn(unsigned char* ws, int l, LAS unsigned char* lds, int unit) {
    asm volatile("" : "+s"(ws)); int tid_ = threadIdx.x; asm volatile("" : "+v"(tid_));
    const float* par = (const float*)(ws + WS_PAR) + l * PAR_L;
    const int tid = tid_;
    const int kvh = unit & 1, blk = (unit >> 1) & 15, b = unit >> 5; const size_t rbase = (size_t)b * SEQ;
    bf16_t* Q = (bf16_t*)(ws + WS_Q); const bf16_t* K = (const bf16_t*)(ws + WS_K); const bf16_t* V = (const bf16_t*)(ws + WS_V);
    LAS unsigned* Kl = (LAS unsigned*)lds;
    LAS unsigned* Vl = (LAS unsigned*)(lds + 256 * 132);
    for (int i = tid; i < 256 * 8; i += NTHREADS) { const int r = i >> 3, ch = i & 7; const int t = (blk - 1) * 128 + r;
        u32x4 kv = {0u, 0u, 0u, 0u}, vv = {0u, 0u, 0u, 0u};
        if (t >= 0) { kv = *(const u32x4*)(K + (rbase + t) * 128 + kvh * 64 + 8 * ch); vv = *(const u32x4*)(V + (rbase + t) * 128 + kvh * 64 + 8 * ch); }
        LAS unsigned* kd = Kl + r * 33 + 4 * ch; kd[0] = kv.x; kd[1] = kv.y; kd[2] = kv.z; kd[3] = kv.w;
        LAS unsigned* vd = Vl + r * 33 + 4 * ch; vd[0] = vv.x; vd[1] = vv.y; vd[2] = vv.z; vd[3] = vv.w; }
    const int g = tid >> 7, qi = tid & 127, head = kvh * 4 + g;
    bf16_t* qp = Q + (rbase + blk * 128 + qi) * 512 + head * 64;
    float q[64];
#pragma unroll
    for (int c = 0; c < 8; ++c) { f32x4 x0, x1; unpack8(*(const u32x4*)(qp + 8 * c), x0, x1);
#pragma unroll
        for (int j = 0; j < 4; ++j) { q[8 * c + j] = x0[j]; q[8 * c + 4 + j] = x1[j]; } }
    __syncthreads();
    const float sink = par[P_SINK + head];
    float mx = sink, lsum = 0.f; float o[64];
#pragma unroll
    for (int d = 0; d < 64; ++d) o[d] = 0.f;
    const bool first = (blk == 0);
    for (int j = 0; j < 128; ++j) {
        const int kb = qi + 1 + j;
        const LAS unsigned* kr = Kl + kb * 33; float s = 0.f;
#pragma unroll
        for (int d2 = 0; d2 < 32; ++d2) { const unsigned w = kr[d2]; s += q[2 * d2] * bf_lo(w) + q[2 * d2 + 1] * bf_hi(w); }
        if (first && kb < 128) s = -INFINITY;
        const float mn = fmaxf(mx, s), sc = __expf(mx - mn), p = __expf(s - mn);
        lsum = lsum * sc + p; mx = mn;
        const LAS unsigned* vr = Vl + kb * 33;
#pragma unroll
        for (int d2 = 0; d2 < 32; ++d2) { const unsigned w = vr[d2]; o[2 * d2] = o[2 * d2] * sc + p * bf_lo(w); o[2 * d2 + 1] = o[2 * d2 + 1] * sc + p * bf_hi(w); }
    }
    const float inv = 1.0f / (lsum + __expf(sink - mx));
#pragma unroll
    for (int c = 0; c < 8; ++c) { u32x4 w; w.x = cvt_pk_bf16(o[8 * c] * inv, o[8 * c + 1] * inv); w.y = cvt_pk_bf16(o[8 * c + 2] * inv, o[8 * c + 3] * inv);
        w.z = cvt_pk_bf16(o[8 * c + 4] * inv, o[8 * c + 5] * inv); w.w = cvt_pk_bf16(o[8 * c + 6] * inv, o[8 * c + 7] * inv); *(u32x4*)(qp + 8 * c) = w; }
    __syncthreads();
}
__device__ __forceinline__ void mixer_sc(unsigned char* ws, int l, int G) {
    asm volatile("" : "+s"(ws)); int tid_ = threadIdx.x; asm volatile("" : "+v"(tid_));
    bf16_t* BG = (bf16_t*)(ws + WS_BG); const bf16_t* CH = (const bf16_t*)(ws + WS_CH);
    const float* w = (const float*)(ws + WS_PAR) + l * PAR_L + P_SCW;
    for (int i = blockIdx.x * NTHREADS + tid_; i < M * 64; i += G * NTHREADS) {
        const int row = i >> 6, c = 8 * (i & 63), t = row & (SEQ - 1);
        f32x4 a0 = {0.f, 0.f, 0.f, 0.f}, a1 = a0;
#pragma unroll
        for (int k = 0; k < 3; ++k) { if (t - 2 + k >= 0) { f32x4 x0, x1; unpack8(*(const u32x4*)(CH + (size_t)(row - 2 + k) * 512 + c), x0, x1);
            a0 += x0 * *(const f32x4*)(w + k * 512 + c); a1 += x1 * *(const f32x4*)(w + k * 512 + c + 4); } }
        f32x4 g0, g1; unpack8(*(const u32x4*)(BG + (size_t)row * 512 + c), g0, g1);
        *(u32x4*)(BG + (size_t)row * 512 + c) = pack8(g0 * a0, g1 * a1);
    }
}

#define RLX_AGENT __ATOMIC_RELAXED, __HIP_MEMORY_SCOPE_AGENT
#define XB_TMO      128
#define XB_XCNT(j)  (256  + 64 * (j))
#define XB_XSUB(j)  (1280 + 64 * (j))
#define XB_XGEN(j)  (2304 + 64 * (j))
#define XB_TOP      3328
#define XB_TOPGEN   3392
#define XCD_BAR_WORDS 3456
#define XB_SPIN_CAP (1u << 18)

__device__ __forceinline__ unsigned xb_ld(unsigned* p)              { return __hip_atomic_load(p, __ATOMIC_RELAXED, __HIP_MEMORY_SCOPE_AGENT); }
__device__ __forceinline__ unsigned xb_add(unsigned* p, unsigned v) { return __hip_atomic_fetch_add(p, v, __ATOMIC_RELAXED, __HIP_MEMORY_SCOPE_AGENT); }
__device__ __forceinline__ unsigned xb_xcc_id() { return (unsigned)__builtin_amdgcn_s_getreg((3 << 11) | 20) & 0xFu; }
#define XB_SPIN(cond, bar) do { unsigned _sp = 0; while (cond) { __builtin_amdgcn_s_sleep(1); \
    if ((++_sp & 255u) == 0u) { if (xb_ld(&(bar)[XB_TMO])) break; if (_sp > XB_SPIN_CAP) { atomicAdd(&(bar)[XB_TMO], 1u); break; } } } } while (0)

struct XcdBarrier {
    unsigned* bar; unsigned x;
    volatile LAS unsigned* st;
};

__device__ __forceinline__ XcdBarrier xcd_barrier_post(unsigned* bar, volatile LAS unsigned* st) {
    XcdBarrier b; b.bar = bar; b.x = xb_xcc_id(); b.st = st;
    if (threadIdx.x == 0) (void)xb_add(&bar[XB_XCNT(b.x)], 1u);
    return b;
}
__device__ __forceinline__ void xcd_barrier_complete(unsigned* bar, unsigned x, unsigned& nloc, unsigned& nx) {
    const unsigned G = gridDim.x * gridDim.y * gridDim.z;
    unsigned sum, cnt, mine, sp = 0u;
    for (;;) {
        sum = 0u; cnt = 0u; mine = 0u;
#pragma unroll
        for (unsigned j = 0; j < 16; ++j) { const unsigned c = xb_ld(&bar[XB_XCNT(j)]); sum += c; cnt += (c > 0u) ? 1u : 0u; mine = (j == x) ? c : mine; }
        if (sum == G) break;
        __builtin_amdgcn_s_sleep(1);
        if ((++sp & 255u) == 0u) { if (xb_ld(&bar[XB_TMO])) break; if (sp > XB_SPIN_CAP) { atomicAdd(&bar[XB_TMO], 1u); break; } }
    }
    nloc = mine > 0u ? mine : 1u; nx = cnt > 0u ? cnt : 1u;
}

__device__ __forceinline__ void xcd_barrier(const XcdBarrier& b) {
    asm volatile("s_waitcnt vmcnt(0)" ::: "memory");
    __syncthreads();
    if (threadIdx.x == 0) {
        unsigned* bar = b.bar;
        __builtin_amdgcn_s_waitcnt(0);
        unsigned nloc = b.st[0], nx = b.st[1];
        if (nloc == 0u) { xcd_barrier_complete(bar, b.x, nloc, nx); b.st[0] = nloc; b.st[1] = nx; }
        const unsigned old = xb_add(&bar[XB_XSUB(b.x)], 1u);
        const unsigned gen = old / nloc;
        if (old + 1u == (gen + 1u) * nloc) {
            __builtin_amdgcn_fence(__ATOMIC_RELEASE, "agent");
            asm volatile("s_waitcnt vmcnt(0)" ::: "memory");
            const unsigned og = xb_add(&bar[XB_TOP], 1u);
            const unsigned tg = og / nx;
            if (og + 1u == (tg + 1u) * nx) xb_add(&bar[XB_TOPGEN], 1u);
            else XB_SPIN(xb_ld(&bar[XB_TOPGEN]) == tg, bar);
            __builtin_amdgcn_fence(__ATOMIC_ACQUIRE, "agent");
            xb_add(&bar[XB_XGEN(b.x)], 1u);
            asm volatile("s_waitcnt vmcnt(0)" ::: "memory");
        } else {
            XB_SPIN(xb_ld(&bar[XB_XGEN(b.x)]) == gen, bar);
            __builtin_amdgcn_fence(__ATOMIC_ACQUIRE, "agent");
            asm volatile("s_waitcnt vmcnt(0)" ::: "memory");
        }
    }
    __syncthreads();
}


#ifdef DBG_STAGE
__device__ __forceinline__ void dbg_dump(float* out, const bf16_t* src, int ld, int ncols, int c0, int G) {
    for (long i = (long)blockIdx.x * NTHREADS + threadIdx.x; i < (long)M * ncols; i += (long)G * NTHREADS) { const int row = (int)(i / ncols), c = (int)(i % ncols); out[(size_t)row * D + c0 + c] = bf1(src[(size_t)row * ld + c]); }
}
#endif
#define GRID_SYNC() do { XcdBarrier xb_; xb_.bar = (unsigned*)(ws + WS_BAR); xb_.x = xb_xcc_id(); xb_.st = (volatile LAS unsigned*)(lds + MISC_OFF); xcd_barrier(xb_); } while (0)
__global__ void __launch_bounds__(NTHREADS, 2) fwd_megakernel(Args a) {
    extern __shared__ __attribute__((aligned(16))) unsigned char lds_raw[];
    LAS unsigned char* lds = (LAS unsigned char*)lds_raw;
    cg::grid_group grid = cg::this_grid();
    const int G = gridDim.x, c = blockIdx.x;
    unsigned char* ws = a.ws;
    float* ssq = (float*)(ws + WS_SSQ);

    { volatile LAS unsigned* misc = (volatile LAS unsigned*)(lds + MISC_OFF); if (threadIdx.x < 16) misc[threadIdx.x] = 0u; }
    __syncthreads();
    grid.sync();
    (void)xcd_barrier_post((unsigned*)(ws + WS_BAR), (volatile LAS unsigned*)(lds + MISC_OFF));
    prologue(a, lds, G);
    GRID_SYNC();

    for (int l = 0; l < 2; ++l) {
        asm volatile("" : "+s"(ws)); ssq = (float*)(ws + WS_SSQ);
        const float* ssq_mix = ssq + (size_t)(2 * l) * M;
        { pg8::SchedGrid S; S.nM = 64; S.nN = 17; S.nwg = 64 * 17; S.G = G; S.c = c; S.A = (const char*)(ws + WS_XB); S.B = (const char*)(ws + WS_WIN + l * WIN_L); S.lda2 = 2048; S.ldb2 = 2048; S.nt = 16;
          EpiInProj E{ssq_mix, ws};
#ifdef MULTI_UNIT
          pg8::gemm_phase<EpiInProj, pg8::SchedGrid, true>(lds, S, E);
#else
          for (int i = 0; i < 5; ++i) { pg8::SchedOneG S1; S1.S = S; S1.i0 = i; pg8::gemm_phase<EpiInProj, pg8::SchedOneG, false>(lds, S1, E); }
#endif
        }
        GRID_SYNC(); asm volatile("" : "+s"(ws));
#if defined(DBG_STAGE) && DBG_STAGE == 1
        if (l == 0) { dbg_dump(a.out, (const bf16_t*)(ws + WS_ZA), 1024, 1024, 0, G); return; }
#endif
        for (int u = c; u < 512; u += G) mixer_sg(ws, l, lds, u);
        for (int u = c; u < 512; u += G) mixer_conv(ws, l, lds, u);
        for (int u = c; u < 256; u += G) mixer_attn(ws, l, lds, u);
        mixer_sc(ws, l, G);
        GRID_SYNC(); asm volatile("" : "+s"(ws)); ssq = (float*)(ws + WS_SSQ);
        #if defined(DBG_STAGE) && DBG_STAGE == 2
        if (l == 0) { dbg_dump(a.out, (const bf16_t*)(ws + WS_YA), 512, 512, 0, G); dbg_dump(a.out, (const bf16_t*)(ws + WS_YB), 512, 512, 512, G); return; }
#endif
#if defined(DBG_STAGE) && DBG_STAGE == 22
        if (l == 0) { dbg_dump(a.out, (const bf16_t*)(ws + WS_Q), 512, 512, 0, G); dbg_dump(a.out, (const bf16_t*)(ws + WS_BG), 512, 512, 512, G); return; }
#endif
        { pg8::SchedMerge S; S.G = G; S.c = c; S.ws = (const char*)ws; S.WG = (const char*)(ws + WS_WIN + l * WIN_L) + (size_t)NLOG1 * 2048;
          S.WBR = (const char*)(ws + WS_WBR + l * WBR_L);
          EpiStashB ES{(bf16_t*)(ws + WS_MG)}; EpiGateAcc EA{ssq_mix, (bf16_t*)(ws + WS_MG), (bf16_t*)(ws + WS_TMP)};
          for (int br = 0; br < 4; ++br) {
              { pg8::SchedOne S1; S1.M = S; S1.i0 = 2 * br + 1; pg8::gemm_phase<EpiStashB, pg8::SchedOne, false>(lds, S1, ES); }
              { pg8::SchedOne S1; S1.M = S; S1.i0 = 2 * br; pg8::gemm_phase<EpiGateAcc, pg8::SchedOne, false>(lds, S1, EA); }
          }
        }
        GRID_SYNC(); asm volatile("" : "+s"(ws)); ssq = (float*)(ws + WS_SSQ);
        #if defined(DBG_STAGE) && DBG_STAGE == 3
        if (l == 0) { dbg_dump(a.out, (const bf16_t*)(ws + WS_MG), 1024, 1024, 0, G); return; }
#endif
        { pg8::SchedGrid S; S.nM = 64; S.nN = 4; S.nwg = 256; S.G = G; S.c = c; S.A = (const char*)(ws + WS_MG); S.B = (const char*)(ws + WS_WOUT + l * WOUT_L); S.lda2 = 2048; S.ldb2 = 2048; S.nt = 16;
          EpiResid E{l == 0 ? a.in[0] : a.out, a.out, (bf16_t*)(ws + WS_XB), ssq + (size_t)(2 * l + 1) * M};
          pg8::gemm_phase<EpiResid, pg8::SchedGrid, false>(lds, S, E); }
        GRID_SYNC(); asm volatile("" : "+s"(ws)); ssq = (float*)(ws + WS_SSQ);
        #if defined(DBG_STAGE) && DBG_STAGE == 4
        if (l == 0) return;
#endif
        { pg8::SchedGrid S; S.nM = 64; S.nN = 22; S.nwg = 64 * 22; S.G = G; S.c = c; S.A = (const char*)(ws + WS_XB); S.B = (const char*)(ws + WS_WGU + l * WGU_L); S.lda2 = 2048; S.ldb2 = 2048; S.nt = 16;
          EpiSwiGLU E{ssq + (size_t)(2 * l + 1) * M, (bf16_t*)(ws + WS_ACT), ABL_FFN_SCALE(l)};
#ifdef MULTI_UNIT
          pg8::gemm_phase<EpiSwiGLU, pg8::SchedGrid, true>(lds, S, E);
#else
          for (int i = 0; i < 6; ++i) { pg8::SchedOneG S1; S1.S = S; S1.i0 = i; pg8::gemm_phase<EpiSwiGLU, pg8::SchedOneG, false>(lds, S1, E); }
#endif
        }
        GRID_SYNC(); asm volatile("" : "+s"(ws)); ssq = (float*)(ws + WS_SSQ);
        #if defined(DBG_STAGE) && DBG_STAGE == 5
        if (l == 0) { dbg_dump(a.out, (const bf16_t*)(ws + WS_ACT), DFF, 1024, 0, G); return; }
#endif
        { pg8::SchedGrid S; S.nM = 64; S.nN = 4; S.nwg = 256; S.G = G; S.c = c; S.A = (const char*)(ws + WS_ACT); S.B = (const char*)(ws + WS_WDN + l * WDN_L); S.lda2 = DFF * 2; S.ldb2 = DFF * 2; S.nt = DFF / 64;
          EpiResid E{a.out, a.out, (bf16_t*)(ws + WS_XB), ssq + (size_t)(2 * l + 2) * M};
          pg8::gemm_phase<EpiResid, pg8::SchedGrid, false>(lds, S, E); }
        GRID_SYNC();
#if defined(DBG_STAGE) && DBG_STAGE == 6
        if (l == 0) return;
#endif
    }
    { asm volatile("" : "+s"(ws)); int tid_ = threadIdx.x; asm volatile("" : "+v"(tid_));
      const int lane = tid_ & 63, gw = c * NWAVES + (tid_ >> 6), NGW = G * NWAVES; const float* gf = (const float*)(ws + WS_PAR) + P_FINAL; const float* sq = (const float*)(ws + WS_SSQ) + (size_t)4 * M;
      for (int row = gw; row < M; row += NGW) { const float rs = row_rs(sq, row); f32x4* xr = (f32x4*)(a.out + (size_t)row * D) + lane;
#pragma unroll
          for (int j = 0; j < 4; ++j) xr[64 * j] = xr[64 * j] * rs * ((const f32x4*)gf)[64 * j + lane]; } }
}

extern "C" void kernel_launch(void* const* d_in, const int* in_sizes, int n_in, void* d_out, int out_size, void* d_ws, size_t ws_size, hipStream_t stream) {
    static int grid = 0;
    if (grid == 0) {
        if (n_in != 19 || out_size != M * D || ws_size < WS_END) { fprintf(stderr, "kernel_launch: unexpected shapes (n_in %d out %d ws %zu)\n", n_in, out_size, ws_size); grid = -1; return; }
        int dev = 0, cus = 0, per_cu = 0;
        if (hipGetDevice(&dev) != hipSuccess || hipDeviceGetAttribute(&cus, hipDeviceAttributeMultiprocessorCount, dev) != hipSuccess) { grid = -1; return; }
        if (hipFuncSetAttribute((const void*)fwd_megakernel, hipFuncAttributeMaxDynamicSharedMemorySize, LDS_BYTES) != hipSuccess) { fprintf(stderr, "kernel_launch: hipFuncSetAttribute failed\n"); grid = -1; return; }
        if (hipOccupancyMaxActiveBlocksPerMultiprocessor(&per_cu, (const void*)fwd_megakernel, NTHREADS, LDS_BYTES) != hipSuccess || per_cu < 1) { fprintf(stderr, "kernel_launch: occupancy query says %d\n", per_cu); per_cu = 1; }
        (void)hipGetLastError();
        grid = cus * 1;
    }
    if (grid < 0) return;
    if (hipMemsetAsync((char*)d_ws + WS_BAR, 0, 16384, stream) != hipSuccess) { fprintf(stderr, "kernel_launch: memset failed\n"); return; }
    Args a{};
    for (int i = 0; i < 19; ++i) a.in[i] = (const float*)d_in[i];
    a.out = (float*)d_out; a.ws = (unsigned char*)d_ws;
    void* args[] = {&a};
    hipError_t e = hipLaunchCooperativeKernel((const void*)fwd_megakernel, dim3(grid), dim3(NTHREADS), args, LDS_BYTES, stream);
    if (e != hipSuccess) fprintf(stderr, "cooperative launch failed: %s (grid %d)\n", hipGetErrorString(e), grid);
}
```

```cpp
#define MULTI_UNIT 1
#include <hip/hip_runtime.h>
#include <hip/hip_cooperative_groups.h>
#include <cstdio>
#include <cstdint>
namespace cg = cooperative_groups;

#define LAS __attribute__((address_space(3)))
typedef unsigned short bf16_t;
typedef short bf16x8 __attribute__((ext_vector_type(8)));
typedef float f32x4 __attribute__((ext_vector_type(4)));
typedef float f32x2 __attribute__((ext_vector_type(2)));
typedef unsigned u32x4 __attribute__((ext_vector_type(4)));
typedef unsigned u32x2 __attribute__((ext_vector_type(2)));

constexpr int M = 16384, D = 1024, SEQ = 2048, NBATCH = 8, DFF = 2816, PROJ = 8448, NLOG1 = 4352  ;
constexpr float EPS = 1e-6f;
constexpr int NTHREADS = 512, NWAVES = 8;
constexpr int LDS_BYTES = 147456;

constexpr size_t MiB = 1u << 20;
constexpr size_t WS_SSQ = 0;
constexpr size_t WS_PAR = 512 * 1024;
constexpr int PAR_L = 24576, P_SGLNG = 0, P_SGLNB = 512, P_SGB = 1024, P_CVB = 1536, P_CVLNG = 2048, P_CVLNB = 2560, P_SCW = 3072, P_SINK = 4608, P_CVW = 4672, P_FINAL = 2 * PAR_L;
constexpr size_t WS_BAR = 768 * 1024;
constexpr int MISC_OFF = 147200;
constexpr size_t WS_ROPEC = 1 * MiB, WS_ROPES = 1 * MiB + 256 * 1024;
constexpr size_t WS_SGWT = 1 * MiB + 512 * 1024;
constexpr size_t WS_WIN = 2 * MiB, WIN_L = (size_t)PROJ * D * 2;
constexpr size_t WS_WBR = 35 * MiB, WBR_L = 4 * MiB;
constexpr size_t WS_WOUT = 43 * MiB, WOUT_L = 2 * MiB;
constexpr size_t WS_WGU = 47 * MiB, WGU_L = 11 * MiB;
constexpr size_t WS_WDN = 69 * MiB, WDN_L = (size_t)D * DFF * 2;
constexpr size_t WS_XB = 80 * MiB;
constexpr size_t WS_ZA = 112 * MiB;
constexpr size_t WS_MG = WS_ZA;
constexpr size_t WS_GLU = 144 * MiB;
constexpr size_t WS_CH = 160 * MiB;
constexpr size_t WS_TMP = WS_GLU;
constexpr size_t WS_Q = 176 * MiB;
constexpr size_t WS_BG = 192 * MiB;
constexpr size_t WS_K = 208 * MiB, WS_V = 212 * MiB;
constexpr size_t WS_YA = 216 * MiB, WS_YB = 232 * MiB;
constexpr size_t WS_ACT = 112 * MiB;
constexpr size_t WS_END = 248 * MiB;

__device__ const double INVF_REV[32] = {0.15915494309189535, 0.11934937021124886, 0.08949940160889101, 0.06711508300522726, 0.050329212104487035, 0.03774158471741977, 0.0283021958306234, 0.02122365276477766, 0.015915494309189534, 0.011934937021124886, 0.008949940160889102, 0.006711508300522725, 0.005032921210448704, 0.003774158471741977, 0.00283021958306234, 0.0021223652764777662, 0.0015915494309189536, 0.0011934937021124885, 0.0008949940160889102, 0.0006711508300522726, 0.0005032921210448703, 0.00037741584717419774, 0.00028302195830623395, 0.0002122365276477766, 0.00015915494309189535, 0.00011934937021124886, 8.949940160889102e-05, 6.711508300522725e-05, 5.0329212104487035e-05, 3.774158471741978e-05, 2.8302195830623396e-05, 2.122365276477766e-05};

__device__ __forceinline__ unsigned cvt_pk_bf16(float lo, float hi) { unsigned r; asm volatile("v_cvt_pk_bf16_f32 %0, %1, %2" : "=v"(r) : "v"(lo), "v"(hi)); return r; }
__device__ __forceinline__ float bf_lo(unsigned u) { return __builtin_bit_cast(float, u << 16); }
__device__ __forceinline__ float bf_hi(unsigned u) { return __builtin_bit_cast(float, u & 0xffff0000u); }
__device__ __forceinline__ float bf1(bf16_t h) { return __builtin_bit_cast(float, ((unsigned)h) << 16); }
__device__ __forceinline__ float sigmoidf_(float x) { return __builtin_amdgcn_rcpf(1.0f + __expf(-x)); }
__device__ __forceinline__ float wave_sum(float v) {
#pragma unroll
    for (int o = 1; o < 64; o <<= 1) v += __shfl_xor(v, o);
    return v;
}
__device__ __forceinline__ f32x2 gelu_pk(f32x2 v) {
    const f32x2 av = __builtin_elementwise_abs(v), d = av * 0.2316418882f + 1.0f;
    f32x2 t; t.x = __builtin_amdgcn_rcpf(d.x); t.y = __builtin_amdgcn_rcpf(d.y);
    f32x2 q = t * 0.5307027145f + (-0.7265760135f); q = q * t + 0.7107068705f; q = q * t + (-0.142248368f); q = q * t + 0.127414796f; q = q * t;
    const f32x2 s = (v * v) * (-0.72134752044f);
    f32x2 e; e.x = __builtin_amdgcn_exp2f(s.x); e.y = __builtin_amdgcn_exp2f(s.y);
    const f32x2 m = v * (q * e), r = v - m;
    f32x2 o; o.x = v.x < 0.f ? m.x : r.x; o.y = v.y < 0.f ? m.y : r.y; return o;
}
__device__ __forceinline__ u32x4 pack8(f32x4 a, f32x4 b) { u32x4 w; w.x = cvt_pk_bf16(a[0], a[1]); w.y = cvt_pk_bf16(a[2], a[3]); w.z = cvt_pk_bf16(b[0], b[1]); w.w = cvt_pk_bf16(b[2], b[3]); return w; }
__device__ __forceinline__ void unpack8(u32x4 w, f32x4& a, f32x4& b) { a = (f32x4){bf_lo(w.x), bf_hi(w.x), bf_lo(w.y), bf_hi(w.y)}; b = (f32x4){bf_lo(w.z), bf_hi(w.z), bf_lo(w.w), bf_hi(w.w)}; }

namespace pg8 {
constexpr int BM = 256, BK = 64, HALF = 128, HTB = HALF * BK * 2, STAGE_BYTES = 8 * HTB, NXCD = 8, WGM = 8;
__host__ __device__ __forceinline__ int lds_byte(int r, int c) { const int st = (r >> 4) * 2 + (c >> 5), rr = r & 15, cc = c & 31, ob = rr * 64 + cc * 2; return st * 1024 + (ob ^ (((ob >> 9) & 1) << 5)); }
__host__ __device__ __forceinline__ void stage_rc(int b, int& R, int& C) { const int st = b / 1024, sb = b % 1024, swz = sb ^ (((sb >> 9) & 1) << 5); R = (st >> 1) * 16 + swz / 64; C = (st & 1) * 32 + (swz % 64) / 2; }
__host__ __device__ __forceinline__ int perm32(int rho) { const int n = rho >> 4, i = rho & 15; return 8 * (i >> 2) + 4 * n + (i & 3); }

struct Unit { const char* A; const char* B; int lda2, ldb2, nt, pm, pn, z; };

__device__ __forceinline__ void tile_of(int L, int nM, int nN, int& pm, int& pn) {
    const int nwg = nM * nN; int wgid = L; { const int q = nwg / NXCD, r = nwg % NXCD, xcd = wgid % NXCD, off = wgid / NXCD; wgid = (xcd < r ? xcd * (q + 1) : r * (q + 1) + (xcd - r) * q) + off; }
    const int nig = WGM * nN, gid = wgid / nig, fm = gid * WGM, gsz = (nM - fm) < WGM ? (nM - fm) : WGM;
    pm = fm + ((wgid % nig) % gsz); pn = (wgid % nig) / gsz;
}
struct SchedGrid {
    static constexpr bool VARLD = false;
    int nM, nN, nwg, G, c; const char* A; const char* B; int lda2, ldb2, nt;
    __device__ __forceinline__ bool next(int i, Unit& u) const {
        const long L = (long)i * G + c; if (L >= nwg) return false;
        tile_of((int)L, nM, nN, u.pm, u.pn); u.z = 0;
        u.A = A + (size_t)u.pm * 256 * lda2; u.B = B + (size_t)u.pn * 256 * ldb2; u.lda2 = lda2; u.ldb2 = ldb2; u.nt = nt; return true;
    }
};
struct SchedMerge {
    static constexpr bool VARLD = true;
    int G, c; const char* ws; const char* WG  ; const char* WBR;
    __device__ __forceinline__ bool next(int i, Unit& u) const {
        const int ti = i >> 3, sub = i & 7; const long L = (long)ti * G + c; if (L >= 256) return false;
        tile_of((int)L, 64, 4, u.pm, u.pn); u.z = sub; const int br = sub >> 1;
        if ((sub & 1) == 0) { u.A = ws + WS_XB + (size_t)u.pm * 256 * 2048; u.lda2 = 2048; u.B = WG + (size_t)(br * 1024 + u.pn * 256) * 2048; u.ldb2 = 2048; u.nt = 16; }
        else { const size_t yo = br == 0 ? WS_YA : br == 1 ? WS_YB : br == 2 ? WS_Q : WS_BG;
               u.A = ws + yo + (size_t)u.pm * 256 * 1024; u.lda2 = 1024; u.B = WBR + (size_t)br * (1024 * 512 * 2) + (size_t)u.pn * 256 * 1024; u.ldb2 = 1024; u.nt = 8; }
        return true;
    }
};

struct SchedOne {
    static constexpr bool VARLD = false;
    SchedMerge M; int i0;
    __device__ __forceinline__ bool next(int i, Unit& u) const { if (i != 0) return false; return M.next(i0, u); }
};
struct SchedOneG {
    static constexpr bool VARLD = false;
    SchedGrid S; int i0;
    __device__ __forceinline__ bool next(int i, Unit& u) const { if (i != 0) return false; return S.next(i0, u); }
};
template <class Epi, class Sched, bool ALIGN_EPI>
__device__ __forceinline__ void gemm_phase(LAS unsigned char* lds, const Sched& S, const Epi& E) {
    int tid_ = threadIdx.x; asm volatile("" : "+v"(tid_));
    const int tid = tid_, wid = __builtin_amdgcn_readfirstlane(tid >> 6), lane = tid & 63, wr = wid >> 2, wc = wid & 3, fr = lane & 15, fq = lane >> 4;
    unsigned rA[2], rB[2], cc2[2];
#pragma unroll
    for (int i = 0; i < 2; ++i) { int R, C; stage_rc(tid * 16 + i * 8192, R, C); rA[i] = (unsigned)R; rB[i] = (unsigned)((R & ~31) + perm32(R & 31)); cc2[i] = (unsigned)C * 2u; }
    const size_t kstep = (size_t)(BK * 2);
    const unsigned ldsw = (unsigned)wid * 1024u;
    const int aoff = lds_byte(wr * 64 + fr, fq * 8), boff = lds_byte(wc * 32 + fr, fq * 8);
#define PG8_SA(b, h) (((b) * 2 + (h)) * HTB)
#define PG8_SB(b, h) ((4 + (b) * 2 + (h)) * HTB)
#define PG8_STAGE(bufoff, gbase, voff) do { _Pragma("unroll") for (int _i = 0; _i < 2; ++_i) \
        __builtin_amdgcn_global_load_lds((const unsigned*)((const char*)(gbase) + (voff)[_i]), (LAS unsigned*)(lds + (bufoff) + ldsw + _i * 8192), 16, 0, 0); } while (0)
#define PG8_LDA(dst, b, h) do { _Pragma("unroll") for (int m = 0; m < 4; ++m) _Pragma("unroll") for (int k = 0; k < 2; ++k) dst[m][k] = *(const LAS bf16x8*)(lds + PG8_SA(b, h) + aoff + m * 2048 + k * 1024); } while (0)
#define PG8_LDB(dst, b, h) do { _Pragma("unroll") for (int n = 0; n < 2; ++n) _Pragma("unroll") for (int k = 0; k < 2; ++k) dst[n][k] = *(const LAS bf16x8*)(lds + PG8_SB(b, h) + boff + n * 2048 + k * 1024); } while (0)
#define PG8_MMA(ai, bj, At, Bt) do { __builtin_amdgcn_s_setprio(1); _Pragma("unroll") for (int m = 0; m < 4; ++m) _Pragma("unroll") for (int n = 0; n < 2; ++n) _Pragma("unroll") for (int k = 0; k < 2; ++k) \
        acc[ai][bj][m][n] = __builtin_amdgcn_mfma_f32_16x16x32_bf16(Bt[n][k], At[m][k], acc[ai][bj][m][n], 0, 0, 0); __builtin_amdgcn_s_setprio(0); } while (0)
#define PG8_WAIT_V(n) asm volatile("s_waitcnt vmcnt(" #n ")" ::: "memory")
#define PG8_WAIT_L(n) asm volatile("s_waitcnt lgkmcnt(" #n ")" ::: "memory")
#define PG8_BAR __builtin_amdgcn_s_barrier()
#define PG8_SCHED __builtin_amdgcn_sched_barrier(0)
    Unit cur, nxt; int ui = 0;
    if (!S.next(0, cur)) return;
    f32x4 acc[2][2][4][2];
#pragma unroll
    for (int a = 0; a < 2; ++a)
#pragma unroll
        for (int b = 0; b < 2; ++b)
#pragma unroll
            for (int m = 0; m < 4; ++m)
#pragma unroll
                for (int n = 0; n < 2; ++n) acc[a][b][m][n] = (f32x4){0.f, 0.f, 0.f, 0.f};
    bf16x8 At[4][2], B0[2][2], B1[2][2];
    unsigned voffA[2], voffB[2];
#pragma unroll
    for (int i = 0; i < 2; ++i) { voffA[i] = rA[i] * (unsigned)cur.lda2 + cc2[i]; voffB[i] = rB[i] * (unsigned)cur.ldb2 + cc2[i]; }
    const char* cA = cur.A; const char* cB = cur.B;
    unsigned hA = (unsigned)HALF * cur.lda2, hB = (unsigned)HALF * cur.ldb2;
    PG8_STAGE(PG8_SB(0, 0), cB, voffB); PG8_STAGE(PG8_SB(0, 1), cB + hB, voffB); PG8_STAGE(PG8_SA(0, 0), cA, voffA); PG8_STAGE(PG8_SA(0, 1), cA + hA, voffA);
    if (wr == 1) PG8_BAR;
    PG8_WAIT_V(2); PG8_BAR;
    PG8_STAGE(PG8_SB(1, 0), cB + kstep, voffB); PG8_STAGE(PG8_SA(1, 0), cA + kstep, voffA); PG8_STAGE(PG8_SB(1, 1), cB + hB + kstep, voffB);
    PG8_WAIT_V(6); PG8_BAR;
    for (;;) {
        const bool has_next = S.next(ui + 1, nxt);
        if (!has_next) nxt = cur;
        unsigned voffAn[2], voffBn[2];
#pragma unroll
        for (int i = 0; i < 2; ++i) { if constexpr (Sched::VARLD) { voffAn[i] = rA[i] * (unsigned)nxt.lda2 + cc2[i]; voffBn[i] = rB[i] * (unsigned)nxt.ldb2 + cc2[i]; } else { voffAn[i] = voffA[i]; voffBn[i] = voffB[i]; } }
        const char* nA = nxt.A; const char* nB = nxt.B;
        const unsigned hAn = Sched::VARLD ? (unsigned)HALF * nxt.lda2 : hA, hBn = Sched::VARLD ? (unsigned)HALF * nxt.ldb2 : hB;
        const int nt = cur.nt;
        for (int t = 0; t < nt; t += 2) {
            const bool last = (t == nt - 2);
            const char* a1 = cA + (size_t)(t + 1) * kstep;
            const char* a2 = last ? nA : cA + (size_t)(t + 2) * kstep; const char* b2 = last ? nB : cB + (size_t)(t + 2) * kstep;
            const char* a3 = a2 + kstep; const char* b3 = b2 + kstep;
            const unsigned hA2 = last ? hAn : hA, hB2 = last ? hBn : hB;
            unsigned vA2[2], vB2[2];
#pragma unroll
            for (int i = 0; i < 2; ++i) { vA2[i] = last ? voffAn[i] : voffA[i]; vB2[i] = last ? voffBn[i] : voffB[i]; }
            PG8_LDB(B0, 0, 0); PG8_LDB(B1, 0, 1); PG8_SCHED; PG8_LDA(At, 0, 0); PG8_STAGE(PG8_SA(1, 1), a1 + hA, voffA);
            PG8_WAIT_V(8); PG8_WAIT_L(0); PG8_BAR; PG8_MMA(0, 0, At, B0); PG8_MMA(0, 1, At, B1); PG8_BAR; PG8_SCHED;
            PG8_LDA(At, 0, 1); PG8_STAGE(PG8_SB(0, 0), b2, vB2); PG8_STAGE(PG8_SB(0, 1), b2 + hB2, vB2); PG8_STAGE(PG8_SA(0, 0), a2, vA2);
            PG8_WAIT_V(8); PG8_WAIT_L(0); PG8_BAR; PG8_MMA(1, 0, At, B0); PG8_MMA(1, 1, At, B1); PG8_BAR; PG8_SCHED;
            PG8_LDB(B0, 1, 0); PG8_LDB(B1, 1, 1); PG8_SCHED; PG8_LDA(At, 1, 0); PG8_STAGE(PG8_SA(0, 1), a2 + hA2, vA2);
            PG8_WAIT_V(8); PG8_WAIT_L(0); PG8_BAR; PG8_MMA(0, 0, At, B0); PG8_MMA(0, 1, At, B1); PG8_BAR; PG8_SCHED;
            PG8_LDA(At, 1, 1); PG8_STAGE(PG8_SB(1, 0), b3, vB2); PG8_STAGE(PG8_SB(1, 1), b3 + hB2, vB2); PG8_STAGE(PG8_SA(1, 0), a3, vA2);
            PG8_WAIT_V(8); PG8_WAIT_L(0); PG8_BAR; PG8_MMA(1, 0, At, B0); PG8_MMA(1, 1, At, B1); PG8_BAR; PG8_SCHED;
        }
        if constexpr (ALIGN_EPI) { if (wr == 0) PG8_BAR; }
        E(acc, cur, wr, wc, fr, fq);
        if (!has_next) break;
#pragma unroll
        for (int a = 0; a < 2; ++a)
#pragma unroll
            for (int b = 0; b < 2; ++b)
#pragma unroll
                for (int m = 0; m < 4; ++m)
#pragma unroll
                    for (int n = 0; n < 2; ++n) acc[a][b][m][n] = (f32x4){0.f, 0.f, 0.f, 0.f};
        cur = nxt; cA = nA; cB = nB; hA = hAn; hB = hBn; ++ui;
#pragma unroll
        for (int i = 0; i < 2; ++i) { voffA[i] = voffAn[i]; voffB[i] = voffBn[i]; }
        if constexpr (ALIGN_EPI) { if (wr == 1) PG8_BAR; }
    }
    PG8_WAIT_V(0);
    if constexpr (!ALIGN_EPI) { if (wr == 0) PG8_BAR; }
    PG8_BAR;
#undef PG8_SA
#undef PG8_SB
#undef PG8_STAGE
#undef PG8_LDA
#undef PG8_LDB
#undef PG8_MMA
#undef PG8_WAIT_V
#undef PG8_WAIT_L
#undef PG8_BAR
#undef PG8_SCHED
}
}

#define EPI_ROWLOOP _Pragma("unroll") for (int ai = 0; ai < 2; ++ai) _Pragma("unroll") for (int m = 0; m < 4; ++m)
__device__ __forceinline__ float row_rs(const float* ssq, int row) { return __builtin_amdgcn_rsqf(ssq[row] * (1.0f / D) + EPS); }

struct EpiInProj {
    const float* ssq; unsigned char* ws;
    __device__ __forceinline__ void operator()(const f32x4 (&acc)[2][2][4][2], const pg8::Unit& u, int wr, int wc, int fr, int fq) const {
        bf16_t* const ZA = (bf16_t*)(ws + WS_ZA); bf16_t* const GLU = (bf16_t*)(ws + WS_GLU); bf16_t* const BG = (bf16_t*)(ws + WS_BG); bf16_t* const CH = (bf16_t*)(ws + WS_CH);
        const float* const ropeC = (const float*)(ws + WS_ROPEC); const float* const ropeS = (const float*)(ws + WS_ROPES);
        const int T = u.pn, row0 = u.pm * 256 + wr * 64 + fr, jcol = wc * 32 + 8 * fq;
        if (T < 4) {
            EPI_ROWLOOP { const int row = row0 + ai * 128 + m * 16; const float rs = row_rs(ssq, row);
#pragma unroll
                for (int bj = 0; bj < 2; ++bj) { f32x4 v0 = acc[ai][bj][m][0] * rs, v1 = acc[ai][bj][m][1] * rs;
                    f32x2 a = gelu_pk((f32x2){v0[0], v0[1]}), b = gelu_pk((f32x2){v0[2], v0[3]}), c = gelu_pk((f32x2){v1[0], v1[1]}), d = gelu_pk((f32x2){v1[2], v1[3]});
                    *(u32x4*)(ZA + (size_t)row * 1024 + 256 * T + 128 * bj + jcol) = pack8((f32x4){a.x, a.y, b.x, b.y}, (f32x4){c.x, c.y, d.x, d.y}); } }
        } else if (T < 8) {
            EPI_ROWLOOP { const int row = row0 + ai * 128 + m * 16; const float rs = row_rs(ssq, row); f32x4 o[2];
#pragma unroll
                for (int n = 0; n < 2; ++n) { const f32x4 a = acc[ai][0][m][n] * rs, g = acc[ai][1][m][n] * rs;
#pragma unroll
                    for (int j = 0; j < 4; ++j) o[n][j] = a[j] * sigmoidf_(g[j]); }
                *(u32x4*)(GLU + (size_t)row * 512 + 128 * (T - 4) + jcol) = pack8(o[0], o[1]); }
        } else if (T < 11) {
            const bool isq = T < 10; const bool rope = isq || wc < 2; const float sc = isq ? 0.125f : 1.0f;
            const size_t boff = isq ? WS_Q : (wc < 2 ? WS_K : WS_V); bf16_t* const base = (bf16_t*)(ws + boff);
            const int ld = isq ? 512 : 128, hcol = isq ? (4 * (T - 8) + wc) * 64 : (wc & 1) * 64;
            EPI_ROWLOOP { const int row = row0 + ai * 128 + m * 16; const float rs = row_rs(ssq, row) * sc; const int pos = row & (SEQ - 1); f32x4 o1[2], o2[2];
#pragma unroll
                for (int n = 0; n < 2; ++n) { const f32x4 x1 = acc[ai][0][m][n] * rs, x2 = acc[ai][1][m][n] * rs;
                    if (rope) { const f32x4 c = *(const f32x4*)(ropeC + pos * 32 + 8 * fq + 4 * n), s = *(const f32x4*)(ropeS + pos * 32 + 8 * fq + 4 * n);
                        o1[n] = x1 * c - x2 * s; o2[n] = x2 * c + x1 * s; } else { o1[n] = x1; o2[n] = x2; } }
                bf16_t* p = base + (size_t)row * ld + hcol + 8 * fq;
                *(u32x4*)p = pack8(o1[0], o1[1]); *(u32x4*)(p + 32) = pack8(o2[0], o2[1]); }
        } else if (T < 13) {
            EPI_ROWLOOP { const int row = row0 + ai * 128 + m * 16; const float rs = row_rs(ssq, row);
#pragma unroll
                for (int bj = 0; bj < 2; ++bj) *(u32x4*)(BG + (size_t)row * 512 + 256 * (T - 11) + 128 * bj + jcol) = pack8(acc[ai][bj][m][0] * rs, acc[ai][bj][m][1] * rs); }
        } else {
            EPI_ROWLOOP { const int row = row0 + ai * 128 + m * 16; const float rs = row_rs(ssq, row); const float rs2 = rs * rs;
                *(u32x4*)(CH + (size_t)row * 512 + 128 * (T - 13) + jcol) = pack8(acc[ai][0][m][0] * acc[ai][1][m][0] * rs2, acc[ai][0][m][1] * acc[ai][1][m][1] * rs2); }
        }
    }
};
struct EpiGate {
    const float* ssq; bf16_t* MG;
    __device__ __forceinline__ void operator()(const f32x4 (&acc)[2][2][4][2], const pg8::Unit& u, int wr, int wc, int fr, int fq) const {
        const int row0 = u.pm * 256 + wr * 64 + fr, col0 = u.pn * 256 + wc * 32 + 8 * fq;
        EPI_ROWLOOP { const int row = row0 + ai * 128 + m * 16; const float rs = row_rs(ssq, row);
#pragma unroll
            for (int bj = 0; bj < 2; ++bj) { f32x4 v0 = acc[ai][bj][m][0] * rs, v1 = acc[ai][bj][m][1] * rs;
#pragma unroll
                for (int j = 0; j < 4; ++j) { v0[j] = sigmoidf_(v0[j]); v1[j] = sigmoidf_(v1[j]); }
#ifdef ABL_GATE
                if ((u.z >> 1) == ABL_GATE) { v0 = v0 * 0.f + 0.5f; v1 = v1 * 0.f + 0.5f; }
#endif
                *(u32x4*)(MG + (size_t)row * 1024 + col0 + 128 * bj) = pack8(v0, v1); } }
    }
};
struct EpiBranch {
    bf16_t* MG; bf16_t* TMP;
    __device__ __forceinline__ void operator()(const f32x4 (&acc)[2][2][4][2], const pg8::Unit& u, int wr, int wc, int fr, int fq) const {
        const int row0 = u.pm * 256 + wr * 64 + fr, col0 = u.pn * 256 + wc * 32 + 8 * fq, br = u.z >> 1;
        EPI_ROWLOOP { const int row = row0 + ai * 128 + m * 16;
#pragma unroll
            for (int bj = 0; bj < 2; ++bj) { const size_t off = (size_t)row * 1024 + col0 + 128 * bj;
                f32x4 g0, g1; unpack8(*(const u32x4*)(MG + off), g0, g1);
                f32x4 v0 = acc[ai][bj][m][0] * g0, v1 = acc[ai][bj][m][1] * g1;
                if (br > 0) { f32x4 t0, t1; unpack8(*(const u32x4*)(TMP + off), t0, t1); v0 += t0; v1 += t1; }
                if (br < 3) *(u32x4*)(TMP + off) = pack8(v0, v1); else *(u32x4*)(MG + off) = pack8(v0, v1); } }
    }
};
struct EpiStashB {
    bf16_t* MG;
    __device__ __forceinline__ void operator()(const f32x4 (&acc)[2][2][4][2], const pg8::Unit& u, int wr, int wc, int fr, int fq) const {
        const int row0 = u.pm * 256 + wr * 64 + fr, col0 = u.pn * 256 + wc * 32 + 8 * fq;
        EPI_ROWLOOP { const int row = row0 + ai * 128 + m * 16;
#pragma unroll
            for (int bj = 0; bj < 2; ++bj) *(u32x4*)(MG + (size_t)row * 1024 + col0 + 128 * bj) = pack8(acc[ai][bj][m][0], acc[ai][bj][m][1]); }
    }
};
struct EpiGateAcc {
    const float* ssq; bf16_t* MG; bf16_t* TMP;
    __device__ __forceinline__ void operator()(const f32x4 (&acc)[2][2][4][2], const pg8::Unit& u, int wr, int wc, int fr, int fq) const {
        const int row0 = u.pm * 256 + wr * 64 + fr, col0 = u.pn * 256 + wc * 32 + 8 * fq, br = u.z >> 1;
        EPI_ROWLOOP { const int row = row0 + ai * 128 + m * 16; const float rs = row_rs(ssq, row);
#pragma unroll
            for (int bj = 0; bj < 2; ++bj) { const size_t off = (size_t)row * 1024 + col0 + 128 * bj;
                f32x4 b0, b1; unpack8(*(const u32x4*)(MG + off), b0, b1);
                f32x4 v0 = acc[ai][bj][m][0] * rs, v1 = acc[ai][bj][m][1] * rs;
#pragma unroll
                for (int j = 0; j < 4; ++j) { v0[j] = sigmoidf_(v0[j]) * b0[j]; v1[j] = sigmoidf_(v1[j]) * b1[j]; }
                if (br > 0) { f32x4 t0, t1; unpack8(*(const u32x4*)(TMP + off), t0, t1); v0 += t0; v1 += t1; }
                if (br < 3) *(u32x4*)(TMP + off) = pack8(v0, v1); else *(u32x4*)(MG + off) = pack8(v0, v1); } }
    }
};
struct EpiResid {
    const float* SRC; float* DST; bf16_t* XB; float* ssq_out;
    __device__ __forceinline__ void operator()(const f32x4 (&acc)[2][2][4][2], const pg8::Unit& u, int wr, int wc, int fr, int fq) const {
        const int row0 = u.pm * 256 + wr * 64 + fr, col0 = u.pn * 256 + wc * 32 + 8 * fq;
        EPI_ROWLOOP { const int row = row0 + ai * 128 + m * 16; float ss = 0.f;
#pragma unroll
            for (int bj = 0; bj < 2; ++bj) { const size_t off = (size_t)row * 1024 + col0 + 128 * bj;
                const f32x4 v0 = *(const f32x4*)(SRC + off) + acc[ai][bj][m][0], v1 = *(const f32x4*)(SRC + off + 4) + acc[ai][bj][m][1];
                *(f32x4*)(DST + off) = v0; *(f32x4*)(DST + off + 4) = v1; *(u32x4*)(XB + off) = pack8(v0, v1);
                ss += (v0[0] * v0[0] + v0[1] * v0[1]) + (v0[2] * v0[2] + v0[3] * v0[3]) + (v1[0] * v1[0] + v1[1] * v1[1]) + (v1[2] * v1[2] + v1[3] * v1[3]); }
            ss += __shfl_xor(ss, 16); ss += __shfl_xor(ss, 32);
            if (fq == 0) atomicAdd(ssq_out + row, ss); }
    }
};
struct EpiSwiGLU {
    const float* ssq; bf16_t* ACT; float zero_scale;
    __device__ __forceinline__ void operator()(const f32x4 (&acc)[2][2][4][2], const pg8::Unit& u, int wr, int wc, int fr, int fq) const {
        const int row0 = u.pm * 256 + wr * 64 + fr, col0 = u.pn * 128 + wc * 32 + 8 * fq;
        EPI_ROWLOOP { const int row = row0 + ai * 128 + m * 16; const float rs = row_rs(ssq, row); f32x4 o[2];
#pragma unroll
            for (int n = 0; n < 2; ++n) { const f32x4 g = acc[ai][0][m][n] * rs, up = acc[ai][1][m][n] * rs;
#pragma unroll
                for (int j = 0; j < 4; ++j) o[n][j] = g[j] * sigmoidf_(g[j]) * up[j] * zero_scale; }
            *(u32x4*)(ACT + (size_t)row * DFF + col0) = pack8(o[0], o[1]); }
    }
};

#ifndef ABL_FFN
#define ABL_FFN_SCALE(l) 1.0f
#else
#define ABL_FFN_SCALE(l) ((l) == ABL_FFN ? 0.0f : 1.0f)
#endif
struct Args { const float* in[19]; float* out; unsigned char* ws; };

__device__ __forceinline__ int win_src_col(int nlog) {
    const int T = nlog >> 8, o = nlog & 255, bj = o >> 7, j = o & 127;
    if (T < 4) return nlog;
    if (T < 8) return 1024 + bj * 512 + 128 * (T - 4) + j;
    if (T < 10) return 2048 + (4 * (T - 8) + (j >> 5)) * 64 + 32 * bj + (j & 31);
    if (T == 10) { const int h = j >> 5; return (h < 2 ? 2560 + h * 64 : 2688 + (h - 2) * 64) + 32 * bj + (j & 31); }
    if (T < 13) return 2816 + 256 * (T - 11) + o;
    if (T < 17) return 3328 + bj * 512 + 128 * (T - 13) + j;
    return nlog;
}
__device__ __forceinline__ void tr_item(const float* W, int Nsrc, int k0, int scolA, int scolB, const float* gain, bf16_t* WT, int K, int drow, LAS float* scr, int lane) {
    const int c4 = lane & 15; const int sc = ((c4 >> 3) ? scolB : scolA) + 4 * (c4 & 7);
#pragma unroll 4
    for (int i = 0; i < 16; ++i) { const int row = 4 * i + (lane >> 4); f32x4 v = *(const f32x4*)(W + (size_t)(k0 + row) * Nsrc + sc);
        if (gain) v = v * gain[k0 + row];
        LAS float* d = scr + row * 65 + 4 * c4; d[0] = v[0]; d[1] = v[1]; d[2] = v[2]; d[3] = v[3]; }
    asm volatile("s_waitcnt lgkmcnt(0)" ::: "memory");
    const int c = lane & 7;
#pragma unroll
    for (int jj = 0; jj < 8; ++jj) { const int n = (lane >> 3) + 8 * jj; const LAS float* s = scr + (8 * c) * 65 + n;
        u32x4 o; o.x = cvt_pk_bf16(s[0], s[65]); o.y = cvt_pk_bf16(s[2 * 65], s[3 * 65]); o.z = cvt_pk_bf16(s[4 * 65], s[5 * 65]); o.w = cvt_pk_bf16(s[6 * 65], s[7 * 65]);
        *(u32x4*)(WT + (size_t)(drow + n) * K + k0 + 8 * c) = o; }
    asm volatile("s_waitcnt lgkmcnt(0)" ::: "memory");
}
__device__ __forceinline__ void prologue(const Args& a, LAS unsigned char* lds, int G) {
    int tid_ = threadIdx.x; asm volatile("" : "+v"(tid_));
    const int tid = tid_, lane = tid & 63, wave = __builtin_amdgcn_readfirstlane(tid >> 6);
    const int gw = blockIdx.x * NWAVES + wave, NGW = G * NWAVES;
    unsigned char* ws = a.ws;
    LAS float* scr = (LAS float*)(lds + wave * 16640);
    constexpr int I_IN = 16 * 132, I_BR = 512, I_OUT = 256, I_GU = 16 * 88, I_DN = 44 * 16, I_L = I_IN + I_BR + I_OUT + I_GU + I_DN;
    for (int it = gw; it < 2 * I_L; it += NGW) {
        const int l = it / I_L; int r = it % I_L;
        if (r < I_IN) { const int kb = r / 132, nb = r % 132, n0 = 64 * nb;
            tr_item(a.in[2] + (size_t)l * D * PROJ, PROJ, 64 * kb, win_src_col(n0), win_src_col(n0 + 32), a.in[1] + l * D, (bf16_t*)(ws + WS_WIN + l * WIN_L), D, n0, scr, lane); continue; } r -= I_IN;
        if (r < I_BR) { const int br = r >> 7, q = r & 127, kb = q >> 4, nb = q & 15;
            tr_item(a.in[13] + (size_t)(l * 4 + br) * 512 * D, D, 64 * kb, 64 * nb, 64 * nb + 32, nullptr, (bf16_t*)(ws + WS_WBR + l * WBR_L) + (size_t)br * 1024 * 512, 512, 64 * nb, scr, lane); continue; } r -= I_BR;
        if (r < I_OUT) { const int kb = r >> 4, nb = r & 15;
            tr_item(a.in[14] + (size_t)l * D * D, D, 64 * kb, 64 * nb, 64 * nb + 32, nullptr, (bf16_t*)(ws + WS_WOUT + l * WOUT_L), D, 64 * nb, scr, lane); continue; } r -= I_OUT;
        if (r < I_GU) { const int kb = r / 88, nb = r % 88, n0 = 64 * nb, T = n0 >> 8, o = n0 & 255, sc = (o >> 7) * DFF + 128 * T + (o & 127);
            tr_item(a.in[16] + (size_t)l * D * 2 * DFF, 2 * DFF, 64 * kb, sc, sc + 32, a.in[15] + l * D, (bf16_t*)(ws + WS_WGU + l * WGU_L), D, n0, scr, lane); continue; } r -= I_GU;
        { const int kb = r >> 4, nb = r & 15;
            tr_item(a.in[17] + (size_t)l * DFF * D, D, 64 * kb, 64 * nb, 64 * nb + 32, nullptr, (bf16_t*)(ws + WS_WDN + l * WDN_L), DFF, 64 * nb, scr, lane); }
    }
    float* ssq = (float*)(ws + WS_SSQ);
    for (int row = gw; row < M; row += NGW) {
        const f32x4* xr = (const f32x4*)(a.in[0] + (size_t)row * D) + lane; float s = 0.f; f32x4 v[4];
#pragma unroll
        for (int j = 0; j < 4; ++j) { v[j] = xr[64 * j]; s += (v[j][0] * v[j][0] + v[j][1] * v[j][1]) + (v[j][2] * v[j][2] + v[j][3] * v[j][3]); }
        s = wave_sum(s);
        u32x2* o = (u32x2*)((bf16_t*)(ws + WS_XB) + (size_t)row * D) + lane;
#pragma unroll
        for (int j = 0; j < 4; ++j) o[64 * j] = (u32x2){cvt_pk_bf16(v[j][0], v[j][1]), cvt_pk_bf16(v[j][2], v[j][3])};
        if (lane == 0) ssq[row] = s;
    }
    for (int i = blockIdx.x * NTHREADS + tid; i < 4 * M; i += G * NTHREADS) ssq[M + i] = 0.f;
    { float* par = (float*)(ws + WS_PAR); const int gt = blockIdx.x * NTHREADS + tid, GT = G * NTHREADS;
#define CPY(dstoff, srcp, n) for (int i = gt; i < (n); i += GT) par[(dstoff) + i] = (srcp)[i]
      for (int l = 0; l < 2; ++l) { const int o = l * PAR_L;
          CPY(o + P_SGLNG, a.in[3] + l * 512, 512); CPY(o + P_SGLNB, a.in[4] + l * 512, 512); CPY(o + P_SGB, a.in[6] + l * 512, 512);
          CPY(o + P_CVB, a.in[8] + l * 512, 512); CPY(o + P_CVLNG, a.in[9] + l * 512, 512); CPY(o + P_CVLNB, a.in[10] + l * 512, 512);
          CPY(o + P_SCW, a.in[12] + l * 1536, 1536); CPY(o + P_SINK, a.in[11] + l * 8, 8); CPY(o + P_CVW, a.in[7] + l * 31 * 512, 31 * 512); }
      CPY(P_FINAL, a.in[18], 1024);
#undef CPY
    }
    for (int i = blockIdx.x * NTHREADS + tid; i < SEQ * 32; i += G * NTHREADS) { const int pos = i >> 5, f = i & 31;
        const double rev = (double)pos * INVF_REV[f]; const float fr = (float)(rev - floor(rev));
        ((float*)(ws + WS_ROPEC))[i] = __builtin_amdgcn_cosf(fr); ((float*)(ws + WS_ROPES))[i] = __builtin_amdgcn_sinf(fr); }
    for (int i = blockIdx.x * NTHREADS + tid; i < 2 * 4 * 128 * 128; i += G * NTHREADS) { const int s = i & 127, t = (i >> 7) & 127;
        ((bf16_t*)(ws + WS_SGWT))[i] = s <= t ? (bf16_t)(cvt_pk_bf16(a.in[5][i], 0.f) & 0xffffu) : (bf16_t)0; }
}

__device__ __forceinline__ void mixer_sg(unsigned char* ws, int l, LAS unsigned char* lds, int unit) {
    asm volatile("" : "+s"(ws)); int tid_ = threadIdx.x; asm volatile("" : "+v"(tid_));
    const float* par = (const float*)(ws + WS_PAR) + l * PAR_L;
    const int tid = tid_, lane = tid & 63, wave = __builtin_amdgcn_readfirstlane(tid >> 6);
    const int ck = unit >> 2, g = unit & 3, r0 = ck * 128;
    const bf16_t* ZA = (const bf16_t*)(ws + WS_ZA); bf16_t* YA = (bf16_t*)(ws + WS_YA);
    LAS bf16_t* vnT = (LAS bf16_t*)lds;
    const float* lng = par + P_SGLNG; const float* lnb = par + P_SGLNB;
    const f32x4 g0 = *(const f32x4*)(lng + 8 * lane), g1 = *(const f32x4*)(lng + 8 * lane + 4), b0 = *(const f32x4*)(lnb + 8 * lane), b1 = *(const f32x4*)(lnb + 8 * lane + 4);
    for (int s = wave; s < 128; s += NWAVES) {
        f32x4 x0, x1; unpack8(*(const u32x4*)(ZA + (size_t)(r0 + s) * 1024 + 512 + 8 * lane), x0, x1);
        const float mean = wave_sum((x0[0] + x0[1]) + (x0[2] + x0[3]) + (x1[0] + x1[1]) + (x1[2] + x1[3])) * (1.0f / 512.0f);
        x0 -= mean; x1 -= mean;
        const float var = wave_sum((x0[0] * x0[0] + x0[1] * x0[1]) + (x0[2] * x0[2] + x0[3] * x0[3]) + (x1[0] * x1[0] + x1[1] * x1[1]) + (x1[2] * x1[2] + x1[3] * x1[3])) * (1.0f / 512.0f);
        const float rstd = __builtin_amdgcn_rsqf(var + EPS);
        if ((lane >> 4) == g) { const int c = 8 * (lane & 15); x0 = x0 * rstd * g0 + b0; x1 = x1 * rstd * g1 + b1;
            const unsigned p0 = cvt_pk_bf16(x0[0], x0[1]), p1 = cvt_pk_bf16(x0[2], x0[3]), p2 = cvt_pk_bf16(x1[0], x1[1]), p3 = cvt_pk_bf16(x1[2], x1[3]);
            LAS bf16_t* d = vnT + c * 136 + s;
            d[0] = (bf16_t)p0; d[136] = (bf16_t)(p0 >> 16); d[2 * 136] = (bf16_t)p1; d[3 * 136] = (bf16_t)(p1 >> 16);
            d[4 * 136] = (bf16_t)p2; d[5 * 136] = (bf16_t)(p2 >> 16); d[6 * 136] = (bf16_t)p3; d[7 * 136] = (bf16_t)(p3 >> 16); }
    }
    __syncthreads();
    { const int fr = lane & 15, fq = lane >> 4, t0 = 16 * wave, nks = (wave >> 1) + 1;
      const bf16_t* W = (const bf16_t*)(ws + WS_SGWT) + (size_t)(l * 4 + g) * 16384 + (size_t)(t0 + fr) * 128 + 8 * fq;
      f32x4 acc[8];
#pragma unroll
      for (int ct = 0; ct < 8; ++ct) acc[ct] = (f32x4){0.f, 0.f, 0.f, 0.f};
      for (int ks = 0; ks < nks; ++ks) {
          const bf16x8 wf = *(const bf16x8*)(W + 32 * ks);
#pragma unroll
          for (int ct = 0; ct < 8; ++ct) { const bf16x8 vf = *(const LAS bf16x8*)(vnT + (16 * ct + fr) * 136 + 32 * ks + 8 * fq);
              acc[ct] = __builtin_amdgcn_mfma_f32_16x16x32_bf16(vf, wf, acc[ct], 0, 0, 0); }
      }
      const int t = t0 + fr; const size_t row = r0 + t; const float bs = par[P_SGB + g * 128 + t];
#pragma unroll
      for (int ct = 0; ct < 8; ++ct) { const int c = 128 * g + 16 * ct + 4 * fq;
          const u32x2 uu = *(const u32x2*)(ZA + row * 1024 + c);
          const float o0 = bf_lo(uu.x) * (acc[ct][0] + bs), o1 = bf_hi(uu.x) * (acc[ct][1] + bs), o2 = bf_lo(uu.y) * (acc[ct][2] + bs), o3 = bf_hi(uu.y) * (acc[ct][3] + bs);
          *(u32x2*)(YA + row * 512 + c) = (u32x2){cvt_pk_bf16(o0, o1), cvt_pk_bf16(o2, o3)}; }
    }
    __syncthreads();
}
__device__ __forceinline__ void mixer_conv(unsigned char* ws, int l, LAS unsigned char* lds, int unit) {
    asm volatile("" : "+s"(ws)); int tid_ = threadIdx.x; asm volatile("" : "+v"(tid_));
    const float* par = (const float*)(ws + WS_PAR) + l * PAR_L;
    const int tid = tid_, lane = tid & 63, wave = tid >> 6;
    const int b = unit >> 6, tb = unit & 63, t0 = tb * 32; const size_t rbase = (size_t)b * SEQ;
    const bf16_t* GLU = (const bf16_t*)(ws + WS_GLU); bf16_t* YB = (bf16_t*)(ws + WS_YB);
    LAS bf16_t* in = (LAS bf16_t*)lds;
    LAS float* cv = (LAS float*)(lds + 65536);
    for (int i = tid; i < 62 * 64; i += NTHREADS) { const int r = i >> 6, ch = i & 63; const int t = t0 - 30 + r;
        u32x4 v = {0u, 0u, 0u, 0u}; if (t >= 0) v = *(const u32x4*)(GLU + (rbase + t) * 512 + 8 * ch);
        *(LAS u32x4*)(in + r * 512 + 8 * ch) = v; }
    __syncthreads();
    { const int c = tid; float w[31], x[62];
#pragma unroll
      for (int k = 0; k < 31; ++k) w[k] = par[P_CVW + k * 512 + c];
#pragma unroll
      for (int r = 0; r < 62; ++r) x[r] = bf1(in[r * 512 + c]);
      const float bias = par[P_CVB + c];
#pragma unroll
      for (int t = 0; t < 32; ++t) { float s = bias;
#pragma unroll
          for (int k = 0; k < 31; ++k) s += w[k] * x[t + k];
          cv[t * 512 + c] = s; } }
    __syncthreads();
    { const float* lng = par + P_CVLNG; const float* lnb = par + P_CVLNB;
      const f32x4 g0 = *(const f32x4*)(lng + 8 * lane), g1 = *(const f32x4*)(lng + 8 * lane + 4), b0 = *(const f32x4*)(lnb + 8 * lane), b1 = *(const f32x4*)(lnb + 8 * lane + 4);
      for (int t = wave; t < 32; t += NWAVES) {
          f32x4 x0 = *(const LAS f32x4*)(cv + t * 512 + 8 * lane), x1 = *(const LAS f32x4*)(cv + t * 512 + 8 * lane + 4);
          const float mean = wave_sum((x0[0] + x0[1]) + (x0[2] + x0[3]) + (x1[0] + x1[1]) + (x1[2] + x1[3])) * (1.0f / 512.0f);
          x0 -= mean; x1 -= mean;
          const float var = wave_sum((x0[0] * x0[0] + x0[1] * x0[1]) + (x0[2] * x0[2] + x0[3] * x0[3]) + (x1[0] * x1[0] + x1[1] * x1[1]) + (x1[2] * x1[2] + x1[3] * x1[3])) * (1.0f / 512.0f);
          const float rstd = __builtin_amdgcn_rsqf(var + EPS);
          x0 = x0 * rstd * g0 + b0; x1 = x1 * rstd * g1 + b1;
#pragma unroll
          for (int j = 0; j < 4; ++j) { x0[j] = x0[j] * sigmoidf_(x0[j]); x1[j] = x1[j] * sigmoidf_(x1[j]); }
          *(u32x4*)(YB + (rbase + t0 + t) * 512 + 8 * lane) = pack8(x0, x1); } }
    __syncthreads();
}
__device__ __forceinline__ void mixer_attn(unsigned char* ws, int l, LAS unsigned char* lds, int unit) {
    asm volatile("" : "+s"(ws)); int tid_ = threadIdx.x; asm volatile("" : "+v"(tid_));
    const float* par = (const float*)(ws + WS_PAR) + l * PAR_L;
    const int tid = tid_, lane = tid & 63, wave = __builtin_amdgcn_readfirstlane(tid >> 6), fr = lane & 15, fq = lane >> 4;
    const int kvh = unit & 1, blk = (unit >> 1) & 15, b = unit >> 5; const size_t rbase = (size_t)b * SEQ;
    bf16_t* Q = (bf16_t*)(ws + WS_Q); const bf16_t* K = (const bf16_t*)(ws + WS_K); const bf16_t* V = (const bf16_t*)(ws + WS_V);
    LAS bf16_t* Kl = (LAS bf16_t*)lds;
    LAS bf16_t* VT = (LAS bf16_t*)(lds + 36864);
    for (int i = tid; i < 256 * 8; i += NTHREADS) { const int r = i >> 3, ch = i & 7; const int t = (blk - 1) * 128 + r;
        u32x4 kv = {0u, 0u, 0u, 0u}, vv = {0u, 0u, 0u, 0u};
        if (t >= 0) { kv = *(const u32x4*)(K + (rbase + t) * 128 + kvh * 64 + 8 * ch); vv = *(const u32x4*)(V + (rbase + t) * 128 + kvh * 64 + 8 * ch); }
        *(LAS u32x4*)(Kl + r * 72 + 8 * ch) = kv;
        LAS bf16_t* d = VT + (8 * ch) * 264 + r;
        d[0] = (bf16_t)vv.x; d[264] = (bf16_t)(vv.x >> 16); d[2 * 264] = (bf16_t)vv.y; d[3 * 264] = (bf16_t)(vv.y >> 16);
        d[4 * 264] = (bf16_t)vv.z; d[5 * 264] = (bf16_t)(vv.z >> 16); d[6 * 264] = (bf16_t)vv.w; d[7 * 264] = (bf16_t)(vv.w >> 16); }
    __syncthreads();
    const int g = wave >> 1, head = kvh * 4 + g; const float sink = par[P_SINK + head];
    for (int it = 0; it < 2; ++it) {
        const int qs = 2 * (wave & 1) + it, qi0 = 32 * qs; const size_t qrow0 = rbase + blk * 128 + qi0;
        bf16x8 qf[2][2];
#pragma unroll
        for (int qt = 0; qt < 2; ++qt)
#pragma unroll
            for (int ks = 0; ks < 2; ++ks) qf[qt][ks] = *(const bf16x8*)(Q + (qrow0 + 16 * qt + fr) * 512 + head * 64 + 32 * ks + 8 * fq);
        f32x4 S[2][10];
#pragma unroll
        for (int qt = 0; qt < 2; ++qt)
#pragma unroll
            for (int kt = 0; kt < 10; ++kt) S[qt][kt] = (f32x4){0.f, 0.f, 0.f, 0.f};
#pragma unroll
        for (int kt = 0; kt < 10; ++kt)
#pragma unroll
            for (int ks = 0; ks < 2; ++ks) { const bf16x8 kf = *(const LAS bf16x8*)(Kl + (qi0 + 16 * kt + fr) * 72 + 32 * ks + 8 * fq);
#pragma unroll
                for (int qt = 0; qt < 2; ++qt) S[qt][kt] = __builtin_amdgcn_mfma_f32_16x16x32_bf16(kf, qf[qt][ks], S[qt][kt], 0, 0, 0); }
        bf16x8 pf[2][5];
#pragma unroll
        for (int qt = 0; qt < 2; ++qt) { const int qi = qi0 + 16 * qt + fr; float mx = sink;
#pragma unroll
            for (int kt = 0; kt < 10; ++kt)
#pragma unroll
                for (int j = 0; j < 4; ++j) { const int kb = qi0 + 16 * kt + 4 * fq + j; const bool valid = (kb > qi) && (kb <= qi + 128) && (blk > 0 || kb >= 128);
                    const float sv = valid ? S[qt][kt][j] : -INFINITY; S[qt][kt][j] = sv; mx = fmaxf(mx, sv); }
            mx = fmaxf(mx, __shfl_xor(mx, 16)); mx = fmaxf(mx, __shfl_xor(mx, 32));
            float sum = 0.f;
#pragma unroll
            for (int kt = 0; kt < 10; ++kt)
#pragma unroll
                for (int j = 0; j < 4; ++j) { const float p = __expf(S[qt][kt][j] - mx); S[qt][kt][j] = p; sum += p; }
            sum += __shfl_xor(sum, 16); sum += __shfl_xor(sum, 32);
            const float inv = 1.0f / (sum + __expf(sink - mx));
#pragma unroll
            for (int p = 0; p < 5; ++p) { const f32x4 a0 = S[qt][2 * p] * inv, a1 = S[qt][2 * p + 1] * inv; pf[qt][p] = __builtin_bit_cast(bf16x8, pack8(a0, a1)); }
        }
        f32x4 o[2][4];
#pragma unroll
        for (int qt = 0; qt < 2; ++qt)
#pragma unroll
            for (int dt = 0; dt < 4; ++dt) o[qt][dt] = (f32x4){0.f, 0.f, 0.f, 0.f};
#pragma unroll
        for (int p = 0; p < 5; ++p)
#pragma unroll
            for (int dt = 0; dt < 4; ++dt) { const LAS bf16_t* vp = VT + (16 * dt + fr) * 264 + qi0 + 32 * p + 4 * fq;
                const u32x2 lo = *(const LAS u32x2*)vp, hi = *(const LAS u32x2*)(vp + 16);
                const bf16x8 vf = __builtin_bit_cast(bf16x8, (u32x4){lo.x, lo.y, hi.x, hi.y});
#pragma unroll
                for (int qt = 0; qt < 2; ++qt) o[qt][dt] = __builtin_amdgcn_mfma_f32_16x16x32_bf16(vf, pf[qt][p], o[qt][dt], 0, 0, 0); }
#pragma unroll
        for (int qt = 0; qt < 2; ++qt)
#pragma unroll
            for (int dt = 0; dt < 4; ++dt) *(u32x2*)(Q + (qrow0 + 16 * qt + fr) * 512 + head * 64 + 16 * dt + 4 * fq) = (u32x2){cvt_pk_bf16(o[qt][dt][0], o[qt][dt][1]), cvt_pk_bf16(o[qt][dt][2], o[qt][dt][3])};
    }
    __syncthreads();
}
__device__ __forceinline__ void mixer_sc(unsigned char* ws, int l, int G) {
    asm volatile("" : "+s"(ws)); int tid_ = threadIdx.x; asm volatile("" : "+v"(tid_));
    bf16_t* BG = (bf16_t*)(ws + WS_BG); const bf16_t* CH = (const bf16_t*)(ws + WS_CH);
    const float* w = (const float*)(ws + WS_PAR) + l * PAR_L + P_SCW;
    for (int i = blockIdx.x * NTHREADS + tid_; i < M * 64; i += G * NTHREADS) {
        const int row = i >> 6, c = 8 * (i & 63), t = row & (SEQ - 1);
        f32x4 a0 = {0.f, 0.f, 0.f, 0.f}, a1 = a0;
#pragma unroll
        for (int k = 0; k < 3; ++k) { if (t - 2 + k >= 0) { f32x4 x0, x1; unpack8(*(const u32x4*)(CH + (size_t)(row - 2 + k) * 512 + c), x0, x1);
            a0 += x0 * *(const f32x4*)(w + k * 512 + c); a1 += x1 * *(const f32x4*)(w + k * 512 + c + 4); } }
        f32x4 g0, g1; unpack8(*(const u32x4*)(BG + (size_t)row * 512 + c), g0, g1);
        *(u32x4*)(BG + (size_t)row * 512 + c) = pack8(g0 * a0, g1 * a1);
    }
}

#define RLX_AGENT __ATOMIC_RELAXED, __HIP_MEMORY_SCOPE_AGENT
#define XB_TMO      128
#define XB_XCNT(j)  (256  + 64 * (j))
#define XB_XSUB(j)  (1280 + 64 * (j))
#define XB_XGEN(j)  (2304 + 64 * (j))
#define XB_TOP      3328
#define XB_TOPGEN   3392
#define XCD_BAR_WORDS 3456
#define XB_SPIN_CAP (1u << 18)

__device__ __forceinline__ unsigned xb_ld(unsigned* p)              { return __hip_atomic_load(p, __ATOMIC_RELAXED, __HIP_MEMORY_SCOPE_AGENT); }
__device__ __forceinline__ unsigned xb_add(unsigned* p, unsigned v) { return __hip_atomic_fetch_add(p, v, __ATOMIC_RELAXED, __HIP_MEMORY_SCOPE_AGENT); }
__device__ __forceinline__ unsigned xb_xcc_id() { return (unsigned)__builtin_amdgcn_s_getreg((3 << 11) | 20) & 0xFu; }
#define XB_SPIN(cond, bar) do { unsigned _sp = 0; while (cond) { __builtin_amdgcn_s_sleep(1); \
    if ((++_sp & 255u) == 0u) { if (xb_ld(&(bar)[XB_TMO])) break; if (_sp > XB_SPIN_CAP) { atomicAdd(&(bar)[XB_TMO], 1u); break; } } } } while (0)

struct XcdBarrier {
    unsigned* bar; unsigned x;
    volatile LAS unsigned* st;
};

__device__ __forceinline__ XcdBarrier xcd_barrier_post(unsigned* bar, volatile LAS unsigned* st) {
    XcdBarrier b; b.bar = bar; b.x = xb_xcc_id(); b.st = st;
    if (threadIdx.x == 0) (void)xb_add(&bar[XB_XCNT(b.x)], 1u);
    return b;
}
__device__ __forceinline__ void xcd_barrier_complete(unsigned* bar, unsigned x, unsigned& nloc, unsigned& nx) {
    const unsigned G = gridDim.x * gridDim.y * gridDim.z;
    unsigned sum, cnt, mine, sp = 0u;
    for (;;) {
        sum = 0u; cnt = 0u; mine = 0u;
#pragma unroll
        for (unsigned j = 0; j < 16; ++j) { const unsigned c = xb_ld(&bar[XB_XCNT(j)]); sum += c; cnt += (c > 0u) ? 1u : 0u; mine = (j == x) ? c : mine; }
        if (sum == G) break;
        __builtin_amdgcn_s_sleep(1);
        if ((++sp & 255u) == 0u) { if (xb_ld(&bar[XB_TMO])) break; if (sp > XB_SPIN_CAP) { atomicAdd(&bar[XB_TMO], 1u); break; } }
    }
    nloc = mine > 0u ? mine : 1u; nx = cnt > 0u ? cnt : 1u;
}

__device__ __forceinline__ void xcd_barrier(const XcdBarrier& b) {
    asm volatile("s_waitcnt vmcnt(0)" ::: "memory");
    __syncthreads();
    if (threadIdx.x == 0) {
        unsigned* bar = b.bar;
        __builtin_amdgcn_s_waitcnt(0);
        unsigned nloc = b.st[0], nx = b.st[1];
        if (nloc == 0u) { xcd_barrier_complete(bar, b.x, nloc, nx); b.st[0] = nloc; b.st[1] = nx; }
        const unsigned old = xb_add(&bar[XB_XSUB(b.x)], 1u);
        const unsigned gen = old / nloc;
        if (old + 1u == (gen + 1u) * nloc) {
            __builtin_amdgcn_fence(__ATOMIC_RELEASE, "agent");
            asm volatile("s_waitcnt vmcnt(0)" ::: "memory");
            const unsigned og = xb_add(&bar[XB_TOP], 1u);
            const unsigned tg = og / nx;
            if (og + 1u == (tg + 1u) * nx) xb_add(&bar[XB_TOPGEN], 1u);
            else XB_SPIN(xb_ld(&bar[XB_TOPGEN]) == tg, bar);
            __builtin_amdgcn_fence(__ATOMIC_ACQUIRE, "agent");
            xb_add(&bar[XB_XGEN(b.x)], 1u);
            asm volatile("s_waitcnt vmcnt(0)" ::: "memory");
        } else {
            XB_SPIN(xb_ld(&bar[XB_XGEN(b.x)]) == gen, bar);
            __builtin_amdgcn_fence(__ATOMIC_ACQUIRE, "agent");
            asm volatile("s_waitcnt vmcnt(0)" ::: "memory");
        }
    }
    __syncthreads();
}


#ifdef DBG_STAGE
__device__ __forceinline__ void dbg_dump(float* out, const bf16_t* src, int ld, int ncols, int c0, int G) {
    for (long i = (long)blockIdx.x * NTHREADS + threadIdx.x; i < (long)M * ncols; i += (long)G * NTHREADS) { const int row = (int)(i / ncols), c = (int)(i % ncols); out[(size_t)row * D + c0 + c] = bf1(src[(size_t)row * ld + c]); }
}
#endif
#define GRID_SYNC() do { XcdBarrier xb_; xb_.bar = (unsigned*)(ws + WS_BAR); xb_.x = xb_xcc_id(); xb_.st = (volatile LAS unsigned*)(lds + MISC_OFF); xcd_barrier(xb_); } while (0)
__global__ void __launch_bounds__(NTHREADS, 2) fwd_megakernel(Args a) {
    extern __shared__ __attribute__((aligned(16))) unsigned char lds_raw[];
    LAS unsigned char* lds = (LAS unsigned char*)lds_raw;
    cg::grid_group grid = cg::this_grid();
    const int G = gridDim.x, c = blockIdx.x;
    unsigned char* ws = a.ws;
    float* ssq = (float*)(ws + WS_SSQ);

    { volatile LAS unsigned* misc = (volatile LAS unsigned*)(lds + MISC_OFF); if (threadIdx.x < 16) misc[threadIdx.x] = 0u; }
    __syncthreads();
    grid.sync();
    (void)xcd_barrier_post((unsigned*)(ws + WS_BAR), (volatile LAS unsigned*)(lds + MISC_OFF));
    prologue(a, lds, G);
    GRID_SYNC();

    for (int l = 0; l < 2; ++l) {
        asm volatile("" : "+s"(ws)); ssq = (float*)(ws + WS_SSQ);
        const float* ssq_mix = ssq + (size_t)(2 * l) * M;
        { pg8::SchedGrid S; S.nM = 64; S.nN = 17; S.nwg = 64 * 17; S.G = G; S.c = c; S.A = (const char*)(ws + WS_XB); S.B = (const char*)(ws + WS_WIN + l * WIN_L); S.lda2 = 2048; S.ldb2 = 2048; S.nt = 16;
          EpiInProj E{ssq_mix, ws};
#ifdef MULTI_UNIT
          pg8::gemm_phase<EpiInProj, pg8::SchedGrid, true>(lds, S, E);
#else
          for (int i = 0; i < 5; ++i) { pg8::SchedOneG S1; S1.S = S; S1.i0 = i; pg8::gemm_phase<EpiInProj, pg8::SchedOneG, false>(lds, S1, E); }
#endif
        }
        GRID_SYNC(); asm volatile("" : "+s"(ws));
#if defined(DBG_STAGE) && DBG_STAGE == 1
        if (l == 0) { dbg_dump(a.out, (const bf16_t*)(ws + WS_ZA), 1024, 1024, 0, G); return; }
#endif
        for (int u = c; u < 512; u += G) mixer_sg(ws, l, lds, u);
        for (int u = c; u < 512; u += G) mixer_conv(ws, l, lds, u);
        for (int u = c; u < 256; u += G) mixer_attn(ws, l, lds, u);
        mixer_sc(ws, l, G);
        GRID_SYNC(); asm volatile("" : "+s"(ws)); ssq = (float*)(ws + WS_SSQ);
        #if defined(DBG_STAGE) && DBG_STAGE == 2
        if (l == 0) { dbg_dump(a.out, (const bf16_t*)(ws + WS_YA), 512, 512, 0, G); dbg_dump(a.out, (const bf16_t*)(ws + WS_YB), 512, 512, 512, G); return; }
#endif
#if defined(DBG_STAGE) && DBG_STAGE == 22
        if (l == 0) { dbg_dump(a.out, (const bf16_t*)(ws + WS_Q), 512, 512, 0, G); dbg_dump(a.out, (const bf16_t*)(ws + WS_BG), 512, 512, 512, G); return; }
#endif
        { pg8::SchedMerge S; S.G = G; S.c = c; S.ws = (const char*)ws; S.WG = (const char*)(ws + WS_WIN + l * WIN_L) + (size_t)NLOG1 * 2048;
          S.WBR = (const char*)(ws + WS_WBR + l * WBR_L);
          EpiStashB ES{(bf16_t*)(ws + WS_MG)}; EpiGateAcc EA{ssq_mix, (bf16_t*)(ws + WS_MG), (bf16_t*)(ws + WS_TMP)};
          for (int br = 0; br < 4; ++br) {
              { pg8::SchedOne S1; S1.M = S; S1.i0 = 2 * br + 1; pg8::gemm_phase<EpiStashB, pg8::SchedOne, false>(lds, S1, ES); }
              { pg8::SchedOne S1; S1.M = S; S1.i0 = 2 * br; pg8::gemm_phase<EpiGateAcc, pg8::SchedOne, false>(lds, S1, EA); }
          }
        }
        GRID_SYNC(); asm volatile("" : "+s"(ws)); ssq = (float*)(ws + WS_SSQ);
        #if defined(DBG_STAGE) && DBG_STAGE == 3
        if (l == 0) { dbg_dump(a.out, (const bf16_t*)(ws + WS_MG), 1024, 1024, 0, G); return; }
#endif
        { pg8::SchedGrid S; S.nM = 64; S.nN = 4; S.nwg = 256; S.G = G; S.c = c; S.A = (const char*)(ws + WS_MG); S.B = (const char*)(ws + WS_WOUT + l * WOUT_L); S.lda2 = 2048; S.ldb2 = 2048; S.nt = 16;
          EpiResid E{l == 0 ? a.in[0] : a.out, a.out, (bf16_t*)(ws + WS_XB), ssq + (size_t)(2 * l + 1) * M};
          pg8::gemm_phase<EpiResid, pg8::SchedGrid, false>(lds, S, E); }
        GRID_SYNC(); asm volatile("" : "+s"(ws)); ssq = (float*)(ws + WS_SSQ);
        #if defined(DBG_STAGE) && DBG_STAGE == 4
        if (l == 0) return;
#endif
        { pg8::SchedGrid S; S.nM = 64; S.nN = 22; S.nwg = 64 * 22; S.G = G; S.c = c; S.A = (const char*)(ws + WS_XB); S.B = (const char*)(ws + WS_WGU + l * WGU_L); S.lda2 = 2048; S.ldb2 = 2048; S.nt = 16;
          EpiSwiGLU E{ssq + (size_t)(2 * l + 1) * M, (bf16_t*)(ws + WS_ACT), ABL_FFN_SCALE(l)};
#ifdef MULTI_UNIT
          pg8::gemm_phase<EpiSwiGLU, pg8::SchedGrid, true>(lds, S, E);
#else
          for (int i = 0; i < 6; ++i) { pg8::SchedOneG S1; S1.S = S; S1.i0 = i; pg8::gemm_phase<EpiSwiGLU, pg8::SchedOneG, false>(lds, S1, E); }
#endif
        }
        GRID_SYNC(); asm volatile("" : "+s"(ws)); ssq = (float*)(ws + WS_SSQ);
        #if defined(DBG_STAGE) && DBG_STAGE == 5
        if (l == 0) { dbg_dump(a.out, (const bf16_t*)(ws + WS_ACT), DFF, 1024, 0, G); return; }
#endif
        { pg8::SchedGrid S; S.nM = 64; S.nN = 4; S.nwg = 256; S.G = G; S.c = c; S.A = (const char*)(ws + WS_ACT); S.B = (const char*)(ws + WS_WDN + l * WDN_L); S.lda2 = DFF * 2; S.ldb2 = DFF * 2; S.nt = DFF / 64;
          EpiResid E{a.out, a.out, (bf16_t*)(ws + WS_XB), ssq + (size_t)(2 * l + 2) * M};
          pg8::gemm_phase<EpiResid, pg8::SchedGrid, false>(lds, S, E); }
        GRID_SYNC();
#if defined(DBG_STAGE) && DBG_STAGE == 6
        if (l == 0) return;
#endif
    }
    { asm volatile("" : "+s"(ws)); int tid_ = threadIdx.x; asm volatile("" : "+v"(tid_));
      const int lane = tid_ & 63, gw = c * NWAVES + (tid_ >> 6), NGW = G * NWAVES; const float* gf = (const float*)(ws + WS_PAR) + P_FINAL; const float* sq = (const float*)(ws + WS_SSQ) + (size_t)4 * M;
      for (int row = gw; row < M; row += NGW) { const float rs = row_rs(sq, row); f32x4* xr = (f32x4*)(a.out + (size_t)row * D) + lane;
#pragma unroll
          for (int j = 0; j < 4; ++j) xr[64 * j] = xr[64 * j] * rs * ((const f32x4*)gf)[64 * j + lane]; } }
}

extern "C" void kernel_launch(void* const* d_in, const int* in_sizes, int n_in, void* d_out, int out_size, void* d_ws, size_t ws_size, hipStream_t stream) {
    static int grid = 0;
    if (grid == 0) {
        if (n_in != 19 || out_size != M * D || ws_size < WS_END) { fprintf(stderr, "kernel_launch: unexpected shapes (n_in %d out %d ws %zu)\n", n_in, out_size, ws_size); grid = -1; return; }
        int dev = 0, cus = 0, per_cu = 0;
        if (hipGetDevice(&dev) != hipSuccess || hipDeviceGetAttribute(&cus, hipDeviceAttributeMultiprocessorCount, dev) != hipSuccess) { grid = -1; return; }
        if (hipFuncSetAttribute((const void*)fwd_megakernel, hipFuncAttributeMaxDynamicSharedMemorySize, LDS_BYTES) != hipSuccess) { fprintf(stderr, "kernel_launch: hipFuncSetAttribute failed\n"); grid = -1; return; }
        if (hipOccupancyMaxActiveBlocksPerMultiprocessor(&per_cu, (const void*)fwd_megakernel, NTHREADS, LDS_BYTES) != hipSuccess || per_cu < 1) { fprintf(stderr, "kernel_launch: occupancy query says %d\n", per_cu); per_cu = 1; }
        (void)hipGetLastError();
        grid = cus * 1;
    }
    if (grid < 0) return;
    if (hipMemsetAsync((char*)d_ws + WS_BAR, 0, 16384, stream) != hipSuccess) { fprintf(stderr, "kernel_launch: memset failed\n"); return; }
    Args a{};
    for (int i = 0; i < 19; ++i) a.in[i] = (const float*)d_in[i];
    a.out = (float*)d_out; a.ws = (unsigned char*)d_ws;
    void* args[] = {&a};
    hipError_t e = hipLaunchCooperativeKernel((const void*)fwd_megakernel, dim3(grid), dim3(NTHREADS), args, LDS_BYTES, stream);
    if (e != hipSuccess) fprintf(stderr, "cooperative launch failed: %s (grid %d)\n", hipGetErrorString(e), grid);
}
```

```cpp
#define MERGE_MULTI 1
#define MULTI_UNIT 1
#include <hip/hip_runtime.h>
#include <hip/hip_cooperative_groups.h>
#include <cstdio>
#include <cstdint>
namespace cg = cooperative_groups;

#define LAS __attribute__((address_space(3)))
typedef unsigned short bf16_t;
typedef short bf16x8 __attribute__((ext_vector_type(8)));
typedef float f32x4 __attribute__((ext_vector_type(4)));
typedef float f32x2 __attribute__((ext_vector_type(2)));
typedef unsigned u32x4 __attribute__((ext_vector_type(4)));
typedef unsigned u32x2 __attribute__((ext_vector_type(2)));

constexpr int M = 16384, D = 1024, SEQ = 2048, NBATCH = 8, DFF = 2816, PROJ = 8448, NLOG1 = 4352  ;
constexpr float EPS = 1e-6f;
constexpr int NTHREADS = 512, NWAVES = 8;
constexpr int LDS_BYTES = 147456;

constexpr size_t MiB = 1u << 20;
constexpr size_t WS_SSQ = 0;
constexpr size_t WS_PAR = 512 * 1024;
constexpr int PAR_L = 24576, P_SGLNG = 0, P_SGLNB = 512, P_SGB = 1024, P_CVB = 1536, P_CVLNG = 2048, P_CVLNB = 2560, P_SCW = 3072, P_SINK = 4608, P_CVW = 4672, P_FINAL = 2 * PAR_L;
constexpr size_t WS_BAR = 768 * 1024;
constexpr int MISC_OFF = 147200;
constexpr size_t WS_ROPEC = 1 * MiB, WS_ROPES = 1 * MiB + 256 * 1024;
constexpr size_t WS_SGWT = 1 * MiB + 512 * 1024;
constexpr size_t WS_WIN = 2 * MiB, WIN_L = (size_t)PROJ * D * 2;
constexpr size_t WS_WBR = 35 * MiB, WBR_L = 4 * MiB;
constexpr size_t WS_WOUT = 43 * MiB, WOUT_L = 2 * MiB;
constexpr size_t WS_WGU = 47 * MiB, WGU_L = 11 * MiB;
constexpr size_t WS_WDN = 69 * MiB, WDN_L = (size_t)D * DFF * 2;
constexpr size_t WS_XB = 80 * MiB;
constexpr size_t WS_ZA = 112 * MiB;
constexpr size_t WS_MG = WS_ZA;
constexpr size_t WS_GLU = 144 * MiB;
constexpr size_t WS_CH = 160 * MiB;
constexpr size_t WS_TMP = WS_GLU;
constexpr size_t WS_Q = 176 * MiB;
constexpr size_t WS_BG = 192 * MiB;
constexpr size_t WS_K = 208 * MiB, WS_V = 212 * MiB;
constexpr size_t WS_YA = 216 * MiB, WS_YB = 232 * MiB;
constexpr size_t WS_ACT = 112 * MiB;
constexpr size_t WS_END = 248 * MiB;

__device__ const double INVF_REV[32] = {0.15915494309189535, 0.11934937021124886, 0.08949940160889101, 0.06711508300522726, 0.050329212104487035, 0.03774158471741977, 0.0283021958306234, 0.02122365276477766, 0.015915494309189534, 0.011934937021124886, 0.008949940160889102, 0.006711508300522725, 0.005032921210448704, 0.003774158471741977, 0.00283021958306234, 0.0021223652764777662, 0.0015915494309189536, 0.0011934937021124885, 0.0008949940160889102, 0.0006711508300522726, 0.0005032921210448703, 0.00037741584717419774, 0.00028302195830623395, 0.0002122365276477766, 0.00015915494309189535, 0.00011934937021124886, 8.949940160889102e-05, 6.711508300522725e-05, 5.0329212104487035e-05, 3.774158471741978e-05, 2.8302195830623396e-05, 2.122365276477766e-05};

__device__ __forceinline__ unsigned cvt_pk_bf16(float lo, float hi) { unsigned r; asm volatile("v_cvt_pk_bf16_f32 %0, %1, %2" : "=v"(r) : "v"(lo), "v"(hi)); return r; }
__device__ __forceinline__ float bf_lo(unsigned u) { return __builtin_bit_cast(float, u << 16); }
__device__ __forceinline__ float bf_hi(unsigned u) { return __builtin_bit_cast(float, u & 0xffff0000u); }
__device__ __forceinline__ float bf1(bf16_t h) { return __builtin_bit_cast(float, ((unsigned)h) << 16); }
__device__ __forceinline__ float sigmoidf_(float x) { return __builtin_amdgcn_rcpf(1.0f + __expf(-x)); }
__device__ __forceinline__ float wave_sum(float v) {
#pragma unroll
    for (int o = 1; o < 64; o <<= 1) v += __shfl_xor(v, o);
    return v;
}
__device__ __forceinline__ f32x2 gelu_pk(f32x2 v) {
    const f32x2 av = __builtin_elementwise_abs(v), d = av * 0.2316418882f + 1.0f;
    f32x2 t; t.x = __builtin_amdgcn_rcpf(d.x); t.y = __builtin_amdgcn_rcpf(d.y);
    f32x2 q = t * 0.5307027145f + (-0.7265760135f); q = q * t + 0.7107068705f; q = q * t + (-0.142248368f); q = q * t + 0.127414796f; q = q * t;
    const f32x2 s = (v * v) * (-0.72134752044f);
    f32x2 e; e.x = __builtin_amdgcn_exp2f(s.x); e.y = __builtin_amdgcn_exp2f(s.y);
    const f32x2 m = v * (q * e), r = v - m;
    f32x2 o; o.x = v.x < 0.f ? m.x : r.x; o.y = v.y < 0.f ? m.y : r.y; return o;
}
__device__ __forceinline__ u32x4 pack8(f32x4 a, f32x4 b) { u32x4 w; w.x = cvt_pk_bf16(a[0], a[1]); w.y = cvt_pk_bf16(a[2], a[3]); w.z = cvt_pk_bf16(b[0], b[1]); w.w = cvt_pk_bf16(b[2], b[3]); return w; }
__device__ __forceinline__ void unpack8(u32x4 w, f32x4& a, f32x4& b) { a = (f32x4){bf_lo(w.x), bf_hi(w.x), bf_lo(w.y), bf_hi(w.y)}; b = (f32x4){bf_lo(w.z), bf_hi(w.z), bf_lo(w.w), bf_hi(w.w)}; }

namespace pg8 {
constexpr int BM = 256, BK = 64, HALF = 128, HTB = HALF * BK * 2, STAGE_BYTES = 8 * HTB, NXCD = 8, WGM = 8;
__host__ __device__ __forceinline__ int lds_byte(int r, int c) { const int st = (r >> 4) * 2 + (c >> 5), rr = r & 15, cc = c & 31, ob = rr * 64 + cc * 2; return st * 1024 + (ob ^ (((ob >> 9) & 1) << 5)); }
__host__ __device__ __forceinline__ void stage_rc(int b, int& R, int& C) { const int st = b / 1024, sb = b % 1024, swz = sb ^ (((sb >> 9) & 1) << 5); R = (st >> 1) * 16 + swz / 64; C = (st & 1) * 32 + (swz % 64) / 2; }
__host__ __device__ __forceinline__ int perm32(int rho) { const int n = rho >> 4, i = rho & 15; return 8 * (i >> 2) + 4 * n + (i & 3); }

struct Unit { const char* A; const char* B; int lda2, ldb2, nt, pm, pn, z; };

__device__ __forceinline__ void tile_of(int L, int nM, int nN, int& pm, int& pn) {
    const int nwg = nM * nN; int wgid = L; { const int q = nwg / NXCD, r = nwg % NXCD, xcd = wgid % NXCD, off = wgid / NXCD; wgid = (xcd < r ? xcd * (q + 1) : r * (q + 1) + (xcd - r) * q) + off; }
    const int nig = WGM * nN, gid = wgid / nig, fm = gid * WGM, gsz = (nM - fm) < WGM ? (nM - fm) : WGM;
    pm = fm + ((wgid % nig) % gsz); pn = (wgid % nig) / gsz;
}
struct SchedGrid {
    static constexpr bool VARLD = false;
    int nM, nN, nwg, G, c; const char* A; const char* B; int lda2, ldb2, nt;
    __device__ __forceinline__ bool next(int i, Unit& u) const {
        const long L = (long)i * G + c; if (L >= nwg) return false;
        tile_of((int)L, nM, nN, u.pm, u.pn); u.z = 0;
        u.A = A + (size_t)u.pm * 256 * lda2; u.B = B + (size_t)u.pn * 256 * ldb2; u.lda2 = lda2; u.ldb2 = ldb2; u.nt = nt; return true;
    }
};
struct SchedMerge {
    static constexpr bool VARLD = true;
    int G, c; const char* ws; const char* WG  ; const char* WBR; int swap;
    __device__ __forceinline__ bool next(int i, Unit& u) const {
        const int ti = i >> 3, sub = i & 7; const long L = (long)ti * G + c; if (L >= 256) return false;
        tile_of((int)L, 64, 4, u.pm, u.pn); u.z = sub; const int br = sub >> 1;
        if (((sub & 1) ^ swap) == 0) { u.A = ws + WS_XB + (size_t)u.pm * 256 * 2048; u.lda2 = 2048; u.B = WG + (size_t)(br * 1024 + u.pn * 256) * 2048; u.ldb2 = 2048; u.nt = 16; }
        else { const size_t yo = br == 0 ? WS_YA : br == 1 ? WS_YB : br == 2 ? WS_Q : WS_BG;
               u.A = ws + yo + (size_t)u.pm * 256 * 1024; u.lda2 = 1024; u.B = WBR + (size_t)br * (1024 * 512 * 2) + (size_t)u.pn * 256 * 1024; u.ldb2 = 1024; u.nt = 8; }
        return true;
    }
};

struct SchedOne {
    static constexpr bool VARLD = false;
    SchedMerge M; int i0;
    __device__ __forceinline__ bool next(int i, Unit& u) const { if (i != 0) return false; return M.next(i0, u); }
};
struct SchedOneG {
    static constexpr bool VARLD = false;
    SchedGrid S; int i0;
    __device__ __forceinline__ bool next(int i, Unit& u) const { if (i != 0) return false; return S.next(i0, u); }
};
template <class Epi, class Sched, bool ALIGN_EPI>
__device__ __forceinline__ void gemm_phase(LAS unsigned char* lds, const Sched& S, const Epi& E) {
    int tid_ = threadIdx.x; asm volatile("" : "+v"(tid_));
    const int tid = tid_, wid = __builtin_amdgcn_readfirstlane(tid >> 6), lane = tid & 63, wr = wid >> 2, wc = wid & 3, fr = lane & 15, fq = lane >> 4;
    unsigned rA[2], rB[2], cc2[2];
#pragma unroll
    for (int i = 0; i < 2; ++i) { int R, C; stage_rc(tid * 16 + i * 8192, R, C); rA[i] = (unsigned)R; rB[i] = (unsigned)((R & ~31) + perm32(R & 31)); cc2[i] = (unsigned)C * 2u; }
    const size_t kstep = (size_t)(BK * 2);
    const unsigned ldsw = (unsigned)wid * 1024u;
    const int aoff = lds_byte(wr * 64 + fr, fq * 8), boff = lds_byte(wc * 32 + fr, fq * 8);
#define PG8_SA(b, h) (((b) * 2 + (h)) * HTB)
#define PG8_SB(b, h) ((4 + (b) * 2 + (h)) * HTB)
#define PG8_STAGE(bufoff, gbase, voff) do { _Pragma("unroll") for (int _i = 0; _i < 2; ++_i) \
        __builtin_amdgcn_global_load_lds((const unsigned*)((const char*)(gbase) + (voff)[_i]), (LAS unsigned*)(lds + (bufoff) + ldsw + _i * 8192), 16, 0, 0); } while (0)
#define PG8_LDA(dst, b, h) do { _Pragma("unroll") for (int m = 0; m < 4; ++m) _Pragma("unroll") for (int k = 0; k < 2; ++k) dst[m][k] = *(const LAS bf16x8*)(lds + PG8_SA(b, h) + aoff + m * 2048 + k * 1024); } while (0)
#define PG8_LDB(dst, b, h) do { _Pragma("unroll") for (int n = 0; n < 2; ++n) _Pragma("unroll") for (int k = 0; k < 2; ++k) dst[n][k] = *(const LAS bf16x8*)(lds + PG8_SB(b, h) + boff + n * 2048 + k * 1024); } while (0)
#define PG8_MMA(ai, bj, At, Bt) do { __builtin_amdgcn_s_setprio(1); _Pragma("unroll") for (int m = 0; m < 4; ++m) _Pragma("unroll") for (int n = 0; n < 2; ++n) _Pragma("unroll") for (int k = 0; k < 2; ++k) \
        acc[ai][bj][m][n] = __builtin_amdgcn_mfma_f32_16x16x32_bf16(Bt[n][k], At[m][k], acc[ai][bj][m][n], 0, 0, 0); __builtin_amdgcn_s_setprio(0); } while (0)
#define PG8_WAIT_V(n) asm volatile("s_waitcnt vmcnt(" #n ")" ::: "memory")
#define PG8_WAIT_L(n) asm volatile("s_waitcnt lgkmcnt(" #n ")" ::: "memory")
#define PG8_BAR __builtin_amdgcn_s_barrier()
#define PG8_SCHED __builtin_amdgcn_sched_barrier(0)
    Unit cur, nxt; int ui = 0;
    if (!S.next(0, cur)) return;
    f32x4 acc[2][2][4][2];
#pragma unroll
    for (int a = 0; a < 2; ++a)
#pragma unroll
        for (int b = 0; b < 2; ++b)
#pragma unroll
            for (int m = 0; m < 4; ++m)
#pragma unroll
                for (int n = 0; n < 2; ++n) acc[a][b][m][n] = (f32x4){0.f, 0.f, 0.f, 0.f};
    bf16x8 At[4][2], B0[2][2], B1[2][2];
    unsigned voffA[2], voffB[2];
#pragma unroll
    for (int i = 0; i < 2; ++i) { voffA[i] = rA[i] * (unsigned)cur.lda2 + cc2[i]; voffB[i] = rB[i] * (unsigned)cur.ldb2 + cc2[i]; }
    const char* cA = cur.A; const char* cB = cur.B;
    unsigned hA = (unsigned)HALF * cur.lda2, hB = (unsigned)HALF * cur.ldb2;
    PG8_STAGE(PG8_SB(0, 0), cB, voffB); PG8_STAGE(PG8_SB(0, 1), cB + hB, voffB); PG8_STAGE(PG8_SA(0, 0), cA, voffA); PG8_STAGE(PG8_SA(0, 1), cA + hA, voffA);
    if (wr == 1) PG8_BAR;
    PG8_WAIT_V(2); PG8_BAR;
    PG8_STAGE(PG8_SB(1, 0), cB + kstep, voffB); PG8_STAGE(PG8_SA(1, 0), cA + kstep, voffA); PG8_STAGE(PG8_SB(1, 1), cB + hB + kstep, voffB);
    PG8_WAIT_V(6); PG8_BAR;
    for (;;) {
        const bool has_next = S.next(ui + 1, nxt);
        if (!has_next) nxt = cur;
        unsigned voffAn[2], voffBn[2];
#pragma unroll
        for (int i = 0; i < 2; ++i) { if constexpr (Sched::VARLD) { voffAn[i] = rA[i] * (unsigned)nxt.lda2 + cc2[i]; voffBn[i] = rB[i] * (unsigned)nxt.ldb2 + cc2[i]; } else { voffAn[i] = voffA[i]; voffBn[i] = voffB[i]; } }
        const char* nA = nxt.A; const char* nB = nxt.B;
        const unsigned hAn = Sched::VARLD ? (unsigned)HALF * nxt.lda2 : hA, hBn = Sched::VARLD ? (unsigned)HALF * nxt.ldb2 : hB;
        const int nt = cur.nt;
        for (int t = 0; t < nt; t += 2) {
            const bool last = (t == nt - 2);
            const char* a1 = cA + (size_t)(t + 1) * kstep;
            const char* a2 = last ? nA : cA + (size_t)(t + 2) * kstep; const char* b2 = last ? nB : cB + (size_t)(t + 2) * kstep;
            const char* a3 = a2 + kstep; const char* b3 = b2 + kstep;
            const unsigned hA2 = last ? hAn : hA, hB2 = last ? hBn : hB;
            unsigned vA2[2], vB2[2];
#pragma unroll
            for (int i = 0; i < 2; ++i) { vA2[i] = last ? voffAn[i] : voffA[i]; vB2[i] = last ? voffBn[i] : voffB[i]; }
            PG8_LDB(B0, 0, 0); PG8_LDB(B1, 0, 1); PG8_SCHED; PG8_LDA(At, 0, 0); PG8_STAGE(PG8_SA(1, 1), a1 + hA, voffA);
            PG8_WAIT_V(8); PG8_WAIT_L(0); PG8_BAR; PG8_MMA(0, 0, At, B0); PG8_MMA(0, 1, At, B1); PG8_BAR; PG8_SCHED;
            PG8_LDA(At, 0, 1); PG8_STAGE(PG8_SB(0, 0), b2, vB2); PG8_STAGE(PG8_SB(0, 1), b2 + hB2, vB2); PG8_STAGE(PG8_SA(0, 0), a2, vA2);
            PG8_WAIT_V(8); PG8_WAIT_L(0); PG8_BAR; PG8_MMA(1, 0, At, B0); PG8_MMA(1, 1, At, B1); PG8_BAR; PG8_SCHED;
            PG8_LDB(B0, 1, 0); PG8_LDB(B1, 1, 1); PG8_SCHED; PG8_LDA(At, 1, 0); PG8_STAGE(PG8_SA(0, 1), a2 + hA2, vA2);
            PG8_WAIT_V(8); PG8_WAIT_L(0); PG8_BAR; PG8_MMA(0, 0, At, B0); PG8_MMA(0, 1, At, B1); PG8_BAR; PG8_SCHED;
            PG8_LDA(At, 1, 1); PG8_STAGE(PG8_SB(1, 0), b3, vB2); PG8_STAGE(PG8_SB(1, 1), b3 + hB2, vB2); PG8_STAGE(PG8_SA(1, 0), a3, vA2);
            PG8_WAIT_V(8); PG8_WAIT_L(0); PG8_BAR; PG8_MMA(1, 0, At, B0); PG8_MMA(1, 1, At, B1); PG8_BAR; PG8_SCHED;
        }
        if constexpr (ALIGN_EPI) { if (wr == 0) PG8_BAR; }
        E(acc, cur, wr, wc, fr, fq);
        if (!has_next) break;
#pragma unroll
        for (int a = 0; a < 2; ++a)
#pragma unroll
            for (int b = 0; b < 2; ++b)
#pragma unroll
                for (int m = 0; m < 4; ++m)
#pragma unroll
                    for (int n = 0; n < 2; ++n) acc[a][b][m][n] = (f32x4){0.f, 0.f, 0.f, 0.f};
        cur = nxt; cA = nA; cB = nB; hA = hAn; hB = hBn; ++ui;
#pragma unroll
        for (int i = 0; i < 2; ++i) { voffA[i] = voffAn[i]; voffB[i] = voffBn[i]; }
        if constexpr (ALIGN_EPI) { if (wr == 1) PG8_BAR; }
    }
    PG8_WAIT_V(0);
    if constexpr (!ALIGN_EPI) { if (wr == 0) PG8_BAR; }
    PG8_BAR;
#undef PG8_SA
#undef PG8_SB
#undef PG8_STAGE
#undef PG8_LDA
#undef PG8_LDB
#undef PG8_MMA
#undef PG8_WAIT_V
#undef PG8_WAIT_L
#undef PG8_BAR
#undef PG8_SCHED
}
}

#define EPI_ROWLOOP _Pragma("unroll") for (int ai = 0; ai < 2; ++ai) _Pragma("unroll") for (int m = 0; m < 4; ++m)
__device__ __forceinline__ float row_rs(const float* ssq, int row) { return __builtin_amdgcn_rsqf(ssq[row] * (1.0f / D) + EPS); }

struct EpiInProj {
    const float* ssq; unsigned char* ws;
    __device__ __forceinline__ void operator()(const f32x4 (&acc)[2][2][4][2], const pg8::Unit& u, int wr, int wc, int fr, int fq) const {
        bf16_t* const ZA = (bf16_t*)(ws + WS_ZA); bf16_t* const GLU = (bf16_t*)(ws + WS_GLU); bf16_t* const BG = (bf16_t*)(ws + WS_BG); bf16_t* const CH = (bf16_t*)(ws + WS_CH);
        const float* const ropeC = (const float*)(ws + WS_ROPEC); const float* const ropeS = (const float*)(ws + WS_ROPES);
        const int T = u.pn, row0 = u.pm * 256 + wr * 64 + fr, jcol = wc * 32 + 8 * fq;
        if (T < 4) {
            EPI_ROWLOOP { const int row = row0 + ai * 128 + m * 16; const float rs = row_rs(ssq, row);
#pragma unroll
                for (int bj = 0; bj < 2; ++bj) { f32x4 v0 = acc[ai][bj][m][0] * rs, v1 = acc[ai][bj][m][1] * rs;
                    f32x2 a = gelu_pk((f32x2){v0[0], v0[1]}), b = gelu_pk((f32x2){v0[2], v0[3]}), c = gelu_pk((f32x2){v1[0], v1[1]}), d = gelu_pk((f32x2){v1[2], v1[3]});
                    *(u32x4*)(ZA + (size_t)row * 1024 + 256 * T + 128 * bj + jcol) = pack8((f32x4){a.x, a.y, b.x, b.y}, (f32x4){c.x, c.y, d.x, d.y}); } }
        } else if (T < 8) {
            EPI_ROWLOOP { const int row = row0 + ai * 128 + m * 16; const float rs = row_rs(ssq, row); f32x4 o[2];
#pragma unroll
                for (int n = 0; n < 2; ++n) { const f32x4 a = acc[ai][0][m][n] * rs, g = acc[ai][1][m][n] * rs;
#pragma unroll
                    for (int j = 0; j < 4; ++j) o[n][j] = a[j] * sigmoidf_(g[j]); }
                *(u32x4*)(GLU + (size_t)row * 512 + 128 * (T - 4) + jcol) = pack8(o[0], o[1]); }
        } else if (T < 11) {
            const bool isq = T < 10; const bool rope = isq || wc < 2; const float sc = isq ? 0.125f : 1.0f;
            const size_t boff = isq ? WS_Q : (wc < 2 ? WS_K : WS_V); bf16_t* const base = (bf16_t*)(ws + boff);
            const int ld = isq ? 512 : 128, hcol = isq ? (4 * (T - 8) + wc) * 64 : (wc & 1) * 64;
            EPI_ROWLOOP { const int row = row0 + ai * 128 + m * 16; const float rs = row_rs(ssq, row) * sc; const int pos = row & (SEQ - 1); f32x4 o1[2], o2[2];
#pragma unroll
                for (int n = 0; n < 2; ++n) { const f32x4 x1 = acc[ai][0][m][n] * rs, x2 = acc[ai][1][m][n] * rs;
                    if (rope) { const f32x4 c = *(const f32x4*)(ropeC + pos * 32 + 8 * fq + 4 * n), s = *(const f32x4*)(ropeS + pos * 32 + 8 * fq + 4 * n);
                        o1[n] = x1 * c - x2 * s; o2[n] = x2 * c + x1 * s; } else { o1[n] = x1; o2[n] = x2; } }
                bf16_t* p = base + (size_t)row * ld + hcol + 8 * fq;
                *(u32x4*)p = pack8(o1[0], o1[1]); *(u32x4*)(p + 32) = pack8(o2[0], o2[1]); }
        } else if (T < 13) {
            EPI_ROWLOOP { const int row = row0 + ai * 128 + m * 16; const float rs = row_rs(ssq, row);
#pragma unroll
                for (int bj = 0; bj < 2; ++bj) *(u32x4*)(BG + (size_t)row * 512 + 256 * (T - 11) + 128 * bj + jcol) = pack8(acc[ai][bj][m][0] * rs, acc[ai][bj][m][1] * rs); }
        } else {
            EPI_ROWLOOP { const int row = row0 + ai * 128 + m * 16; const float rs = row_rs(ssq, row); const float rs2 = rs * rs;
                *(u32x4*)(CH + (size_t)row * 512 + 128 * (T - 13) + jcol) = pack8(acc[ai][0][m][0] * acc[ai][1][m][0] * rs2, acc[ai][0][m][1] * acc[ai][1][m][1] * rs2); }
        }
    }
};
struct EpiGate {
    const float* ssq; bf16_t* MG;
    __device__ __forceinline__ void operator()(const f32x4 (&acc)[2][2][4][2], const pg8::Unit& u, int wr, int wc, int fr, int fq) const {
        const int row0 = u.pm * 256 + wr * 64 + fr, col0 = u.pn * 256 + wc * 32 + 8 * fq;
        EPI_ROWLOOP { const int row = row0 + ai * 128 + m * 16; const float rs = row_rs(ssq, row);
#pragma unroll
            for (int bj = 0; bj < 2; ++bj) { f32x4 v0 = acc[ai][bj][m][0] * rs, v1 = acc[ai][bj][m][1] * rs;
#pragma unroll
                for (int j = 0; j < 4; ++j) { v0[j] = sigmoidf_(v0[j]); v1[j] = sigmoidf_(v1[j]); }
#ifdef ABL_GATE
                if ((u.z >> 1) == ABL_GATE) { v0 = v0 * 0.f + 0.5f; v1 = v1 * 0.f + 0.5f; }
#endif
                *(u32x4*)(MG + (size_t)row * 1024 + col0 + 128 * bj) = pack8(v0, v1); } }
    }
};
struct EpiBranch {
    bf16_t* MG; bf16_t* TMP;
    __device__ __forceinline__ void operator()(const f32x4 (&acc)[2][2][4][2], const pg8::Unit& u, int wr, int wc, int fr, int fq) const {
        const int row0 = u.pm * 256 + wr * 64 + fr, col0 = u.pn * 256 + wc * 32 + 8 * fq, br = u.z >> 1;
        EPI_ROWLOOP { const int row = row0 + ai * 128 + m * 16;
#pragma unroll
            for (int bj = 0; bj < 2; ++bj) { const size_t off = (size_t)row * 1024 + col0 + 128 * bj;
                f32x4 g0, g1; unpack8(*(const u32x4*)(MG + off), g0, g1);
                f32x4 v0 = acc[ai][bj][m][0] * g0, v1 = acc[ai][bj][m][1] * g1;
                if (br > 0) { f32x4 t0, t1; unpack8(*(const u32x4*)(TMP + off), t0, t1); v0 += t0; v1 += t1; }
                if (br < 3) *(u32x4*)(TMP + off) = pack8(v0, v1); else *(u32x4*)(MG + off) = pack8(v0, v1); } }
    }
};
struct EpiStashB {
    bf16_t* MG;
    __device__ __forceinline__ void operator()(const f32x4 (&acc)[2][2][4][2], const pg8::Unit& u, int wr, int wc, int fr, int fq) const {
        const int row0 = u.pm * 256 + wr * 64 + fr, col0 = u.pn * 256 + wc * 32 + 8 * fq;
        EPI_ROWLOOP { const int row = row0 + ai * 128 + m * 16;
#pragma unroll
            for (int bj = 0; bj < 2; ++bj) *(u32x4*)(MG + (size_t)row * 1024 + col0 + 128 * bj) = pack8(acc[ai][bj][m][0], acc[ai][bj][m][1]); }
    }
};
struct EpiGateAcc {
    const float* ssq; bf16_t* MG; bf16_t* TMP;
    __device__ __forceinline__ void operator()(const f32x4 (&acc)[2][2][4][2], const pg8::Unit& u, int wr, int wc, int fr, int fq) const {
        const int row0 = u.pm * 256 + wr * 64 + fr, col0 = u.pn * 256 + wc * 32 + 8 * fq, br = u.z >> 1;
        EPI_ROWLOOP { const int row = row0 + ai * 128 + m * 16; const float rs = row_rs(ssq, row);
#pragma unroll
            for (int bj = 0; bj < 2; ++bj) { const size_t off = (size_t)row * 1024 + col0 + 128 * bj;
                f32x4 b0, b1; unpack8(*(const u32x4*)(MG + off), b0, b1);
                f32x4 v0 = acc[ai][bj][m][0] * rs, v1 = acc[ai][bj][m][1] * rs;
#pragma unroll
                for (int j = 0; j < 4; ++j) { v0[j] = sigmoidf_(v0[j]) * b0[j]; v1[j] = sigmoidf_(v1[j]) * b1[j]; }
                if (br > 0) { f32x4 t0, t1; unpack8(*(const u32x4*)(TMP + off), t0, t1); v0 += t0; v1 += t1; }
                if (br < 3) *(u32x4*)(TMP + off) = pack8(v0, v1); else *(u32x4*)(MG + off) = pack8(v0, v1); } }
    }
};
struct EpiMerge2 {
    EpiStashB ES; EpiGateAcc EA;
    __device__ __forceinline__ void operator()(const f32x4 (&acc)[2][2][4][2], const pg8::Unit& u, int wr, int wc, int fr, int fq) const {
        if ((u.z & 1) == 0) ES(acc, u, wr, wc, fr, fq); else EA(acc, u, wr, wc, fr, fq);
    }
};
struct EpiResid {
    const float* SRC; float* DST; bf16_t* XB; float* ssq_out;
    __device__ __forceinline__ void operator()(const f32x4 (&acc)[2][2][4][2], const pg8::Unit& u, int wr, int wc, int fr, int fq) const {
        const int row0 = u.pm * 256 + wr * 64 + fr, col0 = u.pn * 256 + wc * 32 + 8 * fq;
        EPI_ROWLOOP { const int row = row0 + ai * 128 + m * 16; float ss = 0.f;
#pragma unroll
            for (int bj = 0; bj < 2; ++bj) { const size_t off = (size_t)row * 1024 + col0 + 128 * bj;
                const f32x4 v0 = *(const f32x4*)(SRC + off) + acc[ai][bj][m][0], v1 = *(const f32x4*)(SRC + off + 4) + acc[ai][bj][m][1];
                *(f32x4*)(DST + off) = v0; *(f32x4*)(DST + off + 4) = v1; *(u32x4*)(XB + off) = pack8(v0, v1);
                ss += (v0[0] * v0[0] + v0[1] * v0[1]) + (v0[2] * v0[2] + v0[3] * v0[3]) + (v1[0] * v1[0] + v1[1] * v1[1]) + (v1[2] * v1[2] + v1[3] * v1[3]); }
            ss += __shfl_xor(ss, 16); ss += __shfl_xor(ss, 32);
            if (fq == 0) atomicAdd(ssq_out + row, ss); }
    }
};
struct EpiSwiGLU {
    const float* ssq; bf16_t* ACT; float zero_scale;
    __device__ __forceinline__ void operator()(const f32x4 (&acc)[2][2][4][2], const pg8::Unit& u, int wr, int wc, int fr, int fq) const {
        const int row0 = u.pm * 256 + wr * 64 + fr, col0 = u.pn * 128 + wc * 32 + 8 * fq;
        EPI_ROWLOOP { const int row = row0 + ai * 128 + m * 16; const float rs = row_rs(ssq, row); f32x4 o[2];
#pragma unroll
            for (int n = 0; n < 2; ++n) { const f32x4 g = acc[ai][0][m][n] * rs, up = acc[ai][1][m][n] * rs;
#pragma unroll
                for (int j = 0; j < 4; ++j) o[n][j] = g[j] * sigmoidf_(g[j]) * up[j] * zero_scale; }
            *(u32x4*)(ACT + (size_t)row * DFF + col0) = pack8(o[0], o[1]); }
    }
};

#ifndef ABL_FFN
#define ABL_FFN_SCALE(l) 1.0f
#else
#define ABL_FFN_SCALE(l) ((l) == ABL_FFN ? 0.0f : 1.0f)
#endif
struct Args { const float* in[19]; float* out; unsigned char* ws; };

__device__ __forceinline__ int win_src_col(int nlog) {
    const int T = nlog >> 8, o = nlog & 255, bj = o >> 7, j = o & 127;
    if (T < 4) return nlog;
    if (T < 8) return 1024 + bj * 512 + 128 * (T - 4) + j;
    if (T < 10) return 2048 + (4 * (T - 8) + (j >> 5)) * 64 + 32 * bj + (j & 31);
    if (T == 10) { const int h = j >> 5; return (h < 2 ? 2560 + h * 64 : 2688 + (h - 2) * 64) + 32 * bj + (j & 31); }
    if (T < 13) return 2816 + 256 * (T - 11) + o;
    if (T < 17) return 3328 + bj * 512 + 128 * (T - 13) + j;
    return nlog;
}
__device__ __forceinline__ void tr_item(const float* W, int Nsrc, int k0, int scolA, int scolB, const float* gain, bf16_t* WT, int K, int drow, LAS float* scr, int lane) {
    const int c4 = lane & 15; const int sc = ((c4 >> 3) ? scolB : scolA) + 4 * (c4 & 7);
    f32x4 v[16];
#pragma unroll
    for (int i = 0; i < 16; ++i) v[i] = __builtin_nontemporal_load((const f32x4*)(W + (size_t)(k0 + 4 * i + (lane >> 4)) * Nsrc + sc));
#pragma unroll
    for (int i = 0; i < 16; ++i) { const int row = 4 * i + (lane >> 4); if (gain) v[i] = v[i] * gain[k0 + row];
        LAS float* d = scr + row * 65 + 4 * c4; d[0] = v[i][0]; d[1] = v[i][1]; d[2] = v[i][2]; d[3] = v[i][3]; }
    asm volatile("s_waitcnt lgkmcnt(0)" ::: "memory");
    const int c = lane & 7;
#pragma unroll
    for (int jj = 0; jj < 8; ++jj) { const int n = (lane >> 3) + 8 * jj; const LAS float* s = scr + (8 * c) * 65 + n;
        u32x4 o; o.x = cvt_pk_bf16(s[0], s[65]); o.y = cvt_pk_bf16(s[2 * 65], s[3 * 65]); o.z = cvt_pk_bf16(s[4 * 65], s[5 * 65]); o.w = cvt_pk_bf16(s[6 * 65], s[7 * 65]);
        *(u32x4*)(WT + (size_t)(drow + n) * K + k0 + 8 * c) = o; }
    asm volatile("s_waitcnt lgkmcnt(0)" ::: "memory");
}
__device__ __forceinline__ void prologue(const Args& a, LAS unsigned char* lds, int G) {
    int tid_ = threadIdx.x; asm volatile("" : "+v"(tid_));
    const int tid = tid_, lane = tid & 63, wave = __builtin_amdgcn_readfirstlane(tid >> 6);
    const int gw = blockIdx.x * NWAVES + wave, NGW = G * NWAVES;
    unsigned char* ws = a.ws;
    LAS float* scr = (LAS float*)(lds + wave * 16640);
    constexpr int I_IN = 16 * 132, I_BR = 512, I_OUT = 256, I_GU = 16 * 88, I_DN = 44 * 16, I_L = I_IN + I_BR + I_OUT + I_GU + I_DN;
    for (int it = gw; it < 2 * I_L; it += NGW) {
        const int l = it / I_L; int r = it % I_L;
        if (r < I_IN) { const int kb = r / 132, nb = r % 132, n0 = 64 * nb;
            tr_item(a.in[2] + (size_t)l * D * PROJ, PROJ, 64 * kb, win_src_col(n0), win_src_col(n0 + 32), a.in[1] + l * D, (bf16_t*)(ws + WS_WIN + l * WIN_L), D, n0, scr, lane); continue; } r -= I_IN;
        if (r < I_BR) { const int br = r >> 7, q = r & 127, kb = q >> 4, nb = q & 15;
            tr_item(a.in[13] + (size_t)(l * 4 + br) * 512 * D, D, 64 * kb, 64 * nb, 64 * nb + 32, nullptr, (bf16_t*)(ws + WS_WBR + l * WBR_L) + (size_t)br * 1024 * 512, 512, 64 * nb, scr, lane); continue; } r -= I_BR;
        if (r < I_OUT) { const int kb = r >> 4, nb = r & 15;
            tr_item(a.in[14] + (size_t)l * D * D, D, 64 * kb, 64 * nb, 64 * nb + 32, nullptr, (bf16_t*)(ws + WS_WOUT + l * WOUT_L), D, 64 * nb, scr, lane); continue; } r -= I_OUT;
        if (r < I_GU) { const int kb = r / 88, nb = r % 88, n0 = 64 * nb, T = n0 >> 8, o = n0 & 255, sc = (o >> 7) * DFF + 128 * T + (o & 127);
            tr_item(a.in[16] + (size_t)l * D * 2 * DFF, 2 * DFF, 64 * kb, sc, sc + 32, a.in[15] + l * D, (bf16_t*)(ws + WS_WGU + l * WGU_L), D, n0, scr, lane); continue; } r -= I_GU;
        { const int kb = r >> 4, nb = r & 15;
            tr_item(a.in[17] + (size_t)l * DFF * D, D, 64 * kb, 64 * nb, 64 * nb + 32, nullptr, (bf16_t*)(ws + WS_WDN + l * WDN_L), DFF, 64 * nb, scr, lane); }
    }
    float* ssq = (float*)(ws + WS_SSQ);
    for (int row = gw; row < M; row += NGW) {
        const f32x4* xr = (const f32x4*)(a.in[0] + (size_t)row * D) + lane; float s = 0.f; f32x4 v[4];
#pragma unroll
        for (int j = 0; j < 4; ++j) { v[j] = xr[64 * j]; s += (v[j][0] * v[j][0] + v[j][1] * v[j][1]) + (v[j][2] * v[j][2] + v[j][3] * v[j][3]); }
        s = wave_sum(s);
        u32x2* o = (u32x2*)((bf16_t*)(ws + WS_XB) + (size_t)row * D) + lane;
#pragma unroll
        for (int j = 0; j < 4; ++j) o[64 * j] = (u32x2){cvt_pk_bf16(v[j][0], v[j][1]), cvt_pk_bf16(v[j][2], v[j][3])};
        if (lane == 0) ssq[row] = s;
    }
    for (int i = blockIdx.x * NTHREADS + tid; i < 4 * M; i += G * NTHREADS) ssq[M + i] = 0.f;
    { float* par = (float*)(ws + WS_PAR); const int gt = blockIdx.x * NTHREADS + tid, GT = G * NTHREADS;
#define CPY(dstoff, srcp, n) for (int i = gt; i < (n); i += GT) par[(dstoff) + i] = (srcp)[i]
      for (int l = 0; l < 2; ++l) { const int o = l * PAR_L;
          CPY(o + P_SGLNG, a.in[3] + l * 512, 512); CPY(o + P_SGLNB, a.in[4] + l * 512, 512); CPY(o + P_SGB, a.in[6] + l * 512, 512);
          CPY(o + P_CVB, a.in[8] + l * 512, 512); CPY(o + P_CVLNG, a.in[9] + l * 512, 512); CPY(o + P_CVLNB, a.in[10] + l * 512, 512);
          CPY(o + P_SCW, a.in[12] + l * 1536, 1536); CPY(o + P_SINK, a.in[11] + l * 8, 8); CPY(o + P_CVW, a.in[7] + l * 31 * 512, 31 * 512); }
      CPY(P_FINAL, a.in[18], 1024);
#undef CPY
    }
    for (int i = blockIdx.x * NTHREADS + tid; i < SEQ * 32; i += G * NTHREADS) { const int pos = i >> 5, f = i & 31;
        const double rev = (double)pos * INVF_REV[f]; const float fr = (float)(rev - floor(rev));
        ((float*)(ws + WS_ROPEC))[i] = __builtin_amdgcn_cosf(fr); ((float*)(ws + WS_ROPES))[i] = __builtin_amdgcn_sinf(fr); }
    for (int i = blockIdx.x * NTHREADS + tid; i < 2 * 4 * 128 * 128; i += G * NTHREADS) { const int s = i & 127, t = (i >> 7) & 127;
        ((bf16_t*)(ws + WS_SGWT))[i] = s <= t ? (bf16_t)(cvt_pk_bf16(a.in[5][i], 0.f) & 0xffffu) : (bf16_t)0; }
}

__device__ __forceinline__ void mixer_sg(unsigned char* ws, int l, LAS unsigned char* lds, int unit) {
    { size_t z_ = 0; asm volatile("" : "+s"(z_)); ws += z_; } int tid_ = threadIdx.x; asm volatile("" : "+v"(tid_));
    const float* par = (const float*)(ws + WS_PAR) + l * PAR_L;
    const int tid = tid_, lane = tid & 63, wave = __builtin_amdgcn_readfirstlane(tid >> 6);
    const int ck = unit >> 2, g = unit & 3, r0 = ck * 128;
    const bf16_t* ZA = (const bf16_t*)(ws + WS_ZA); bf16_t* YA = (bf16_t*)(ws + WS_YA);
    LAS bf16_t* vnT = (LAS bf16_t*)lds;
    const float* lng = par + P_SGLNG; const float* lnb = par + P_SGLNB;
    const f32x4 g0 = *(const f32x4*)(lng + 8 * lane), g1 = *(const f32x4*)(lng + 8 * lane + 4), b0 = *(const f32x4*)(lnb + 8 * lane), b1 = *(const f32x4*)(lnb + 8 * lane + 4);
    for (int s = wave; s < 128; s += NWAVES) {
        f32x4 x0, x1; unpack8(*(const u32x4*)(ZA + (size_t)(r0 + s) * 1024 + 512 + 8 * lane), x0, x1);
        const float mean = wave_sum((x0[0] + x0[1]) + (x0[2] + x0[3]) + (x1[0] + x1[1]) + (x1[2] + x1[3])) * (1.0f / 512.0f);
        x0 -= mean; x1 -= mean;
        const float var = wave_sum((x0[0] * x0[0] + x0[1] * x0[1]) + (x0[2] * x0[2] + x0[3] * x0[3]) + (x1[0] * x1[0] + x1[1] * x1[1]) + (x1[2] * x1[2] + x1[3] * x1[3])) * (1.0f / 512.0f);
        const float rstd = __builtin_amdgcn_rsqf(var + EPS);
        if ((lane >> 4) == g) { const int c = 8 * (lane & 15); x0 = x0 * rstd * g0 + b0; x1 = x1 * rstd * g1 + b1;
            const unsigned p0 = cvt_pk_bf16(x0[0], x0[1]), p1 = cvt_pk_bf16(x0[2], x0[3]), p2 = cvt_pk_bf16(x1[0], x1[1]), p3 = cvt_pk_bf16(x1[2], x1[3]);
            LAS bf16_t* d = vnT + c * 136 + s;
            d[0] = (bf16_t)p0; d[136] = (bf16_t)(p0 >> 16); d[2 * 136] = (bf16_t)p1; d[3 * 136] = (bf16_t)(p1 >> 16);
            d[4 * 136] = (bf16_t)p2; d[5 * 136] = (bf16_t)(p2 >> 16); d[6 * 136] = (bf16_t)p3; d[7 * 136] = (bf16_t)(p3 >> 16); }
    }
    __syncthreads();
    { const int fr = lane & 15, fq = lane >> 4, t0 = 16 * wave, nks = (wave >> 1) + 1;
      const bf16_t* W = (const bf16_t*)(ws + WS_SGWT) + (size_t)(l * 4 + g) * 16384 + (size_t)(t0 + fr) * 128 + 8 * fq;
      f32x4 acc[8];
#pragma unroll
      for (int ct = 0; ct < 8; ++ct) acc[ct] = (f32x4){0.f, 0.f, 0.f, 0.f};
      for (int ks = 0; ks < nks; ++ks) {
          const bf16x8 wf = *(const bf16x8*)(W + 32 * ks);
#pragma unroll
          for (int ct = 0; ct < 8; ++ct) { const bf16x8 vf = *(const LAS bf16x8*)(vnT + (16 * ct + fr) * 136 + 32 * ks + 8 * fq);
              acc[ct] = __builtin_amdgcn_mfma_f32_16x16x32_bf16(vf, wf, acc[ct], 0, 0, 0); }
      }
      const int t = t0 + fr; const size_t row = r0 + t; const float bs = par[P_SGB + g * 128 + t];
#pragma unroll
      for (int ct = 0; ct < 8; ++ct) { const int c = 128 * g + 16 * ct + 4 * fq;
          const u32x2 uu = *(const u32x2*)(ZA + row * 1024 + c);
          const float o0 = bf_lo(uu.x) * (acc[ct][0] + bs), o1 = bf_hi(uu.x) * (acc[ct][1] + bs), o2 = bf_lo(uu.y) * (acc[ct][2] + bs), o3 = bf_hi(uu.y) * (acc[ct][3] + bs);
          *(u32x2*)(YA + row * 512 + c) = (u32x2){cvt_pk_bf16(o0, o1), cvt_pk_bf16(o2, o3)}; }
    }
    __syncthreads();
}
__device__ __forceinline__ void mixer_conv(unsigned char* ws, int l, LAS unsigned char* lds, int unit) {
    { size_t z_ = 0; asm volatile("" : "+s"(z_)); ws += z_; } int tid_ = threadIdx.x; asm volatile("" : "+v"(tid_));
    const float* par = (const float*)(ws + WS_PAR) + l * PAR_L;
    const int tid = tid_, lane = tid & 63, wave = tid >> 6;
    const int b = unit >> 6, tb = unit & 63, t0 = tb * 32; const size_t rbase = (size_t)b * SEQ;
    const bf16_t* GLU = (const bf16_t*)(ws + WS_GLU); bf16_t* YB = (bf16_t*)(ws + WS_YB);
    LAS bf16_t* in = (LAS bf16_t*)lds;
    LAS float* cv = (LAS float*)(lds + 65536);
    for (int i = tid; i < 62 * 64; i += NTHREADS) { const int r = i >> 6, ch = i & 63; const int t = t0 - 30 + r;
        u32x4 v = {0u, 0u, 0u, 0u}; if (t >= 0) v = *(const u32x4*)(GLU + (rbase + t) * 512 + 8 * ch);
        *(LAS u32x4*)(in + r * 512 + 8 * ch) = v; }
    __syncthreads();
    { const int c = tid; float w[31], x[62];
#pragma unroll
      for (int k = 0; k < 31; ++k) w[k] = par[P_CVW + k * 512 + c];
#pragma unroll
      for (int r = 0; r < 62; ++r) x[r] = bf1(in[r * 512 + c]);
      const float bias = par[P_CVB + c];
#pragma unroll
      for (int t = 0; t < 32; ++t) { float s = bias;
#pragma unroll
          for (int k = 0; k < 31; ++k) s += w[k] * x[t + k];
          cv[t * 512 + c] = s; } }
    __syncthreads();
    { const float* lng = par + P_CVLNG; const float* lnb = par + P_CVLNB;
      const f32x4 g0 = *(const f32x4*)(lng + 8 * lane), g1 = *(const f32x4*)(lng + 8 * lane + 4), b0 = *(const f32x4*)(lnb + 8 * lane), b1 = *(const f32x4*)(lnb + 8 * lane + 4);
      for (int t = wave; t < 32; t += NWAVES) {
          f32x4 x0 = *(const LAS f32x4*)(cv + t * 512 + 8 * lane), x1 = *(const LAS f32x4*)(cv + t * 512 + 8 * lane + 4);
          const float mean = wave_sum((x0[0] + x0[1]) + (x0[2] + x0[3]) + (x1[0] + x1[1]) + (x1[2] + x1[3])) * (1.0f / 512.0f);
          x0 -= mean; x1 -= mean;
          const float var = wave_sum((x0[0] * x0[0] + x0[1] * x0[1]) + (x0[2] * x0[2] + x0[3] * x0[3]) + (x1[0] * x1[0] + x1[1] * x1[1]) + (x1[2] * x1[2] + x1[3] * x1[3])) * (1.0f / 512.0f);
          const float rstd = __builtin_amdgcn_rsqf(var + EPS);
          x0 = x0 * rstd * g0 + b0; x1 = x1 * rstd * g1 + b1;
#pragma unroll
          for (int j = 0; j < 4; ++j) { x0[j] = x0[j] * sigmoidf_(x0[j]); x1[j] = x1[j] * sigmoidf_(x1[j]); }
          *(u32x4*)(YB + (rbase + t0 + t) * 512 + 8 * lane) = pack8(x0, x1); } }
    __syncthreads();
}
__device__ __forceinline__ void mixer_attn(unsigned char* ws, int l, LAS unsigned char* lds, int unit) {
    { size_t z_ = 0; asm volatile("" : "+s"(z_)); ws += z_; } int tid_ = threadIdx.x; asm volatile("" : "+v"(tid_));
    const float* par = (const float*)(ws + WS_PAR) + l * PAR_L;
    const int tid = tid_, lane = tid & 63, wave = __builtin_amdgcn_readfirstlane(tid >> 6), fr = lane & 15, fq = lane >> 4;
    const int kvh = unit & 1, blk = (unit >> 1) & 15, b = unit >> 5; const size_t rbase = (size_t)b * SEQ;
    bf16_t* Q = (bf16_t*)(ws + WS_Q); const bf16_t* K = (const bf16_t*)(ws + WS_K); const bf16_t* V = (const bf16_t*)(ws + WS_V);
    LAS bf16_t* Kl = (LAS bf16_t*)lds;
    LAS bf16_t* VT = (LAS bf16_t*)(lds + 36864);
    for (int i = tid; i < 256 * 8; i += NTHREADS) { const int r = i >> 3, ch = i & 7; const int t = (blk - 1) * 128 + r;
        u32x4 kv = {0u, 0u, 0u, 0u}, vv = {0u, 0u, 0u, 0u};
        if (t >= 0) { kv = *(const u32x4*)(K + (rbase + t) * 128 + kvh * 64 + 8 * ch); vv = *(const u32x4*)(V + (rbase + t) * 128 + kvh * 64 + 8 * ch); }
        *(LAS u32x4*)(Kl + r * 72 + 8 * ch) = kv;
        LAS bf16_t* d = VT + (8 * ch) * 264 + r;
        d[0] = (bf16_t)vv.x; d[264] = (bf16_t)(vv.x >> 16); d[2 * 264] = (bf16_t)vv.y; d[3 * 264] = (bf16_t)(vv.y >> 16);
        d[4 * 264] = (bf16_t)vv.z; d[5 * 264] = (bf16_t)(vv.z >> 16); d[6 * 264] = (bf16_t)vv.w; d[7 * 264] = (bf16_t)(vv.w >> 16); }
    __syncthreads();
    const int g = wave >> 1, head = kvh * 4 + g; const float sink = par[P_SINK + head];
    for (int it = 0; it < 2; ++it) {
        const int qs = 2 * (wave & 1) + it, qi0 = 32 * qs; const size_t qrow0 = rbase + blk * 128 + qi0;
        bf16x8 qf[2][2];
#pragma unroll
        for (int qt = 0; qt < 2; ++qt)
#pragma unroll
            for (int ks = 0; ks < 2; ++ks) qf[qt][ks] = *(const bf16x8*)(Q + (qrow0 + 16 * qt + fr) * 512 + head * 64 + 32 * ks + 8 * fq);
        f32x4 S[2][10];
#pragma unroll
        for (int qt = 0; qt < 2; ++qt)
#pragma unroll
            for (int kt = 0; kt < 10; ++kt) S[qt][kt] = (f32x4){0.f, 0.f, 0.f, 0.f};
#pragma unroll
        for (int kt = 0; kt < 10; ++kt)
#pragma unroll
            for (int ks = 0; ks < 2; ++ks) { const bf16x8 kf = *(const LAS bf16x8*)(Kl + (qi0 + 16 * kt + fr) * 72 + 32 * ks + 8 * fq);
#pragma unroll
                for (int qt = 0; qt < 2; ++qt) S[qt][kt] = __builtin_amdgcn_mfma_f32_16x16x32_bf16(kf, qf[qt][ks], S[qt][kt], 0, 0, 0); }
        bf16x8 pf[2][5];
#pragma unroll
        for (int qt = 0; qt < 2; ++qt) { const int qi = qi0 + 16 * qt + fr; float mx = sink;
#pragma unroll
            for (int kt = 0; kt < 10; ++kt)
#pragma unroll
                for (int j = 0; j < 4; ++j) { const int kb = qi0 + 16 * kt + 4 * fq + j; const bool valid = (kb > qi) && (kb <= qi + 128) && (blk > 0 || kb >= 128);
                    const float sv = valid ? S[qt][kt][j] : -INFINITY; S[qt][kt][j] = sv; mx = fmaxf(mx, sv); }
            mx = fmaxf(mx, __shfl_xor(mx, 16)); mx = fmaxf(mx, __shfl_xor(mx, 32));
            float sum = 0.f;
#pragma unroll
            for (int kt = 0; kt < 10; ++kt)
#pragma unroll
                for (int j = 0; j < 4; ++j) { const float p = __expf(S[qt][kt][j] - mx); S[qt][kt][j] = p; sum += p; }
            sum += __shfl_xor(sum, 16); sum += __shfl_xor(sum, 32);
            const float inv = 1.0f / (sum + __expf(sink - mx));
#pragma unroll
            for (int p = 0; p < 5; ++p) { const f32x4 a0 = S[qt][2 * p] * inv, a1 = S[qt][2 * p + 1] * inv; pf[qt][p] = __builtin_bit_cast(bf16x8, pack8(a0, a1)); }
        }
        f32x4 o[2][4];
#pragma unroll
        for (int qt = 0; qt < 2; ++qt)
#pragma unroll
            for (int dt = 0; dt < 4; ++dt) o[qt][dt] = (f32x4){0.f, 0.f, 0.f, 0.f};
#pragma unroll
        for (int p = 0; p < 5; ++p)
#pragma unroll
            for (int dt = 0; dt < 4; ++dt) { const LAS bf16_t* vp = VT + (16 * dt + fr) * 264 + qi0 + 32 * p + 4 * fq;
                const u32x2 lo = *(const LAS u32x2*)vp, hi = *(const LAS u32x2*)(vp + 16);
                const bf16x8 vf = __builtin_bit_cast(bf16x8, (u32x4){lo.x, lo.y, hi.x, hi.y});
#pragma unroll
                for (int qt = 0; qt < 2; ++qt) o[qt][dt] = __builtin_amdgcn_mfma_f32_16x16x32_bf16(vf, pf[qt][p], o[qt][dt], 0, 0, 0); }
#pragma unroll
        for (int qt = 0; qt < 2; ++qt)
#pragma unroll
            for (int dt = 0; dt < 4; ++dt) *(u32x2*)(Q + (qrow0 + 16 * qt + fr) * 512 + head * 64 + 16 * dt + 4 * fq) = (u32x2){cvt_pk_bf16(o[qt][dt][0], o[qt][dt][1]), cvt_pk_bf16(o[qt][dt][2], o[qt][dt][3])};
    }
    __syncthreads();
}
__device__ __forceinline__ void mixer_sc(unsigned char* ws, int l, int G) {
    { size_t z_ = 0; asm volatile("" : "+s"(z_)); ws += z_; } int tid_ = threadIdx.x; asm volatile("" : "+v"(tid_));
    bf16_t* BG = (bf16_t*)(ws + WS_BG); const bf16_t* CH = (const bf16_t*)(ws + WS_CH);
    const float* w = (const float*)(ws + WS_PAR) + l * PAR_L + P_SCW;
    for (int i = blockIdx.x * NTHREADS + tid_; i < M * 64; i += G * NTHREADS) {
        const int row = i >> 6, c = 8 * (i & 63), t = row & (SEQ - 1);
        f32x4 a0 = {0.f, 0.f, 0.f, 0.f}, a1 = a0;
#pragma unroll
        for (int k = 0; k < 3; ++k) { if (t - 2 + k >= 0) { f32x4 x0, x1; unpack8(*(const u32x4*)(CH + (size_t)(row - 2 + k) * 512 + c), x0, x1);
            a0 += x0 * *(const f32x4*)(w + k * 512 + c); a1 += x1 * *(const f32x4*)(w + k * 512 + c + 4); } }
        f32x4 g0, g1; unpack8(*(const u32x4*)(BG + (size_t)row * 512 + c), g0, g1);
        *(u32x4*)(BG + (size_t)row * 512 + c) = pack8(g0 * a0, g1 * a1);
    }
}

#define RLX_AGENT __ATOMIC_RELAXED, __HIP_MEMORY_SCOPE_AGENT
#define XB_TMO      128
#define XB_XCNT(j)  (256  + 64 * (j))
#define XB_XSUB(j)  (1280 + 64 * (j))
#define XB_XGEN(j)  (2304 + 64 * (j))
#define XB_TOP      3328
#define XB_TOPGEN   3392
#define XCD_BAR_WORDS 3456
#define XB_SPIN_CAP (1u << 18)

__device__ __forceinline__ unsigned xb_ld(unsigned* p)              { return __hip_atomic_load(p, __ATOMIC_RELAXED, __HIP_MEMORY_SCOPE_AGENT); }
__device__ __forceinline__ unsigned xb_add(unsigned* p, unsigned v) { return __hip_atomic_fetch_add(p, v, __ATOMIC_RELAXED, __HIP_MEMORY_SCOPE_AGENT); }
__device__ __forceinline__ unsigned xb_xcc_id() { return (unsigned)__builtin_amdgcn_s_getreg((3 << 11) | 20) & 0xFu; }
#define XB_SPIN(cond, bar) do { unsigned _sp = 0; while (cond) { __builtin_amdgcn_s_sleep(1); \
    if ((++_sp & 255u) == 0u) { if (xb_ld(&(bar)[XB_TMO])) break; if (_sp > XB_SPIN_CAP) { atomicAdd(&(bar)[XB_TMO], 1u); break; } } } } while (0)

struct XcdBarrier {
    unsigned* bar; unsigned x;
    volatile LAS unsigned* st;
};

__device__ __forceinline__ XcdBarrier xcd_barrier_post(unsigned* bar, volatile LAS unsigned* st) {
    XcdBarrier b; b.bar = bar; b.x = xb_xcc_id(); b.st = st;
    if (threadIdx.x == 0) (void)xb_add(&bar[XB_XCNT(b.x)], 1u);
    return b;
}
__device__ __forceinline__ void xcd_barrier_complete(unsigned* bar, unsigned x, unsigned& nloc, unsigned& nx) {
    const unsigned G = gridDim.x * gridDim.y * gridDim.z;
    unsigned sum, cnt, mine, sp = 0u;
    for (;;) {
        sum = 0u; cnt = 0u; mine = 0u;
#pragma unroll
        for (unsigned j = 0; j < 16; ++j) { const unsigned c = xb_ld(&bar[XB_XCNT(j)]); sum += c; cnt += (c > 0u) ? 1u : 0u; mine = (j == x) ? c : mine; }
        if (sum == G) break;
        __builtin_amdgcn_s_sleep(1);
        if ((++sp & 255u) == 0u) { if (xb_ld(&bar[XB_TMO])) break; if (sp > XB_SPIN_CAP) { atomicAdd(&bar[XB_TMO], 1u); break; } }
    }
    nloc = mine > 0u ? mine : 1u; nx = cnt > 0u ? cnt : 1u;
}

__device__ __forceinline__ void xcd_barrier(const XcdBarrier& b) {
    asm volatile("s_waitcnt vmcnt(0)" ::: "memory");
    __syncthreads();
    if (threadIdx.x == 0) {
        unsigned* bar = b.bar;
        __builtin_amdgcn_s_waitcnt(0);
        unsigned nloc = b.st[0], nx = b.st[1];
        if (nloc == 0u) { xcd_barrier_complete(bar, b.x, nloc, nx); b.st[0] = nloc; b.st[1] = nx; }
        const unsigned old = xb_add(&bar[XB_XSUB(b.x)], 1u);
        const unsigned gen = old / nloc;
        if (old + 1u == (gen + 1u) * nloc) {
            __builtin_amdgcn_fence(__ATOMIC_RELEASE, "agent");
            asm volatile("s_waitcnt vmcnt(0)" ::: "memory");
            const unsigned og = xb_add(&bar[XB_TOP], 1u);
            const unsigned tg = og / nx;
            if (og + 1u == (tg + 1u) * nx) xb_add(&bar[XB_TOPGEN], 1u);
            else XB_SPIN(xb_ld(&bar[XB_TOPGEN]) == tg, bar);
            __builtin_amdgcn_fence(__ATOMIC_ACQUIRE, "agent");
            xb_add(&bar[XB_XGEN(b.x)], 1u);
            asm volatile("s_waitcnt vmcnt(0)" ::: "memory");
        } else {
            XB_SPIN(xb_ld(&bar[XB_XGEN(b.x)]) == gen, bar);
            __builtin_amdgcn_fence(__ATOMIC_ACQUIRE, "agent");
            asm volatile("s_waitcnt vmcnt(0)" ::: "memory");
        }
    }
    __syncthreads();
}


#ifdef DBG_STAGE
__device__ __forceinline__ void dbg_dump(float* out, const bf16_t* src, int ld, int ncols, int c0, int G) {
    for (long i = (long)blockIdx.x * NTHREADS + threadIdx.x; i < (long)M * ncols; i += (long)G * NTHREADS) { const int row = (int)(i / ncols), c = (int)(i % ncols); out[(size_t)row * D + c0 + c] = bf1(src[(size_t)row * ld + c]); }
}
#endif
#define GRID_SYNC() do { XcdBarrier xb_; xb_.bar = (unsigned*)(ws + WS_BAR); xb_.x = xb_xcc_id(); xb_.st = (volatile LAS unsigned*)(lds + MISC_OFF); xcd_barrier(xb_); } while (0)
__global__ void __launch_bounds__(NTHREADS, 2) fwd_megakernel(Args a) {
    extern __shared__ __attribute__((aligned(16))) unsigned char lds_raw[];
    LAS unsigned char* lds = (LAS unsigned char*)lds_raw;
    cg::grid_group grid = cg::this_grid();
    const int G = gridDim.x, c = blockIdx.x;
    unsigned char* ws = a.ws;
    float* ssq = (float*)(ws + WS_SSQ);

    { volatile LAS unsigned* misc = (volatile LAS unsigned*)(lds + MISC_OFF); if (threadIdx.x < 16) misc[threadIdx.x] = 0u; }
    __syncthreads();
    grid.sync();
    (void)xcd_barrier_post((unsigned*)(ws + WS_BAR), (volatile LAS unsigned*)(lds + MISC_OFF));
    prologue(a, lds, G);
    GRID_SYNC();

    for (int l = 0; l < 2; ++l) {
        { size_t z_ = 0; asm volatile("" : "+s"(z_)); ws += z_; } ssq = (float*)(ws + WS_SSQ);
        const float* ssq_mix = ssq + (size_t)(2 * l) * M;
        { pg8::SchedGrid S; S.nM = 64; S.nN = 17; S.nwg = 64 * 17; S.G = G; S.c = c; S.A = (const char*)(ws + WS_XB); S.B = (const char*)(ws + WS_WIN + l * WIN_L); S.lda2 = 2048; S.ldb2 = 2048; S.nt = 16;
          EpiInProj E{ssq_mix, ws};
#ifdef MULTI_UNIT
          pg8::gemm_phase<EpiInProj, pg8::SchedGrid, true>(lds, S, E);
#else
          for (int i = 0; i < 5; ++i) { pg8::SchedOneG S1; S1.S = S; S1.i0 = i; pg8::gemm_phase<EpiInProj, pg8::SchedOneG, false>(lds, S1, E); }
#endif
        }
        GRID_SYNC(); { size_t z_ = 0; asm volatile("" : "+s"(z_)); ws += z_; }
#if defined(DBG_STAGE) && DBG_STAGE == 1
        if (l == 0) { dbg_dump(a.out, (const bf16_t*)(ws + WS_ZA), 1024, 1024, 0, G); return; }
#endif
        for (int u = c; u < 512; u += G) mixer_sg(ws, l, lds, u);
        for (int u = c; u < 512; u += G) mixer_conv(ws, l, lds, u);
        for (int u = c; u < 256; u += G) mixer_attn(ws, l, lds, u);
        mixer_sc(ws, l, G);
        GRID_SYNC(); { size_t z_ = 0; asm volatile("" : "+s"(z_)); ws += z_; } ssq = (float*)(ws + WS_SSQ);
        #if defined(DBG_STAGE) && DBG_STAGE == 2
        if (l == 0) { dbg_dump(a.out, (const bf16_t*)(ws + WS_YA), 512, 512, 0, G); dbg_dump(a.out, (const bf16_t*)(ws + WS_YB), 512, 512, 512, G); return; }
#endif
#if defined(DBG_STAGE) && DBG_STAGE == 22
        if (l == 0) { dbg_dump(a.out, (const bf16_t*)(ws + WS_Q), 512, 512, 0, G); dbg_dump(a.out, (const bf16_t*)(ws + WS_BG), 512, 512, 512, G); return; }
#endif
        { pg8::SchedMerge S; S.G = G; S.c = c; S.ws = (const char*)ws; S.WG = (const char*)(ws + WS_WIN + l * WIN_L) + (size_t)NLOG1 * 2048;
          S.WBR = (const char*)(ws + WS_WBR + l * WBR_L);
          EpiStashB ES{(bf16_t*)(ws + WS_MG)}; EpiGateAcc EA{ssq_mix, (bf16_t*)(ws + WS_MG), (bf16_t*)(ws + WS_TMP)};
#ifdef MERGE_MULTI
          S.swap = 1; EpiMerge2 E2{ES, EA};
          pg8::gemm_phase<EpiMerge2, pg8::SchedMerge, true>(lds, S, E2);
#else
          S.swap = 0;
          for (int br = 0; br < 4; ++br) {
              { pg8::SchedOne S1; S1.M = S; S1.i0 = 2 * br + 1; pg8::gemm_phase<EpiStashB, pg8::SchedOne, false>(lds, S1, ES); }
              { pg8::SchedOne S1; S1.M = S; S1.i0 = 2 * br; pg8::gemm_phase<EpiGateAcc, pg8::SchedOne, false>(lds, S1, EA); }
          }
#endif
        }
        GRID_SYNC(); { size_t z_ = 0; asm volatile("" : "+s"(z_)); ws += z_; } ssq = (float*)(ws + WS_SSQ);
        #if defined(DBG_STAGE) && DBG_STAGE == 3
        if (l == 0) { dbg_dump(a.out, (const bf16_t*)(ws + WS_MG), 1024, 1024, 0, G); return; }
#endif
        { pg8::SchedGrid S; S.nM = 64; S.nN = 4; S.nwg = 256; S.G = G; S.c = c; S.A = (const char*)(ws + WS_MG); S.B = (const char*)(ws + WS_WOUT + l * WOUT_L); S.lda2 = 2048; S.ldb2 = 2048; S.nt = 16;
          EpiResid E{l == 0 ? a.in[0] : a.out, a.out, (bf16_t*)(ws + WS_XB), ssq + (size_t)(2 * l + 1) * M};
          pg8::gemm_phase<EpiResid, pg8::SchedGrid, false>(lds, S, E); }
        GRID_SYNC(); { size_t z_ = 0; asm volatile("" : "+s"(z_)); ws += z_; } ssq = (float*)(ws + WS_SSQ);
        #if defined(DBG_STAGE) && DBG_STAGE == 4
        if (l == 0) return;
#endif
        { pg8::SchedGrid S; S.nM = 64; S.nN = 22; S.nwg = 64 * 22; S.G = G; S.c = c; S.A = (const char*)(ws + WS_XB); S.B = (const char*)(ws + WS_WGU + l * WGU_L); S.lda2 = 2048; S.ldb2 = 2048; S.nt = 16;
          EpiSwiGLU E{ssq + (size_t)(2 * l + 1) * M, (bf16_t*)(ws + WS_ACT), ABL_FFN_SCALE(l)};
#ifdef MULTI_UNIT
          pg8::gemm_phase<EpiSwiGLU, pg8::SchedGrid, true>(lds, S, E);
#else
          for (int i = 0; i < 6; ++i) { pg8::SchedOneG S1; S1.S = S; S1.i0 = i; pg8::gemm_phase<EpiSwiGLU, pg8::SchedOneG, false>(lds, S1, E); }
#endif
        }
        GRID_SYNC(); { size_t z_ = 0; asm volatile("" : "+s"(z_)); ws += z_; } ssq = (float*)(ws + WS_SSQ);
        #if defined(DBG_STAGE) && DBG_STAGE == 5
        if (l == 0) { dbg_dump(a.out, (const bf16_t*)(ws + WS_ACT), DFF, 1024, 0, G); return; }
#endif
        { pg8::SchedGrid S; S.nM = 64; S.nN = 4; S.nwg = 256; S.G = G; S.c = c; S.A = (const char*)(ws + WS_ACT); S.B = (const char*)(ws + WS_WDN + l * WDN_L); S.lda2 = DFF * 2; S.ldb2 = DFF * 2; S.nt = DFF / 64;
          EpiResid E{a.out, a.out, (bf16_t*)(ws + WS_XB), ssq + (size_t)(2 * l + 2) * M};
          pg8::gemm_phase<EpiResid, pg8::SchedGrid, false>(lds, S, E); }
        GRID_SYNC();
#if defined(DBG_STAGE) && DBG_STAGE == 6
        if (l == 0) return;
#endif
    }
    { { size_t z_ = 0; asm volatile("" : "+s"(z_)); ws += z_; } int tid_ = threadIdx.x; asm volatile("" : "+v"(tid_));
      const int lane = tid_ & 63, gw = c * NWAVES + (tid_ >> 6), NGW = G * NWAVES; const float* gf = (const float*)(ws + WS_PAR) + P_FINAL; const float* sq = (const float*)(ws + WS_SSQ) + (size_t)4 * M;
      for (int row = gw; row < M; row += NGW) { const float rs = row_rs(sq, row); f32x4* xr = (f32x4*)(a.out + (size_t)row * D) + lane;
#pragma unroll
          for (int j = 0; j < 4; ++j) xr[64 * j] = xr[64 * j] * rs * ((const f32x4*)gf)[64 * j + lane]; } }
}

extern "C" void kernel_launch(void* const* d_in, const int* in_sizes, int n_in, void* d_out, int out_size, void* d_ws, size_t ws_size, hipStream_t stream) {
    static int grid = 0;
    if (grid == 0) {
        if (n_in != 19 || out_size != M * D || ws_size < WS_END) { fprintf(stderr, "kernel_launch: unexpected shapes (n_in %d out %d ws %zu)\n", n_in, out_size, ws_size); grid = -1; return; }
        int dev = 0, cus = 0, per_cu = 0;
        if (hipGetDevice(&dev) != hipSuccess || hipDeviceGetAttribute(&cus, hipDeviceAttributeMultiprocessorCount, dev) != hipSuccess) { grid = -1; return; }
        if (hipFuncSetAttribute((const void*)fwd_megakernel, hipFuncAttributeMaxDynamicSharedMemorySize, LDS_BYTES) != hipSuccess) { fprintf(stderr, "kernel_launch: hipFuncSetAttribute failed\n"); grid = -1; return; }
        if (hipOccupancyMaxActiveBlocksPerMultiprocessor(&per_cu, (const void*)fwd_megakernel, NTHREADS, LDS_BYTES) != hipSuccess || per_cu < 1) { fprintf(stderr, "kernel_launch: occupancy query says %d\n", per_cu); per_cu = 1; }
        (void)hipGetLastError();
        grid = cus * 1;
    }
    if (grid < 0) return;
    if (hipMemsetAsync((char*)d_ws + WS_BAR, 0, 16384, stream) != hipSuccess) { fprintf(stderr, "kernel_launch: memset failed\n"); return; }
    Args a{};
    for (int i = 0; i < 19; ++i) a.in[i] = (const float*)d_in[i];
    a.out = (float*)d_out; a.ws = (unsigned char*)d_ws;
    void* args[] = {&a};
    hipError_t e = hipLaunchCooperativeKernel((const void*)fwd_megakernel, dim3(grid), dim3(NTHREADS), args, LDS_BYTES, stream);
    if (e != hipSuccess) fprintf(stderr, "cooperative launch failed: %s (grid %d)\n", hipGetErrorString(e), grid);
}
```

```cpp
#define MERGE_MULTI 1
#define MULTI_UNIT 1
#include <hip/hip_runtime.h>
#include <hip/hip_cooperative_groups.h>
#include <cstdio>
#include <cstdint>
namespace cg = cooperative_groups;

#define LAS __attribute__((address_space(3)))
typedef unsigned short bf16_t;
typedef short bf16x8 __attribute__((ext_vector_type(8)));
typedef float f32x4 __attribute__((ext_vector_type(4)));
typedef float f32x2 __attribute__((ext_vector_type(2)));
typedef unsigned u32x4 __attribute__((ext_vector_type(4)));
typedef unsigned u32x2 __attribute__((ext_vector_type(2)));

constexpr int M = 16384, D = 1024, SEQ = 2048, NBATCH = 8, DFF = 2816, PROJ = 8448, NLOG1 = 4352  ;
constexpr float EPS = 1e-6f;
constexpr int NTHREADS = 512, NWAVES = 8;
constexpr int LDS_BYTES = 147456;

constexpr size_t MiB = 1u << 20;
constexpr size_t WS_SSQ = 248 * (size_t)(1u << 20);
constexpr size_t WS_PAR = 512 * 1024;
constexpr int PAR_L = 24576, P_SGLNG = 0, P_SGLNB = 512, P_SGB = 1024, P_CVB = 1536, P_CVLNG = 2048, P_CVLNB = 2560, P_SCW = 3072, P_SINK = 4608, P_CVW = 4672, P_FINAL = 2 * PAR_L;
constexpr size_t WS_BAR = 768 * 1024;
constexpr int MISC_OFF = 147200;
constexpr size_t WS_ROPEC = 1 * MiB, WS_ROPES = 1 * MiB + 256 * 1024;
constexpr size_t WS_SGWT = 1 * MiB + 512 * 1024;
constexpr size_t WS_WIN = 2 * MiB, WIN_L = (size_t)PROJ * D * 2;
constexpr size_t WS_WBR = 35 * MiB, WBR_L = 4 * MiB;
constexpr size_t WS_WOUT = 43 * MiB, WOUT_L = 2 * MiB;
constexpr size_t WS_WGU = 47 * MiB, WGU_L = 11 * MiB;
constexpr size_t WS_WDN = 69 * MiB, WDN_L = (size_t)D * DFF * 2;
constexpr size_t WS_XB = 80 * MiB;
constexpr size_t WS_ZA = 112 * MiB;
constexpr size_t WS_MG = WS_ZA;
constexpr size_t WS_GLU = 144 * MiB;
constexpr size_t WS_CH = 160 * MiB;
constexpr size_t WS_TMP = WS_GLU;
constexpr size_t WS_Q = 176 * MiB;
constexpr size_t WS_BG = 192 * MiB;
constexpr size_t WS_K = 208 * MiB, WS_V = 212 * MiB;
constexpr size_t WS_YA = 216 * MiB, WS_YB = 232 * MiB;
constexpr size_t WS_ACT = 112 * MiB;
constexpr size_t WS_END = 254 * MiB;

__device__ const double INVF_REV[32] = {0.15915494309189535, 0.11934937021124886, 0.08949940160889101, 0.06711508300522726, 0.050329212104487035, 0.03774158471741977, 0.0283021958306234, 0.02122365276477766, 0.015915494309189534, 0.011934937021124886, 0.008949940160889102, 0.006711508300522725, 0.005032921210448704, 0.003774158471741977, 0.00283021958306234, 0.0021223652764777662, 0.0015915494309189536, 0.0011934937021124885, 0.0008949940160889102, 0.0006711508300522726, 0.0005032921210448703, 0.00037741584717419774, 0.00028302195830623395, 0.0002122365276477766, 0.00015915494309189535, 0.00011934937021124886, 8.949940160889102e-05, 6.711508300522725e-05, 5.0329212104487035e-05, 3.774158471741978e-05, 2.8302195830623396e-05, 2.122365276477766e-05};

__device__ __forceinline__ unsigned cvt_pk_bf16(float lo, float hi) { unsigned r; asm volatile("v_cvt_pk_bf16_f32 %0, %1, %2" : "=v"(r) : "v"(lo), "v"(hi)); return r; }
__device__ __forceinline__ float bf_lo(unsigned u) { return __builtin_bit_cast(float, u << 16); }
__device__ __forceinline__ float bf_hi(unsigned u) { return __builtin_bit_cast(float, u & 0xffff0000u); }
__device__ __forceinline__ float bf1(bf16_t h) { return __builtin_bit_cast(float, ((unsigned)h) << 16); }
__device__ __forceinline__ float sigmoidf_(float x) { return __builtin_amdgcn_rcpf(1.0f + __expf(-x)); }
__device__ __forceinline__ float wave_sum(float v) {
#pragma unroll
    for (int o = 1; o < 64; o <<= 1) v += __shfl_xor(v, o);
    return v;
}
__device__ __forceinline__ f32x2 gelu_pk(f32x2 v) {
    const f32x2 av = __builtin_elementwise_abs(v), d = av * 0.2316418882f + 1.0f;
    f32x2 t; t.x = __builtin_amdgcn_rcpf(d.x); t.y = __builtin_amdgcn_rcpf(d.y);
    f32x2 q = t * 0.5307027145f + (-0.7265760135f); q = q * t + 0.7107068705f; q = q * t + (-0.142248368f); q = q * t + 0.127414796f; q = q * t;
    const f32x2 s = (v * v) * (-0.72134752044f);
    f32x2 e; e.x = __builtin_amdgcn_exp2f(s.x); e.y = __builtin_amdgcn_exp2f(s.y);
    const f32x2 m = v * (q * e), r = v - m;
    f32x2 o; o.x = v.x < 0.f ? m.x : r.x; o.y = v.y < 0.f ? m.y : r.y; return o;
}
__device__ __forceinline__ u32x4 pack8(f32x4 a, f32x4 b) { u32x4 w; w.x = cvt_pk_bf16(a[0], a[1]); w.y = cvt_pk_bf16(a[2], a[3]); w.z = cvt_pk_bf16(b[0], b[1]); w.w = cvt_pk_bf16(b[2], b[3]); return w; }
__device__ __forceinline__ void unpack8(u32x4 w, f32x4& a, f32x4& b) { a = (f32x4){bf_lo(w.x), bf_hi(w.x), bf_lo(w.y), bf_hi(w.y)}; b = (f32x4){bf_lo(w.z), bf_hi(w.z), bf_lo(w.w), bf_hi(w.w)}; }

namespace pg8 {
constexpr int BM = 256, BK = 64, HALF = 128, HTB = HALF * BK * 2, STAGE_BYTES = 8 * HTB, NXCD = 8, WGM = 8;
__host__ __device__ __forceinline__ int lds_byte(int r, int c) { const int st = (r >> 4) * 2 + (c >> 5), rr = r & 15, cc = c & 31, ob = rr * 64 + cc * 2; return st * 1024 + (ob ^ (((ob >> 9) & 1) << 5)); }
__host__ __device__ __forceinline__ void stage_rc(int b, int& R, int& C) { const int st = b / 1024, sb = b % 1024, swz = sb ^ (((sb >> 9) & 1) << 5); R = (st >> 1) * 16 + swz / 64; C = (st & 1) * 32 + (swz % 64) / 2; }
__host__ __device__ __forceinline__ int perm32(int rho) { const int n = rho >> 4, i = rho & 15; return 8 * (i >> 2) + 4 * n + (i & 3); }

struct Unit { const char* A; const char* B; int lda2, ldb2, nt, pm, pn, z; };

__device__ __forceinline__ void tile_of(int L, int nM, int nN, int& pm, int& pn) {
    const int nwg = nM * nN; int wgid = L; { const int q = nwg / NXCD, r = nwg % NXCD, xcd = wgid % NXCD, off = wgid / NXCD; wgid = (xcd < r ? xcd * (q + 1) : r * (q + 1) + (xcd - r) * q) + off; }
    const int nig = WGM * nN, gid = wgid / nig, fm = gid * WGM, gsz = (nM - fm) < WGM ? (nM - fm) : WGM;
    pm = fm + ((wgid % nig) % gsz); pn = (wgid % nig) / gsz;
}
struct SchedGrid {
    static constexpr bool VARLD = false;
    int nM, nN, nwg, G, c; const char* A; const char* B; int lda2, ldb2, nt;
    __device__ __forceinline__ bool next(int i, Unit& u) const {
        const long L = (long)i * G + c; if (L >= nwg) return false;
        tile_of((int)L, nM, nN, u.pm, u.pn); u.z = 0;
        u.A = A + (size_t)u.pm * 256 * lda2; u.B = B + (size_t)u.pn * 256 * ldb2; u.lda2 = lda2; u.ldb2 = ldb2; u.nt = nt; return true;
    }
};
struct SchedMerge {
    static constexpr bool VARLD = true;
    int G, c; const char* ws; const char* WG  ; const char* WBR; int swap;
    __device__ __forceinline__ bool next(int i, Unit& u) const {
        const int ti = i >> 3, sub = i & 7; const long L = (long)ti * G + c; if (L >= 256) return false;
        tile_of((int)L, 64, 4, u.pm, u.pn); u.z = sub; const int br = sub >> 1;
        if (((sub & 1) ^ swap) == 0) { u.A = ws + WS_XB + (size_t)u.pm * 256 * 2048; u.lda2 = 2048; u.B = WG + (size_t)(br * 1024 + u.pn * 256) * 2048; u.ldb2 = 2048; u.nt = 16; }
        else { const size_t yo = br == 0 ? WS_YA : br == 1 ? WS_YB : br == 2 ? WS_Q : WS_BG;
               u.A = ws + yo + (size_t)u.pm * 256 * 1024; u.lda2 = 1024; u.B = WBR + (size_t)br * (1024 * 512 * 2) + (size_t)u.pn * 256 * 1024; u.ldb2 = 1024; u.nt = 8; }
        return true;
    }
};

struct SchedOne {
    static constexpr bool VARLD = false;
    SchedMerge M; int i0;
    __device__ __forceinline__ bool next(int i, Unit& u) const { if (i != 0) return false; return M.next(i0, u); }
};
struct SchedOneG {
    static constexpr bool VARLD = false;
    SchedGrid S; int i0;
    __device__ __forceinline__ bool next(int i, Unit& u) const { if (i != 0) return false; return S.next(i0, u); }
};
template <class Epi, class Sched, bool ALIGN_EPI>
__device__ __forceinline__ void gemm_phase(LAS unsigned char* lds, const Sched& S, const Epi& E) {
    int tid_ = threadIdx.x; asm volatile("" : "+v"(tid_));
    const int tid = tid_, wid = __builtin_amdgcn_readfirstlane(tid >> 6), lane = tid & 63, wr = wid >> 2, wc = wid & 3, fr = lane & 15, fq = lane >> 4;
    unsigned rA[2], rB[2], cc2[2];
#pragma unroll
    for (int i = 0; i < 2; ++i) { int R, C; stage_rc(tid * 16 + i * 8192, R, C); rA[i] = (unsigned)R; rB[i] = (unsigned)((R & ~31) + perm32(R & 31)); cc2[i] = (unsigned)C * 2u; }
    const size_t kstep = (size_t)(BK * 2);
    const unsigned ldsw = (unsigned)wid * 1024u;
    const int aoff = lds_byte(wr * 64 + fr, fq * 8), boff = lds_byte(wc * 32 + fr, fq * 8);
#define PG8_SA(b, h) (((b) * 2 + (h)) * HTB)
#define PG8_SB(b, h) ((4 + (b) * 2 + (h)) * HTB)
#define PG8_STAGE(bufoff, gbase, voff) do { _Pragma("unroll") for (int _i = 0; _i < 2; ++_i) \
        __builtin_amdgcn_global_load_lds((const unsigned*)((const char*)(gbase) + (voff)[_i]), (LAS unsigned*)(lds + (bufoff) + ldsw + _i * 8192), 16, 0, 0); } while (0)
#define PG8_LDA(dst, b, h) do { _Pragma("unroll") for (int m = 0; m < 4; ++m) _Pragma("unroll") for (int k = 0; k < 2; ++k) dst[m][k] = *(const LAS bf16x8*)(lds + PG8_SA(b, h) + aoff + m * 2048 + k * 1024); } while (0)
#define PG8_LDB(dst, b, h) do { _Pragma("unroll") for (int n = 0; n < 2; ++n) _Pragma("unroll") for (int k = 0; k < 2; ++k) dst[n][k] = *(const LAS bf16x8*)(lds + PG8_SB(b, h) + boff + n * 2048 + k * 1024); } while (0)
#define PG8_MMA(ai, bj, At, Bt) do { __builtin_amdgcn_s_setprio(1); _Pragma("unroll") for (int m = 0; m < 4; ++m) _Pragma("unroll") for (int n = 0; n < 2; ++n) _Pragma("unroll") for (int k = 0; k < 2; ++k) \
        acc[ai][bj][m][n] = __builtin_amdgcn_mfma_f32_16x16x32_bf16(Bt[n][k], At[m][k], acc[ai][bj][m][n], 0, 0, 0); __builtin_amdgcn_s_setprio(0); } while (0)
#define PG8_WAIT_V(n) asm volatile("s_waitcnt vmcnt(" #n ")" ::: "memory")
#define PG8_WAIT_L(n) asm volatile("s_waitcnt lgkmcnt(" #n ")" ::: "memory")
#define PG8_BAR __builtin_amdgcn_s_barrier()
#define PG8_SCHED __builtin_amdgcn_sched_barrier(0)
    Unit cur, nxt; int ui = 0;
    if (!S.next(0, cur)) return;
    f32x4 acc[2][2][4][2];
#pragma unroll
    for (int a = 0; a < 2; ++a)
#pragma unroll
        for (int b = 0; b < 2; ++b)
#pragma unroll
            for (int m = 0; m < 4; ++m)
#pragma unroll
                for (int n = 0; n < 2; ++n) acc[a][b][m][n] = (f32x4){0.f, 0.f, 0.f, 0.f};
    bf16x8 At[4][2], B0[2][2], B1[2][2];
    unsigned voffA[2], voffB[2];
#pragma unroll
    for (int i = 0; i < 2; ++i) { voffA[i] = rA[i] * (unsigned)cur.lda2 + cc2[i]; voffB[i] = rB[i] * (unsigned)cur.ldb2 + cc2[i]; }
    const char* cA = cur.A; const char* cB = cur.B;
    unsigned hA = (unsigned)HALF * cur.lda2, hB = (unsigned)HALF * cur.ldb2;
    PG8_STAGE(PG8_SB(0, 0), cB, voffB); PG8_STAGE(PG8_SB(0, 1), cB + hB, voffB); PG8_STAGE(PG8_SA(0, 0), cA, voffA); PG8_STAGE(PG8_SA(0, 1), cA + hA, voffA);
    if (wr == 1) PG8_BAR;
    PG8_WAIT_V(2); PG8_BAR;
    PG8_STAGE(PG8_SB(1, 0), cB + kstep, voffB); PG8_STAGE(PG8_SA(1, 0), cA + kstep, voffA); PG8_STAGE(PG8_SB(1, 1), cB + hB + kstep, voffB);
    PG8_WAIT_V(6); PG8_BAR;
    for (;;) {
        const bool has_next = S.next(ui + 1, nxt);
        if (!has_next) nxt = cur;
        unsigned voffAn[2], voffBn[2];
#pragma unroll
        for (int i = 0; i < 2; ++i) { if constexpr (Sched::VARLD) { voffAn[i] = rA[i] * (unsigned)nxt.lda2 + cc2[i]; voffBn[i] = rB[i] * (unsigned)nxt.ldb2 + cc2[i]; } else { voffAn[i] = voffA[i]; voffBn[i] = voffB[i]; } }
        const char* nA = nxt.A; const char* nB = nxt.B;
        const unsigned hAn = Sched::VARLD ? (unsigned)HALF * nxt.lda2 : hA, hBn = Sched::VARLD ? (unsigned)HALF * nxt.ldb2 : hB;
        const int nt = cur.nt;
        for (int t = 0; t < nt; t += 2) {
            const bool last = (t == nt - 2);
            const char* a1 = cA + (size_t)(t + 1) * kstep;
            const char* a2 = last ? nA : cA + (size_t)(t + 2) * kstep; const char* b2 = last ? nB : cB + (size_t)(t + 2) * kstep;
            const char* a3 = a2 + kstep; const char* b3 = b2 + kstep;
            const unsigned hA2 = last ? hAn : hA, hB2 = last ? hBn : hB;
            unsigned vA2[2], vB2[2];
#pragma unroll
            for (int i = 0; i < 2; ++i) { vA2[i] = last ? voffAn[i] : voffA[i]; vB2[i] = last ? voffBn[i] : voffB[i]; }
            PG8_LDB(B0, 0, 0); PG8_LDB(B1, 0, 1); PG8_SCHED; PG8_LDA(At, 0, 0); PG8_STAGE(PG8_SA(1, 1), a1 + hA, voffA);
            PG8_WAIT_V(8); PG8_WAIT_L(0); PG8_BAR; PG8_MMA(0, 0, At, B0); PG8_MMA(0, 1, At, B1); PG8_BAR; PG8_SCHED;
            PG8_LDA(At, 0, 1); PG8_STAGE(PG8_SB(0, 0), b2, vB2); PG8_STAGE(PG8_SB(0, 1), b2 + hB2, vB2); PG8_STAGE(PG8_SA(0, 0), a2, vA2);
            PG8_WAIT_V(8); PG8_WAIT_L(0); PG8_BAR; PG8_MMA(1, 0, At, B0); PG8_MMA(1, 1, At, B1); PG8_BAR; PG8_SCHED;
            PG8_LDB(B0, 1, 0); PG8_LDB(B1, 1, 1); PG8_SCHED; PG8_LDA(At, 1, 0); PG8_STAGE(PG8_SA(0, 1), a2 + hA2, vA2);
            PG8_WAIT_V(8); PG8_WAIT_L(0); PG8_BAR; PG8_MMA(0, 0, At, B0); PG8_MMA(0, 1, At, B1); PG8_BAR; PG8_SCHED;
            PG8_LDA(At, 1, 1); PG8_STAGE(PG8_SB(1, 0), b3, vB2); PG8_STAGE(PG8_SB(1, 1), b3 + hB2, vB2); PG8_STAGE(PG8_SA(1, 0), a3, vA2);
            PG8_WAIT_V(8); PG8_WAIT_L(0); PG8_BAR; PG8_MMA(1, 0, At, B0); PG8_MMA(1, 1, At, B1); PG8_BAR; PG8_SCHED;
        }
        if constexpr (ALIGN_EPI) { if (wr == 0) PG8_BAR; }
        E(acc, cur, wr, wc, fr, fq);
        if (!has_next) break;
#pragma unroll
        for (int a = 0; a < 2; ++a)
#pragma unroll
            for (int b = 0; b < 2; ++b)
#pragma unroll
                for (int m = 0; m < 4; ++m)
#pragma unroll
                    for (int n = 0; n < 2; ++n) acc[a][b][m][n] = (f32x4){0.f, 0.f, 0.f, 0.f};
        cur = nxt; cA = nA; cB = nB; hA = hAn; hB = hBn; ++ui;
#pragma unroll
        for (int i = 0; i < 2; ++i) { voffA[i] = voffAn[i]; voffB[i] = voffBn[i]; }
        if constexpr (ALIGN_EPI) { if (wr == 1) PG8_BAR; }
    }
    PG8_WAIT_V(0);
    if constexpr (!ALIGN_EPI) { if (wr == 0) PG8_BAR; }
    PG8_BAR;
#undef PG8_SA
#undef PG8_SB
#undef PG8_STAGE
#undef PG8_LDA
#undef PG8_LDB
#undef PG8_MMA
#undef PG8_WAIT_V
#undef PG8_WAIT_L
#undef PG8_BAR
#undef PG8_SCHED
}
}

#define EPI_ROWLOOP _Pragma("unroll") for (int ai = 0; ai < 2; ++ai) _Pragma("unroll") for (int m = 0; m < 4; ++m)
__device__ __forceinline__ float row_rs(const float* ssq, int row) { const f32x4* p = (const f32x4*)(ssq + (size_t)row * 16); const f32x4 a = p[0], b = p[1], c = p[2], d = p[3];
    const float s = (((a[0] + a[1]) + (a[2] + a[3])) + ((b[0] + b[1]) + (b[2] + b[3]))) + (((c[0] + c[1]) + (c[2] + c[3])) + ((d[0] + d[1]) + (d[2] + d[3])));
    return __builtin_amdgcn_rsqf(s * (1.0f / D) + EPS); }

struct EpiInProj {
    const float* ssq; unsigned char* ws;
    __device__ __forceinline__ void operator()(const f32x4 (&acc)[2][2][4][2], const pg8::Unit& u, int wr, int wc, int fr, int fq) const {
        bf16_t* const ZA = (bf16_t*)(ws + WS_ZA); bf16_t* const GLU = (bf16_t*)(ws + WS_GLU); bf16_t* const BG = (bf16_t*)(ws + WS_BG); bf16_t* const CH = (bf16_t*)(ws + WS_CH);
        const float* const ropeC = (const float*)(ws + WS_ROPEC); const float* const ropeS = (const float*)(ws + WS_ROPES);
        const int T = u.pn, row0 = u.pm * 256 + wr * 64 + fr, jcol = wc * 32 + 8 * fq;
        if (T < 4) {
            EPI_ROWLOOP { const int row = row0 + ai * 128 + m * 16; const float rs = row_rs(ssq, row);
#pragma unroll
                for (int bj = 0; bj < 2; ++bj) { f32x4 v0 = acc[ai][bj][m][0] * rs, v1 = acc[ai][bj][m][1] * rs;
                    f32x2 a = gelu_pk((f32x2){v0[0], v0[1]}), b = gelu_pk((f32x2){v0[2], v0[3]}), c = gelu_pk((f32x2){v1[0], v1[1]}), d = gelu_pk((f32x2){v1[2], v1[3]});
                    *(u32x4*)(ZA + (size_t)row * 1024 + 256 * T + 128 * bj + jcol) = pack8((f32x4){a.x, a.y, b.x, b.y}, (f32x4){c.x, c.y, d.x, d.y}); } }
        } else if (T < 8) {
            EPI_ROWLOOP { const int row = row0 + ai * 128 + m * 16; const float rs = row_rs(ssq, row); f32x4 o[2];
#pragma unroll
                for (int n = 0; n < 2; ++n) { const f32x4 a = acc[ai][0][m][n] * rs, g = acc[ai][1][m][n] * rs;
#pragma unroll
                    for (int j = 0; j < 4; ++j) o[n][j] = a[j] * sigmoidf_(g[j]); }
                *(u32x4*)(GLU + (size_t)row * 512 + 128 * (T - 4) + jcol) = pack8(o[0], o[1]); }
        } else if (T < 11) {
            const bool isq = T < 10; const bool rope = isq || wc < 2; const float sc = isq ? 0.125f : 1.0f;
            const size_t boff = isq ? WS_Q : (wc < 2 ? WS_K : WS_V); bf16_t* const base = (bf16_t*)(ws + boff);
            const int ld = isq ? 512 : 128, hcol = isq ? (4 * (T - 8) + wc) * 64 : (wc & 1) * 64;
            EPI_ROWLOOP { const int row = row0 + ai * 128 + m * 16; const float rs = row_rs(ssq, row) * sc; const int pos = row & (SEQ - 1); f32x4 o1[2], o2[2];
#pragma unroll
                for (int n = 0; n < 2; ++n) { const f32x4 x1 = acc[ai][0][m][n] * rs, x2 = acc[ai][1][m][n] * rs;
                    if (rope) { const f32x4 c = *(const f32x4*)(ropeC + pos * 32 + 8 * fq + 4 * n), s = *(const f32x4*)(ropeS + pos * 32 + 8 * fq + 4 * n);
                        o1[n] = x1 * c - x2 * s; o2[n] = x2 * c + x1 * s; } else { o1[n] = x1; o2[n] = x2; } }
                bf16_t* p = base + (size_t)row * ld + hcol + 8 * fq;
                *(u32x4*)p = pack8(o1[0], o1[1]); *(u32x4*)(p + 32) = pack8(o2[0], o2[1]); }
        } else if (T < 13) {
            EPI_ROWLOOP { const int row = row0 + ai * 128 + m * 16; const float rs = row_rs(ssq, row);
#pragma unroll
                for (int bj = 0; bj < 2; ++bj) *(u32x4*)(BG + (size_t)row * 512 + 256 * (T - 11) + 128 * bj + jcol) = pack8(acc[ai][bj][m][0] * rs, acc[ai][bj][m][1] * rs); }
        } else {
            EPI_ROWLOOP { const int row = row0 + ai * 128 + m * 16; const float rs = row_rs(ssq, row); const float rs2 = rs * rs;
                *(u32x4*)(CH + (size_t)row * 512 + 128 * (T - 13) + jcol) = pack8(acc[ai][0][m][0] * acc[ai][1][m][0] * rs2, acc[ai][0][m][1] * acc[ai][1][m][1] * rs2); }
        }
    }
};
struct EpiGate {
    const float* ssq; bf16_t* MG;
    __device__ __forceinline__ void operator()(const f32x4 (&acc)[2][2][4][2], const pg8::Unit& u, int wr, int wc, int fr, int fq) const {
        const int row0 = u.pm * 256 + wr * 64 + fr, col0 = u.pn * 256 + wc * 32 + 8 * fq;
        EPI_ROWLOOP { const int row = row0 + ai * 128 + m * 16; const float rs = row_rs(ssq, row);
#pragma unroll
            for (int bj = 0; bj < 2; ++bj) { f32x4 v0 = acc[ai][bj][m][0] * rs, v1 = acc[ai][bj][m][1] * rs;
#pragma unroll
                for (int j = 0; j < 4; ++j) { v0[j] = sigmoidf_(v0[j]); v1[j] = sigmoidf_(v1[j]); }
#ifdef ABL_GATE
                if ((u.z >> 1) == ABL_GATE) { v0 = v0 * 0.f + 0.5f; v1 = v1 * 0.f + 0.5f; }
#endif
                *(u32x4*)(MG + (size_t)row * 1024 + col0 + 128 * bj) = pack8(v0, v1); } }
    }
};
struct EpiBranch {
    bf16_t* MG; bf16_t* TMP;
    __device__ __forceinline__ void operator()(const f32x4 (&acc)[2][2][4][2], const pg8::Unit& u, int wr, int wc, int fr, int fq) const {
        const int row0 = u.pm * 256 + wr * 64 + fr, col0 = u.pn * 256 + wc * 32 + 8 * fq, br = u.z >> 1;
        EPI_ROWLOOP { const int row = row0 + ai * 128 + m * 16;
#pragma unroll
            for (int bj = 0; bj < 2; ++bj) { const size_t off = (size_t)row * 1024 + col0 + 128 * bj;
                f32x4 g0, g1; unpack8(*(const u32x4*)(MG + off), g0, g1);
                f32x4 v0 = acc[ai][bj][m][0] * g0, v1 = acc[ai][bj][m][1] * g1;
                if (br > 0) { f32x4 t0, t1; unpack8(*(const u32x4*)(TMP + off), t0, t1); v0 += t0; v1 += t1; }
                if (br < 3) *(u32x4*)(TMP + off) = pack8(v0, v1); else *(u32x4*)(MG + off) = pack8(v0, v1); } }
    }
};
struct EpiStashB {
    bf16_t* MG;
    __device__ __forceinline__ void operator()(const f32x4 (&acc)[2][2][4][2], const pg8::Unit& u, int wr, int wc, int fr, int fq) const {
        const int row0 = u.pm * 256 + wr * 64 + fr, col0 = u.pn * 256 + wc * 32 + 8 * fq;
        EPI_ROWLOOP { const int row = row0 + ai * 128 + m * 16;
#pragma unroll
            for (int bj = 0; bj < 2; ++bj) *(u32x4*)(MG + (size_t)row * 1024 + col0 + 128 * bj) = pack8(acc[ai][bj][m][0], acc[ai][bj][m][1]); }
    }
};
struct EpiGateAcc {
    const float* ssq; bf16_t* MG; bf16_t* TMP;
    __device__ __forceinline__ void operator()(const f32x4 (&acc)[2][2][4][2], const pg8::Unit& u, int wr, int wc, int fr, int fq) const {
        const int row0 = u.pm * 256 + wr * 64 + fr, col0 = u.pn * 256 + wc * 32 + 8 * fq, br = u.z >> 1;
        EPI_ROWLOOP { const int row = row0 + ai * 128 + m * 16; const float rs = row_rs(ssq, row);
#pragma unroll
            for (int bj = 0; bj < 2; ++bj) { const size_t off = (size_t)row * 1024 + col0 + 128 * bj;
                f32x4 b0, b1; unpack8(*(const u32x4*)(MG + off), b0, b1);
                f32x4 v0 = acc[ai][bj][m][0] * rs, v1 = acc[ai][bj][m][1] * rs;
#pragma unroll
                for (int j = 0; j < 4; ++j) { v0[j] = sigmoidf_(v0[j]) * b0[j]; v1[j] = sigmoidf_(v1[j]) * b1[j]; }
                if (br > 0) { f32x4 t0, t1; unpack8(*(const u32x4*)(TMP + off), t0, t1); v0 += t0; v1 += t1; }
                if (br < 3) *(u32x4*)(TMP + off) = pack8(v0, v1); else *(u32x4*)(MG + off) = pack8(v0, v1); } }
    }
};
struct EpiMerge2 {
    EpiStashB ES; EpiGateAcc EA;
    __device__ __forceinline__ void operator()(const f32x4 (&acc)[2][2][4][2], const pg8::Unit& u, int wr, int wc, int fr, int fq) const {
        if ((u.z & 1) == 0) ES(acc, u, wr, wc, fr, fq); else EA(acc, u, wr, wc, fr, fq);
    }
};
struct EpiResid {
    bf16_t* XB; float* ssq_out;
    __device__ __forceinline__ void operator()(const f32x4 (&acc)[2][2][4][2], const pg8::Unit& u, int wr, int wc, int fr, int fq) const {
        const int row0 = u.pm * 256 + wr * 64 + fr, col0 = u.pn * 256 + wc * 32 + 8 * fq;
        EPI_ROWLOOP { const int row = row0 + ai * 128 + m * 16; float ss = 0.f;
#pragma unroll
            for (int bj = 0; bj < 2; ++bj) { const size_t off = (size_t)row * 1024 + col0 + 128 * bj;
                f32x4 x0, x1; unpack8(*(const u32x4*)(XB + off), x0, x1);
                const f32x4 v0 = x0 + acc[ai][bj][m][0], v1 = x1 + acc[ai][bj][m][1];
                *(u32x4*)(XB + off) = pack8(v0, v1);
                ss += (v0[0] * v0[0] + v0[1] * v0[1]) + (v0[2] * v0[2] + v0[3] * v0[3]) + (v1[0] * v1[0] + v1[1] * v1[1]) + (v1[2] * v1[2] + v1[3] * v1[3]); }
            ss += __shfl_xor(ss, 16); ss += __shfl_xor(ss, 32);
            if (fq == 0) ssq_out[(size_t)row * 16 + u.pn * 4 + wc] = ss; }
    }
};
struct EpiSwiGLU {
    const float* ssq; bf16_t* ACT; float zero_scale;
    __device__ __forceinline__ void operator()(const f32x4 (&acc)[2][2][4][2], const pg8::Unit& u, int wr, int wc, int fr, int fq) const {
        const int row0 = u.pm * 256 + wr * 64 + fr, col0 = u.pn * 128 + wc * 32 + 8 * fq;
        EPI_ROWLOOP { const int row = row0 + ai * 128 + m * 16; const float rs = row_rs(ssq, row); f32x4 o[2];
#pragma unroll
            for (int n = 0; n < 2; ++n) { const f32x4 g = acc[ai][0][m][n] * rs, up = acc[ai][1][m][n] * rs;
#pragma unroll
                for (int j = 0; j < 4; ++j) o[n][j] = g[j] * sigmoidf_(g[j]) * up[j] * zero_scale; }
            *(u32x4*)(ACT + (size_t)row * DFF + col0) = pack8(o[0], o[1]); }
    }
};

#ifndef ABL_FFN
#define ABL_FFN_SCALE(l) 1.0f
#else
#define ABL_FFN_SCALE(l) ((l) == ABL_FFN ? 0.0f : 1.0f)
#endif
struct Args { const float* in[19]; float* out; unsigned char* ws; };

__device__ __forceinline__ int win_src_col(int nlog) {
    const int T = nlog >> 8, o = nlog & 255, bj = o >> 7, j = o & 127;
    if (T < 4) return nlog;
    if (T < 8) return 1024 + bj * 512 + 128 * (T - 4) + j;
    if (T < 10) return 2048 + (4 * (T - 8) + (j >> 5)) * 64 + 32 * bj + (j & 31);
    if (T == 10) { const int h = j >> 5; return (h < 2 ? 2560 + h * 64 : 2688 + (h - 2) * 64) + 32 * bj + (j & 31); }
    if (T < 13) return 2816 + 256 * (T - 11) + o;
    if (T < 17) return 3328 + bj * 512 + 128 * (T - 13) + j;
    return nlog;
}
__device__ __forceinline__ void tr_item(const float* W, int Nsrc, int k0, int scolA, int scolB, const float* gain, bf16_t* WT, int K, int drow, LAS float* scr, int lane) {
    const int c4 = lane & 15; const int sc = ((c4 >> 3) ? scolB : scolA) + 4 * (c4 & 7);
    f32x4 v[16];
#pragma unroll
    for (int i = 0; i < 16; ++i) v[i] = __builtin_nontemporal_load((const f32x4*)(W + (size_t)(k0 + 4 * i + (lane >> 4)) * Nsrc + sc));
#pragma unroll
    for (int i = 0; i < 16; ++i) { const int row = 4 * i + (lane >> 4); if (gain) v[i] = v[i] * gain[k0 + row];
        LAS float* d = scr + row * 65 + 4 * c4; d[0] = v[i][0]; d[1] = v[i][1]; d[2] = v[i][2]; d[3] = v[i][3]; }
    asm volatile("s_waitcnt lgkmcnt(0)" ::: "memory");
    const int c = lane & 7;
#pragma unroll
    for (int jj = 0; jj < 8; ++jj) { const int n = (lane >> 3) + 8 * jj; const LAS float* s = scr + (8 * c) * 65 + n;
        u32x4 o; o.x = cvt_pk_bf16(s[0], s[65]); o.y = cvt_pk_bf16(s[2 * 65], s[3 * 65]); o.z = cvt_pk_bf16(s[4 * 65], s[5 * 65]); o.w = cvt_pk_bf16(s[6 * 65], s[7 * 65]);
        *(u32x4*)(WT + (size_t)(drow + n) * K + k0 + 8 * c) = o; }
    asm volatile("s_waitcnt lgkmcnt(0)" ::: "memory");
}
__device__ __forceinline__ void prologue(const Args& a, LAS unsigned char* lds, int G) {
    int tid_ = threadIdx.x; asm volatile("" : "+v"(tid_));
    const int tid = tid_, lane = tid & 63, wave = __builtin_amdgcn_readfirstlane(tid >> 6);
    const int gw = blockIdx.x * NWAVES + wave, NGW = G * NWAVES;
    unsigned char* ws = a.ws;
    LAS float* scr = (LAS float*)(lds + wave * 16640);
    constexpr int I_IN = 16 * 132, I_BR = 512, I_OUT = 256, I_GU = 16 * 88, I_DN = 44 * 16, I_L = I_IN + I_BR + I_OUT + I_GU + I_DN;
    for (int it = gw; it < 2 * I_L; it += NGW) {
        const int l = it / I_L; int r = it % I_L;
        if (r < I_IN) { const int kb = r / 132, nb = r % 132, n0 = 64 * nb;
            tr_item(a.in[2] + (size_t)l * D * PROJ, PROJ, 64 * kb, win_src_col(n0), win_src_col(n0 + 32), a.in[1] + l * D, (bf16_t*)(ws + WS_WIN + l * WIN_L), D, n0, scr, lane); continue; } r -= I_IN;
        if (r < I_BR) { const int br = r >> 7, q = r & 127, kb = q >> 4, nb = q & 15;
            tr_item(a.in[13] + (size_t)(l * 4 + br) * 512 * D, D, 64 * kb, 64 * nb, 64 * nb + 32, nullptr, (bf16_t*)(ws + WS_WBR + l * WBR_L) + (size_t)br * 1024 * 512, 512, 64 * nb, scr, lane); continue; } r -= I_BR;
        if (r < I_OUT) { const int kb = r >> 4, nb = r & 15;
            tr_item(a.in[14] + (size_t)l * D * D, D, 64 * kb, 64 * nb, 64 * nb + 32, nullptr, (bf16_t*)(ws + WS_WOUT + l * WOUT_L), D, 64 * nb, scr, lane); continue; } r -= I_OUT;
        if (r < I_GU) { const int kb = r / 88, nb = r % 88, n0 = 64 * nb, T = n0 >> 8, o = n0 & 255, sc = (o >> 7) * DFF + 128 * T + (o & 127);
            tr_item(a.in[16] + (size_t)l * D * 2 * DFF, 2 * DFF, 64 * kb, sc, sc + 32, a.in[15] + l * D, (bf16_t*)(ws + WS_WGU + l * WGU_L), D, n0, scr, lane); continue; } r -= I_GU;
        { const int kb = r >> 4, nb = r & 15;
            tr_item(a.in[17] + (size_t)l * DFF * D, D, 64 * kb, 64 * nb, 64 * nb + 32, nullptr, (bf16_t*)(ws + WS_WDN + l * WDN_L), DFF, 64 * nb, scr, lane); }
    }
    float* ssq = (float*)(ws + WS_SSQ);
    for (int row = gw; row < M; row += NGW) {
        const f32x4* xr = (const f32x4*)(a.in[0] + (size_t)row * D) + lane; float s = 0.f; f32x4 v[4];
#pragma unroll
        for (int j = 0; j < 4; ++j) { v[j] = xr[64 * j]; s += (v[j][0] * v[j][0] + v[j][1] * v[j][1]) + (v[j][2] * v[j][2] + v[j][3] * v[j][3]); }
        s = wave_sum(s);
        u32x2* o = (u32x2*)((bf16_t*)(ws + WS_XB) + (size_t)row * D) + lane;
#pragma unroll
        for (int j = 0; j < 4; ++j) o[64 * j] = (u32x2){cvt_pk_bf16(v[j][0], v[j][1]), cvt_pk_bf16(v[j][2], v[j][3])};
        if (lane < 16) ssq[(size_t)row * 16 + lane] = lane == 0 ? s : 0.f;
    }
    { float* par = (float*)(ws + WS_PAR); const int gt = blockIdx.x * NTHREADS + tid, GT = G * NTHREADS;
#define CPY(dstoff, srcp, n) for (int i = gt; i < (n); i += GT) par[(dstoff) + i] = (srcp)[i]
      for (int l = 0; l < 2; ++l) { const int o = l * PAR_L;
          CPY(o + P_SGLNG, a.in[3] + l * 512, 512); CPY(o + P_SGLNB, a.in[4] + l * 512, 512); CPY(o + P_SGB, a.in[6] + l * 512, 512);
          CPY(o + P_CVB, a.in[8] + l * 512, 512); CPY(o + P_CVLNG, a.in[9] + l * 512, 512); CPY(o + P_CVLNB, a.in[10] + l * 512, 512);
          CPY(o + P_SCW, a.in[12] + l * 1536, 1536); CPY(o + P_SINK, a.in[11] + l * 8, 8); CPY(o + P_CVW, a.in[7] + l * 31 * 512, 31 * 512); }
      CPY(P_FINAL, a.in[18], 1024);
#undef CPY
    }
    for (int i = blockIdx.x * NTHREADS + tid; i < SEQ * 32; i += G * NTHREADS) { const int pos = i >> 5, f = i & 31;
        const double rev = (double)pos * INVF_REV[f]; const float fr = (float)(rev - floor(rev));
        ((float*)(ws + WS_ROPEC))[i] = __builtin_amdgcn_cosf(fr); ((float*)(ws + WS_ROPES))[i] = __builtin_amdgcn_sinf(fr); }
    for (int i = blockIdx.x * NTHREADS + tid; i < 2 * 4 * 128 * 128; i += G * NTHREADS) { const int s = i & 127, t = (i >> 7) & 127;
        ((bf16_t*)(ws + WS_SGWT))[i] = s <= t ? (bf16_t)(cvt_pk_bf16(a.in[5][i], 0.f) & 0xffffu) : (bf16_t)0; }
}

__device__ __forceinline__ void mixer_sg(unsigned char* ws, int l, LAS unsigned char* lds, int unit) {
    { size_t z_ = 0; asm volatile("" : "+s"(z_)); ws += z_; } int tid_ = threadIdx.x; asm volatile("" : "+v"(tid_));
    const float* par = (const float*)(ws + WS_PAR) + l * PAR_L;
    const int tid = tid_, lane = tid & 63, wave = __builtin_amdgcn_readfirstlane(tid >> 6);
    const int ck = unit >> 2, g = unit & 3, r0 = ck * 128;
    const bf16_t* ZA = (const bf16_t*)(ws + WS_ZA); bf16_t* YA = (bf16_t*)(ws + WS_YA);
    LAS bf16_t* vnT = (LAS bf16_t*)lds;
    const float* lng = par + P_SGLNG; const float* lnb = par + P_SGLNB;
    const f32x4 g0 = *(const f32x4*)(lng + 8 * lane), g1 = *(const f32x4*)(lng + 8 * lane + 4), b0 = *(const f32x4*)(lnb + 8 * lane), b1 = *(const f32x4*)(lnb + 8 * lane + 4);
    u32x4 raw[16];
#pragma unroll
    for (int i = 0; i < 16; ++i) raw[i] = *(const u32x4*)(ZA + (size_t)(r0 + wave + 8 * i) * 1024 + 512 + 8 * lane);
#pragma unroll
    for (int i = 0; i < 16; ++i) { const int s = wave + 8 * i;
        f32x4 x0, x1; unpack8(raw[i], x0, x1);
        const float mean = wave_sum((x0[0] + x0[1]) + (x0[2] + x0[3]) + (x1[0] + x1[1]) + (x1[2] + x1[3])) * (1.0f / 512.0f);
        x0 -= mean; x1 -= mean;
        const float var = wave_sum((x0[0] * x0[0] + x0[1] * x0[1]) + (x0[2] * x0[2] + x0[3] * x0[3]) + (x1[0] * x1[0] + x1[1] * x1[1]) + (x1[2] * x1[2] + x1[3] * x1[3])) * (1.0f / 512.0f);
        const float rstd = __builtin_amdgcn_rsqf(var + EPS);
        if ((lane >> 4) == g) { const int c = 8 * (lane & 15); x0 = x0 * rstd * g0 + b0; x1 = x1 * rstd * g1 + b1;
            const unsigned p0 = cvt_pk_bf16(x0[0], x0[1]), p1 = cvt_pk_bf16(x0[2], x0[3]), p2 = cvt_pk_bf16(x1[0], x1[1]), p3 = cvt_pk_bf16(x1[2], x1[3]);
            LAS bf16_t* d = vnT + c * 136 + s;
            d[0] = (bf16_t)p0; d[136] = (bf16_t)(p0 >> 16); d[2 * 136] = (bf16_t)p1; d[3 * 136] = (bf16_t)(p1 >> 16);
            d[4 * 136] = (bf16_t)p2; d[5 * 136] = (bf16_t)(p2 >> 16); d[6 * 136] = (bf16_t)p3; d[7 * 136] = (bf16_t)(p3 >> 16); }
    }
    __syncthreads();
    { const int fr = lane & 15, fq = lane >> 4, t0 = 16 * wave, nks = (wave >> 1) + 1;
      const bf16_t* W = (const bf16_t*)(ws + WS_SGWT) + (size_t)(l * 4 + g) * 16384 + (size_t)(t0 + fr) * 128 + 8 * fq;
      f32x4 acc[8];
#pragma unroll
      for (int ct = 0; ct < 8; ++ct) acc[ct] = (f32x4){0.f, 0.f, 0.f, 0.f};
      for (int ks = 0; ks < nks; ++ks) {
          const bf16x8 wf = *(const bf16x8*)(W + 32 * ks);
#pragma unroll
          for (int ct = 0; ct < 8; ++ct) { const bf16x8 vf = *(const LAS bf16x8*)(vnT + (16 * ct + fr) * 136 + 32 * ks + 8 * fq);
              acc[ct] = __builtin_amdgcn_mfma_f32_16x16x32_bf16(vf, wf, acc[ct], 0, 0, 0); }
      }
      const int t = t0 + fr; const size_t row = r0 + t; const float bs = par[P_SGB + g * 128 + t];
#pragma unroll
      for (int ct = 0; ct < 8; ++ct) { const int c = 128 * g + 16 * ct + 4 * fq;
          const u32x2 uu = *(const u32x2*)(ZA + row * 1024 + c);
          const float o0 = bf_lo(uu.x) * (acc[ct][0] + bs), o1 = bf_hi(uu.x) * (acc[ct][1] + bs), o2 = bf_lo(uu.y) * (acc[ct][2] + bs), o3 = bf_hi(uu.y) * (acc[ct][3] + bs);
          *(u32x2*)(YA + row * 512 + c) = (u32x2){cvt_pk_bf16(o0, o1), cvt_pk_bf16(o2, o3)}; }
    }
    __syncthreads();
}
__device__ __forceinline__ void mixer_conv(unsigned char* ws, int l, LAS unsigned char* lds, int unit) {
    { size_t z_ = 0; asm volatile("" : "+s"(z_)); ws += z_; } int tid_ = threadIdx.x; asm volatile("" : "+v"(tid_));
    const float* par = (const float*)(ws + WS_PAR) + l * PAR_L;
    const int tid = tid_, lane = tid & 63, wave = tid >> 6;
    const int b = unit >> 6, tb = unit & 63, t0 = tb * 32; const size_t rbase = (size_t)b * SEQ;
    const bf16_t* GLU = (const bf16_t*)(ws + WS_GLU); bf16_t* YB = (bf16_t*)(ws + WS_YB);
    LAS bf16_t* in = (LAS bf16_t*)lds;
    LAS float* cv = (LAS float*)(lds + 65536);
    for (int i = tid; i < 62 * 64; i += NTHREADS) { const int r = i >> 6, ch = i & 63; const int t = t0 - 30 + r;
        u32x4 v = {0u, 0u, 0u, 0u}; if (t >= 0) v = *(const u32x4*)(GLU + (rbase + t) * 512 + 8 * ch);
        *(LAS u32x4*)(in + r * 512 + 8 * ch) = v; }
    __syncthreads();
    { const int c = tid; float w[31], x[62];
#pragma unroll
      for (int k = 0; k < 31; ++k) w[k] = par[P_CVW + k * 512 + c];
#pragma unroll
      for (int r = 0; r < 62; ++r) x[r] = bf1(in[r * 512 + c]);
      const float bias = par[P_CVB + c];
#pragma unroll
      for (int t = 0; t < 32; ++t) { float s = bias;
#pragma unroll
          for (int k = 0; k < 31; ++k) s += w[k] * x[t + k];
          cv[t * 512 + c] = s; } }
    __syncthreads();
    { const float* lng = par + P_CVLNG; const float* lnb = par + P_CVLNB;
      const f32x4 g0 = *(const f32x4*)(lng + 8 * lane), g1 = *(const f32x4*)(lng + 8 * lane + 4), b0 = *(const f32x4*)(lnb + 8 * lane), b1 = *(const f32x4*)(lnb + 8 * lane + 4);
      for (int t = wave; t < 32; t += NWAVES) {
          f32x4 x0 = *(const LAS f32x4*)(cv + t * 512 + 8 * lane), x1 = *(const LAS f32x4*)(cv + t * 512 + 8 * lane + 4);
          const float mean = wave_sum((x0[0] + x0[1]) + (x0[2] + x0[3]) + (x1[0] + x1[1]) + (x1[2] + x1[3])) * (1.0f / 512.0f);
          x0 -= mean; x1 -= mean;
          const float var = wave_sum((x0[0] * x0[0] + x0[1] * x0[1]) + (x0[2] * x0[2] + x0[3] * x0[3]) + (x1[0] * x1[0] + x1[1] * x1[1]) + (x1[2] * x1[2] + x1[3] * x1[3])) * (1.0f / 512.0f);
          const float rstd = __builtin_amdgcn_rsqf(var + EPS);
          x0 = x0 * rstd * g0 + b0; x1 = x1 * rstd * g1 + b1;
#pragma unroll
          for (int j = 0; j < 4; ++j) { x0[j] = x0[j] * sigmoidf_(x0[j]); x1[j] = x1[j] * sigmoidf_(x1[j]); }
          *(u32x4*)(YB + (rbase + t0 + t) * 512 + 8 * lane) = pack8(x0, x1); } }
    __syncthreads();
}
__device__ __forceinline__ void mixer_attn(unsigned char* ws, int l, LAS unsigned char* lds, int unit) {
    { size_t z_ = 0; asm volatile("" : "+s"(z_)); ws += z_; } int tid_ = threadIdx.x; asm volatile("" : "+v"(tid_));
    const float* par = (const float*)(ws + WS_PAR) + l * PAR_L;
    const int tid = tid_, lane = tid & 63, wave = __builtin_amdgcn_readfirstlane(tid >> 6), fr = lane & 15, fq = lane >> 4;
    const int kvh = unit & 1, blk = (unit >> 1) & 15, b = unit >> 5; const size_t rbase = (size_t)b * SEQ;
    bf16_t* Q = (bf16_t*)(ws + WS_Q); const bf16_t* K = (const bf16_t*)(ws + WS_K); const bf16_t* V = (const bf16_t*)(ws + WS_V);
    LAS bf16_t* Kl = (LAS bf16_t*)lds;
    LAS bf16_t* VT = (LAS bf16_t*)(lds + 36864);
    for (int i = tid; i < 256 * 8; i += NTHREADS) { const int r = i >> 3, ch = i & 7; const int t = (blk - 1) * 128 + r;
        u32x4 kv = {0u, 0u, 0u, 0u}, vv = {0u, 0u, 0u, 0u};
        if (t >= 0) { kv = *(const u32x4*)(K + (rbase + t) * 128 + kvh * 64 + 8 * ch); vv = *(const u32x4*)(V + (rbase + t) * 128 + kvh * 64 + 8 * ch); }
        *(LAS u32x4*)(Kl + r * 72 + 8 * ch) = kv;
        LAS bf16_t* d = VT + (8 * ch) * 264 + r;
        d[0] = (bf16_t)vv.x; d[264] = (bf16_t)(vv.x >> 16); d[2 * 264] = (bf16_t)vv.y; d[3 * 264] = (bf16_t)(vv.y >> 16);
        d[4 * 264] = (bf16_t)vv.z; d[5 * 264] = (bf16_t)(vv.z >> 16); d[6 * 264] = (bf16_t)vv.w; d[7 * 264] = (bf16_t)(vv.w >> 16); }
    __syncthreads();
    const int g = wave >> 1, head = kvh * 4 + g; const float sink = par[P_SINK + head];
    for (int it = 0; it < 2; ++it) {
        const int qs = 2 * (wave & 1) + it, qi0 = 32 * qs; const size_t qrow0 = rbase + blk * 128 + qi0;
        bf16x8 qf[2][2];
#pragma unroll
        for (int qt = 0; qt < 2; ++qt)
#pragma unroll
            for (int ks = 0; ks < 2; ++ks) qf[qt][ks] = *(const bf16x8*)(Q + (qrow0 + 16 * qt + fr) * 512 + head * 64 + 32 * ks + 8 * fq);
        f32x4 S[2][10];
#pragma unroll
        for (int qt = 0; qt < 2; ++qt)
#pragma unroll
            for (int kt = 0; kt < 10; ++kt) S[qt][kt] = (f32x4){0.f, 0.f, 0.f, 0.f};
#pragma unroll
        for (int kt = 0; kt < 10; ++kt)
#pragma unroll
            for (int ks = 0; ks < 2; ++ks) { const bf16x8 kf = *(const LAS bf16x8*)(Kl + (qi0 + 16 * kt + fr) * 72 + 32 * ks + 8 * fq);
#pragma unroll
                for (int qt = 0; qt < 2; ++qt) S[qt][kt] = __builtin_amdgcn_mfma_f32_16x16x32_bf16(kf, qf[qt][ks], S[qt][kt], 0, 0, 0); }
        bf16x8 pf[2][5];
#pragma unroll
        for (int qt = 0; qt < 2; ++qt) { const int qi = qi0 + 16 * qt + fr; float mx = sink;
#pragma unroll
            for (int kt = 0; kt < 10; ++kt)
#pragma unroll
                for (int j = 0; j < 4; ++j) { const int kb = qi0 + 16 * kt + 4 * fq + j; const bool valid = (kb > qi) && (kb <= qi + 128) && (blk > 0 || kb >= 128);
                    const float sv = valid ? S[qt][kt][j] : -INFINITY; S[qt][kt][j] = sv; mx = fmaxf(mx, sv); }
            mx = fmaxf(mx, __shfl_xor(mx, 16)); mx = fmaxf(mx, __shfl_xor(mx, 32));
            float sum = 0.f;
#pragma unroll
            for (int kt = 0; kt < 10; ++kt)
#pragma unroll
                for (int j = 0; j < 4; ++j) { const float p = __expf(S[qt][kt][j] - mx); S[qt][kt][j] = p; sum += p; }
            sum += __shfl_xor(sum, 16); sum += __shfl_xor(sum, 32);
            const float inv = 1.0f / (sum + __expf(sink - mx));
#pragma unroll
            for (int p = 0; p < 5; ++p) { const f32x4 a0 = S[qt][2 * p] * inv, a1 = S[qt][2 * p + 1] * inv; pf[qt][p] = __builtin_bit_cast(bf16x8, pack8(a0, a1)); }
        }
        f32x4 o[2][4];
#pragma unroll
        for (int qt = 0; qt < 2; ++qt)
#pragma unroll
            for (int dt = 0; dt < 4; ++dt) o[qt][dt] = (f32x4){0.f, 0.f, 0.f, 0.f};
#pragma unroll
        for (int p = 0; p < 5; ++p)
#pragma unroll
            for (int dt = 0; dt < 4; ++dt) { const LAS bf16_t* vp = VT + (16 * dt + fr) * 264 + qi0 + 32 * p + 4 * fq;
                const u32x2 lo = *(const LAS u32x2*)vp, hi = *(const LAS u32x2*)(vp + 16);
                const bf16x8 vf = __builtin_bit_cast(bf16x8, (u32x4){lo.x, lo.y, hi.x, hi.y});
#pragma unroll
                for (int qt = 0; qt < 2; ++qt) o[qt][dt] = __builtin_amdgcn_mfma_f32_16x16x32_bf16(vf, pf[qt][p], o[qt][dt], 0, 0, 0); }
#pragma unroll
        for (int qt = 0; qt < 2; ++qt)
#pragma unroll
            for (int dt = 0; dt < 4; ++dt) *(u32x2*)(Q + (qrow0 + 16 * qt + fr) * 512 + head * 64 + 16 * dt + 4 * fq) = (u32x2){cvt_pk_bf16(o[qt][dt][0], o[qt][dt][1]), cvt_pk_bf16(o[qt][dt][2], o[qt][dt][3])};
    }
    __syncthreads();
}
__device__ __forceinline__ void mixer_sc(unsigned char* ws, int l, int G) {
    { size_t z_ = 0; asm volatile("" : "+s"(z_)); ws += z_; } int tid_ = threadIdx.x; asm volatile("" : "+v"(tid_));
    bf16_t* BG = (bf16_t*)(ws + WS_BG); const bf16_t* CH = (const bf16_t*)(ws + WS_CH);
    const float* w = (const float*)(ws + WS_PAR) + l * PAR_L + P_SCW;
    for (int i = blockIdx.x * NTHREADS + tid_; i < (M / 8) * 64; i += G * NTHREADS) {
        const int row0 = 8 * (i >> 6), c = 8 * (i & 63), t0 = row0 & (SEQ - 1);
        u32x4 ch[10], bg[8];
#pragma unroll
        for (int r = 0; r < 10; ++r) { ch[r] = (u32x4){0u, 0u, 0u, 0u}; if (t0 - 2 + r >= 0) ch[r] = *(const u32x4*)(CH + (size_t)(row0 - 2 + r) * 512 + c); }
#pragma unroll
        for (int r = 0; r < 8; ++r) bg[r] = *(const u32x4*)(BG + (size_t)(row0 + r) * 512 + c);
        f32x4 wa[3], wb[3];
#pragma unroll
        for (int k = 0; k < 3; ++k) { wa[k] = *(const f32x4*)(w + k * 512 + c); wb[k] = *(const f32x4*)(w + k * 512 + c + 4); }
#pragma unroll
        for (int r = 0; r < 8; ++r) { f32x4 a0 = {0.f, 0.f, 0.f, 0.f}, a1 = a0;
#pragma unroll
            for (int k = 0; k < 3; ++k) { f32x4 x0, x1; unpack8(ch[r + k], x0, x1); a0 += x0 * wa[k]; a1 += x1 * wb[k]; }
            f32x4 g0, g1; unpack8(bg[r], g0, g1);
            *(u32x4*)(BG + (size_t)(row0 + r) * 512 + c) = pack8(g0 * a0, g1 * a1); }
    }
}

#define RLX_AGENT __ATOMIC_RELAXED, __HIP_MEMORY_SCOPE_AGENT
#define XB_TMO      128
#define XB_XCNT(j)  (256  + 64 * (j))
#define XB_XSUB(j)  (1280 + 64 * (j))
#define XB_XGEN(j)  (2304 + 64 * (j))
#define XB_TOP      3328
#define XB_TOPGEN   3392
#define XCD_BAR_WORDS 3456
#define XB_SPIN_CAP (1u << 18)

__device__ __forceinline__ unsigned xb_ld(unsigned* p)              { return __hip_atomic_load(p, __ATOMIC_RELAXED, __HIP_MEMORY_SCOPE_AGENT); }
__device__ __forceinline__ unsigned xb_add(unsigned* p, unsigned v) { return __hip_atomic_fetch_add(p, v, __ATOMIC_RELAXED, __HIP_MEMORY_SCOPE_AGENT); }
__device__ __forceinline__ unsigned xb_xcc_id() { return (unsigned)__builtin_amdgcn_s_getreg((3 << 11) | 20) & 0xFu; }
#define XB_SPIN(cond, bar) do { unsigned _sp = 0; while (cond) { __builtin_amdgcn_s_sleep(1); \
    if ((++_sp & 255u) == 0u) { if (xb_ld(&(bar)[XB_TMO])) break; if (_sp > XB_SPIN_CAP) { atomicAdd(&(bar)[XB_TMO], 1u); break; } } } } while (0)

struct XcdBarrier {
    unsigned* bar; unsigned x;
    volatile LAS unsigned* st;
};

__device__ __forceinline__ XcdBarrier xcd_barrier_post(unsigned* bar, volatile LAS unsigned* st) {
    XcdBarrier b; b.bar = bar; b.x = xb_xcc_id(); b.st = st;
    if (threadIdx.x == 0) (void)xb_add(&bar[XB_XCNT(b.x)], 1u);
    return b;
}
__device__ __forceinline__ void xcd_barrier_complete(unsigned* bar, unsigned x, unsigned& nloc, unsigned& nx) {
    const unsigned G = gridDim.x * gridDim.y * gridDim.z;
    unsigned sum, cnt, mine, sp = 0u;
    for (;;) {
        sum = 0u; cnt = 0u; mine = 0u;
#pragma unroll
        for (unsigned j = 0; j < 16; ++j) { const unsigned c = xb_ld(&bar[XB_XCNT(j)]); sum += c; cnt += (c > 0u) ? 1u : 0u; mine = (j == x) ? c : mine; }
        if (sum == G) break;
        __builtin_amdgcn_s_sleep(1);
        if ((++sp & 255u) == 0u) { if (xb_ld(&bar[XB_TMO])) break; if (sp > XB_SPIN_CAP) { atomicAdd(&bar[XB_TMO], 1u); break; } }
    }
    nloc = mine > 0u ? mine : 1u; nx = cnt > 0u ? cnt : 1u;
}

__device__ __forceinline__ void xcd_barrier(const XcdBarrier& b) {
    asm volatile("s_waitcnt vmcnt(0)" ::: "memory");
    __syncthreads();
    if (threadIdx.x == 0) {
        unsigned* bar = b.bar;
        __builtin_amdgcn_s_waitcnt(0);
        unsigned nloc = b.st[0], nx = b.st[1];
        if (nloc == 0u) { xcd_barrier_complete(bar, b.x, nloc, nx); b.st[0] = nloc; b.st[1] = nx; }
        const unsigned old = xb_add(&bar[XB_XSUB(b.x)], 1u);
        const unsigned gen = old / nloc;
        if (old + 1u == (gen + 1u) * nloc) {
            __builtin_amdgcn_fence(__ATOMIC_RELEASE, "agent");
            asm volatile("s_waitcnt vmcnt(0)" ::: "memory");
            const unsigned og = xb_add(&bar[XB_TOP], 1u);
            const unsigned tg = og / nx;
            if (og + 1u == (tg + 1u) * nx) xb_add(&bar[XB_TOPGEN], 1u);
            else XB_SPIN(xb_ld(&bar[XB_TOPGEN]) == tg, bar);
            __builtin_amdgcn_fence(__ATOMIC_ACQUIRE, "agent");
            xb_add(&bar[XB_XGEN(b.x)], 1u);
            asm volatile("s_waitcnt vmcnt(0)" ::: "memory");
        } else {
            XB_SPIN(xb_ld(&bar[XB_XGEN(b.x)]) == gen, bar);
            __builtin_amdgcn_fence(__ATOMIC_ACQUIRE, "agent");
            asm volatile("s_waitcnt vmcnt(0)" ::: "memory");
        }
    }
    __syncthreads();
}


#ifdef DBG_STAGE
__device__ __forceinline__ void dbg_dump(float* out, const bf16_t* src, int ld, int ncols, int c0, int G) {
    for (long i = (long)blockIdx.x * NTHREADS + threadIdx.x; i < (long)M * ncols; i += (long)G * NTHREADS) { const int row = (int)(i / ncols), c = (int)(i % ncols); out[(size_t)row * D + c0 + c] = bf1(src[(size_t)row * ld + c]); }
}
#endif
#define GRID_SYNC() do { XcdBarrier xb_; xb_.bar = (unsigned*)(ws + WS_BAR); xb_.x = xb_xcc_id(); xb_.st = (volatile LAS unsigned*)(lds + MISC_OFF); xcd_barrier(xb_); } while (0)
__global__ void __launch_bounds__(NTHREADS, 2) fwd_megakernel(Args a) {
    extern __shared__ __attribute__((aligned(16))) unsigned char lds_raw[];
    LAS unsigned char* lds = (LAS unsigned char*)lds_raw;
    cg::grid_group grid = cg::this_grid();
    const int G = gridDim.x, c = blockIdx.x;
    unsigned char* ws = a.ws;
    float* ssq = (float*)(ws + WS_SSQ);

    { volatile LAS unsigned* misc = (volatile LAS unsigned*)(lds + MISC_OFF); if (threadIdx.x < 16) misc[threadIdx.x] = 0u; }
    __syncthreads();
    grid.sync();
    (void)xcd_barrier_post((unsigned*)(ws + WS_BAR), (volatile LAS unsigned*)(lds + MISC_OFF));
    prologue(a, lds, G);
    GRID_SYNC();

    for (int l = 0; l < 2; ++l) {
        { size_t z_ = 0; asm volatile("" : "+s"(z_)); ws += z_; } ssq = (float*)(ws + WS_SSQ);
        const float* ssq_mix = ssq + (size_t)(2 * l) * M * 16;
        { pg8::SchedGrid S; S.nM = 64; S.nN = 17; S.nwg = 64 * 17; S.G = G; S.c = c; S.A = (const char*)(ws + WS_XB); S.B = (const char*)(ws + WS_WIN + l * WIN_L); S.lda2 = 2048; S.ldb2 = 2048; S.nt = 16;
          EpiInProj E{ssq_mix, ws};
#ifdef MULTI_UNIT
          pg8::gemm_phase<EpiInProj, pg8::SchedGrid, true>(lds, S, E);
#else
          for (int i = 0; i < 5; ++i) { pg8::SchedOneG S1; S1.S = S; S1.i0 = i; pg8::gemm_phase<EpiInProj, pg8::SchedOneG, false>(lds, S1, E); }
#endif
        }
        GRID_SYNC(); { size_t z_ = 0; asm volatile("" : "+s"(z_)); ws += z_; }
#if defined(DBG_STAGE) && DBG_STAGE == 1
        if (l == 0) { dbg_dump(a.out, (const bf16_t*)(ws + WS_ZA), 1024, 1024, 0, G); return; }
#endif
        for (int u = c; u < 512; u += G) mixer_sg(ws, l, lds, u);
        for (int u = c; u < 512; u += G) mixer_conv(ws, l, lds, u);
        for (int u = c; u < 256; u += G) mixer_attn(ws, l, lds, u);
        mixer_sc(ws, l, G);
        GRID_SYNC(); { size_t z_ = 0; asm volatile("" : "+s"(z_)); ws += z_; } ssq = (float*)(ws + WS_SSQ);
        #if defined(DBG_STAGE) && DBG_STAGE == 2
        if (l == 0) { dbg_dump(a.out, (const bf16_t*)(ws + WS_YA), 512, 512, 0, G); dbg_dump(a.out, (const bf16_t*)(ws + WS_YB), 512, 512, 512, G); return; }
#endif
#if defined(DBG_STAGE) && DBG_STAGE == 22
        if (l == 0) { dbg_dump(a.out, (const bf16_t*)(ws + WS_Q), 512, 512, 0, G); dbg_dump(a.out, (const bf16_t*)(ws + WS_BG), 512, 512, 512, G); return; }
#endif
        { pg8::SchedMerge S; S.G = G; S.c = c; S.ws = (const char*)ws; S.WG = (const char*)(ws + WS_WIN + l * WIN_L) + (size_t)NLOG1 * 2048;
          S.WBR = (const char*)(ws + WS_WBR + l * WBR_L);
          EpiStashB ES{(bf16_t*)(ws + WS_MG)}; EpiGateAcc EA{ssq_mix, (bf16_t*)(ws + WS_MG), (bf16_t*)(ws + WS_TMP)};
#ifdef MERGE_MULTI
          S.swap = 1; EpiMerge2 E2{ES, EA};
          pg8::gemm_phase<EpiMerge2, pg8::SchedMerge, true>(lds, S, E2);
#else
          S.swap = 0;
          for (int br = 0; br < 4; ++br) {
              { pg8::SchedOne S1; S1.M = S; S1.i0 = 2 * br + 1; pg8::gemm_phase<EpiStashB, pg8::SchedOne, false>(lds, S1, ES); }
              { pg8::SchedOne S1; S1.M = S; S1.i0 = 2 * br; pg8::gemm_phase<EpiGateAcc, pg8::SchedOne, false>(lds, S1, EA); }
          }
#endif
        }
        GRID_SYNC(); { size_t z_ = 0; asm volatile("" : "+s"(z_)); ws += z_; } ssq = (float*)(ws + WS_SSQ);
        #if defined(DBG_STAGE) && DBG_STAGE == 3
        if (l == 0) { dbg_dump(a.out, (const bf16_t*)(ws + WS_MG), 1024, 1024, 0, G); return; }
#endif
        { pg8::SchedGrid S; S.nM = 64; S.nN = 4; S.nwg = 256; S.G = G; S.c = c; S.A = (const char*)(ws + WS_MG); S.B = (const char*)(ws + WS_WOUT + l * WOUT_L); S.lda2 = 2048; S.ldb2 = 2048; S.nt = 16;
          EpiResid E{(bf16_t*)(ws + WS_XB), ssq + (size_t)(2 * l + 1) * M * 16};
          pg8::gemm_phase<EpiResid, pg8::SchedGrid, false>(lds, S, E); }
        GRID_SYNC(); { size_t z_ = 0; asm volatile("" : "+s"(z_)); ws += z_; } ssq = (float*)(ws + WS_SSQ);
        #if defined(DBG_STAGE) && DBG_STAGE == 4
        if (l == 0) return;
#endif
        { pg8::SchedGrid S; S.nM = 64; S.nN = 22; S.nwg = 64 * 22; S.G = G; S.c = c; S.A = (const char*)(ws + WS_XB); S.B = (const char*)(ws + WS_WGU + l * WGU_L); S.lda2 = 2048; S.ldb2 = 2048; S.nt = 16;
          EpiSwiGLU E{ssq + (size_t)(2 * l + 1) * M * 16, (bf16_t*)(ws + WS_ACT), ABL_FFN_SCALE(l)};
#ifdef MULTI_UNIT
          pg8::gemm_phase<EpiSwiGLU, pg8::SchedGrid, true>(lds, S, E);
#else
          for (int i = 0; i < 6; ++i) { pg8::SchedOneG S1; S1.S = S; S1.i0 = i; pg8::gemm_phase<EpiSwiGLU, pg8::SchedOneG, false>(lds, S1, E); }
#endif
        }
        GRID_SYNC(); { size_t z_ = 0; asm volatile("" : "+s"(z_)); ws += z_; } ssq = (float*)(ws + WS_SSQ);
        #if defined(DBG_STAGE) && DBG_STAGE == 5
        if (l == 0) { dbg_dump(a.out, (const bf16_t*)(ws + WS_ACT), DFF, 1024, 0, G); return; }
#endif
        { pg8::SchedGrid S; S.nM = 64; S.nN = 4; S.nwg = 256; S.G = G; S.c = c; S.A = (const char*)(ws + WS_ACT); S.B = (const char*)(ws + WS_WDN + l * WDN_L); S.lda2 = DFF * 2; S.ldb2 = DFF * 2; S.nt = DFF / 64;
          EpiResid E{(bf16_t*)(ws + WS_XB), ssq + (size_t)(2 * l + 2) * M * 16};
          pg8::gemm_phase<EpiResid, pg8::SchedGrid, false>(lds, S, E); }
        GRID_SYNC();
#if defined(DBG_STAGE) && DBG_STAGE == 6
        if (l == 0) return;
#endif
    }
    { { size_t z_ = 0; asm volatile("" : "+s"(z_)); ws += z_; } int tid_ = threadIdx.x; asm volatile("" : "+v"(tid_));
      const int lane = tid_ & 63, gw = c * NWAVES + (tid_ >> 6), NGW = G * NWAVES; const float* gf = (const float*)(ws + WS_PAR) + P_FINAL; const float* sq = (const float*)(ws + WS_SSQ) + (size_t)4 * M * 16;
      const bf16_t* XBp = (const bf16_t*)(ws + WS_XB);
      for (int row = gw; row < M; row += 2 * NGW) { const int row2 = row + NGW;
          u32x4 ra_[2], rb_[2];
#pragma unroll
          for (int j = 0; j < 2; ++j) { ra_[j] = *(const u32x4*)(XBp + (size_t)row * D + 512 * j + 8 * lane); rb_[j] = *(const u32x4*)(XBp + (size_t)row2 * D + 512 * j + 8 * lane); }
          const float ra = row_rs(sq, row), rb = row_rs(sq, row2);
#pragma unroll
          for (int j = 0; j < 2; ++j) { const f32x4 g0 = *(const f32x4*)(gf + 512 * j + 8 * lane), g1 = *(const f32x4*)(gf + 512 * j + 8 * lane + 4);
              f32x4 x0, x1; unpack8(ra_[j], x0, x1); float* oa = a.out + (size_t)row * D + 512 * j + 8 * lane; *(f32x4*)oa = x0 * ra * g0; *(f32x4*)(oa + 4) = x1 * ra * g1;
              unpack8(rb_[j], x0, x1); float* ob = a.out + (size_t)row2 * D + 512 * j + 8 * lane; *(f32x4*)ob = x0 * rb * g0; *(f32x4*)(ob + 4) = x1 * rb * g1; } } }
}

extern "C" void kernel_launch(void* const* d_in, const int* in_sizes, int n_in, void* d_out, int out_size, void* d_ws, size_t ws_size, hipStream_t stream) {
    static int grid = 0;
    if (grid == 0) {
        if (n_in != 19 || out_size != M * D || ws_size < WS_END) { fprintf(stderr, "kernel_launch: unexpected shapes (n_in %d out %d ws %zu)\n", n_in, out_size, ws_size); grid = -1; return; }
        int dev = 0, cus = 0, per_cu = 0;
        if (hipGetDevice(&dev) != hipSuccess || hipDeviceGetAttribute(&cus, hipDeviceAttributeMultiprocessorCount, dev) != hipSuccess) { grid = -1; return; }
        if (hipFuncSetAttribute((const void*)fwd_megakernel, hipFuncAttributeMaxDynamicSharedMemorySize, LDS_BYTES) != hipSuccess) { fprintf(stderr, "kernel_launch: hipFuncSetAttribute failed\n"); grid = -1; return; }
        if (hipOccupancyMaxActiveBlocksPerMultiprocessor(&per_cu, (const void*)fwd_megakernel, NTHREADS, LDS_BYTES) != hipSuccess || per_cu < 1) { fprintf(stderr, "kernel_launch: occupancy query says %d\n", per_cu); per_cu = 1; }
        (void)hipGetLastError();
        grid = cus * 1;
    }
    if (grid < 0) return;
    if (hipMemsetAsync((char*)d_ws + WS_BAR, 0, 16384, stream) != hipSuccess) { fprintf(stderr, "kernel_launch: memset failed\n"); return; }
    Args a{};
    for (int i = 0; i < 19; ++i) a.in[i] = (const float*)d_in[i];
    a.out = (float*)d_out; a.ws = (unsigned char*)d_ws;
    void* args[] = {&a};
    hipError_t e = hipLaunchCooperativeKernel((const void*)fwd_megakernel, dim3(grid), dim3(NTHREADS), args, LDS_BYTES, stream);
    if (e != hipSuccess) fprintf(stderr, "cooperative launch failed: %s (grid %d)\n", hipGetErrorString(e), grid);
}
```

```cpp
#include <hip/hip_runtime.h>
#include <hip/hip_cooperative_groups.h>
#include <cstdio>
#include <cstdint>
namespace cg = cooperative_groups;

#define LAS __attribute__((address_space(3)))
typedef unsigned short bf16_t;
typedef short bf16x8 __attribute__((ext_vector_type(8)));
typedef float f32x4 __attribute__((ext_vector_type(4)));
typedef float f32x2 __attribute__((ext_vector_type(2)));
typedef unsigned u32x4 __attribute__((ext_vector_type(4)));
typedef unsigned u32x2 __attribute__((ext_vector_type(2)));

constexpr int M = 16384, D = 1024, SEQ = 2048, NBATCH = 8, DFF = 2816, PROJ = 8448, NLOG1 = 4352  ;
constexpr float EPS = 1e-6f;
constexpr int NTHREADS = 512, NWAVES = 8;
constexpr int LDS_BYTES = 147456;

constexpr size_t MiB = 1u << 20;
constexpr size_t WS_SSQ = 248 * (size_t)(1u << 20);
constexpr size_t WS_PAR = 512 * 1024;
constexpr int PAR_L = 24576, P_SGLNG = 0, P_SGLNB = 512, P_SGB = 1024, P_CVB = 1536, P_CVLNG = 2048, P_CVLNB = 2560, P_SCW = 3072, P_SINK = 4608, P_CVW = 4672, P_FINAL = 2 * PAR_L;
constexpr size_t WS_BAR = 768 * 1024;
constexpr int MISC_OFF = 147200;
constexpr size_t WS_ROPEC = 1 * MiB, WS_ROPES = 1 * MiB + 256 * 1024;
constexpr size_t WS_SGWT = 1 * MiB + 512 * 1024;
constexpr size_t WS_WIN = 2 * MiB, WIN_L = (size_t)PROJ * D * 2;
constexpr size_t WS_WBR = 35 * MiB, WBR_L = 4 * MiB;
constexpr size_t WS_WOUT = 43 * MiB, WOUT_L = 2 * MiB;
constexpr size_t WS_WGU = 47 * MiB, WGU_L = 11 * MiB;
constexpr size_t WS_WDN = 69 * MiB, WDN_L = (size_t)D * DFF * 2;
constexpr size_t WS_XB = 80 * MiB;
constexpr size_t WS_ZA = 112 * MiB;
constexpr size_t WS_MG = WS_ZA;
constexpr size_t WS_GLU = 144 * MiB;
constexpr size_t WS_CH = 160 * MiB;
constexpr size_t WS_TMP = WS_GLU;
constexpr size_t WS_Q = 176 * MiB;
constexpr size_t WS_BG = 192 * MiB;
constexpr size_t WS_K = 208 * MiB, WS_V = 212 * MiB;
constexpr size_t WS_YA = 216 * MiB, WS_YB = 232 * MiB;
constexpr size_t WS_ACT = 112 * MiB;
constexpr size_t WS_END = 254 * MiB;

__device__ const double INVF_REV[32] = {0.15915494309189535, 0.11934937021124886, 0.08949940160889101, 0.06711508300522726, 0.050329212104487035, 0.03774158471741977, 0.0283021958306234, 0.02122365276477766, 0.015915494309189534, 0.011934937021124886, 0.008949940160889102, 0.006711508300522725, 0.005032921210448704, 0.003774158471741977, 0.00283021958306234, 0.0021223652764777662, 0.0015915494309189536, 0.0011934937021124885, 0.0008949940160889102, 0.0006711508300522726, 0.0005032921210448703, 0.00037741584717419774, 0.00028302195830623395, 0.0002122365276477766, 0.00015915494309189535, 0.00011934937021124886, 8.949940160889102e-05, 6.711508300522725e-05, 5.0329212104487035e-05, 3.774158471741978e-05, 2.8302195830623396e-05, 2.122365276477766e-05};

__device__ __forceinline__ unsigned cvt_pk_bf16(float lo, float hi) { unsigned r; asm volatile("v_cvt_pk_bf16_f32 %0, %1, %2" : "=v"(r) : "v"(lo), "v"(hi)); return r; }
__device__ __forceinline__ float bf_lo(unsigned u) { return __builtin_bit_cast(float, u << 16); }
__device__ __forceinline__ float bf_hi(unsigned u) { return __builtin_bit_cast(float, u & 0xffff0000u); }
__device__ __forceinline__ float bf1(bf16_t h) { return __builtin_bit_cast(float, ((unsigned)h) << 16); }
__device__ __forceinline__ float sigmoidf_(float x) { return __builtin_amdgcn_rcpf(1.0f + __expf(-x)); }
__device__ __forceinline__ float wave_sum(float v) {
#pragma unroll
    for (int o = 1; o < 64; o <<= 1) v += __shfl_xor(v, o);
    return v;
}
__device__ __forceinline__ f32x2 gelu_pk(f32x2 v) {
    const f32x2 av = __builtin_elementwise_abs(v), d = av * 0.2316418882f + 1.0f;
    f32x2 t; t.x = __builtin_amdgcn_rcpf(d.x); t.y = __builtin_amdgcn_rcpf(d.y);
    f32x2 q = t * 0.5307027145f + (-0.7265760135f); q = q * t + 0.7107068705f; q = q * t + (-0.142248368f); q = q * t + 0.127414796f; q = q * t;
    const f32x2 s = (v * v) * (-0.72134752044f);
    f32x2 e; e.x = __builtin_amdgcn_exp2f(s.x); e.y = __builtin_amdgcn_exp2f(s.y);
    const f32x2 m = v * (q * e), r = v - m;
    f32x2 o; o.x = v.x < 0.f ? m.x : r.x; o.y = v.y < 0.f ? m.y : r.y; return o;
}
__device__ __forceinline__ u32x4 pack8(f32x4 a, f32x4 b) { u32x4 w; w.x = cvt_pk_bf16(a[0], a[1]); w.y = cvt_pk_bf16(a[2], a[3]); w.z = cvt_pk_bf16(b[0], b[1]); w.w = cvt_pk_bf16(b[2], b[3]); return w; }
__device__ __forceinline__ void unpack8(u32x4 w, f32x4& a, f32x4& b) { a = (f32x4){bf_lo(w.x), bf_hi(w.x), bf_lo(w.y), bf_hi(w.y)}; b = (f32x4){bf_lo(w.z), bf_hi(w.z), bf_lo(w.w), bf_hi(w.w)}; }

namespace pg8 {
constexpr int BM = 256, BK = 64, HALF = 128, HTB = HALF * BK * 2, STAGE_BYTES = 8 * HTB, NXCD = 8, WGM = 8;
__host__ __device__ __forceinline__ int lds_byte(int r, int c) { const int st = (r >> 4) * 2 + (c >> 5), rr = r & 15, cc = c & 31, ob = rr * 64 + cc * 2; return st * 1024 + (ob ^ (((ob >> 9) & 1) << 5)); }
__host__ __device__ __forceinline__ void stage_rc(int b, int& R, int& C) { const int st = b / 1024, sb = b % 1024, swz = sb ^ (((sb >> 9) & 1) << 5); R = (st >> 1) * 16 + swz / 64; C = (st & 1) * 32 + (swz % 64) / 2; }
__host__ __device__ __forceinline__ int perm32(int rho) { const int n = rho >> 4, i = rho & 15; return 8 * (i >> 2) + 4 * n + (i & 3); }

struct Unit { const char* A; const char* B; int lda2, ldb2, nt, pm, pn, z; };

__device__ __forceinline__ void tile_of(int L, int nM, int nN, int& pm, int& pn) {
    const int nwg = nM * nN; int wgid = L; { const int q = nwg / NXCD, r = nwg % NXCD, xcd = wgid % NXCD, off = wgid / NXCD; wgid = (xcd < r ? xcd * (q + 1) : r * (q + 1) + (xcd - r) * q) + off; }
    const int nig = WGM * nN, gid = wgid / nig, fm = gid * WGM, gsz = (nM - fm) < WGM ? (nM - fm) : WGM;
    pm = fm + ((wgid % nig) % gsz); pn = (wgid % nig) / gsz;
}
struct SchedGrid {
    static constexpr bool VARLD = false;
    int nM, nN, nwg, G, c; const char* A; const char* B; int lda2, ldb2, nt;
    __device__ __forceinline__ bool next(int i, Unit& u) const {
        const long L = (long)i * G + c; if (L >= nwg) return false;
        tile_of((int)L, nM, nN, u.pm, u.pn); u.z = 0;
        u.A = A + (size_t)u.pm * 256 * lda2; u.B = B + (size_t)u.pn * 256 * ldb2; u.lda2 = lda2; u.ldb2 = ldb2; u.nt = nt; return true;
    }
};
struct SchedMerge {
    static constexpr bool VARLD = true;
    int G, c; const char* ws; const char* WG  ; const char* WBR; int swap;
    __device__ __forceinline__ bool next(int i, Unit& u) const {
        const int ti = i >> 3, sub = i & 7; const long L = (long)ti * G + c; if (L >= 256) return false;
        tile_of((int)L, 64, 4, u.pm, u.pn); u.z = sub; const int br = sub >> 1;
        if (((sub & 1) ^ swap) == 0) { u.A = ws + WS_XB + (size_t)u.pm * 256 * 2048; u.lda2 = 2048; u.B = WG + (size_t)(br * 1024 + u.pn * 256) * 2048; u.ldb2 = 2048; u.nt = 16; }
        else { const size_t yo = br == 0 ? WS_YA : br == 1 ? WS_YB : br == 2 ? WS_Q : WS_BG;
               u.A = ws + yo + (size_t)u.pm * 256 * 1024; u.lda2 = 1024; u.B = WBR + (size_t)br * (1024 * 512 * 2) + (size_t)u.pn * 256 * 1024; u.ldb2 = 1024; u.nt = 8; }
        return true;
    }
};

struct SchedOne {
    static constexpr bool VARLD = false;
    SchedMerge M; int i0;
    __device__ __forceinline__ bool next(int i, Unit& u) const { if (i != 0) return false; return M.next(i0, u); }
};
struct SchedOneG {
    static constexpr bool VARLD = false;
    SchedGrid S; int i0;
    __device__ __forceinline__ bool next(int i, Unit& u) const { if (i != 0) return false; return S.next(i0, u); }
};
template <class Epi, class Sched, bool ALIGN_EPI>
__device__ __forceinline__ void gemm_phase(LAS unsigned char* lds, const Sched& S, const Epi& E) {
    int tid_ = threadIdx.x; asm volatile("" : "+v"(tid_));
    const int tid = tid_, wid = __builtin_amdgcn_readfirstlane(tid >> 6), lane = tid & 63, wr = wid >> 2, wc = wid & 3, fr = lane & 15, fq = lane >> 4;
    unsigned rA[2], rB[2], cc2[2];
#pragma unroll
    for (int i = 0; i < 2; ++i) { int R, C; stage_rc(tid * 16 + i * 8192, R, C); rA[i] = (unsigned)R; rB[i] = (unsigned)((R & ~31) + perm32(R & 31)); cc2[i] = (unsigned)C * 2u; }
    const size_t kstep = (size_t)(BK * 2);
    const unsigned ldsw = (unsigned)wid * 1024u;
    const int aoff = lds_byte(wr * 64 + fr, fq * 8), boff = lds_byte(wc * 32 + fr, fq * 8);
#define PG8_SA(b, h) (((b) * 2 + (h)) * HTB)
#define PG8_SB(b, h) ((4 + (b) * 2 + (h)) * HTB)
#define PG8_STAGE(bufoff, gbase, voff) do { _Pragma("unroll") for (int _i = 0; _i < 2; ++_i) \
        __builtin_amdgcn_global_load_lds((const unsigned*)((const char*)(gbase) + (voff)[_i]), (LAS unsigned*)(lds + (bufoff) + ldsw + _i * 8192), 16, 0, 0); } while (0)
#define PG8_LDA(dst, b, h) do { _Pragma("unroll") for (int m = 0; m < 4; ++m) _Pragma("unroll") for (int k = 0; k < 2; ++k) dst[m][k] = *(const LAS bf16x8*)(lds + PG8_SA(b, h) + aoff + m * 2048 + k * 1024); } while (0)
#define PG8_LDB(dst, b, h) do { _Pragma("unroll") for (int n = 0; n < 2; ++n) _Pragma("unroll") for (int k = 0; k < 2; ++k) dst[n][k] = *(const LAS bf16x8*)(lds + PG8_SB(b, h) + boff + n * 2048 + k * 1024); } while (0)
#define PG8_MMA(ai, bj, At, Bt) do { __builtin_amdgcn_s_setprio(1); _Pragma("unroll") for (int m = 0; m < 4; ++m) _Pragma("unroll") for (int n = 0; n < 2; ++n) _Pragma("unroll") for (int k = 0; k < 2; ++k) \
        acc[ai][bj][m][n] = __builtin_amdgcn_mfma_f32_16x16x32_bf16(Bt[n][k], At[m][k], acc[ai][bj][m][n], 0, 0, 0); __builtin_amdgcn_s_setprio(0); } while (0)
#define PG8_WAIT_V(n) asm volatile("s_waitcnt vmcnt(" #n ")" ::: "memory")
#define PG8_WAIT_L(n) asm volatile("s_waitcnt lgkmcnt(" #n ")" ::: "memory")
#define PG8_BAR __builtin_amdgcn_s_barrier()
#define PG8_SCHED __builtin_amdgcn_sched_barrier(0)
    Unit cur, nxt; int ui = 0;
    if (!S.next(0, cur)) return;
    f32x4 acc[2][2][4][2];
#pragma unroll
    for (int a = 0; a < 2; ++a)
#pragma unroll
        for (int b = 0; b < 2; ++b)
#pragma unroll
            for (int m = 0; m < 4; ++m)
#pragma unroll
                for (int n = 0; n < 2; ++n) acc[a][b][m][n] = (f32x4){0.f, 0.f, 0.f, 0.f};
    bf16x8 At[4][2], B0[2][2], B1[2][2];
    unsigned voffA[2], voffB[2];
#pragma unroll
    for (int i = 0; i < 2; ++i) { voffA[i] = rA[i] * (unsigned)cur.lda2 + cc2[i]; voffB[i] = rB[i] * (unsigned)cur.ldb2 + cc2[i]; }
    const char* cA = cur.A; const char* cB = cur.B;
    unsigned hA = (unsigned)HALF * cur.lda2, hB = (unsigned)HALF * cur.ldb2;
    PG8_STAGE(PG8_SB(0, 0), cB, voffB); PG8_STAGE(PG8_SB(0, 1), cB + hB, voffB); PG8_STAGE(PG8_SA(0, 0), cA, voffA); PG8_STAGE(PG8_SA(0, 1), cA + hA, voffA);
    if (wr == 1) PG8_BAR;
    PG8_WAIT_V(2); PG8_BAR;
    PG8_STAGE(PG8_SB(1, 0), cB + kstep, voffB); PG8_STAGE(PG8_SA(1, 0), cA + kstep, voffA); PG8_STAGE(PG8_SB(1, 1), cB + hB + kstep, voffB);
    PG8_WAIT_V(6); PG8_BAR;
    for (;;) {
        const bool has_next = S.next(ui + 1, nxt);
        if (!has_next) nxt = cur;
        unsigned voffAn[2], voffBn[2];
#pragma unroll
        for (int i = 0; i < 2; ++i) { if constexpr (Sched::VARLD) { voffAn[i] = rA[i] * (unsigned)nxt.lda2 + cc2[i]; voffBn[i] = rB[i] * (unsigned)nxt.ldb2 + cc2[i]; } else { voffAn[i] = voffA[i]; voffBn[i] = voffB[i]; } }
        const char* nA = nxt.A; const char* nB = nxt.B;
        const unsigned hAn = Sched::VARLD ? (unsigned)HALF * nxt.lda2 : hA, hBn = Sched::VARLD ? (unsigned)HALF * nxt.ldb2 : hB;
        const int nt = cur.nt;
        for (int t = 0; t < nt; t += 2) {
            const bool last = (t == nt - 2);
            const char* a1 = cA + (size_t)(t + 1) * kstep;
            const char* a2 = last ? nA : cA + (size_t)(t + 2) * kstep; const char* b2 = last ? nB : cB + (size_t)(t + 2) * kstep;
            const char* a3 = a2 + kstep; const char* b3 = b2 + kstep;
            const unsigned hA2 = last ? hAn : hA, hB2 = last ? hBn : hB;
            unsigned vA2[2], vB2[2];
#pragma unroll
            for (int i = 0; i < 2; ++i) { vA2[i] = last ? voffAn[i] : voffA[i]; vB2[i] = last ? voffBn[i] : voffB[i]; }
            PG8_LDB(B0, 0, 0); PG8_LDB(B1, 0, 1); PG8_SCHED; PG8_LDA(At, 0, 0); PG8_STAGE(PG8_SA(1, 1), a1 + hA, voffA);
            PG8_WAIT_V(8); PG8_WAIT_L(0); PG8_BAR; PG8_MMA(0, 0, At, B0); PG8_MMA(0, 1, At, B1); PG8_BAR; PG8_SCHED;
            PG8_LDA(At, 0, 1); PG8_STAGE(PG8_SB(0, 0), b2, vB2); PG8_STAGE(PG8_SB(0, 1), b2 + hB2, vB2); PG8_STAGE(PG8_SA(0, 0), a2, vA2);
            PG8_WAIT_V(8); PG8_WAIT_L(0); PG8_BAR; PG8_MMA(1, 0, At, B0); PG8_MMA(1, 1, At, B1); PG8_BAR; PG8_SCHED;
            PG8_LDB(B0, 1, 0); PG8_LDB(B1, 1, 1); PG8_SCHED; PG8_LDA(At, 1, 0); PG8_STAGE(PG8_SA(0, 1), a2 + hA2, vA2);
            PG8_WAIT_V(8); PG8_WAIT_L(0); PG8_BAR; PG8_MMA(0, 0, At, B0); PG8_MMA(0, 1, At, B1); PG8_BAR; PG8_SCHED;
            PG8_LDA(At, 1, 1); PG8_STAGE(PG8_SB(1, 0), b3, vB2); PG8_STAGE(PG8_SB(1, 1), b3 + hB2, vB2); PG8_STAGE(PG8_SA(1, 0), a3, vA2);
            PG8_WAIT_V(8); PG8_WAIT_L(0); PG8_BAR; PG8_MMA(1, 0, At, B0); PG8_MMA(1, 1, At, B1); PG8_BAR; PG8_SCHED;
        }
        if constexpr (ALIGN_EPI) { if (wr == 0) PG8_BAR; }
        E(acc, cur, wr, wc, fr, fq);
        if (!has_next) break;
#pragma unroll
        for (int a = 0; a < 2; ++a)
#pragma unroll
            for (int b = 0; b < 2; ++b)
#pragma unroll
                for (int m = 0; m < 4; ++m)
#pragma unroll
                    for (int n = 0; n < 2; ++n) acc[a][b][m][n] = (f32x4){0.f, 0.f, 0.f, 0.f};
        cur = nxt; cA = nA; cB = nB; hA = hAn; hB = hBn; ++ui;
#pragma unroll
        for (int i = 0; i < 2; ++i) { voffA[i] = voffAn[i]; voffB[i] = voffBn[i]; }
        if constexpr (ALIGN_EPI) { if (wr == 1) PG8_BAR; }
    }
    PG8_WAIT_V(0);
    if constexpr (!ALIGN_EPI) { if (wr == 0) PG8_BAR; }
    PG8_BAR;
#undef PG8_SA
#undef PG8_SB
#undef PG8_STAGE
#undef PG8_LDA
#undef PG8_LDB
#undef PG8_MMA
#undef PG8_WAIT_V
#undef PG8_WAIT_L
#undef PG8_BAR
#undef PG8_SCHED
}
}

#define EPI_ROWLOOP _Pragma("unroll") for (int ai = 0; ai < 2; ++ai) _Pragma("unroll") for (int m = 0; m < 4; ++m)
__device__ __forceinline__ float row_rs(const float* ssq, int row) { const f32x4* p = (const f32x4*)(ssq + (size_t)row * 16); const f32x4 a = p[0], b = p[1], c = p[2], d = p[3];
    const float s = (((a[0] + a[1]) + (a[2] + a[3])) + ((b[0] + b[1]) + (b[2] + b[3]))) + (((c[0] + c[1]) + (c[2] + c[3])) + ((d[0] + d[1]) + (d[2] + d[3])));
    return __builtin_amdgcn_rsqf(s * (1.0f / D) + EPS); }

struct EpiInProj {
    const float* ssq; unsigned char* ws;
    __device__ __forceinline__ void operator()(const f32x4 (&acc)[2][2][4][2], const pg8::Unit& u, int wr, int wc, int fr, int fq) const {
        bf16_t* const ZA = (bf16_t*)(ws + WS_ZA); bf16_t* const GLU = (bf16_t*)(ws + WS_GLU); bf16_t* const BG = (bf16_t*)(ws + WS_BG); bf16_t* const CH = (bf16_t*)(ws + WS_CH);
        const float* const ropeC = (const float*)(ws + WS_ROPEC); const float* const ropeS = (const float*)(ws + WS_ROPES);
        const int T = u.pn, row0 = u.pm * 256 + wr * 64 + fr, jcol = wc * 32 + 8 * fq;
        if (T < 4) {
            EPI_ROWLOOP { const int row = row0 + ai * 128 + m * 16; const float rs = row_rs(ssq, row);
#pragma unroll
                for (int bj = 0; bj < 2; ++bj) { f32x4 v0 = acc[ai][bj][m][0] * rs, v1 = acc[ai][bj][m][1] * rs;
                    f32x2 a = gelu_pk((f32x2){v0[0], v0[1]}), b = gelu_pk((f32x2){v0[2], v0[3]}), c = gelu_pk((f32x2){v1[0], v1[1]}), d = gelu_pk((f32x2){v1[2], v1[3]});
                    *(u32x4*)(ZA + (size_t)row * 1024 + 256 * T + 128 * bj + jcol) = pack8((f32x4){a.x, a.y, b.x, b.y}, (f32x4){c.x, c.y, d.x, d.y}); } }
        } else if (T < 8) {
            EPI_ROWLOOP { const int row = row0 + ai * 128 + m * 16; const float rs = row_rs(ssq, row); f32x4 o[2];
#pragma unroll
                for (int n = 0; n < 2; ++n) { const f32x4 a = acc[ai][0][m][n] * rs, g = acc[ai][1][m][n] * rs;
#pragma unroll
                    for (int j = 0; j < 4; ++j) o[n][j] = a[j] * sigmoidf_(g[j]); }
                *(u32x4*)(GLU + (size_t)row * 512 + 128 * (T - 4) + jcol) = pack8(o[0], o[1]); }
        } else if (T < 11) {
            const bool isq = T < 10; const bool rope = isq || wc < 2; const float sc = isq ? 0.125f : 1.0f;
            const size_t boff = isq ? WS_Q : (wc < 2 ? WS_K : WS_V); bf16_t* const base = (bf16_t*)(ws + boff);
            const int ld = isq ? 512 : 128, hcol = isq ? (4 * (T - 8) + wc) * 64 : (wc & 1) * 64;
            EPI_ROWLOOP { const int row = row0 + ai * 128 + m * 16; const float rs = row_rs(ssq, row) * sc; const int pos = row & (SEQ - 1); f32x4 o1[2], o2[2];
#pragma unroll
                for (int n = 0; n < 2; ++n) { const f32x4 x1 = acc[ai][0][m][n] * rs, x2 = acc[ai][1][m][n] * rs;
                    if (rope) { const f32x4 c = *(const f32x4*)(ropeC + pos * 32 + 8 * fq + 4 * n), s = *(const f32x4*)(ropeS + pos * 32 + 8 * fq + 4 * n);
                        o1[n] = x1 * c - x2 * s; o2[n] = x2 * c + x1 * s; } else { o1[n] = x1; o2[n] = x2; } }
                bf16_t* p = base + (size_t)row * ld + hcol + 8 * fq;
                *(u32x4*)p = pack8(o1[0], o1[1]); *(u32x4*)(p + 32) = pack8(o2[0], o2[1]); }
        } else if (T < 13) {
            EPI_ROWLOOP { const int row = row0 + ai * 128 + m * 16; const float rs = row_rs(ssq, row);
#pragma unroll
                for (int bj = 0; bj < 2; ++bj) *(u32x4*)(BG + (size_t)row * 512 + 256 * (T - 11) + 128 * bj + jcol) = pack8(acc[ai][bj][m][0] * rs, acc[ai][bj][m][1] * rs); }
        } else {
            EPI_ROWLOOP { const int row = row0 + ai * 128 + m * 16; const float rs = row_rs(ssq, row); const float rs2 = rs * rs;
                *(u32x4*)(CH + (size_t)row * 512 + 128 * (T - 13) + jcol) = pack8(acc[ai][0][m][0] * acc[ai][1][m][0] * rs2, acc[ai][0][m][1] * acc[ai][1][m][1] * rs2); }
        }
    }
};
struct EpiGate {
    const float* ssq; bf16_t* MG;
    __device__ __forceinline__ void operator()(const f32x4 (&acc)[2][2][4][2], const pg8::Unit& u, int wr, int wc, int fr, int fq) const {
        const int row0 = u.pm * 256 + wr * 64 + fr, col0 = u.pn * 256 + wc * 32 + 8 * fq;
        EPI_ROWLOOP { const int row = row0 + ai * 128 + m * 16; const float rs = row_rs(ssq, row);
#pragma unroll
            for (int bj = 0; bj < 2; ++bj) { f32x4 v0 = acc[ai][bj][m][0] * rs, v1 = acc[ai][bj][m][1] * rs;
#pragma unroll
                for (int j = 0; j < 4; ++j) { v0[j] = sigmoidf_(v0[j]); v1[j] = sigmoidf_(v1[j]); }
                *(u32x4*)(MG + (size_t)row * 1024 + col0 + 128 * bj) = pack8(v0, v1); } }
    }
};
struct EpiBranch {
    bf16_t* MG; bf16_t* TMP;
    __device__ __forceinline__ void operator()(const f32x4 (&acc)[2][2][4][2], const pg8::Unit& u, int wr, int wc, int fr, int fq) const {
        const int row0 = u.pm * 256 + wr * 64 + fr, col0 = u.pn * 256 + wc * 32 + 8 * fq, br = u.z >> 1;
        EPI_ROWLOOP { const int row = row0 + ai * 128 + m * 16;
#pragma unroll
            for (int bj = 0; bj < 2; ++bj) { const size_t off = (size_t)row * 1024 + col0 + 128 * bj;
                f32x4 g0, g1; unpack8(*(const u32x4*)(MG + off), g0, g1);
                f32x4 v0 = acc[ai][bj][m][0] * g0, v1 = acc[ai][bj][m][1] * g1;
                if (br > 0) { f32x4 t0, t1; unpack8(*(const u32x4*)(TMP + off), t0, t1); v0 += t0; v1 += t1; }
                if (br < 3) *(u32x4*)(TMP + off) = pack8(v0, v1); else *(u32x4*)(MG + off) = pack8(v0, v1); } }
    }
};
struct EpiStashB {
    bf16_t* MG;
    __device__ __forceinline__ void operator()(const f32x4 (&acc)[2][2][4][2], const pg8::Unit& u, int wr, int wc, int fr, int fq) const {
        const int row0 = u.pm * 256 + wr * 64 + fr, col0 = u.pn * 256 + wc * 32 + 8 * fq;
        EPI_ROWLOOP { const int row = row0 + ai * 128 + m * 16;
#pragma unroll
            for (int bj = 0; bj < 2; ++bj) *(u32x4*)(MG + (size_t)row * 1024 + col0 + 128 * bj) = pack8(acc[ai][bj][m][0], acc[ai][bj][m][1]); }
    }
};
struct EpiGateAcc {
    const float* ssq; bf16_t* MG; bf16_t* TMP;
    __device__ __forceinline__ void operator()(const f32x4 (&acc)[2][2][4][2], const pg8::Unit& u, int wr, int wc, int fr, int fq) const {
        const int row0 = u.pm * 256 + wr * 64 + fr, col0 = u.pn * 256 + wc * 32 + 8 * fq, br = u.z >> 1;
        EPI_ROWLOOP { const int row = row0 + ai * 128 + m * 16; const float rs = row_rs(ssq, row);
#pragma unroll
            for (int bj = 0; bj < 2; ++bj) { const size_t off = (size_t)row * 1024 + col0 + 128 * bj;
                f32x4 b0, b1; unpack8(*(const u32x4*)(MG + off), b0, b1);
                f32x4 v0 = acc[ai][bj][m][0] * rs, v1 = acc[ai][bj][m][1] * rs;
#pragma unroll
                for (int j = 0; j < 4; ++j) { v0[j] = sigmoidf_(v0[j]) * b0[j]; v1[j] = sigmoidf_(v1[j]) * b1[j]; }
                if (br > 0) { f32x4 t0, t1; unpack8(*(const u32x4*)(TMP + off), t0, t1); v0 += t0; v1 += t1; }
                if (br < 3) *(u32x4*)(TMP + off) = pack8(v0, v1); else *(u32x4*)(MG + off) = pack8(v0, v1); } }
    }
};
struct EpiMerge2 {
    EpiStashB ES; EpiGateAcc EA;
    __device__ __forceinline__ void operator()(const f32x4 (&acc)[2][2][4][2], const pg8::Unit& u, int wr, int wc, int fr, int fq) const {
        if ((u.z & 1) == 0) ES(acc, u, wr, wc, fr, fq); else EA(acc, u, wr, wc, fr, fq);
    }
};
struct EpiResid {
    bf16_t* XB; float* ssq_out;
    __device__ __forceinline__ void operator()(const f32x4 (&acc)[2][2][4][2], const pg8::Unit& u, int wr, int wc, int fr, int fq) const {
        const int row0 = u.pm * 256 + wr * 64 + fr, col0 = u.pn * 256 + wc * 32 + 8 * fq;
        EPI_ROWLOOP { const int row = row0 + ai * 128 + m * 16; float ss = 0.f;
#pragma unroll
            for (int bj = 0; bj < 2; ++bj) { const size_t off = (size_t)row * 1024 + col0 + 128 * bj;
                f32x4 x0, x1; unpack8(*(const u32x4*)(XB + off), x0, x1);
                const f32x4 v0 = x0 + acc[ai][bj][m][0], v1 = x1 + acc[ai][bj][m][1];
                *(u32x4*)(XB + off) = pack8(v0, v1);
                ss += (v0[0] * v0[0] + v0[1] * v0[1]) + (v0[2] * v0[2] + v0[3] * v0[3]) + (v1[0] * v1[0] + v1[1] * v1[1]) + (v1[2] * v1[2] + v1[3] * v1[3]); }
            ss += __shfl_xor(ss, 16); ss += __shfl_xor(ss, 32);
            if (fq == 0) ssq_out[(size_t)row * 16 + u.pn * 4 + wc] = ss; }
    }
};
struct EpiSwiGLU {
    const float* ssq; bf16_t* ACT; float zero_scale;
    __device__ __forceinline__ void operator()(const f32x4 (&acc)[2][2][4][2], const pg8::Unit& u, int wr, int wc, int fr, int fq) const {
        const int row0 = u.pm * 256 + wr * 64 + fr, col0 = u.pn * 128 + wc * 32 + 8 * fq;
        EPI_ROWLOOP { const int row = row0 + ai * 128 + m * 16; const float rs = row_rs(ssq, row); f32x4 o[2];
#pragma unroll
            for (int n = 0; n < 2; ++n) { const f32x4 g = acc[ai][0][m][n] * rs, up = acc[ai][1][m][n] * rs;
#pragma unroll
                for (int j = 0; j < 4; ++j) o[n][j] = g[j] * sigmoidf_(g[j]) * up[j] * zero_scale; }
            *(u32x4*)(ACT + (size_t)row * DFF + col0) = pack8(o[0], o[1]); }
    }
};

#define ABL_FFN_SCALE(l) 1.0f
struct Args { const float* in[19]; float* out; unsigned char* ws; };

__device__ __forceinline__ int win_src_col(int nlog) {
    const int T = nlog >> 8, o = nlog & 255, bj = o >> 7, j = o & 127;
    if (T < 4) return nlog;
    if (T < 8) return 1024 + bj * 512 + 128 * (T - 4) + j;
    if (T < 10) return 2048 + (4 * (T - 8) + (j >> 5)) * 64 + 32 * bj + (j & 31);
    if (T == 10) { const int h = j >> 5; return (h < 2 ? 2560 + h * 64 : 2688 + (h - 2) * 64) + 32 * bj + (j & 31); }
    if (T < 13) return 2816 + 256 * (T - 11) + o;
    if (T < 17) return 3328 + bj * 512 + 128 * (T - 13) + j;
    return nlog;
}
__device__ __forceinline__ void tr_item(const float* W, int Nsrc, int k0, int scolA, int scolB, const float* gain, bf16_t* WT, int K, int drow, LAS float* scr, int lane) {
    const int c4 = lane & 15; const int sc = ((c4 >> 3) ? scolB : scolA) + 4 * (c4 & 7);
    f32x4 v[16];
#pragma unroll
    for (int i = 0; i < 16; ++i) v[i] = __builtin_nontemporal_load((const f32x4*)(W + (size_t)(k0 + 4 * i + (lane >> 4)) * Nsrc + sc));
#pragma unroll
    for (int i = 0; i < 16; ++i) { const int row = 4 * i + (lane >> 4); if (gain) v[i] = v[i] * gain[k0 + row];
        LAS float* d = scr + row * 65 + 4 * c4; d[0] = v[i][0]; d[1] = v[i][1]; d[2] = v[i][2]; d[3] = v[i][3]; }
    asm volatile("s_waitcnt lgkmcnt(0)" ::: "memory");
    const int c = lane & 7;
#pragma unroll
    for (int jj = 0; jj < 8; ++jj) { const int n = (lane >> 3) + 8 * jj; const LAS float* s = scr + (8 * c) * 65 + n;
        u32x4 o; o.x = cvt_pk_bf16(s[0], s[65]); o.y = cvt_pk_bf16(s[2 * 65], s[3 * 65]); o.z = cvt_pk_bf16(s[4 * 65], s[5 * 65]); o.w = cvt_pk_bf16(s[6 * 65], s[7 * 65]);
        *(u32x4*)(WT + (size_t)(drow + n) * K + k0 + 8 * c) = o; }
    asm volatile("s_waitcnt lgkmcnt(0)" ::: "memory");
}
__device__ __forceinline__ void prologue(const Args& a, LAS unsigned char* lds, int G) {
    int tid_ = threadIdx.x; asm volatile("" : "+v"(tid_));
    const int tid = tid_, lane = tid & 63, wave = __builtin_amdgcn_readfirstlane(tid >> 6);
    const int gw = blockIdx.x * NWAVES + wave, NGW = G * NWAVES;
    unsigned char* ws = a.ws;
    LAS float* scr = (LAS float*)(lds + wave * 16640);
    constexpr int I_IN = 16 * 132, I_BR = 512, I_OUT = 256, I_GU = 16 * 88, I_DN = 44 * 16, I_L = I_IN + I_BR + I_OUT + I_GU + I_DN;
    for (int it = gw; it < 2 * I_L; it += NGW) {
        const int l = it / I_L; int r = it % I_L;
        if (r < I_IN) { const int kb = r / 132, nb = r % 132, n0 = 64 * nb;
            tr_item(a.in[2] + (size_t)l * D * PROJ, PROJ, 64 * kb, win_src_col(n0), win_src_col(n0 + 32), a.in[1] + l * D, (bf16_t*)(ws + WS_WIN + l * WIN_L), D, n0, scr, lane); continue; } r -= I_IN;
        if (r < I_BR) { const int br = r >> 7, q = r & 127, kb = q >> 4, nb = q & 15;
            tr_item(a.in[13] + (size_t)(l * 4 + br) * 512 * D, D, 64 * kb, 64 * nb, 64 * nb + 32, nullptr, (bf16_t*)(ws + WS_WBR + l * WBR_L) + (size_t)br * 1024 * 512, 512, 64 * nb, scr, lane); continue; } r -= I_BR;
        if (r < I_OUT) { const int kb = r >> 4, nb = r & 15;
            tr_item(a.in[14] + (size_t)l * D * D, D, 64 * kb, 64 * nb, 64 * nb + 32, nullptr, (bf16_t*)(ws + WS_WOUT + l * WOUT_L), D, 64 * nb, scr, lane); continue; } r -= I_OUT;
        if (r < I_GU) { const int kb = r / 88, nb = r % 88, n0 = 64 * nb, T = n0 >> 8, o = n0 & 255, sc = (o >> 7) * DFF + 128 * T + (o & 127);
            tr_item(a.in[16] + (size_t)l * D * 2 * DFF, 2 * DFF, 64 * kb, sc, sc + 32, a.in[15] + l * D, (bf16_t*)(ws + WS_WGU + l * WGU_L), D, n0, scr, lane); continue; } r -= I_GU;
        { const int kb = r >> 4, nb = r & 15;
            tr_item(a.in[17] + (size_t)l * DFF * D, D, 64 * kb, 64 * nb, 64 * nb + 32, nullptr, (bf16_t*)(ws + WS_WDN + l * WDN_L), DFF, 64 * nb, scr, lane); }
    }
    float* ssq = (float*)(ws + WS_SSQ);
    for (int row = gw; row < M; row += NGW) {
        const f32x4* xr = (const f32x4*)(a.in[0] + (size_t)row * D) + lane; float s = 0.f; f32x4 v[4];
#pragma unroll
        for (int j = 0; j < 4; ++j) { v[j] = xr[64 * j]; s += (v[j][0] * v[j][0] + v[j][1] * v[j][1]) + (v[j][2] * v[j][2] + v[j][3] * v[j][3]); }
        s = wave_sum(s);
        u32x2* o = (u32x2*)((bf16_t*)(ws + WS_XB) + (size_t)row * D) + lane;
#pragma unroll
        for (int j = 0; j < 4; ++j) o[64 * j] = (u32x2){cvt_pk_bf16(v[j][0], v[j][1]), cvt_pk_bf16(v[j][2], v[j][3])};
        if (lane < 16) ssq[(size_t)row * 16 + lane] = lane == 0 ? s : 0.f;
    }
    { float* par = (float*)(ws + WS_PAR); const int gt = blockIdx.x * NTHREADS + tid, GT = G * NTHREADS;
#define CPY(dstoff, srcp, n) for (int i = gt; i < (n); i += GT) par[(dstoff) + i] = (srcp)[i]
      for (int l = 0; l < 2; ++l) { const int o = l * PAR_L;
          CPY(o + P_SGLNG, a.in[3] + l * 512, 512); CPY(o + P_SGLNB, a.in[4] + l * 512, 512); CPY(o + P_SGB, a.in[6] + l * 512, 512);
          CPY(o + P_CVB, a.in[8] + l * 512, 512); CPY(o + P_CVLNG, a.in[9] + l * 512, 512); CPY(o + P_CVLNB, a.in[10] + l * 512, 512);
          CPY(o + P_SCW, a.in[12] + l * 1536, 1536); CPY(o + P_SINK, a.in[11] + l * 8, 8); CPY(o + P_CVW, a.in[7] + l * 31 * 512, 31 * 512); }
      CPY(P_FINAL, a.in[18], 1024);
#undef CPY
    }
    for (int i = blockIdx.x * NTHREADS + tid; i < SEQ * 32; i += G * NTHREADS) { const int pos = i >> 5, f = i & 31;
        const double rev = (double)pos * INVF_REV[f]; const float fr = (float)(rev - floor(rev));
        ((float*)(ws + WS_ROPEC))[i] = __builtin_amdgcn_cosf(fr); ((float*)(ws + WS_ROPES))[i] = __builtin_amdgcn_sinf(fr); }
    for (int i = blockIdx.x * NTHREADS + tid; i < 2 * 4 * 128 * 128; i += G * NTHREADS) { const int s = i & 127, t = (i >> 7) & 127;
        ((bf16_t*)(ws + WS_SGWT))[i] = s <= t ? (bf16_t)(cvt_pk_bf16(a.in[5][i], 0.f) & 0xffffu) : (bf16_t)0; }
}

__device__ __forceinline__ void mixer_sg(unsigned char* ws, int l, LAS unsigned char* lds, int unit) {
    { size_t z_ = 0; asm volatile("" : "+s"(z_)); ws += z_; } int tid_ = threadIdx.x; asm volatile("" : "+v"(tid_));
    const float* par = (const float*)(ws + WS_PAR) + l * PAR_L;
    const int tid = tid_, lane = tid & 63, wave = __builtin_amdgcn_readfirstlane(tid >> 6);
    const int ck = unit >> 2, g = unit & 3, r0 = ck * 128;
    const bf16_t* ZA = (const bf16_t*)(ws + WS_ZA); bf16_t* YA = (bf16_t*)(ws + WS_YA);
    LAS bf16_t* vnT = (LAS bf16_t*)lds;
    const float* lng = par + P_SGLNG; const float* lnb = par + P_SGLNB;
    const f32x4 g0 = *(const f32x4*)(lng + 8 * lane), g1 = *(const f32x4*)(lng + 8 * lane + 4), b0 = *(const f32x4*)(lnb + 8 * lane), b1 = *(const f32x4*)(lnb + 8 * lane + 4);
    u32x4 raw[16];
#pragma unroll
    for (int i = 0; i < 16; ++i) raw[i] = *(const u32x4*)(ZA + (size_t)(r0 + wave + 8 * i) * 1024 + 512 + 8 * lane);
#pragma unroll
    for (int i = 0; i < 16; ++i) { const int s = wave + 8 * i;
        f32x4 x0, x1; unpack8(raw[i], x0, x1);
        const float mean = wave_sum((x0[0] + x0[1]) + (x0[2] + x0[3]) + (x1[0] + x1[1]) + (x1[2] + x1[3])) * (1.0f / 512.0f);
        x0 -= mean; x1 -= mean;
        const float var = wave_sum((x0[0] * x0[0] + x0[1] * x0[1]) + (x0[2] * x0[2] + x0[3] * x0[3]) + (x1[0] * x1[0] + x1[1] * x1[1]) + (x1[2] * x1[2] + x1[3] * x1[3])) * (1.0f / 512.0f);
        const float rstd = __builtin_amdgcn_rsqf(var + EPS);
        if ((lane >> 4) == g) { const int c = 8 * (lane & 15); x0 = x0 * rstd * g0 + b0; x1 = x1 * rstd * g1 + b1;
            const unsigned p0 = cvt_pk_bf16(x0[0], x0[1]), p1 = cvt_pk_bf16(x0[2], x0[3]), p2 = cvt_pk_bf16(x1[0], x1[1]), p3 = cvt_pk_bf16(x1[2], x1[3]);
            LAS bf16_t* d = vnT + c * 136 + s;
            d[0] = (bf16_t)p0; d[136] = (bf16_t)(p0 >> 16); d[2 * 136] = (bf16_t)p1; d[3 * 136] = (bf16_t)(p1 >> 16);
            d[4 * 136] = (bf16_t)p2; d[5 * 136] = (bf16_t)(p2 >> 16); d[6 * 136] = (bf16_t)p3; d[7 * 136] = (bf16_t)(p3 >> 16); }
    }
    __syncthreads();
    { const int fr = lane & 15, fq = lane >> 4, t0 = 16 * wave, nks = (wave >> 1) + 1;
      const bf16_t* W = (const bf16_t*)(ws + WS_SGWT) + (size_t)(l * 4 + g) * 16384 + (size_t)(t0 + fr) * 128 + 8 * fq;
      f32x4 acc[8];
#pragma unroll
      for (int ct = 0; ct < 8; ++ct) acc[ct] = (f32x4){0.f, 0.f, 0.f, 0.f};
      for (int ks = 0; ks < nks; ++ks) {
          const bf16x8 wf = *(const bf16x8*)(W + 32 * ks);
#pragma unroll
          for (int ct = 0; ct < 8; ++ct) { const bf16x8 vf = *(const LAS bf16x8*)(vnT + (16 * ct + fr) * 136 + 32 * ks + 8 * fq);
              acc[ct] = __builtin_amdgcn_mfma_f32_16x16x32_bf16(vf, wf, acc[ct], 0, 0, 0); }
      }
      const int t = t0 + fr; const size_t row = r0 + t; const float bs = par[P_SGB + g * 128 + t];
#pragma unroll
      for (int ct = 0; ct < 8; ++ct) { const int c = 128 * g + 16 * ct + 4 * fq;
          const u32x2 uu = *(const u32x2*)(ZA + row * 1024 + c);
          const float o0 = bf_lo(uu.x) * (acc[ct][0] + bs), o1 = bf_hi(uu.x) * (acc[ct][1] + bs), o2 = bf_lo(uu.y) * (acc[ct][2] + bs), o3 = bf_hi(uu.y) * (acc[ct][3] + bs);
          *(u32x2*)(YA + row * 512 + c) = (u32x2){cvt_pk_bf16(o0, o1), cvt_pk_bf16(o2, o3)}; }
    }
    __syncthreads();
}
__device__ __forceinline__ void mixer_conv(unsigned char* ws, int l, LAS unsigned char* lds, int unit) {
    { size_t z_ = 0; asm volatile("" : "+s"(z_)); ws += z_; } int tid_ = threadIdx.x; asm volatile("" : "+v"(tid_));
    const float* par = (const float*)(ws + WS_PAR) + l * PAR_L;
    const int tid = tid_, lane = tid & 63, wave = tid >> 6;
    const int b = unit >> 6, tb = unit & 63, t0 = tb * 32; const size_t rbase = (size_t)b * SEQ;
    const bf16_t* GLU = (const bf16_t*)(ws + WS_GLU); bf16_t* YB = (bf16_t*)(ws + WS_YB);
    LAS bf16_t* in = (LAS bf16_t*)lds;
    LAS float* cv = (LAS float*)(lds + 65536);
    for (int i = tid; i < 62 * 64; i += NTHREADS) { const int r = i >> 6, ch = i & 63; const int t = t0 - 30 + r;
        u32x4 v = {0u, 0u, 0u, 0u}; if (t >= 0) v = *(const u32x4*)(GLU + (rbase + t) * 512 + 8 * ch);
        *(LAS u32x4*)(in + r * 512 + 8 * ch) = v; }
    __syncthreads();
    { const int c = tid; float w[31], x[62];
#pragma unroll
      for (int k = 0; k < 31; ++k) w[k] = par[P_CVW + k * 512 + c];
#pragma unroll
      for (int r = 0; r < 62; ++r) x[r] = bf1(in[r * 512 + c]);
      const float bias = par[P_CVB + c];
#pragma unroll
      for (int t = 0; t < 32; ++t) { float s = bias;
#pragma unroll
          for (int k = 0; k < 31; ++k) s += w[k] * x[t + k];
          cv[t * 512 + c] = s; } }
    __syncthreads();
    { const float* lng = par + P_CVLNG; const float* lnb = par + P_CVLNB;
      const f32x4 g0 = *(const f32x4*)(lng + 8 * lane), g1 = *(const f32x4*)(lng + 8 * lane + 4), b0 = *(const f32x4*)(lnb + 8 * lane), b1 = *(const f32x4*)(lnb + 8 * lane + 4);
      for (int t = wave; t < 32; t += NWAVES) {
          f32x4 x0 = *(const LAS f32x4*)(cv + t * 512 + 8 * lane), x1 = *(const LAS f32x4*)(cv + t * 512 + 8 * lane + 4);
          const float mean = wave_sum((x0[0] + x0[1]) + (x0[2] + x0[3]) + (x1[0] + x1[1]) + (x1[2] + x1[3])) * (1.0f / 512.0f);
          x0 -= mean; x1 -= mean;
          const float var = wave_sum((x0[0] * x0[0] + x0[1] * x0[1]) + (x0[2] * x0[2] + x0[3] * x0[3]) + (x1[0] * x1[0] + x1[1] * x1[1]) + (x1[2] * x1[2] + x1[3] * x1[3])) * (1.0f / 512.0f);
          const float rstd = __builtin_amdgcn_rsqf(var + EPS);
          x0 = x0 * rstd * g0 + b0; x1 = x1 * rstd * g1 + b1;
#pragma unroll
          for (int j = 0; j < 4; ++j) { x0[j] = x0[j] * sigmoidf_(x0[j]); x1[j] = x1[j] * sigmoidf_(x1[j]); }
          *(u32x4*)(YB + (rbase + t0 + t) * 512 + 8 * lane) = pack8(x0, x1); } }
    __syncthreads();
}
__device__ __forceinline__ void mixer_attn(unsigned char* ws, int l, LAS unsigned char* lds, int unit) {
    { size_t z_ = 0; asm volatile("" : "+s"(z_)); ws += z_; } int tid_ = threadIdx.x; asm volatile("" : "+v"(tid_));
    const float* par = (const float*)(ws + WS_PAR) + l * PAR_L;
    const int tid = tid_, lane = tid & 63, wave = __builtin_amdgcn_readfirstlane(tid >> 6), fr = lane & 15, fq = lane >> 4;
    const int kvh = unit & 1, blk = (unit >> 1) & 15, b = unit >> 5; const size_t rbase = (size_t)b * SEQ;
    bf16_t* Q = (bf16_t*)(ws + WS_Q); const bf16_t* K = (const bf16_t*)(ws + WS_K); const bf16_t* V = (const bf16_t*)(ws + WS_V);
    LAS bf16_t* Kl = (LAS bf16_t*)lds;
    LAS bf16_t* VT = (LAS bf16_t*)(lds + 36864);
    for (int i = tid; i < 256 * 8; i += NTHREADS) { const int r = i >> 3, ch = i & 7; const int t = (blk - 1) * 128 + r;
        u32x4 kv = {0u, 0u, 0u, 0u}, vv = {0u, 0u, 0u, 0u};
        if (t >= 0) { kv = *(const u32x4*)(K + (rbase + t) * 128 + kvh * 64 + 8 * ch); vv = *(const u32x4*)(V + (rbase + t) * 128 + kvh * 64 + 8 * ch); }
        *(LAS u32x4*)(Kl + r * 72 + 8 * ch) = kv;
        LAS bf16_t* d = VT + (8 * ch) * 264 + r;
        d[0] = (bf16_t)vv.x; d[264] = (bf16_t)(vv.x >> 16); d[2 * 264] = (bf16_t)vv.y; d[3 * 264] = (bf16_t)(vv.y >> 16);
        d[4 * 264] = (bf16_t)vv.z; d[5 * 264] = (bf16_t)(vv.z >> 16); d[6 * 264] = (bf16_t)vv.w; d[7 * 264] = (bf16_t)(vv.w >> 16); }
    __syncthreads();
    const int g = wave >> 1, head = kvh * 4 + g; const float sink = par[P_SINK + head];
    for (int it = 0; it < 2; ++it) {
        const int qs = 2 * (wave & 1) + it, qi0 = 32 * qs; const size_t qrow0 = rbase + blk * 128 + qi0;
        bf16x8 qf[2][2];
#pragma unroll
        for (int qt = 0; qt < 2; ++qt)
#pragma unroll
            for (int ks = 0; ks < 2; ++ks) qf[qt][ks] = *(const bf16x8*)(Q + (qrow0 + 16 * qt + fr) * 512 + head * 64 + 32 * ks + 8 * fq);
        f32x4 S[2][10];
#pragma unroll
        for (int qt = 0; qt < 2; ++qt)
#pragma unroll
            for (int kt = 0; kt < 10; ++kt) S[qt][kt] = (f32x4){0.f, 0.f, 0.f, 0.f};
#pragma unroll
        for (int kt = 0; kt < 10; ++kt)
#pragma unroll
            for (int ks = 0; ks < 2; ++ks) { const bf16x8 kf = *(const LAS bf16x8*)(Kl + (qi0 + 16 * kt + fr) * 72 + 32 * ks + 8 * fq);
#pragma unroll
                for (int qt = 0; qt < 2; ++qt) S[qt][kt] = __builtin_amdgcn_mfma_f32_16x16x32_bf16(kf, qf[qt][ks], S[qt][kt], 0, 0, 0); }
        bf16x8 pf[2][5];
#pragma unroll
        for (int qt = 0; qt < 2; ++qt) { const int qi = qi0 + 16 * qt + fr; float mx = sink;
#pragma unroll
            for (int kt = 0; kt < 10; ++kt)
#pragma unroll
                for (int j = 0; j < 4; ++j) { const int kb = qi0 + 16 * kt + 4 * fq + j; const bool valid = (kb > qi) && (kb <= qi + 128) && (blk > 0 || kb >= 128);
                    const float sv = valid ? S[qt][kt][j] : -INFINITY; S[qt][kt][j] = sv; mx = fmaxf(mx, sv); }
            mx = fmaxf(mx, __shfl_xor(mx, 16)); mx = fmaxf(mx, __shfl_xor(mx, 32));
            float sum = 0.f;
#pragma unroll
            for (int kt = 0; kt < 10; ++kt)
#pragma unroll
                for (int j = 0; j < 4; ++j) { const float p = __expf(S[qt][kt][j] - mx); S[qt][kt][j] = p; sum += p; }
            sum += __shfl_xor(sum, 16); sum += __shfl_xor(sum, 32);
            const float inv = 1.0f / (sum + __expf(sink - mx));
#pragma unroll
            for (int p = 0; p < 5; ++p) { const f32x4 a0 = S[qt][2 * p] * inv, a1 = S[qt][2 * p + 1] * inv; pf[qt][p] = __builtin_bit_cast(bf16x8, pack8(a0, a1)); }
        }
        f32x4 o[2][4];
#pragma unroll
        for (int qt = 0; qt < 2; ++qt)
#pragma unroll
            for (int dt = 0; dt < 4; ++dt) o[qt][dt] = (f32x4){0.f, 0.f, 0.f, 0.f};
#pragma unroll
        for (int p = 0; p < 5; ++p)
#pragma unroll
            for (int dt = 0; dt < 4; ++dt) { const LAS bf16_t* vp = VT + (16 * dt + fr) * 264 + qi0 + 32 * p + 4 * fq;
                const u32x2 lo = *(const LAS u32x2*)vp, hi = *(const LAS u32x2*)(vp + 16);
                const bf16x8 vf = __builtin_bit_cast(bf16x8, (u32x4){lo.x, lo.y, hi.x, hi.y});
#pragma unroll
                for (int qt = 0; qt < 2; ++qt) o[qt][dt] = __builtin_amdgcn_mfma_f32_16x16x32_bf16(vf, pf[qt][p], o[qt][dt], 0, 0, 0); }
#pragma unroll
        for (int qt = 0; qt < 2; ++qt)
#pragma unroll
            for (int dt = 0; dt < 4; ++dt) *(u32x2*)(Q + (qrow0 + 16 * qt + fr) * 512 + head * 64 + 16 * dt + 4 * fq) = (u32x2){cvt_pk_bf16(o[qt][dt][0], o[qt][dt][1]), cvt_pk_bf16(o[qt][dt][2], o[qt][dt][3])};
    }
    __syncthreads();
}
__device__ __forceinline__ void mixer_sc(unsigned char* ws, int l, int G) {
    { size_t z_ = 0; asm volatile("" : "+s"(z_)); ws += z_; } int tid_ = threadIdx.x; asm volatile("" : "+v"(tid_));
    bf16_t* BG = (bf16_t*)(ws + WS_BG); const bf16_t* CH = (const bf16_t*)(ws + WS_CH);
    const float* w = (const float*)(ws + WS_PAR) + l * PAR_L + P_SCW;
    for (int i = blockIdx.x * NTHREADS + tid_; i < (M / 8) * 64; i += G * NTHREADS) {
        const int row0 = 8 * (i >> 6), c = 8 * (i & 63), t0 = row0 & (SEQ - 1);
        u32x4 ch[10], bg[8];
#pragma unroll
        for (int r = 0; r < 10; ++r) { ch[r] = (u32x4){0u, 0u, 0u, 0u}; if (t0 - 2 + r >= 0) ch[r] = *(const u32x4*)(CH + (size_t)(row0 - 2 + r) * 512 + c); }
#pragma unroll
        for (int r = 0; r < 8; ++r) bg[r] = *(const u32x4*)(BG + (size_t)(row0 + r) * 512 + c);
        f32x4 wa[3], wb[3];
#pragma unroll
        for (int k = 0; k < 3; ++k) { wa[k] = *(const f32x4*)(w + k * 512 + c); wb[k] = *(const f32x4*)(w + k * 512 + c + 4); }
#pragma unroll
        for (int r = 0; r < 8; ++r) { f32x4 a0 = {0.f, 0.f, 0.f, 0.f}, a1 = a0;
#pragma unroll
            for (int k = 0; k < 3; ++k) { f32x4 x0, x1; unpack8(ch[r + k], x0, x1); a0 += x0 * wa[k]; a1 += x1 * wb[k]; }
            f32x4 g0, g1; unpack8(bg[r], g0, g1);
            *(u32x4*)(BG + (size_t)(row0 + r) * 512 + c) = pack8(g0 * a0, g1 * a1); }
    }
}

#define RLX_AGENT __ATOMIC_RELAXED, __HIP_MEMORY_SCOPE_AGENT
#define XB_TMO      128
#define XB_XCNT(j)  (256  + 64 * (j))
#define XB_XSUB(j)  (1280 + 64 * (j))
#define XB_XGEN(j)  (2304 + 64 * (j))
#define XB_TOP      3328
#define XB_TOPGEN   3392
#define XCD_BAR_WORDS 3456
#define XB_SPIN_CAP (1u << 18)

__device__ __forceinline__ unsigned xb_ld(unsigned* p)              { return __hip_atomic_load(p, __ATOMIC_RELAXED, __HIP_MEMORY_SCOPE_AGENT); }
__device__ __forceinline__ unsigned xb_add(unsigned* p, unsigned v) { return __hip_atomic_fetch_add(p, v, __ATOMIC_RELAXED, __HIP_MEMORY_SCOPE_AGENT); }
__device__ __forceinline__ unsigned xb_xcc_id() { return (unsigned)__builtin_amdgcn_s_getreg((3 << 11) | 20) & 0xFu; }
#define XB_SPIN(cond, bar) do { unsigned _sp = 0; while (cond) { __builtin_amdgcn_s_sleep(1); \
    if ((++_sp & 255u) == 0u) { if (xb_ld(&(bar)[XB_TMO])) break; if (_sp > XB_SPIN_CAP) { atomicAdd(&(bar)[XB_TMO], 1u); break; } } } } while (0)

struct XcdBarrier {
    unsigned* bar; unsigned x;
    volatile LAS unsigned* st;
};

__device__ __forceinline__ XcdBarrier xcd_barrier_post(unsigned* bar, volatile LAS unsigned* st) {
    XcdBarrier b; b.bar = bar; b.x = xb_xcc_id(); b.st = st;
    if (threadIdx.x == 0) (void)xb_add(&bar[XB_XCNT(b.x)], 1u);
    return b;
}
__device__ __forceinline__ void xcd_barrier_complete(unsigned* bar, unsigned x, unsigned& nloc, unsigned& nx) {
    const unsigned G = gridDim.x * gridDim.y * gridDim.z;
    unsigned sum, cnt, mine, sp = 0u;
    for (;;) {
        sum = 0u; cnt = 0u; mine = 0u;
#pragma unroll
        for (unsigned j = 0; j < 16; ++j) { const unsigned c = xb_ld(&bar[XB_XCNT(j)]); sum += c; cnt += (c > 0u) ? 1u : 0u; mine = (j == x) ? c : mine; }
        if (sum == G) break;
        __builtin_amdgcn_s_sleep(1);
        if ((++sp & 255u) == 0u) { if (xb_ld(&bar[XB_TMO])) break; if (sp > XB_SPIN_CAP) { atomicAdd(&bar[XB_TMO], 1u); break; } }
    }
    nloc = mine > 0u ? mine : 1u; nx = cnt > 0u ? cnt : 1u;
}

__device__ __forceinline__ void xcd_barrier(const XcdBarrier& b) {
    asm volatile("s_waitcnt vmcnt(0)" ::: "memory");
    __syncthreads();
    if (threadIdx.x == 0) {
        unsigned* bar = b.bar;
        __builtin_amdgcn_s_waitcnt(0);
        unsigned nloc = b.st[0], nx = b.st[1];
        if (nloc == 0u) { xcd_barrier_complete(bar, b.x, nloc, nx); b.st[0] = nloc; b.st[1] = nx; }
        const unsigned old = xb_add(&bar[XB_XSUB(b.x)], 1u);
        const unsigned gen = old / nloc;
        if (old + 1u == (gen + 1u) * nloc) {
            __builtin_amdgcn_fence(__ATOMIC_RELEASE, "agent");
            asm volatile("s_waitcnt vmcnt(0)" ::: "memory");
            const unsigned og = xb_add(&bar[XB_TOP], 1u);
            const unsigned tg = og / nx;
            if (og + 1u == (tg + 1u) * nx) xb_add(&bar[XB_TOPGEN], 1u);
            else XB_SPIN(xb_ld(&bar[XB_TOPGEN]) == tg, bar);
            __builtin_amdgcn_fence(__ATOMIC_ACQUIRE, "agent");
            xb_add(&bar[XB_XGEN(b.x)], 1u);
            asm volatile("s_waitcnt vmcnt(0)" ::: "memory");
        } else {
            XB_SPIN(xb_ld(&bar[XB_XGEN(b.x)]) == gen, bar);
            __builtin_amdgcn_fence(__ATOMIC_ACQUIRE, "agent");
            asm volatile("s_waitcnt vmcnt(0)" ::: "memory");
        }
    }
    __syncthreads();
}


#define GRID_SYNC() do { XcdBarrier xb_; xb_.bar = (unsigned*)(ws + WS_BAR); xb_.x = xb_xcc_id(); xb_.st = (volatile LAS unsigned*)(lds + MISC_OFF); xcd_barrier(xb_); } while (0)
__global__ void __launch_bounds__(NTHREADS, 2) fwd_megakernel(Args a) {
    extern __shared__ __attribute__((aligned(16))) unsigned char lds_raw[];
    LAS unsigned char* lds = (LAS unsigned char*)lds_raw;
    cg::grid_group grid = cg::this_grid();
    const int G = gridDim.x, c = blockIdx.x;
    unsigned char* ws = a.ws;
    float* ssq = (float*)(ws + WS_SSQ);

    { volatile LAS unsigned* misc = (volatile LAS unsigned*)(lds + MISC_OFF); if (threadIdx.x < 16) misc[threadIdx.x] = 0u; }
    __syncthreads();
    grid.sync();
    (void)xcd_barrier_post((unsigned*)(ws + WS_BAR), (volatile LAS unsigned*)(lds + MISC_OFF));
    prologue(a, lds, G);
    GRID_SYNC();

    for (int l = 0; l < 2; ++l) {
        { size_t z_ = 0; asm volatile("" : "+s"(z_)); ws += z_; } ssq = (float*)(ws + WS_SSQ);
        const float* ssq_mix = ssq + (size_t)(2 * l) * M * 16;
        { pg8::SchedGrid S; S.nM = 64; S.nN = 17; S.nwg = 64 * 17; S.G = G; S.c = c; S.A = (const char*)(ws + WS_XB); S.B = (const char*)(ws + WS_WIN + l * WIN_L); S.lda2 = 2048; S.ldb2 = 2048; S.nt = 16;
          EpiInProj E{ssq_mix, ws};
          pg8::gemm_phase<EpiInProj, pg8::SchedGrid, true>(lds, S, E);
        }
        GRID_SYNC(); { size_t z_ = 0; asm volatile("" : "+s"(z_)); ws += z_; }
        for (int u = c; u < 512; u += G) mixer_sg(ws, l, lds, u);
        for (int u = c; u < 512; u += G) mixer_conv(ws, l, lds, u);
        for (int u = c; u < 256; u += G) mixer_attn(ws, l, lds, u);
        mixer_sc(ws, l, G);
        GRID_SYNC(); { size_t z_ = 0; asm volatile("" : "+s"(z_)); ws += z_; } ssq = (float*)(ws + WS_SSQ);
        { pg8::SchedMerge S; S.G = G; S.c = c; S.ws = (const char*)ws; S.WG = (const char*)(ws + WS_WIN + l * WIN_L) + (size_t)NLOG1 * 2048;
          S.WBR = (const char*)(ws + WS_WBR + l * WBR_L);
          EpiStashB ES{(bf16_t*)(ws + WS_MG)}; EpiGateAcc EA{ssq_mix, (bf16_t*)(ws + WS_MG), (bf16_t*)(ws + WS_TMP)};
          S.swap = 1; EpiMerge2 E2{ES, EA};
          pg8::gemm_phase<EpiMerge2, pg8::SchedMerge, true>(lds, S, E2);
        }
        GRID_SYNC(); { size_t z_ = 0; asm volatile("" : "+s"(z_)); ws += z_; } ssq = (float*)(ws + WS_SSQ);
        { pg8::SchedGrid S; S.nM = 64; S.nN = 4; S.nwg = 256; S.G = G; S.c = c; S.A = (const char*)(ws + WS_MG); S.B = (const char*)(ws + WS_WOUT + l * WOUT_L); S.lda2 = 2048; S.ldb2 = 2048; S.nt = 16;
          EpiResid E{(bf16_t*)(ws + WS_XB), ssq + (size_t)(2 * l + 1) * M * 16};
          pg8::gemm_phase<EpiResid, pg8::SchedGrid, false>(lds, S, E); }
        GRID_SYNC(); { size_t z_ = 0; asm volatile("" : "+s"(z_)); ws += z_; } ssq = (float*)(ws + WS_SSQ);
        { pg8::SchedGrid S; S.nM = 64; S.nN = 22; S.nwg = 64 * 22; S.G = G; S.c = c; S.A = (const char*)(ws + WS_XB); S.B = (const char*)(ws + WS_WGU + l * WGU_L); S.lda2 = 2048; S.ldb2 = 2048; S.nt = 16;
          EpiSwiGLU E{ssq + (size_t)(2 * l + 1) * M * 16, (bf16_t*)(ws + WS_ACT), ABL_FFN_SCALE(l)};
          pg8::gemm_phase<EpiSwiGLU, pg8::SchedGrid, true>(lds, S, E);
        }
        GRID_SYNC(); { size_t z_ = 0; asm volatile("" : "+s"(z_)); ws += z_; } ssq = (float*)(ws + WS_SSQ);
        { pg8::SchedGrid S; S.nM = 64; S.nN = 4; S.nwg = 256; S.G = G; S.c = c; S.A = (const char*)(ws + WS_ACT); S.B = (const char*)(ws + WS_WDN + l * WDN_L); S.lda2 = DFF * 2; S.ldb2 = DFF * 2; S.nt = DFF / 64;
          EpiResid E{(bf16_t*)(ws + WS_XB), ssq + (size_t)(2 * l + 2) * M * 16};
          pg8::gemm_phase<EpiResid, pg8::SchedGrid, false>(lds, S, E); }
        GRID_SYNC();
    }
    { { size_t z_ = 0; asm volatile("" : "+s"(z_)); ws += z_; } int tid_ = threadIdx.x; asm volatile("" : "+v"(tid_));
      const int lane = tid_ & 63, gw = c * NWAVES + (tid_ >> 6), NGW = G * NWAVES; const float* gf = (const float*)(ws + WS_PAR) + P_FINAL; const float* sq = (const float*)(ws + WS_SSQ) + (size_t)4 * M * 16;
      const bf16_t* XBp = (const bf16_t*)(ws + WS_XB);
      for (int row = gw; row < M; row += 2 * NGW) { const int row2 = row + NGW;
          u32x4 ra_[2], rb_[2];
#pragma unroll
          for (int j = 0; j < 2; ++j) { ra_[j] = *(const u32x4*)(XBp + (size_t)row * D + 512 * j + 8 * lane); rb_[j] = *(const u32x4*)(XBp + (size_t)row2 * D + 512 * j + 8 * lane); }
          const float ra = row_rs(sq, row), rb = row_rs(sq, row2);
#pragma unroll
          for (int j = 0; j < 2; ++j) { const f32x4 g0 = *(const f32x4*)(gf + 512 * j + 8 * lane), g1 = *(const f32x4*)(gf + 512 * j + 8 * lane + 4);
              f32x4 x0, x1; unpack8(ra_[j], x0, x1); float* oa = a.out + (size_t)row * D + 512 * j + 8 * lane; *(f32x4*)oa = x0 * ra * g0; *(f32x4*)(oa + 4) = x1 * ra * g1;
              unpack8(rb_[j], x0, x1); float* ob = a.out + (size_t)row2 * D + 512 * j + 8 * lane; *(f32x4*)ob = x0 * rb * g0; *(f32x4*)(ob + 4) = x1 * rb * g1; } } }
}

extern "C" void kernel_launch(void* const* d_in, const int* in_sizes, int n_in, void* d_out, int out_size, void* d_ws, size_t ws_size, hipStream_t stream) {
    static int grid = 0;
    if (grid == 0) {
        if (n_in != 19 || out_size != M * D || ws_size < WS_END) { fprintf(stderr, "kernel_launch: unexpected shapes (n_in %d out %d ws %zu)\n", n_in, out_size, ws_size); grid = -1; return; }
        int dev = 0, cus = 0, per_cu = 0;
        if (hipGetDevice(&dev) != hipSuccess || hipDeviceGetAttribute(&cus, hipDeviceAttributeMultiprocessorCount, dev) != hipSuccess) { grid = -1; return; }
        if (hipFuncSetAttribute((const void*)fwd_megakernel, hipFuncAttributeMaxDynamicSharedMemorySize, LDS_BYTES) != hipSuccess) { fprintf(stderr, "kernel_launch: hipFuncSetAttribute failed\n"); grid = -1; return; }
        if (hipOccupancyMaxActiveBlocksPerMultiprocessor(&per_cu, (const void*)fwd_megakernel, NTHREADS, LDS_BYTES) != hipSuccess || per_cu < 1) { fprintf(stderr, "kernel_launch: occupancy query says %d\n", per_cu); per_cu = 1; }
        (void)hipGetLastError();
        grid = cus * 1;
    }
    if (grid < 0) return;
    if (hipMemsetAsync((char*)d_ws + WS_BAR, 0, 16384, stream) != hipSuccess) { fprintf(stderr, "kernel_launch: memset failed\n"); return; }
    Args a{};
    for (int i = 0; i < 19; ++i) a.in[i] = (const float*)d_in[i];
    a.out = (float*)d_out; a.ws = (unsigned char*)d_ws;
    void* args[] = {&a};
    hipError_t e = hipLaunchCooperativeKernel((const void*)fwd_megakernel, dim3(grid), dim3(NTHREADS), args, LDS_BYTES, stream);
    if (e != hipSuccess) fprintf(stderr, "cooperative launch failed: %s (grid %d)\n", hipGetErrorString(e), grid);
}
```

```cpp
#include <hip/hip_runtime.h>
#include <hip/hip_cooperative_groups.h>
#include <cstdio>
#include <cstdint>
namespace cg = cooperative_groups;

#define LAS __attribute__((address_space(3)))
typedef unsigned short bf16_t;
typedef short bf16x8 __attribute__((ext_vector_type(8)));
typedef float f32x4 __attribute__((ext_vector_type(4)));
typedef float f32x2 __attribute__((ext_vector_type(2)));
typedef unsigned u32x4 __attribute__((ext_vector_type(4)));
typedef unsigned u32x2 __attribute__((ext_vector_type(2)));

constexpr int M = 16384, D = 1024, SEQ = 2048, NBATCH = 8, DFF = 2816, PROJ = 8448, NLOG1 = 4352  ;
constexpr float EPS = 1e-6f;
constexpr int NTHREADS = 512, NWAVES = 8;
constexpr int LDS_BYTES = 147456;

constexpr size_t MiB = 1u << 20;
constexpr size_t WS_SSQ = 248 * (size_t)(1u << 20);
constexpr size_t WS_PAR = 512 * 1024;
constexpr int PAR_L = 24576, P_SGLNG = 0, P_SGLNB = 512, P_SGB = 1024, P_CVB = 1536, P_CVLNG = 2048, P_CVLNB = 2560, P_SCW = 3072, P_SINK = 4608, P_CVW = 4672, P_FINAL = 2 * PAR_L;
constexpr size_t WS_BAR = 768 * 1024;
constexpr int MISC_OFF = 147200;
constexpr size_t WS_ROPEC = 1 * MiB, WS_ROPES = 1 * MiB + 256 * 1024;
constexpr size_t WS_SGWT = 1 * MiB + 512 * 1024;
constexpr size_t WS_WIN = 2 * MiB, WIN_L = (size_t)PROJ * D * 2;
constexpr size_t WS_WBR = 35 * MiB, WBR_L = 4 * MiB;
constexpr size_t WS_WOUT = 43 * MiB, WOUT_L = 2 * MiB;
constexpr size_t WS_WGU = 47 * MiB, WGU_L = 11 * MiB;
constexpr size_t WS_WDN = 69 * MiB, WDN_L = (size_t)D * DFF * 2;
constexpr size_t WS_XB = 80 * MiB;
constexpr size_t WS_ZA = 112 * MiB;
constexpr size_t WS_MG = WS_ZA;
constexpr size_t WS_GLU = 144 * MiB;
constexpr size_t WS_CH = 160 * MiB;
constexpr size_t WS_TMP = WS_GLU;
constexpr size_t WS_Q = 176 * MiB;
constexpr size_t WS_BG = 192 * MiB;
constexpr size_t WS_K = 208 * MiB, WS_V = 212 * MiB;
constexpr size_t WS_YA = 216 * MiB, WS_YB = 232 * MiB;
constexpr size_t WS_ACT = 112 * MiB;
constexpr size_t WS_END = 254 * MiB;

__device__ const double INVF_REV[32] = {0.15915494309189535, 0.11934937021124886, 0.08949940160889101, 0.06711508300522726, 0.050329212104487035, 0.03774158471741977, 0.0283021958306234, 0.02122365276477766, 0.015915494309189534, 0.011934937021124886, 0.008949940160889102, 0.006711508300522725, 0.005032921210448704, 0.003774158471741977, 0.00283021958306234, 0.0021223652764777662, 0.0015915494309189536, 0.0011934937021124885, 0.0008949940160889102, 0.0006711508300522726, 0.0005032921210448703, 0.00037741584717419774, 0.00028302195830623395, 0.0002122365276477766, 0.00015915494309189535, 0.00011934937021124886, 8.949940160889102e-05, 6.711508300522725e-05, 5.0329212104487035e-05, 3.774158471741978e-05, 2.8302195830623396e-05, 2.122365276477766e-05};

__device__ __forceinline__ unsigned cvt_pk_bf16(float lo, float hi) { unsigned r; asm volatile("v_cvt_pk_bf16_f32 %0, %1, %2" : "=v"(r) : "v"(lo), "v"(hi)); return r; }
__device__ __forceinline__ float bf_lo(unsigned u) { return __builtin_bit_cast(float, u << 16); }
__device__ __forceinline__ float bf_hi(unsigned u) { return __builtin_bit_cast(float, u & 0xffff0000u); }
__device__ __forceinline__ float bf1(bf16_t h) { return __builtin_bit_cast(float, ((unsigned)h) << 16); }
__device__ __forceinline__ float sigmoidf_(float x) { return __builtin_amdgcn_rcpf(1.0f + __expf(-x)); }
__device__ __forceinline__ float wave_sum(float v) {
#pragma unroll
    for (int o = 1; o < 64; o <<= 1) v += __shfl_xor(v, o);
    return v;
}
__device__ __forceinline__ f32x2 gelu_pk(f32x2 v) {
    const f32x2 av = __builtin_elementwise_abs(v), d = av * 0.2316418882f + 1.0f;
    f32x2 t; t.x = __builtin_amdgcn_rcpf(d.x); t.y = __builtin_amdgcn_rcpf(d.y);
    f32x2 q = t * 0.5307027145f + (-0.7265760135f); q = q * t + 0.7107068705f; q = q * t + (-0.142248368f); q = q * t + 0.127414796f; q = q * t;
    const f32x2 s = (v * v) * (-0.72134752044f);
    f32x2 e; e.x = __builtin_amdgcn_exp2f(s.x); e.y = __builtin_amdgcn_exp2f(s.y);
    const f32x2 m = v * (q * e), r = v - m;
    f32x2 o; o.x = v.x < 0.f ? m.x : r.x; o.y = v.y < 0.f ? m.y : r.y; return o;
}
__device__ __forceinline__ u32x4 pack8(f32x4 a, f32x4 b) { u32x4 w; w.x = cvt_pk_bf16(a[0], a[1]); w.y = cvt_pk_bf16(a[2], a[3]); w.z = cvt_pk_bf16(b[0], b[1]); w.w = cvt_pk_bf16(b[2], b[3]); return w; }
__device__ __forceinline__ void unpack8(u32x4 w, f32x4& a, f32x4& b) { a = (f32x4){bf_lo(w.x), bf_hi(w.x), bf_lo(w.y), bf_hi(w.y)}; b = (f32x4){bf_lo(w.z), bf_hi(w.z), bf_lo(w.w), bf_hi(w.w)}; }

namespace pg8 {
constexpr int BM = 256, BK = 64, HALF = 128, HTB = HALF * BK * 2, STAGE_BYTES = 8 * HTB, NXCD = 8, WGM = 8;
__host__ __device__ __forceinline__ int lds_byte(int r, int c) { const int st = (r >> 4) * 2 + (c >> 5), rr = r & 15, cc = c & 31, ob = rr * 64 + cc * 2; return st * 1024 + (ob ^ (((ob >> 9) & 1) << 5)); }
__host__ __device__ __forceinline__ void stage_rc(int b, int& R, int& C) { const int st = b / 1024, sb = b % 1024, swz = sb ^ (((sb >> 9) & 1) << 5); R = (st >> 1) * 16 + swz / 64; C = (st & 1) * 32 + (swz % 64) / 2; }
__host__ __device__ __forceinline__ int perm32(int rho) { const int n = rho >> 4, i = rho & 15; return 8 * (i >> 2) + 4 * n + (i & 3); }

struct Unit { const char* A; const char* B; int lda2, ldb2, nt, pm, pn, z; };

__device__ __forceinline__ void tile_of(int L, int nM, int nN, int& pm, int& pn) {
    const int nwg = nM * nN; int wgid = L; { const int q = nwg / NXCD, r = nwg % NXCD, xcd = wgid % NXCD, off = wgid / NXCD; wgid = (xcd < r ? xcd * (q + 1) : r * (q + 1) + (xcd - r) * q) + off; }
    const int nig = WGM * nN, gid = wgid / nig, fm = gid * WGM, gsz = (nM - fm) < WGM ? (nM - fm) : WGM;
    pm = fm + ((wgid % nig) % gsz); pn = (wgid % nig) / gsz;
}
struct SchedGrid {
    static constexpr bool VARLD = false;
    int nM, nN, nwg, G, c; const char* A; const char* B; int lda2, ldb2, nt;
    __device__ __forceinline__ bool next(int i, Unit& u) const {
        const long L = (long)i * G + c; if (L >= nwg) return false;
        tile_of((int)L, nM, nN, u.pm, u.pn); u.z = 0;
        u.A = A + (size_t)u.pm * 256 * lda2; u.B = B + (size_t)u.pn * 256 * ldb2; u.lda2 = lda2; u.ldb2 = ldb2; u.nt = nt; return true;
    }
};
struct SchedMerge {
    static constexpr bool VARLD = true;
    int G, c; const char* ws; const char* WG  ; const char* WBR; int swap;
    __device__ __forceinline__ bool next(int i, Unit& u) const {
        const int ti = i >> 3, sub = i & 7; const long L = (long)ti * G + c; if (L >= 256) return false;
        tile_of((int)L, 64, 4, u.pm, u.pn); u.z = sub; const int br = sub >> 1;
        if (((sub & 1) ^ swap) == 0) { u.A = ws + WS_XB + (size_t)u.pm * 256 * 2048; u.lda2 = 2048; u.B = WG + (size_t)(br * 1024 + u.pn * 256) * 2048; u.ldb2 = 2048; u.nt = 16; }
        else { const size_t yo = br == 0 ? WS_YA : br == 1 ? WS_YB : br == 2 ? WS_Q : WS_BG;
               u.A = ws + yo + (size_t)u.pm * 256 * 1024; u.lda2 = 1024; u.B = WBR + (size_t)br * (1024 * 512 * 2) + (size_t)u.pn * 256 * 1024; u.ldb2 = 1024; u.nt = 8; }
        return true;
    }
};

struct SchedOne {
    static constexpr bool VARLD = false;
    SchedMerge M; int i0;
    __device__ __forceinline__ bool next(int i, Unit& u) const { if (i != 0) return false; return M.next(i0, u); }
};
struct SchedOneG {
    static constexpr bool VARLD = false;
    SchedGrid S; int i0;
    __device__ __forceinline__ bool next(int i, Unit& u) const { if (i != 0) return false; return S.next(i0, u); }
};
template <class Epi, class Sched, bool ALIGN_EPI>
__device__ __forceinline__ void gemm_phase(LAS unsigned char* lds, const Sched& S, const Epi& E) {
    int tid_ = threadIdx.x; asm volatile("" : "+v"(tid_));
    const int tid = tid_, wid = __builtin_amdgcn_readfirstlane(tid >> 6), lane = tid & 63, wr = wid >> 2, wc = wid & 3, fr = lane & 15, fq = lane >> 4;
    unsigned rA[2], rB[2], cc2[2];
#pragma unroll
    for (int i = 0; i < 2; ++i) { int R, C; stage_rc(tid * 16 + i * 8192, R, C); rA[i] = (unsigned)R; rB[i] = (unsigned)((R & ~31) + perm32(R & 31)); cc2[i] = (unsigned)C * 2u; }
    const size_t kstep = (size_t)(BK * 2);
    const unsigned ldsw = (unsigned)wid * 1024u;
    const int aoff = lds_byte(wr * 64 + fr, fq * 8), boff = lds_byte(wc * 32 + fr, fq * 8);
#define PG8_SA(b, h) (((b) * 2 + (h)) * HTB)
#define PG8_SB(b, h) ((4 + (b) * 2 + (h)) * HTB)
#define PG8_STAGE(bufoff, gbase, voff) do { _Pragma("unroll") for (int _i = 0; _i < 2; ++_i) \
        __builtin_amdgcn_global_load_lds((const unsigned*)((const char*)(gbase) + (voff)[_i]), (LAS unsigned*)(lds + (bufoff) + ldsw + _i * 8192), 16, 0, 0); } while (0)
#define PG8_LDA(dst, b, h) do { _Pragma("unroll") for (int m = 0; m < 4; ++m) _Pragma("unroll") for (int k = 0; k < 2; ++k) dst[m][k] = *(const LAS bf16x8*)(lds + PG8_SA(b, h) + aoff + m * 2048 + k * 1024); } while (0)
#define PG8_LDB(dst, b, h) do { _Pragma("unroll") for (int n = 0; n < 2; ++n) _Pragma("unroll") for (int k = 0; k < 2; ++k) dst[n][k] = *(const LAS bf16x8*)(lds + PG8_SB(b, h) + boff + n * 2048 + k * 1024); } while (0)
#define PG8_MMA(ai, bj, At, Bt) do { __builtin_amdgcn_s_setprio(1); _Pragma("unroll") for (int m = 0; m < 4; ++m) _Pragma("unroll") for (int n = 0; n < 2; ++n) _Pragma("unroll") for (int k = 0; k < 2; ++k) \
        acc[ai][bj][m][n] = __builtin_amdgcn_mfma_f32_16x16x32_bf16(Bt[n][k], At[m][k], acc[ai][bj][m][n], 0, 0, 0); __builtin_amdgcn_s_setprio(0); } while (0)
#define PG8_WAIT_V(n) asm volatile("s_waitcnt vmcnt(" #n ")" ::: "memory")
#define PG8_WAIT_L(n) asm volatile("s_waitcnt lgkmcnt(" #n ")" ::: "memory")
#define PG8_BAR __builtin_amdgcn_s_barrier()
#define PG8_SCHED __builtin_amdgcn_sched_barrier(0)
    Unit cur, nxt; int ui = 0;
    if (!S.next(0, cur)) return;
    f32x4 acc[2][2][4][2];
#pragma unroll
    for (int a = 0; a < 2; ++a)
#pragma unroll
        for (int b = 0; b < 2; ++b)
#pragma unroll
            for (int m = 0; m < 4; ++m)
#pragma unroll
                for (int n = 0; n < 2; ++n) acc[a][b][m][n] = (f32x4){0.f, 0.f, 0.f, 0.f};
    bf16x8 At[4][2], B0[2][2], B1[2][2];
    unsigned voffA[2], voffB[2];
#pragma unroll
    for (int i = 0; i < 2; ++i) { voffA[i] = rA[i] * (unsigned)cur.lda2 + cc2[i]; voffB[i] = rB[i] * (unsigned)cur.ldb2 + cc2[i]; }
    const char* cA = cur.A; const char* cB = cur.B;
    unsigned hA = (unsigned)HALF * cur.lda2, hB = (unsigned)HALF * cur.ldb2;
    PG8_STAGE(PG8_SB(0, 0), cB, voffB); PG8_STAGE(PG8_SB(0, 1), cB + hB, voffB); PG8_STAGE(PG8_SA(0, 0), cA, voffA); PG8_STAGE(PG8_SA(0, 1), cA + hA, voffA);
    if (wr == 1) PG8_BAR;
    PG8_WAIT_V(2); PG8_BAR;
    PG8_STAGE(PG8_SB(1, 0), cB + kstep, voffB); PG8_STAGE(PG8_SA(1, 0), cA + kstep, voffA); PG8_STAGE(PG8_SB(1, 1), cB + hB + kstep, voffB);
    PG8_WAIT_V(6); PG8_BAR;
    for (;;) {
        const bool has_next = S.next(ui + 1, nxt);
        if (!has_next) nxt = cur;
        unsigned voffAn[2], voffBn[2];
#pragma unroll
        for (int i = 0; i < 2; ++i) { if constexpr (Sched::VARLD) { voffAn[i] = rA[i] * (unsigned)nxt.lda2 + cc2[i]; voffBn[i] = rB[i] * (unsigned)nxt.ldb2 + cc2[i]; } else { voffAn[i] = voffA[i]; voffBn[i] = voffB[i]; } }
        const char* nA = nxt.A; const char* nB = nxt.B;
        const unsigned hAn = Sched::VARLD ? (unsigned)HALF * nxt.lda2 : hA, hBn = Sched::VARLD ? (unsigned)HALF * nxt.ldb2 : hB;
        const int nt = cur.nt;
        for (int t = 0; t < nt; t += 2) {
            const bool last = (t == nt - 2);
            const char* a1 = cA + (size_t)(t + 1) * kstep;
            const char* a2 = last ? nA : cA + (size_t)(t + 2) * kstep; const char* b2 = last ? nB : cB + (size_t)(t + 2) * kstep;
            const char* a3 = a2 + kstep; const char* b3 = b2 + kstep;
            const unsigned hA2 = last ? hAn : hA, hB2 = last ? hBn : hB;
            unsigned vA2[2], vB2[2];
#pragma unroll
            for (int i = 0; i < 2; ++i) { vA2[i] = last ? voffAn[i] : voffA[i]; vB2[i] = last ? voffBn[i] : voffB[i]; }
            PG8_LDB(B0, 0, 0); PG8_LDB(B1, 0, 1); PG8_SCHED; PG8_LDA(At, 0, 0); PG8_STAGE(PG8_SA(1, 1), a1 + hA, voffA);
            PG8_WAIT_V(8); PG8_WAIT_L(0); PG8_BAR; PG8_MMA(0, 0, At, B0); PG8_MMA(0, 1, At, B1); PG8_BAR; PG8_SCHED;
            PG8_LDA(At, 0, 1); PG8_STAGE(PG8_SB(0, 0), b2, vB2); PG8_STAGE(PG8_SB(0, 1), b2 + hB2, vB2); PG8_STAGE(PG8_SA(0, 0), a2, vA2);
            PG8_WAIT_V(8); PG8_WAIT_L(0); PG8_BAR; PG8_MMA(1, 0, At, B0); PG8_MMA(1, 1, At, B1); PG8_BAR; PG8_SCHED;
            PG8_LDB(B0, 1, 0); PG8_LDB(B1, 1, 1); PG8_SCHED; PG8_LDA(At, 1, 0); PG8_STAGE(PG8_SA(0, 1), a2 + hA2, vA2);
            PG8_WAIT_V(8); PG8_WAIT_L(0); PG8_BAR; PG8_MMA(0, 0, At, B0); PG8_MMA(0, 1, At, B1); PG8_BAR; PG8_SCHED;
            PG8_LDA(At, 1, 1); PG8_STAGE(PG8_SB(1, 0), b3, vB2); PG8_STAGE(PG8_SB(1, 1), b3 + hB2, vB2); PG8_STAGE(PG8_SA(1, 0), a3, vA2);
            PG8_WAIT_V(8); PG8_WAIT_L(0); PG8_BAR; PG8_MMA(1, 0, At, B0); PG8_MMA(1, 1, At, B1); PG8_BAR; PG8_SCHED;
        }
        if constexpr (ALIGN_EPI) { if (wr == 0) PG8_BAR; }
        E(acc, cur, wr, wc, fr, fq);
        if (!has_next) break;
#pragma unroll
        for (int a = 0; a < 2; ++a)
#pragma unroll
            for (int b = 0; b < 2; ++b)
#pragma unroll
                for (int m = 0; m < 4; ++m)
#pragma unroll
                    for (int n = 0; n < 2; ++n) acc[a][b][m][n] = (f32x4){0.f, 0.f, 0.f, 0.f};
        cur = nxt; cA = nA; cB = nB; hA = hAn; hB = hBn; ++ui;
#pragma unroll
        for (int i = 0; i < 2; ++i) { voffA[i] = voffAn[i]; voffB[i] = voffBn[i]; }
        if constexpr (ALIGN_EPI) { if (wr == 1) PG8_BAR; }
    }
    PG8_WAIT_V(0);
    if constexpr (!ALIGN_EPI) { if (wr == 0) PG8_BAR; }
    PG8_BAR;
#undef PG8_SA
#undef PG8_SB
#undef PG8_STAGE
#undef PG8_LDA
#undef PG8_LDB
#undef PG8_MMA
#undef PG8_WAIT_V
#undef PG8_WAIT_L
#undef PG8_BAR
#undef PG8_SCHED
}
}

#define EPI_ROWLOOP _Pragma("unroll") for (int ai = 0; ai < 2; ++ai) _Pragma("unroll") for (int m = 0; m < 4; ++m)
__device__ __forceinline__ float row_rs(const float* ssq, int row) { const f32x4* p = (const f32x4*)(ssq + (size_t)row * 16); const f32x4 a = p[0], b = p[1], c = p[2], d = p[3];
    const float s = (((a[0] + a[1]) + (a[2] + a[3])) + ((b[0] + b[1]) + (b[2] + b[3]))) + (((c[0] + c[1]) + (c[2] + c[3])) + ((d[0] + d[1]) + (d[2] + d[3])));
    return __builtin_amdgcn_rsqf(s * (1.0f / D) + EPS); }

struct EpiInProj {
    const float* ssq; unsigned char* ws;
    __device__ __forceinline__ void operator()(const f32x4 (&acc)[2][2][4][2], const pg8::Unit& u, int wr, int wc, int fr, int fq) const {
        bf16_t* const ZA = (bf16_t*)(ws + WS_ZA); bf16_t* const GLU = (bf16_t*)(ws + WS_GLU); bf16_t* const BG = (bf16_t*)(ws + WS_BG); bf16_t* const CH = (bf16_t*)(ws + WS_CH);
        const float* const ropeC = (const float*)(ws + WS_ROPEC); const float* const ropeS = (const float*)(ws + WS_ROPES);
        const int T = u.pn, row0 = u.pm * 256 + wr * 64 + fr, jcol = wc * 32 + 8 * fq;
        if (T < 4) {
            EPI_ROWLOOP { const int row = row0 + ai * 128 + m * 16; const float rs = row_rs(ssq, row);
#pragma unroll
                for (int bj = 0; bj < 2; ++bj) { f32x4 v0 = acc[ai][bj][m][0] * rs, v1 = acc[ai][bj][m][1] * rs;
                    f32x2 a = gelu_pk((f32x2){v0[0], v0[1]}), b = gelu_pk((f32x2){v0[2], v0[3]}), c = gelu_pk((f32x2){v1[0], v1[1]}), d = gelu_pk((f32x2){v1[2], v1[3]});
                    *(u32x4*)(ZA + (size_t)row * 1024 + 256 * T + 128 * bj + jcol) = pack8((f32x4){a.x, a.y, b.x, b.y}, (f32x4){c.x, c.y, d.x, d.y}); } }
        } else if (T < 8) {
            EPI_ROWLOOP { const int row = row0 + ai * 128 + m * 16; const float rs = row_rs(ssq, row); f32x4 o[2];
#pragma unroll
                for (int n = 0; n < 2; ++n) { const f32x4 a = acc[ai][0][m][n] * rs, g = acc[ai][1][m][n] * rs;
#pragma unroll
                    for (int j = 0; j < 4; ++j) o[n][j] = a[j] * sigmoidf_(g[j]); }
                *(u32x4*)(GLU + (size_t)row * 512 + 128 * (T - 4) + jcol) = pack8(o[0], o[1]); }
        } else if (T < 11) {
            const bool isq = T < 10; const bool rope = isq || wc < 2; const float sc = isq ? 0.125f : 1.0f;
            const size_t boff = isq ? WS_Q : (wc < 2 ? WS_K : WS_V); bf16_t* const base = (bf16_t*)(ws + boff);
            const int ld = isq ? 512 : 128, hcol = isq ? (4 * (T - 8) + wc) * 64 : (wc & 1) * 64;
            EPI_ROWLOOP { const int row = row0 + ai * 128 + m * 16; const float rs = row_rs(ssq, row) * sc; const int pos = row & (SEQ - 1); f32x4 o1[2], o2[2];
#pragma unroll
                for (int n = 0; n < 2; ++n) { const f32x4 x1 = acc[ai][0][m][n] * rs, x2 = acc[ai][1][m][n] * rs;
                    if (rope) { const f32x4 c = *(const f32x4*)(ropeC + pos * 32 + 8 * fq + 4 * n), s = *(const f32x4*)(ropeS + pos * 32 + 8 * fq + 4 * n);
                        o1[n] = x1 * c - x2 * s; o2[n] = x2 * c + x1 * s; } else { o1[n] = x1; o2[n] = x2; } }
                bf16_t* p = base + (size_t)row * ld + hcol + 8 * fq;
                *(u32x4*)p = pack8(o1[0], o1[1]); *(u32x4*)(p + 32) = pack8(o2[0], o2[1]); }
        } else if (T < 13) {
            EPI_ROWLOOP { const int row = row0 + ai * 128 + m * 16; const float rs = row_rs(ssq, row);
#pragma unroll
                for (int bj = 0; bj < 2; ++bj) *(u32x4*)(BG + (size_t)row * 512 + 256 * (T - 11) + 128 * bj + jcol) = pack8(acc[ai][bj][m][0] * rs, acc[ai][bj][m][1] * rs); }
        } else {
            EPI_ROWLOOP { const int row = row0 + ai * 128 + m * 16; const float rs = row_rs(ssq, row); const float rs2 = rs * rs;
                *(u32x4*)(CH + (size_t)row * 512 + 128 * (T - 13) + jcol) = pack8(acc[ai][0][m][0] * acc[ai][1][m][0] * rs2, acc[ai][0][m][1] * acc[ai][1][m][1] * rs2); }
        }
    }
};
struct EpiGate {
    const float* ssq; bf16_t* MG;
    __device__ __forceinline__ void operator()(const f32x4 (&acc)[2][2][4][2], const pg8::Unit& u, int wr, int wc, int fr, int fq) const {
        const int row0 = u.pm * 256 + wr * 64 + fr, col0 = u.pn * 256 + wc * 32 + 8 * fq;
        EPI_ROWLOOP { const int row = row0 + ai * 128 + m * 16; const float rs = row_rs(ssq, row);
#pragma unroll
            for (int bj = 0; bj < 2; ++bj) { f32x4 v0 = acc[ai][bj][m][0] * rs, v1 = acc[ai][bj][m][1] * rs;
#pragma unroll
                for (int j = 0; j < 4; ++j) { v0[j] = sigmoidf_(v0[j]); v1[j] = sigmoidf_(v1[j]); }
                *(u32x4*)(MG + (size_t)row * 1024 + col0 + 128 * bj) = pack8(v0, v1); } }
    }
};
struct EpiBranch {
    bf16_t* MG; bf16_t* TMP;
    __device__ __forceinline__ void operator()(const f32x4 (&acc)[2][2][4][2], const pg8::Unit& u, int wr, int wc, int fr, int fq) const {
        const int row0 = u.pm * 256 + wr * 64 + fr, col0 = u.pn * 256 + wc * 32 + 8 * fq, br = u.z >> 1;
        EPI_ROWLOOP { const int row = row0 + ai * 128 + m * 16;
#pragma unroll
            for (int bj = 0; bj < 2; ++bj) { const size_t off = (size_t)row * 1024 + col0 + 128 * bj;
                f32x4 g0, g1; unpack8(*(const u32x4*)(MG + off), g0, g1);
                f32x4 v0 = acc[ai][bj][m][0] * g0, v1 = acc[ai][bj][m][1] * g1;
                if (br > 0) { f32x4 t0, t1; unpack8(*(const u32x4*)(TMP + off), t0, t1); v0 += t0; v1 += t1; }
                if (br < 3) *(u32x4*)(TMP + off) = pack8(v0, v1); else *(u32x4*)(MG + off) = pack8(v0, v1); } }
    }
};
struct EpiStashB {
    bf16_t* MG;
    __device__ __forceinline__ void operator()(const f32x4 (&acc)[2][2][4][2], const pg8::Unit& u, int wr, int wc, int fr, int fq) const {
        const int row0 = u.pm * 256 + wr * 64 + fr, col0 = u.pn * 256 + wc * 32 + 8 * fq;
        EPI_ROWLOOP { const int row = row0 + ai * 128 + m * 16;
#pragma unroll
            for (int bj = 0; bj < 2; ++bj) *(u32x4*)(MG + (size_t)row * 1024 + col0 + 128 * bj) = pack8(acc[ai][bj][m][0], acc[ai][bj][m][1]); }
    }
};
struct EpiGateAcc {
    const float* ssq; bf16_t* MG; bf16_t* TMP;
    __device__ __forceinline__ void operator()(const f32x4 (&acc)[2][2][4][2], const pg8::Unit& u, int wr, int wc, int fr, int fq) const {
        const int row0 = u.pm * 256 + wr * 64 + fr, col0 = u.pn * 256 + wc * 32 + 8 * fq, br = u.z >> 1;
        EPI_ROWLOOP { const int row = row0 + ai * 128 + m * 16; const float rs = row_rs(ssq, row);
#pragma unroll
            for (int bj = 0; bj < 2; ++bj) { const size_t off = (size_t)row * 1024 + col0 + 128 * bj;
                f32x4 b0, b1; unpack8(*(const u32x4*)(MG + off), b0, b1);
                f32x4 v0 = acc[ai][bj][m][0] * rs, v1 = acc[ai][bj][m][1] * rs;
#pragma unroll
                for (int j = 0; j < 4; ++j) { v0[j] = sigmoidf_(v0[j]) * b0[j]; v1[j] = sigmoidf_(v1[j]) * b1[j]; }
                if (br > 0) { f32x4 t0, t1; unpack8(*(const u32x4*)(TMP + off), t0, t1); v0 += t0; v1 += t1; }
                if (br < 3) *(u32x4*)(TMP + off) = pack8(v0, v1); else *(u32x4*)(MG + off) = pack8(v0, v1); } }
    }
};
struct EpiMerge2 {
    EpiStashB ES; EpiGateAcc EA;
    __device__ __forceinline__ void operator()(const f32x4 (&acc)[2][2][4][2], const pg8::Unit& u, int wr, int wc, int fr, int fq) const {
        if ((u.z & 1) == 0) ES(acc, u, wr, wc, fr, fq); else EA(acc, u, wr, wc, fr, fq);
    }
};
struct EpiResid {
    bf16_t* XB; float* ssq_out;
    __device__ __forceinline__ void operator()(const f32x4 (&acc)[2][2][4][2], const pg8::Unit& u, int wr, int wc, int fr, int fq) const {
        const int row0 = u.pm * 256 + wr * 64 + fr, col0 = u.pn * 256 + wc * 32 + 8 * fq;
        EPI_ROWLOOP { const int row = row0 + ai * 128 + m * 16; float ss = 0.f;
#pragma unroll
            for (int bj = 0; bj < 2; ++bj) { const size_t off = (size_t)row * 1024 + col0 + 128 * bj;
                f32x4 x0, x1; unpack8(*(const u32x4*)(XB + off), x0, x1);
                const f32x4 v0 = x0 + acc[ai][bj][m][0], v1 = x1 + acc[ai][bj][m][1];
                *(u32x4*)(XB + off) = pack8(v0, v1);
                ss += (v0[0] * v0[0] + v0[1] * v0[1]) + (v0[2] * v0[2] + v0[3] * v0[3]) + (v1[0] * v1[0] + v1[1] * v1[1]) + (v1[2] * v1[2] + v1[3] * v1[3]); }
            ss += __shfl_xor(ss, 16); ss += __shfl_xor(ss, 32);
            if (fq == 0) ssq_out[(size_t)row * 16 + u.pn * 4 + wc] = ss; }
    }
};
struct EpiSwiGLU {
    const float* ssq; bf16_t* ACT; float zero_scale;
    __device__ __forceinline__ void operator()(const f32x4 (&acc)[2][2][4][2], const pg8::Unit& u, int wr, int wc, int fr, int fq) const {
        const int row0 = u.pm * 256 + wr * 64 + fr, col0 = u.pn * 128 + wc * 32 + 8 * fq;
        EPI_ROWLOOP { const int row = row0 + ai * 128 + m * 16; const float rs = row_rs(ssq, row); f32x4 o[2];
#pragma unroll
            for (int n = 0; n < 2; ++n) { const f32x4 g = acc[ai][0][m][n] * rs, up = acc[ai][1][m][n] * rs;
#pragma unroll
                for (int j = 0; j < 4; ++j) o[n][j] = g[j] * sigmoidf_(g[j]) * up[j] * zero_scale; }
            *(u32x4*)(ACT + (size_t)row * DFF + col0) = pack8(o[0], o[1]); }
    }
};

#define ABL_FFN_SCALE(l) 1.0f
struct Args { const float* in[19]; float* out; unsigned char* ws; };

__device__ __forceinline__ int win_src_col(int nlog) {
    const int T = nlog >> 8, o = nlog & 255, bj = o >> 7, j = o & 127;
    if (T < 4) return nlog;
    if (T < 8) return 1024 + bj * 512 + 128 * (T - 4) + j;
    if (T < 10) return 2048 + (4 * (T - 8) + (j >> 5)) * 64 + 32 * bj + (j & 31);
    if (T == 10) { const int h = j >> 5; return (h < 2 ? 2560 + h * 64 : 2688 + (h - 2) * 64) + 32 * bj + (j & 31); }
    if (T < 13) return 2816 + 256 * (T - 11) + o;
    if (T < 17) return 3328 + bj * 512 + 128 * (T - 13) + j;
    return nlog;
}
__device__ __forceinline__ void tr_item(const float* W, int Nsrc, int k0, int scolA, int scolB, const float* gain, bf16_t* WT, int K, int drow, LAS float* scr, int lane) {
    const int c4 = lane & 15; const int sc = ((c4 >> 3) ? scolB : scolA) + 4 * (c4 & 7);
    f32x4 v[16];
#pragma unroll
    for (int i = 0; i < 16; ++i) v[i] = __builtin_nontemporal_load((const f32x4*)(W + (size_t)(k0 + 4 * i + (lane >> 4)) * Nsrc + sc));
#pragma unroll
    for (int i = 0; i < 16; ++i) { const int row = 4 * i + (lane >> 4); if (gain) v[i] = v[i] * gain[k0 + row];
        LAS float* d = scr + row * 65 + 4 * c4; d[0] = v[i][0]; d[1] = v[i][1]; d[2] = v[i][2]; d[3] = v[i][3]; }
    asm volatile("s_waitcnt lgkmcnt(0)" ::: "memory");
    const int c = lane & 7;
#pragma unroll
    for (int jj = 0; jj < 8; ++jj) { const int n = (lane >> 3) + 8 * jj; const LAS float* s = scr + (8 * c) * 65 + n;
        u32x4 o; o.x = cvt_pk_bf16(s[0], s[65]); o.y = cvt_pk_bf16(s[2 * 65], s[3 * 65]); o.z = cvt_pk_bf16(s[4 * 65], s[5 * 65]); o.w = cvt_pk_bf16(s[6 * 65], s[7 * 65]);
        *(u32x4*)(WT + (size_t)(drow + n) * K + k0 + 8 * c) = o; }
    asm volatile("s_waitcnt lgkmcnt(0)" ::: "memory");
}
__device__ __forceinline__ void prologue(const Args& a, LAS unsigned char* lds, int G) {
    int tid_ = threadIdx.x; asm volatile("" : "+v"(tid_));
    const int tid = tid_, lane = tid & 63, wave = __builtin_amdgcn_readfirstlane(tid >> 6);
    const int gw = blockIdx.x * NWAVES + wave, NGW = G * NWAVES;
    unsigned char* ws = a.ws;
    LAS float* scr = (LAS float*)(lds + wave * 16640);
    constexpr int I_IN = 16 * 132, I_BR = 512, I_OUT = 256, I_GU = 16 * 88, I_DN = 44 * 16, I_L = I_IN + I_BR + I_OUT + I_GU + I_DN;
    for (int it = gw; it < 2 * I_L; it += NGW) {
        const int l = it / I_L; int r = it % I_L;
        if (r < I_IN) { const int kb = r / 132, nb = r % 132, n0 = 64 * nb;
            tr_item(a.in[2] + (size_t)l * D * PROJ, PROJ, 64 * kb, win_src_col(n0), win_src_col(n0 + 32), a.in[1] + l * D, (bf16_t*)(ws + WS_WIN + l * WIN_L), D, n0, scr, lane); continue; } r -= I_IN;
        if (r < I_BR) { const int br = r >> 7, q = r & 127, kb = q >> 4, nb = q & 15;
            tr_item(a.in[13] + (size_t)(l * 4 + br) * 512 * D, D, 64 * kb, 64 * nb, 64 * nb + 32, nullptr, (bf16_t*)(ws + WS_WBR + l * WBR_L) + (size_t)br * 1024 * 512, 512, 64 * nb, scr, lane); continue; } r -= I_BR;
        if (r < I_OUT) { const int kb = r >> 4, nb = r & 15;
            tr_item(a.in[14] + (size_t)l * D * D, D, 64 * kb, 64 * nb, 64 * nb + 32, nullptr, (bf16_t*)(ws + WS_WOUT + l * WOUT_L), D, 64 * nb, scr, lane); continue; } r -= I_OUT;
        if (r < I_GU) { const int kb = r / 88, nb = r % 88, n0 = 64 * nb, T = n0 >> 8, o = n0 & 255, sc = (o >> 7) * DFF + 128 * T + (o & 127);
            tr_item(a.in[16] + (size_t)l * D * 2 * DFF, 2 * DFF, 64 * kb, sc, sc + 32, a.in[15] + l * D, (bf16_t*)(ws + WS_WGU + l * WGU_L), D, n0, scr, lane); continue; } r -= I_GU;
        { const int kb = r >> 4, nb = r & 15;
            tr_item(a.in[17] + (size_t)l * DFF * D, D, 64 * kb, 64 * nb, 64 * nb + 32, nullptr, (bf16_t*)(ws + WS_WDN + l * WDN_L), DFF, 64 * nb, scr, lane); }
    }
    float* ssq = (float*)(ws + WS_SSQ);
    for (int row = gw; row < M; row += NGW) {
        const f32x4* xr = (const f32x4*)(a.in[0] + (size_t)row * D) + lane; float s = 0.f; f32x4 v[4];
#pragma unroll
        for (int j = 0; j < 4; ++j) { v[j] = xr[64 * j]; s += (v[j][0] * v[j][0] + v[j][1] * v[j][1]) + (v[j][2] * v[j][2] + v[j][3] * v[j][3]); }
        s = wave_sum(s);
        u32x2* o = (u32x2*)((bf16_t*)(ws + WS_XB) + (size_t)row * D) + lane;
#pragma unroll
        for (int j = 0; j < 4; ++j) o[64 * j] = (u32x2){cvt_pk_bf16(v[j][0], v[j][1]), cvt_pk_bf16(v[j][2], v[j][3])};
        if (lane < 16) ssq[(size_t)row * 16 + lane] = lane == 0 ? s : 0.f;
    }
    { float* par = (float*)(ws + WS_PAR); const int gt = blockIdx.x * NTHREADS + tid, GT = G * NTHREADS;
#define CPY(dstoff, srcp, n) for (int i = gt; i < (n); i += GT) par[(dstoff) + i] = (srcp)[i]
      for (int l = 0; l < 2; ++l) { const int o = l * PAR_L;
          CPY(o + P_SGLNG, a.in[3] + l * 512, 512); CPY(o + P_SGLNB, a.in[4] + l * 512, 512); CPY(o + P_SGB, a.in[6] + l * 512, 512);
          CPY(o + P_CVB, a.in[8] + l * 512, 512); CPY(o + P_CVLNG, a.in[9] + l * 512, 512); CPY(o + P_CVLNB, a.in[10] + l * 512, 512);
          CPY(o + P_SCW, a.in[12] + l * 1536, 1536); CPY(o + P_SINK, a.in[11] + l * 8, 8); CPY(o + P_CVW, a.in[7] + l * 31 * 512, 31 * 512); }
      CPY(P_FINAL, a.in[18], 1024);
#undef CPY
    }
    for (int i = blockIdx.x * NTHREADS + tid; i < SEQ * 32; i += G * NTHREADS) { const int pos = i >> 5, f = i & 31;
        const double rev = (double)pos * INVF_REV[f]; const float fr = (float)(rev - floor(rev));
        ((float*)(ws + WS_ROPEC))[i] = __builtin_amdgcn_cosf(fr); ((float*)(ws + WS_ROPES))[i] = __builtin_amdgcn_sinf(fr); }
    for (int i = blockIdx.x * NTHREADS + tid; i < 2 * 4 * 128 * 128; i += G * NTHREADS) { const int s = i & 127, t = (i >> 7) & 127;
        ((bf16_t*)(ws + WS_SGWT))[i] = s <= t ? (bf16_t)(cvt_pk_bf16(a.in[5][i], 0.f) & 0xffffu) : (bf16_t)0; }
}

__device__ __forceinline__ void mixer_sg(unsigned char* ws, int l, LAS unsigned char* lds, int unit) {
    { size_t z_ = 0; asm volatile("" : "+s"(z_)); ws += z_; } int tid_ = threadIdx.x; asm volatile("" : "+v"(tid_));
    const float* par = (const float*)(ws + WS_PAR) + l * PAR_L;
    const int tid = tid_, lane = tid & 63, wave = __builtin_amdgcn_readfirstlane(tid >> 6);
    const int ck = unit >> 2, g = unit & 3, r0 = ck * 128;
    const bf16_t* ZA = (const bf16_t*)(ws + WS_ZA); bf16_t* YA = (bf16_t*)(ws + WS_YA);
    LAS bf16_t* vnT = (LAS bf16_t*)lds;
    const float* lng = par + P_SGLNG; const float* lnb = par + P_SGLNB;
    const f32x4 g0 = *(const f32x4*)(lng + 8 * lane), g1 = *(const f32x4*)(lng + 8 * lane + 4), b0 = *(const f32x4*)(lnb + 8 * lane), b1 = *(const f32x4*)(lnb + 8 * lane + 4);
    u32x4 raw[16];
#pragma unroll
    for (int i = 0; i < 16; ++i) raw[i] = *(const u32x4*)(ZA + (size_t)(r0 + wave + 8 * i) * 1024 + 512 + 8 * lane);
    const int fr = lane & 15, fq = lane >> 4, t0 = 16 * wave, nks = (wave >> 1) + 1;
    const bf16_t* W = (const bf16_t*)(ws + WS_SGWT) + (size_t)(l * 4 + g) * 16384 + (size_t)(t0 + fr) * 128 + 8 * fq;
    bf16x8 wf[4];
#pragma unroll
    for (int ks = 0; ks < 4; ++ks) wf[ks] = *(const bf16x8*)(W + 32 * (ks < nks ? ks : 0));
    const int tt = t0 + fr; const size_t orow = r0 + tt; const float bs = par[P_SGB + g * 128 + tt];
    u32x2 uu[8];
#pragma unroll
    for (int ct = 0; ct < 8; ++ct) uu[ct] = *(const u32x2*)(ZA + orow * 1024 + 128 * g + 16 * ct + 4 * fq);
#pragma unroll
    for (int i = 0; i < 16; ++i) { const int s = wave + 8 * i;
        f32x4 x0, x1; unpack8(raw[i], x0, x1);
        const float mean = wave_sum((x0[0] + x0[1]) + (x0[2] + x0[3]) + (x1[0] + x1[1]) + (x1[2] + x1[3])) * (1.0f / 512.0f);
        x0 -= mean; x1 -= mean;
        const float var = wave_sum((x0[0] * x0[0] + x0[1] * x0[1]) + (x0[2] * x0[2] + x0[3] * x0[3]) + (x1[0] * x1[0] + x1[1] * x1[1]) + (x1[2] * x1[2] + x1[3] * x1[3])) * (1.0f / 512.0f);
        const float rstd = __builtin_amdgcn_rsqf(var + EPS);
        if ((lane >> 4) == g) { const int c = 8 * (lane & 15); x0 = x0 * rstd * g0 + b0; x1 = x1 * rstd * g1 + b1;
            const unsigned p0 = cvt_pk_bf16(x0[0], x0[1]), p1 = cvt_pk_bf16(x0[2], x0[3]), p2 = cvt_pk_bf16(x1[0], x1[1]), p3 = cvt_pk_bf16(x1[2], x1[3]);
            LAS bf16_t* d = vnT + c * 136 + (s ^ (8 * (lane & 15)));
            d[0] = (bf16_t)p0; d[136] = (bf16_t)(p0 >> 16); d[2 * 136] = (bf16_t)p1; d[3 * 136] = (bf16_t)(p1 >> 16);
            d[4 * 136] = (bf16_t)p2; d[5 * 136] = (bf16_t)(p2 >> 16); d[6 * 136] = (bf16_t)p3; d[7 * 136] = (bf16_t)(p3 >> 16); }
    }
    __syncthreads();
    { f32x4 acc[8];
#pragma unroll
      for (int ct = 0; ct < 8; ++ct) acc[ct] = (f32x4){0.f, 0.f, 0.f, 0.f};
#pragma unroll
      for (int ks = 0; ks < 4; ++ks) if (ks < nks) {
#pragma unroll
          for (int ct = 0; ct < 8; ++ct) { const bf16x8 vf = *(const LAS bf16x8*)(vnT + (16 * ct + fr) * 136 + 8 * ((4 * ks + fq) ^ ((2 * ct + (fr >> 3)) & 15)));
              acc[ct] = __builtin_amdgcn_mfma_f32_16x16x32_bf16(vf, wf[ks], acc[ct], 0, 0, 0); }
      }
#pragma unroll
      for (int ct = 0; ct < 8; ++ct) { const int c = 128 * g + 16 * ct + 4 * fq;
          const float o0 = bf_lo(uu[ct].x) * (acc[ct][0] + bs), o1 = bf_hi(uu[ct].x) * (acc[ct][1] + bs), o2 = bf_lo(uu[ct].y) * (acc[ct][2] + bs), o3 = bf_hi(uu[ct].y) * (acc[ct][3] + bs);
          *(u32x2*)(YA + orow * 512 + c) = (u32x2){cvt_pk_bf16(o0, o1), cvt_pk_bf16(o2, o3)}; }
    }
    __syncthreads();
}
__device__ __forceinline__ void mixer_conv(unsigned char* ws, int l, LAS unsigned char* lds, int unit) {
    { size_t z_ = 0; asm volatile("" : "+s"(z_)); ws += z_; } int tid_ = threadIdx.x; asm volatile("" : "+v"(tid_));
    const float* par = (const float*)(ws + WS_PAR) + l * PAR_L;
    const int tid = tid_, lane = tid & 63, wave = tid >> 6;
    const int b = unit >> 6, tb = unit & 63, t0 = tb * 32; const size_t rbase = (size_t)b * SEQ;
    const bf16_t* GLU = (const bf16_t*)(ws + WS_GLU); bf16_t* YB = (bf16_t*)(ws + WS_YB);
    LAS bf16_t* in = (LAS bf16_t*)lds;
    LAS float* cv = (LAS float*)(lds + 65536);
    for (int i = tid; i < 62 * 64; i += NTHREADS) { const int r = i >> 6, ch = i & 63; const int t = t0 - 30 + r;
        u32x4 v = {0u, 0u, 0u, 0u}; if (t >= 0) v = *(const u32x4*)(GLU + (rbase + t) * 512 + 8 * ch);
        *(LAS u32x4*)(in + r * 512 + 8 * ch) = v; }
    __syncthreads();
    { const int c = tid; float w[31], x[62];
#pragma unroll
      for (int k = 0; k < 31; ++k) w[k] = par[P_CVW + k * 512 + c];
#pragma unroll
      for (int r = 0; r < 62; ++r) x[r] = bf1(in[r * 512 + c]);
      const float bias = par[P_CVB + c];
#pragma unroll
      for (int t = 0; t < 32; ++t) { float s = bias;
#pragma unroll
          for (int k = 0; k < 31; ++k) s += w[k] * x[t + k];
          cv[t * 512 + c] = s; } }
    __syncthreads();
    { const float* lng = par + P_CVLNG; const float* lnb = par + P_CVLNB;
      const f32x4 g0 = *(const f32x4*)(lng + 8 * lane), g1 = *(const f32x4*)(lng + 8 * lane + 4), b0 = *(const f32x4*)(lnb + 8 * lane), b1 = *(const f32x4*)(lnb + 8 * lane + 4);
      for (int t = wave; t < 32; t += NWAVES) {
          f32x4 x0 = *(const LAS f32x4*)(cv + t * 512 + 8 * lane), x1 = *(const LAS f32x4*)(cv + t * 512 + 8 * lane + 4);
          const float mean = wave_sum((x0[0] + x0[1]) + (x0[2] + x0[3]) + (x1[0] + x1[1]) + (x1[2] + x1[3])) * (1.0f / 512.0f);
          x0 -= mean; x1 -= mean;
          const float var = wave_sum((x0[0] * x0[0] + x0[1] * x0[1]) + (x0[2] * x0[2] + x0[3] * x0[3]) + (x1[0] * x1[0] + x1[1] * x1[1]) + (x1[2] * x1[2] + x1[3] * x1[3])) * (1.0f / 512.0f);
          const float rstd = __builtin_amdgcn_rsqf(var + EPS);
          x0 = x0 * rstd * g0 + b0; x1 = x1 * rstd * g1 + b1;
#pragma unroll
          for (int j = 0; j < 4; ++j) { x0[j] = x0[j] * sigmoidf_(x0[j]); x1[j] = x1[j] * sigmoidf_(x1[j]); }
          *(u32x4*)(YB + (rbase + t0 + t) * 512 + 8 * lane) = pack8(x0, x1); } }
    __syncthreads();
}
__device__ __forceinline__ void mixer_attn(unsigned char* ws, int l, LAS unsigned char* lds, int unit) {
    { size_t z_ = 0; asm volatile("" : "+s"(z_)); ws += z_; } int tid_ = threadIdx.x; asm volatile("" : "+v"(tid_));
    const float* par = (const float*)(ws + WS_PAR) + l * PAR_L;
    const int tid = tid_, lane = tid & 63, wave = __builtin_amdgcn_readfirstlane(tid >> 6), fr = lane & 15, fq = lane >> 4;
    const int kvh = unit & 1, blk = (unit >> 1) & 15, b = unit >> 5; const size_t rbase = (size_t)b * SEQ;
    bf16_t* Q = (bf16_t*)(ws + WS_Q); const bf16_t* K = (const bf16_t*)(ws + WS_K); const bf16_t* V = (const bf16_t*)(ws + WS_V);
    LAS bf16_t* Kl = (LAS bf16_t*)lds;
    LAS bf16_t* VT = (LAS bf16_t*)(lds + 36864);
    for (int i = tid; i < 256 * 8; i += NTHREADS) { const int r = i >> 3, ch = i & 7; const int t = (blk - 1) * 128 + r;
        u32x4 kv = {0u, 0u, 0u, 0u}, vv = {0u, 0u, 0u, 0u};
        if (t >= 0) { kv = *(const u32x4*)(K + (rbase + t) * 128 + kvh * 64 + 8 * ch); vv = *(const u32x4*)(V + (rbase + t) * 128 + kvh * 64 + 8 * ch); }
        *(LAS u32x4*)(Kl + r * 72 + 8 * ch) = kv;
        LAS bf16_t* d = VT + (8 * ch) * 264 + r;
        d[0] = (bf16_t)vv.x; d[264] = (bf16_t)(vv.x >> 16); d[2 * 264] = (bf16_t)vv.y; d[3 * 264] = (bf16_t)(vv.y >> 16);
        d[4 * 264] = (bf16_t)vv.z; d[5 * 264] = (bf16_t)(vv.z >> 16); d[6 * 264] = (bf16_t)vv.w; d[7 * 264] = (bf16_t)(vv.w >> 16); }
    __syncthreads();
    const int g = wave >> 1, head = kvh * 4 + g; const float sink = par[P_SINK + head];
    for (int it = 0; it < 2; ++it) {
        const int qs = 2 * (wave & 1) + it, qi0 = 32 * qs; const size_t qrow0 = rbase + blk * 128 + qi0;
        bf16x8 qf[2][2];
#pragma unroll
        for (int qt = 0; qt < 2; ++qt)
#pragma unroll
            for (int ks = 0; ks < 2; ++ks) qf[qt][ks] = *(const bf16x8*)(Q + (qrow0 + 16 * qt + fr) * 512 + head * 64 + 32 * ks + 8 * fq);
        f32x4 S[2][10];
#pragma unroll
        for (int qt = 0; qt < 2; ++qt)
#pragma unroll
            for (int kt = 0; kt < 10; ++kt) S[qt][kt] = (f32x4){0.f, 0.f, 0.f, 0.f};
#pragma unroll
        for (int kt = 0; kt < 10; ++kt)
#pragma unroll
            for (int ks = 0; ks < 2; ++ks) { const bf16x8 kf = *(const LAS bf16x8*)(Kl + (qi0 + 16 * kt + fr) * 72 + 32 * ks + 8 * fq);
#pragma unroll
                for (int qt = 0; qt < 2; ++qt) S[qt][kt] = __builtin_amdgcn_mfma_f32_16x16x32_bf16(kf, qf[qt][ks], S[qt][kt], 0, 0, 0); }
        bf16x8 pf[2][5];
#pragma unroll
        for (int qt = 0; qt < 2; ++qt) { const int qi = qi0 + 16 * qt + fr; float mx = sink;
#pragma unroll
            for (int kt = 0; kt < 10; ++kt)
#pragma unroll
                for (int j = 0; j < 4; ++j) { const int kb = qi0 + 16 * kt + 4 * fq + j; const bool valid = (kb > qi) && (kb <= qi + 128) && (blk > 0 || kb >= 128);
                    const float sv = valid ? S[qt][kt][j] : -INFINITY; S[qt][kt][j] = sv; mx = fmaxf(mx, sv); }
            mx = fmaxf(mx, __shfl_xor(mx, 16)); mx = fmaxf(mx, __shfl_xor(mx, 32));
            float sum = 0.f;
#pragma unroll
            for (int kt = 0; kt < 10; ++kt)
#pragma unroll
                for (int j = 0; j < 4; ++j) { const float p = __expf(S[qt][kt][j] - mx); S[qt][kt][j] = p; sum += p; }
            sum += __shfl_xor(sum, 16); sum += __shfl_xor(sum, 32);
            const float inv = 1.0f / (sum + __expf(sink - mx));
#pragma unroll
            for (int p = 0; p < 5; ++p) { const f32x4 a0 = S[qt][2 * p] * inv, a1 = S[qt][2 * p + 1] * inv; pf[qt][p] = __builtin_bit_cast(bf16x8, pack8(a0, a1)); }
        }
        f32x4 o[2][4];
#pragma unroll
        for (int qt = 0; qt < 2; ++qt)
#pragma unroll
            for (int dt = 0; dt < 4; ++dt) o[qt][dt] = (f32x4){0.f, 0.f, 0.f, 0.f};
#pragma unroll
        for (int p = 0; p < 5; ++p)
#pragma unroll
            for (int dt = 0; dt < 4; ++dt) { const LAS bf16_t* vp = VT + (16 * dt + fr) * 264 + qi0 + 32 * p + 4 * fq;
                const u32x2 lo = *(const LAS u32x2*)vp, hi = *(const LAS u32x2*)(vp + 16);
                const bf16x8 vf = __builtin_bit_cast(bf16x8, (u32x4){lo.x, lo.y, hi.x, hi.y});
#pragma unroll
                for (int qt = 0; qt < 2; ++qt) o[qt][dt] = __builtin_amdgcn_mfma_f32_16x16x32_bf16(vf, pf[qt][p], o[qt][dt], 0, 0, 0); }
#pragma unroll
        for (int qt = 0; qt < 2; ++qt)
#pragma unroll
            for (int dt = 0; dt < 4; ++dt) *(u32x2*)(Q + (qrow0 + 16 * qt + fr) * 512 + head * 64 + 16 * dt + 4 * fq) = (u32x2){cvt_pk_bf16(o[qt][dt][0], o[qt][dt][1]), cvt_pk_bf16(o[qt][dt][2], o[qt][dt][3])};
    }
    __syncthreads();
}
__device__ __forceinline__ void mixer_sc(unsigned char* ws, int l, int G) {
    { size_t z_ = 0; asm volatile("" : "+s"(z_)); ws += z_; } int tid_ = threadIdx.x; asm volatile("" : "+v"(tid_));
    bf16_t* BG = (bf16_t*)(ws + WS_BG); const bf16_t* CH = (const bf16_t*)(ws + WS_CH);
    const float* w = (const float*)(ws + WS_PAR) + l * PAR_L + P_SCW;
    for (int i = blockIdx.x * NTHREADS + tid_; i < (M / 8) * 64; i += G * NTHREADS) {
        const int row0 = 8 * (i >> 6), c = 8 * (i & 63), t0 = row0 & (SEQ - 1);
        u32x4 ch[10], bg[8];
#pragma unroll
        for (int r = 0; r < 10; ++r) { ch[r] = (u32x4){0u, 0u, 0u, 0u}; if (t0 - 2 + r >= 0) ch[r] = *(const u32x4*)(CH + (size_t)(row0 - 2 + r) * 512 + c); }
#pragma unroll
        for (int r = 0; r < 8; ++r) bg[r] = *(const u32x4*)(BG + (size_t)(row0 + r) * 512 + c);
        f32x4 wa[3], wb[3];
#pragma unroll
        for (int k = 0; k < 3; ++k) { wa[k] = *(const f32x4*)(w + k * 512 + c); wb[k] = *(const f32x4*)(w + k * 512 + c + 4); }
#pragma unroll
        for (int r = 0; r < 8; ++r) { f32x4 a0 = {0.f, 0.f, 0.f, 0.f}, a1 = a0;
#pragma unroll
            for (int k = 0; k < 3; ++k) { f32x4 x0, x1; unpack8(ch[r + k], x0, x1); a0 += x0 * wa[k]; a1 += x1 * wb[k]; }
            f32x4 g0, g1; unpack8(bg[r], g0, g1);
            *(u32x4*)(BG + (size_t)(row0 + r) * 512 + c) = pack8(g0 * a0, g1 * a1); }
    }
}

#define RLX_AGENT __ATOMIC_RELAXED, __HIP_MEMORY_SCOPE_AGENT
#define XB_TMO      128
#define XB_XCNT(j)  (256  + 64 * (j))
#define XB_XSUB(j)  (1280 + 64 * (j))
#define XB_XGEN(j)  (2304 + 64 * (j))
#define XB_TOP      3328
#define XB_TOPGEN   3392
#define XCD_BAR_WORDS 3456
#define XB_SPIN_CAP (1u << 18)

__device__ __forceinline__ unsigned xb_ld(unsigned* p)              { return __hip_atomic_load(p, __ATOMIC_RELAXED, __HIP_MEMORY_SCOPE_AGENT); }
__device__ __forceinline__ unsigned xb_add(unsigned* p, unsigned v) { return __hip_atomic_fetch_add(p, v, __ATOMIC_RELAXED, __HIP_MEMORY_SCOPE_AGENT); }
__device__ __forceinline__ unsigned xb_xcc_id() { return (unsigned)__builtin_amdgcn_s_getreg((3 << 11) | 20) & 0xFu; }
#define XB_SPIN(cond, bar) do { unsigned _sp = 0; while (cond) { __builtin_amdgcn_s_sleep(1); \
    if ((++_sp & 255u) == 0u) { if (xb_ld(&(bar)[XB_TMO])) break; if (_sp > XB_SPIN_CAP) { atomicAdd(&(bar)[XB_TMO], 1u); break; } } } } while (0)

struct XcdBarrier {
    unsigned* bar; unsigned x;
    volatile LAS unsigned* st;
};

__device__ __forceinline__ XcdBarrier xcd_barrier_post(unsigned* bar, volatile LAS unsigned* st) {
    XcdBarrier b; b.bar = bar; b.x = xb_xcc_id(); b.st = st;
    if (threadIdx.x == 0) (void)xb_add(&bar[XB_XCNT(b.x)], 1u);
    return b;
}
__device__ __forceinline__ void xcd_barrier_complete(unsigned* bar, unsigned x, unsigned& nloc, unsigned& nx) {
    const unsigned G = gridDim.x * gridDim.y * gridDim.z;
    unsigned sum, cnt, mine, sp = 0u;
    for (;;) {
        sum = 0u; cnt = 0u; mine = 0u;
#pragma unroll
        for (unsigned j = 0; j < 16; ++j) { const unsigned c = xb_ld(&bar[XB_XCNT(j)]); sum += c; cnt += (c > 0u) ? 1u : 0u; mine = (j == x) ? c : mine; }
        if (sum == G) break;
        __builtin_amdgcn_s_sleep(1);
        if ((++sp & 255u) == 0u) { if (xb_ld(&bar[XB_TMO])) break; if (sp > XB_SPIN_CAP) { atomicAdd(&bar[XB_TMO], 1u); break; } }
    }
    nloc = mine > 0u ? mine : 1u; nx = cnt > 0u ? cnt : 1u;
}

__device__ __forceinline__ void xcd_barrier(const XcdBarrier& b) {
    asm volatile("s_waitcnt vmcnt(0)" ::: "memory");
    __syncthreads();
    if (threadIdx.x == 0) {
        unsigned* bar = b.bar;
        __builtin_amdgcn_s_waitcnt(0);
        unsigned nloc = b.st[0], nx = b.st[1];
        if (nloc == 0u) { xcd_barrier_complete(bar, b.x, nloc, nx); b.st[0] = nloc; b.st[1] = nx; }
        const unsigned old = xb_add(&bar[XB_XSUB(b.x)], 1u);
        const unsigned gen = old / nloc;
        if (old + 1u == (gen + 1u) * nloc) {
            __builtin_amdgcn_fence(__ATOMIC_RELEASE, "agent");
            asm volatile("s_waitcnt vmcnt(0)" ::: "memory");
            const unsigned og = xb_add(&bar[XB_TOP], 1u);
            const unsigned tg = og / nx;
            if (og + 1u == (tg + 1u) * nx) xb_add(&bar[XB_TOPGEN], 1u);
            else XB_SPIN(xb_ld(&bar[XB_TOPGEN]) == tg, bar);
            __builtin_amdgcn_fence(__ATOMIC_ACQUIRE, "agent");
            xb_add(&bar[XB_XGEN(b.x)], 1u);
            asm volatile("s_waitcnt vmcnt(0)" ::: "memory");
        } else {
            XB_SPIN(xb_ld(&bar[XB_XGEN(b.x)]) == gen, bar);
            __builtin_amdgcn_fence(__ATOMIC_ACQUIRE, "agent");
            asm volatile("s_waitcnt vmcnt(0)" ::: "memory");
        }
    }
    __syncthreads();
}


#define GRID_SYNC() do { XcdBarrier xb_; xb_.bar = (unsigned*)(ws + WS_BAR); xb_.x = xb_xcc_id(); xb_.st = (volatile LAS unsigned*)(lds + MISC_OFF); xcd_barrier(xb_); } while (0)
__global__ void __launch_bounds__(NTHREADS, 2) fwd_megakernel(Args a) {
    extern __shared__ __attribute__((aligned(16))) unsigned char lds_raw[];
    LAS unsigned char* lds = (LAS unsigned char*)lds_raw;
    cg::grid_group grid = cg::this_grid();
    const int G = gridDim.x, c = blockIdx.x;
    unsigned char* ws = a.ws;
    float* ssq = (float*)(ws + WS_SSQ);

    { volatile LAS unsigned* misc = (volatile LAS unsigned*)(lds + MISC_OFF); if (threadIdx.x < 16) misc[threadIdx.x] = 0u; }
    __syncthreads();
    grid.sync();
    (void)xcd_barrier_post((unsigned*)(ws + WS_BAR), (volatile LAS unsigned*)(lds + MISC_OFF));
    prologue(a, lds, G);
    GRID_SYNC();

    for (int l = 0; l < 2; ++l) {
        { size_t z_ = 0; asm volatile("" : "+s"(z_)); ws += z_; } ssq = (float*)(ws + WS_SSQ);
        const float* ssq_mix = ssq + (size_t)(2 * l) * M * 16;
        { pg8::SchedGrid S; S.nM = 64; S.nN = 17; S.nwg = 64 * 17; S.G = G; S.c = c; S.A = (const char*)(ws + WS_XB); S.B = (const char*)(ws + WS_WIN + l * WIN_L); S.lda2 = 2048; S.ldb2 = 2048; S.nt = 16;
          EpiInProj E{ssq_mix, ws};
          pg8::gemm_phase<EpiInProj, pg8::SchedGrid, true>(lds, S, E);
        }
        GRID_SYNC(); { size_t z_ = 0; asm volatile("" : "+s"(z_)); ws += z_; }
        for (int u = c; u < 512; u += G) mixer_sg(ws, l, lds, u);
        for (int u = c; u < 512; u += G) mixer_conv(ws, l, lds, u);
        for (int u = c; u < 256; u += G) mixer_attn(ws, l, lds, u);
        mixer_sc(ws, l, G);
        GRID_SYNC(); { size_t z_ = 0; asm volatile("" : "+s"(z_)); ws += z_; } ssq = (float*)(ws + WS_SSQ);
        { pg8::SchedMerge S; S.G = G; S.c = c; S.ws = (const char*)ws; S.WG = (const char*)(ws + WS_WIN + l * WIN_L) + (size_t)NLOG1 * 2048;
          S.WBR = (const char*)(ws + WS_WBR + l * WBR_L);
          EpiStashB ES{(bf16_t*)(ws + WS_MG)}; EpiGateAcc EA{ssq_mix, (bf16_t*)(ws + WS_MG), (bf16_t*)(ws + WS_TMP)};
          S.swap = 1; EpiMerge2 E2{ES, EA};
          pg8::gemm_phase<EpiMerge2, pg8::SchedMerge, true>(lds, S, E2);
        }
        GRID_SYNC(); { size_t z_ = 0; asm volatile("" : "+s"(z_)); ws += z_; } ssq = (float*)(ws + WS_SSQ);
        { pg8::SchedGrid S; S.nM = 64; S.nN = 4; S.nwg = 256; S.G = G; S.c = c; S.A = (const char*)(ws + WS_MG); S.B = (const char*)(ws + WS_WOUT + l * WOUT_L); S.lda2 = 2048; S.ldb2 = 2048; S.nt = 16;
          EpiResid E{(bf16_t*)(ws + WS_XB), ssq + (size_t)(2 * l + 1) * M * 16};
          pg8::gemm_phase<EpiResid, pg8::SchedGrid, false>(lds, S, E); }
        GRID_SYNC(); { size_t z_ = 0; asm volatile("" : "+s"(z_)); ws += z_; } ssq = (float*)(ws + WS_SSQ);
        { pg8::SchedGrid S; S.nM = 64; S.nN = 22; S.nwg = 64 * 22; S.G = G; S.c = c; S.A = (const char*)(ws + WS_XB); S.B = (const char*)(ws + WS_WGU + l * WGU_L); S.lda2 = 2048; S.ldb2 = 2048; S.nt = 16;
          EpiSwiGLU E{ssq + (size_t)(2 * l + 1) * M * 16, (bf16_t*)(ws + WS_ACT), ABL_FFN_SCALE(l)};
          pg8::gemm_phase<EpiSwiGLU, pg8::SchedGrid, true>(lds, S, E);
        }
        GRID_SYNC(); { size_t z_ = 0; asm volatile("" : "+s"(z_)); ws += z_; } ssq = (float*)(ws + WS_SSQ);
        { pg8::SchedGrid S; S.nM = 64; S.nN = 4; S.nwg = 256; S.G = G; S.c = c; S.A = (const char*)(ws + WS_ACT); S.B = (const char*)(ws + WS_WDN + l * WDN_L); S.lda2 = DFF * 2; S.ldb2 = DFF * 2; S.nt = DFF / 64;
          EpiResid E{(bf16_t*)(ws + WS_XB), ssq + (size_t)(2 * l + 2) * M * 16};
          pg8::gemm_phase<EpiResid, pg8::SchedGrid, false>(lds, S, E); }
        GRID_SYNC();
    }
    { { size_t z_ = 0; asm volatile("" : "+s"(z_)); ws += z_; } int tid_ = threadIdx.x; asm volatile("" : "+v"(tid_));
      const int lane = tid_ & 63, gw = c * NWAVES + (tid_ >> 6), NGW = G * NWAVES; const float* gf = (const float*)(ws + WS_PAR) + P_FINAL; const float* sq = (const float*)(ws + WS_SSQ) + (size_t)4 * M * 16;
      const bf16_t* XBp = (const bf16_t*)(ws + WS_XB);
      for (int row = gw; row < M; row += 2 * NGW) { const int row2 = row + NGW;
          u32x4 ra_[2], rb_[2];
#pragma unroll
          for (int j = 0; j < 2; ++j) { ra_[j] = *(const u32x4*)(XBp + (size_t)row * D + 512 * j + 8 * lane); rb_[j] = *(const u32x4*)(XBp + (size_t)row2 * D + 512 * j + 8 * lane); }
          const float ra = row_rs(sq, row), rb = row_rs(sq, row2);
#pragma unroll
          for (int j = 0; j < 2; ++j) { const f32x4 g0 = *(const f32x4*)(gf + 512 * j + 8 * lane), g1 = *(const f32x4*)(gf + 512 * j + 8 * lane + 4);
              f32x4 x0, x1; unpack8(ra_[j], x0, x1); float* oa = a.out + (size_t)row * D + 512 * j + 8 * lane; *(f32x4*)oa = x0 * ra * g0; *(f32x4*)(oa + 4) = x1 * ra * g1;
              unpack8(rb_[j], x0, x1); float* ob = a.out + (size_t)row2 * D + 512 * j + 8 * lane; *(f32x4*)ob = x0 * rb * g0; *(f32x4*)(ob + 4) = x1 * rb * g1; } } }
}

extern "C" void kernel_launch(void* const* d_in, const int* in_sizes, int n_in, void* d_out, int out_size, void* d_ws, size_t ws_size, hipStream_t stream) {
    static int grid = 0;
    if (grid == 0) {
        if (n_in != 19 || out_size != M * D || ws_size < WS_END) { fprintf(stderr, "kernel_launch: unexpected shapes (n_in %d out %d ws %zu)\n", n_in, out_size, ws_size); grid = -1; return; }
        int dev = 0, cus = 0, per_cu = 0;
        if (hipGetDevice(&dev) != hipSuccess || hipDeviceGetAttribute(&cus, hipDeviceAttributeMultiprocessorCount, dev) != hipSuccess) { grid = -1; return; }
        if (hipFuncSetAttribute((const void*)fwd_megakernel, hipFuncAttributeMaxDynamicSharedMemorySize, LDS_BYTES) != hipSuccess) { fprintf(stderr, "kernel_launch: hipFuncSetAttribute failed\n"); grid = -1; return; }
        if (hipOccupancyMaxActiveBlocksPerMultiprocessor(&per_cu, (const void*)fwd_megakernel, NTHREADS, LDS_BYTES) != hipSuccess || per_cu < 1) { fprintf(stderr, "kernel_launch: occupancy query says %d\n", per_cu); per_cu = 1; }
        (void)hipGetLastError();
        grid = cus * 1;
    }
    if (grid < 0) return;
    if (hipMemsetAsync((char*)d_ws + WS_BAR, 0, 16384, stream) != hipSuccess) { fprintf(stderr, "kernel_launch: memset failed\n"); return; }
    Args a{};
    for (int i = 0; i < 19; ++i) a.in[i] = (const float*)d_in[i];
    a.out = (float*)d_out; a.ws = (unsigned char*)d_ws;
    void* args[] = {&a};
    hipError_t e = hipLaunchCooperativeKernel((const void*)fwd_megakernel, dim3(grid), dim3(NTHREADS), args, LDS_BYTES, stream);
    if (e != hipSuccess) fprintf(stderr, "cooperative launch failed: %s (grid %d)\n", hipGetErrorString(e), grid);
}
```

```cpp
#include <hip/hip_runtime.h>
#include <hip/hip_cooperative_groups.h>
#include <cstdio>
#include <cstdint>
namespace cg = cooperative_groups;

#define LAS __attribute__((address_space(3)))
typedef unsigned short bf16_t;
typedef short bf16x8 __attribute__((ext_vector_type(8)));
typedef float f32x4 __attribute__((ext_vector_type(4)));
typedef float f32x2 __attribute__((ext_vector_type(2)));
typedef unsigned u32x4 __attribute__((ext_vector_type(4)));
typedef unsigned u32x2 __attribute__((ext_vector_type(2)));

constexpr int M = 16384, D = 1024, SEQ = 2048, NBATCH = 8, DFF = 2816, PROJ = 8448, NLOG1 = 4352  ;
constexpr float EPS = 1e-6f;
constexpr int NTHREADS = 512, NWAVES = 8;
constexpr int LDS_BYTES = 147456;

constexpr size_t MiB = 1u << 20;
constexpr size_t WS_SSQ = 248 * (size_t)(1u << 20);
constexpr size_t WS_PAR = 512 * 1024;
constexpr int PAR_L = 24576, P_SGLNG = 0, P_SGLNB = 512, P_SGB = 1024, P_CVB = 1536, P_CVLNG = 2048, P_CVLNB = 2560, P_SCW = 3072, P_SINK = 4608, P_CVW = 4672, P_FINAL = 2 * PAR_L;
constexpr size_t WS_BAR = 768 * 1024;
constexpr int MISC_OFF = 147200;
constexpr size_t WS_ROPEC = 1 * MiB, WS_ROPES = 1 * MiB + 256 * 1024;
constexpr size_t WS_SGWT = 1 * MiB + 512 * 1024;
constexpr size_t WS_WIN = 2 * MiB, WIN_L = (size_t)PROJ * D * 2;
constexpr size_t WS_WBR = 35 * MiB, WBR_L = 4 * MiB;
constexpr size_t WS_WOUT = 43 * MiB, WOUT_L = 2 * MiB;
constexpr size_t WS_WGU = 47 * MiB, WGU_L = 11 * MiB;
constexpr size_t WS_WDN = 69 * MiB, WDN_L = (size_t)D * DFF * 2;
constexpr size_t WS_XB = 80 * MiB;
constexpr size_t WS_ZA = 112 * MiB;
constexpr size_t WS_MG = WS_ZA;
constexpr size_t WS_GLU = 144 * MiB;
constexpr size_t WS_CH = 160 * MiB;
constexpr size_t WS_TMP = WS_GLU;
constexpr size_t WS_Q = 176 * MiB;
constexpr size_t WS_BG = 192 * MiB;
constexpr size_t WS_K = 208 * MiB, WS_V = 212 * MiB;
constexpr size_t WS_YA = 216 * MiB, WS_YB = 232 * MiB;
constexpr size_t WS_ACT = 112 * MiB;
constexpr size_t WS_END = 254 * MiB;

__device__ const double INVF_REV[32] = {0.15915494309189535, 0.11934937021124886, 0.08949940160889101, 0.06711508300522726, 0.050329212104487035, 0.03774158471741977, 0.0283021958306234, 0.02122365276477766, 0.015915494309189534, 0.011934937021124886, 0.008949940160889102, 0.006711508300522725, 0.005032921210448704, 0.003774158471741977, 0.00283021958306234, 0.0021223652764777662, 0.0015915494309189536, 0.0011934937021124885, 0.0008949940160889102, 0.0006711508300522726, 0.0005032921210448703, 0.00037741584717419774, 0.00028302195830623395, 0.0002122365276477766, 0.00015915494309189535, 0.00011934937021124886, 8.949940160889102e-05, 6.711508300522725e-05, 5.0329212104487035e-05, 3.774158471741978e-05, 2.8302195830623396e-05, 2.122365276477766e-05};

__device__ __forceinline__ unsigned cvt_pk_bf16(float lo, float hi) { unsigned r; asm volatile("v_cvt_pk_bf16_f32 %0, %1, %2" : "=v"(r) : "v"(lo), "v"(hi)); return r; }
__device__ __forceinline__ float bf_lo(unsigned u) { return __builtin_bit_cast(float, u << 16); }
__device__ __forceinline__ float bf_hi(unsigned u) { return __builtin_bit_cast(float, u & 0xffff0000u); }
__device__ __forceinline__ float bf1(bf16_t h) { return __builtin_bit_cast(float, ((unsigned)h) << 16); }
__device__ __forceinline__ float sigmoidf_(float x) { return __builtin_amdgcn_rcpf(1.0f + __expf(-x)); }
template <int CTRL, int ROW_MASK> __device__ __forceinline__ float dpp_mov(float v) {
    return __builtin_bit_cast(float, __builtin_amdgcn_update_dpp(0, __builtin_bit_cast(int, v), CTRL, ROW_MASK, 0xf, true));
}
__device__ __forceinline__ float wave_sum(float v) {
    v += dpp_mov<0xB1, 0xf>(v);
    v += dpp_mov<0x4E, 0xf>(v);
    v += dpp_mov<0x141, 0xf>(v);
    v += dpp_mov<0x140, 0xf>(v);
    v += dpp_mov<0x142, 0xa>(v);
    v += dpp_mov<0x143, 0xc>(v);
    return __builtin_bit_cast(float, __builtin_amdgcn_readlane(__builtin_bit_cast(int, v), 63));
}
__device__ __forceinline__ f32x2 gelu_pk(f32x2 v) {
    const f32x2 av = __builtin_elementwise_abs(v), d = av * 0.2316418882f + 1.0f;
    f32x2 t; t.x = __builtin_amdgcn_rcpf(d.x); t.y = __builtin_amdgcn_rcpf(d.y);
    f32x2 q = t * 0.5307027145f + (-0.7265760135f); q = q * t + 0.7107068705f; q = q * t + (-0.142248368f); q = q * t + 0.127414796f; q = q * t;
    const f32x2 s = (v * v) * (-0.72134752044f);
    f32x2 e; e.x = __builtin_amdgcn_exp2f(s.x); e.y = __builtin_amdgcn_exp2f(s.y);
    const f32x2 m = v * (q * e), r = v - m;
    f32x2 o; o.x = v.x < 0.f ? m.x : r.x; o.y = v.y < 0.f ? m.y : r.y; return o;
}
__device__ __forceinline__ u32x4 pack8(f32x4 a, f32x4 b) { u32x4 w; w.x = cvt_pk_bf16(a[0], a[1]); w.y = cvt_pk_bf16(a[2], a[3]); w.z = cvt_pk_bf16(b[0], b[1]); w.w = cvt_pk_bf16(b[2], b[3]); return w; }
__device__ __forceinline__ void unpack8(u32x4 w, f32x4& a, f32x4& b) { a = (f32x4){bf_lo(w.x), bf_hi(w.x), bf_lo(w.y), bf_hi(w.y)}; b = (f32x4){bf_lo(w.z), bf_hi(w.z), bf_lo(w.w), bf_hi(w.w)}; }

namespace pg8 {
constexpr int BM = 256, BK = 64, HALF = 128, HTB = HALF * BK * 2, STAGE_BYTES = 8 * HTB, NXCD = 8, WGM = 8;
__host__ __device__ __forceinline__ int lds_byte(int r, int c) { const int st = (r >> 4) * 2 + (c >> 5), rr = r & 15, cc = c & 31, ob = rr * 64 + cc * 2; return st * 1024 + (ob ^ (((ob >> 9) & 1) << 5)); }
__host__ __device__ __forceinline__ void stage_rc(int b, int& R, int& C) { const int st = b / 1024, sb = b % 1024, swz = sb ^ (((sb >> 9) & 1) << 5); R = (st >> 1) * 16 + swz / 64; C = (st & 1) * 32 + (swz % 64) / 2; }
__host__ __device__ __forceinline__ int perm32(int rho) { const int n = rho >> 4, i = rho & 15; return 8 * (i >> 2) + 4 * n + (i & 3); }

struct Unit { const char* A; const char* B; int lda2, ldb2, nt, pm, pn, z; };

__device__ __forceinline__ void tile_of(int L, int nM, int nN, int& pm, int& pn) {
    const int nwg = nM * nN; int wgid = L; { const int q = nwg / NXCD, r = nwg % NXCD, xcd = wgid % NXCD, off = wgid / NXCD; wgid = (xcd < r ? xcd * (q + 1) : r * (q + 1) + (xcd - r) * q) + off; }
    const int nig = WGM * nN, gid = wgid / nig, fm = gid * WGM, gsz = (nM - fm) < WGM ? (nM - fm) : WGM;
    pm = fm + ((wgid % nig) % gsz); pn = (wgid % nig) / gsz;
}
struct SchedGrid {
    static constexpr bool VARLD = false;
    int nM, nN, nwg, G, c; const char* A; const char* B; int lda2, ldb2, nt;
    __device__ __forceinline__ bool next(int i, Unit& u) const {
        const long L = (long)i * G + c; if (L >= nwg) return false;
        tile_of((int)L, nM, nN, u.pm, u.pn); u.z = 0;
        u.A = A + (size_t)u.pm * 256 * lda2; u.B = B + (size_t)u.pn * 256 * ldb2; u.lda2 = lda2; u.ldb2 = ldb2; u.nt = nt; return true;
    }
};
struct SchedMerge {
    static constexpr bool VARLD = true;
    int G, c; const char* ws; const char* WG  ; const char* WBR; int swap;
    __device__ __forceinline__ bool next(int i, Unit& u) const {
        const int ti = i >> 3, sub = i & 7; const long L = (long)ti * G + c; if (L >= 256) return false;
        tile_of((int)L, 64, 4, u.pm, u.pn); u.z = sub; const int br = sub >> 1;
        if (((sub & 1) ^ swap) == 0) { u.A = ws + WS_XB + (size_t)u.pm * 256 * 2048; u.lda2 = 2048; u.B = WG + (size_t)(br * 1024 + u.pn * 256) * 2048; u.ldb2 = 2048; u.nt = 16; }
        else { const size_t yo = br == 0 ? WS_YA : br == 1 ? WS_YB : br == 2 ? WS_Q : WS_BG;
               u.A = ws + yo + (size_t)u.pm * 256 * 1024; u.lda2 = 1024; u.B = WBR + (size_t)br * (1024 * 512 * 2) + (size_t)u.pn * 256 * 1024; u.ldb2 = 1024; u.nt = 8; }
        return true;
    }
};

struct SchedOne {
    static constexpr bool VARLD = false;
    SchedMerge M; int i0;
    __device__ __forceinline__ bool next(int i, Unit& u) const { if (i != 0) return false; return M.next(i0, u); }
};
struct SchedOneG {
    static constexpr bool VARLD = false;
    SchedGrid S; int i0;
    __device__ __forceinline__ bool next(int i, Unit& u) const { if (i != 0) return false; return S.next(i0, u); }
};
template <class Epi, class Sched, bool ALIGN_EPI>
__device__ __forceinline__ void gemm_phase(LAS unsigned char* lds, const Sched& S, const Epi& E) {
    int tid_ = threadIdx.x; asm volatile("" : "+v"(tid_));
    const int tid = tid_, wid = __builtin_amdgcn_readfirstlane(tid >> 6), lane = tid & 63, wr = wid >> 2, wc = wid & 3, fr = lane & 15, fq = lane >> 4;
    unsigned rA[2], rB[2], cc2[2];
#pragma unroll
    for (int i = 0; i < 2; ++i) { int R, C; stage_rc(tid * 16 + i * 8192, R, C); rA[i] = (unsigned)R; rB[i] = (unsigned)((R & ~31) + perm32(R & 31)); cc2[i] = (unsigned)C * 2u; }
    const size_t kstep = (size_t)(BK * 2);
    const unsigned ldsw = (unsigned)wid * 1024u;
    const int aoff = lds_byte(wr * 64 + fr, fq * 8), boff = lds_byte(wc * 32 + fr, fq * 8);
#define PG8_SA(b, h) (((b) * 2 + (h)) * HTB)
#define PG8_SB(b, h) ((4 + (b) * 2 + (h)) * HTB)
#define PG8_STAGE(bufoff, gbase, voff) do { _Pragma("unroll") for (int _i = 0; _i < 2; ++_i) \
        __builtin_amdgcn_global_load_lds((const unsigned*)((const char*)(gbase) + (voff)[_i]), (LAS unsigned*)(lds + (bufoff) + ldsw + _i * 8192), 16, 0, 0); } while (0)
#define PG8_LDA(dst, b, h) do { _Pragma("unroll") for (int m = 0; m < 4; ++m) _Pragma("unroll") for (int k = 0; k < 2; ++k) dst[m][k] = *(const LAS bf16x8*)(lds + PG8_SA(b, h) + aoff + m * 2048 + k * 1024); } while (0)
#define PG8_LDB(dst, b, h) do { _Pragma("unroll") for (int n = 0; n < 2; ++n) _Pragma("unroll") for (int k = 0; k < 2; ++k) dst[n][k] = *(const LAS bf16x8*)(lds + PG8_SB(b, h) + boff + n * 2048 + k * 1024); } while (0)
#define PG8_MMA(ai, bj, At, Bt) do { __builtin_amdgcn_s_setprio(1); _Pragma("unroll") for (int m = 0; m < 4; ++m) _Pragma("unroll") for (int n = 0; n < 2; ++n) _Pragma("unroll") for (int k = 0; k < 2; ++k) \
        acc[ai][bj][m][n] = __builtin_amdgcn_mfma_f32_16x16x32_bf16(Bt[n][k], At[m][k], acc[ai][bj][m][n], 0, 0, 0); __builtin_amdgcn_s_setprio(0); } while (0)
#define PG8_WAIT_V(n) asm volatile("s_waitcnt vmcnt(" #n ")" ::: "memory")
#define PG8_WAIT_L(n) asm volatile("s_waitcnt lgkmcnt(" #n ")" ::: "memory")
#define PG8_BAR __builtin_amdgcn_s_barrier()
#define PG8_SCHED __builtin_amdgcn_sched_barrier(0)
    Unit cur, nxt; int ui = 0;
    if (!S.next(0, cur)) return;
    f32x4 acc[2][2][4][2];
#pragma unroll
    for (int a = 0; a < 2; ++a)
#pragma unroll
        for (int b = 0; b < 2; ++b)
#pragma unroll
            for (int m = 0; m < 4; ++m)
#pragma unroll
                for (int n = 0; n < 2; ++n) acc[a][b][m][n] = (f32x4){0.f, 0.f, 0.f, 0.f};
    bf16x8 At[4][2], B0[2][2], B1[2][2];
    unsigned voffA[2], voffB[2];
#pragma unroll
    for (int i = 0; i < 2; ++i) { voffA[i] = rA[i] * (unsigned)cur.lda2 + cc2[i]; voffB[i] = rB[i] * (unsigned)cur.ldb2 + cc2[i]; }
    const char* cA = cur.A; const char* cB = cur.B;
    unsigned hA = (unsigned)HALF * cur.lda2, hB = (unsigned)HALF * cur.ldb2;
    PG8_STAGE(PG8_SB(0, 0), cB, voffB); PG8_STAGE(PG8_SB(0, 1), cB + hB, voffB); PG8_STAGE(PG8_SA(0, 0), cA, voffA); PG8_STAGE(PG8_SA(0, 1), cA + hA, voffA);
    if (wr == 1) PG8_BAR;
    PG8_WAIT_V(2); PG8_BAR;
    PG8_STAGE(PG8_SB(1, 0), cB + kstep, voffB); PG8_STAGE(PG8_SA(1, 0), cA + kstep, voffA); PG8_STAGE(PG8_SB(1, 1), cB + hB + kstep, voffB);
    PG8_WAIT_V(6); PG8_BAR;
    for (;;) {
        const bool has_next = S.next(ui + 1, nxt);
        if (!has_next) nxt = cur;
        unsigned voffAn[2], voffBn[2];
#pragma unroll
        for (int i = 0; i < 2; ++i) { if constexpr (Sched::VARLD) { voffAn[i] = rA[i] * (unsigned)nxt.lda2 + cc2[i]; voffBn[i] = rB[i] * (unsigned)nxt.ldb2 + cc2[i]; } else { voffAn[i] = voffA[i]; voffBn[i] = voffB[i]; } }
        const char* nA = nxt.A; const char* nB = nxt.B;
        const unsigned hAn = Sched::VARLD ? (unsigned)HALF * nxt.lda2 : hA, hBn = Sched::VARLD ? (unsigned)HALF * nxt.ldb2 : hB;
        const int nt = cur.nt;
        for (int t = 0; t < nt; t += 2) {
            const bool last = (t == nt - 2);
            const char* a1 = cA + (size_t)(t + 1) * kstep;
            const char* a2 = last ? nA : cA + (size_t)(t + 2) * kstep; const char* b2 = last ? nB : cB + (size_t)(t + 2) * kstep;
            const char* a3 = a2 + kstep; const char* b3 = b2 + kstep;
            const unsigned hA2 = last ? hAn : hA, hB2 = last ? hBn : hB;
            unsigned vA2[2], vB2[2];
#pragma unroll
            for (int i = 0; i < 2; ++i) { vA2[i] = last ? voffAn[i] : voffA[i]; vB2[i] = last ? voffBn[i] : voffB[i]; }
            PG8_LDB(B0, 0, 0); PG8_LDB(B1, 0, 1); PG8_SCHED; PG8_LDA(At, 0, 0); PG8_STAGE(PG8_SA(1, 1), a1 + hA, voffA);
            PG8_WAIT_V(8); PG8_WAIT_L(0); PG8_BAR; PG8_MMA(0, 0, At, B0); PG8_MMA(0, 1, At, B1); PG8_BAR; PG8_SCHED;
            PG8_LDA(At, 0, 1); PG8_STAGE(PG8_SB(0, 0), b2, vB2); PG8_STAGE(PG8_SB(0, 1), b2 + hB2, vB2); PG8_STAGE(PG8_SA(0, 0), a2, vA2);
            PG8_WAIT_V(8); PG8_WAIT_L(0); PG8_BAR; PG8_MMA(1, 0, At, B0); PG8_MMA(1, 1, At, B1); PG8_BAR; PG8_SCHED;
            PG8_LDB(B0, 1, 0); PG8_LDB(B1, 1, 1); PG8_SCHED; PG8_LDA(At, 1, 0); PG8_STAGE(PG8_SA(0, 1), a2 + hA2, vA2);
            PG8_WAIT_V(8); PG8_WAIT_L(0); PG8_BAR; PG8_MMA(0, 0, At, B0); PG8_MMA(0, 1, At, B1); PG8_BAR; PG8_SCHED;
            PG8_LDA(At, 1, 1); PG8_STAGE(PG8_SB(1, 0), b3, vB2); PG8_STAGE(PG8_SB(1, 1), b3 + hB2, vB2); PG8_STAGE(PG8_SA(1, 0), a3, vA2);
            PG8_WAIT_V(8); PG8_WAIT_L(0); PG8_BAR; PG8_MMA(1, 0, At, B0); PG8_MMA(1, 1, At, B1); PG8_BAR; PG8_SCHED;
        }
        if constexpr (ALIGN_EPI) { if (wr == 0) PG8_BAR; }
        E(acc, cur, wr, wc, fr, fq);
        if (!has_next) break;
#pragma unroll
        for (int a = 0; a < 2; ++a)
#pragma unroll
            for (int b = 0; b < 2; ++b)
#pragma unroll
                for (int m = 0; m < 4; ++m)
#pragma unroll
                    for (int n = 0; n < 2; ++n) acc[a][b][m][n] = (f32x4){0.f, 0.f, 0.f, 0.f};
        cur = nxt; cA = nA; cB = nB; hA = hAn; hB = hBn; ++ui;
#pragma unroll
        for (int i = 0; i < 2; ++i) { voffA[i] = voffAn[i]; voffB[i] = voffBn[i]; }
        if constexpr (ALIGN_EPI) { if (wr == 1) PG8_BAR; }
    }
    PG8_WAIT_V(0);
    if constexpr (!ALIGN_EPI) { if (wr == 0) PG8_BAR; }
    PG8_BAR;
#undef PG8_SA
#undef PG8_SB
#undef PG8_STAGE
#undef PG8_LDA
#undef PG8_LDB
#undef PG8_MMA
#undef PG8_WAIT_V
#undef PG8_WAIT_L
#undef PG8_BAR
#undef PG8_SCHED
}
}

#define EPI_ROWLOOP _Pragma("unroll") for (int ai = 0; ai < 2; ++ai) _Pragma("unroll") for (int m = 0; m < 4; ++m)
__device__ __forceinline__ float row_rs(const float* ssq, int row) { const f32x4* p = (const f32x4*)(ssq + (size_t)row * 16); const f32x4 a = p[0], b = p[1], c = p[2], d = p[3];
    const float s = (((a[0] + a[1]) + (a[2] + a[3])) + ((b[0] + b[1]) + (b[2] + b[3]))) + (((c[0] + c[1]) + (c[2] + c[3])) + ((d[0] + d[1]) + (d[2] + d[3])));
    return __builtin_amdgcn_rsqf(s * (1.0f / D) + EPS); }

struct EpiInProj {
    const float* ssq; unsigned char* ws;
    __device__ __forceinline__ void operator()(const f32x4 (&acc)[2][2][4][2], const pg8::Unit& u, int wr, int wc, int fr, int fq) const {
        bf16_t* const ZA = (bf16_t*)(ws + WS_ZA); bf16_t* const GLU = (bf16_t*)(ws + WS_GLU); bf16_t* const BG = (bf16_t*)(ws + WS_BG); bf16_t* const CH = (bf16_t*)(ws + WS_CH);
        const float* const ropeC = (const float*)(ws + WS_ROPEC); const float* const ropeS = (const float*)(ws + WS_ROPES);
        const int T = u.pn, row0 = u.pm * 256 + wr * 64 + fr, jcol = wc * 32 + 8 * fq;
        if (T < 4) {
            EPI_ROWLOOP { const int row = row0 + ai * 128 + m * 16; const float rs = row_rs(ssq, row);
#pragma unroll
                for (int bj = 0; bj < 2; ++bj) { f32x4 v0 = acc[ai][bj][m][0] * rs, v1 = acc[ai][bj][m][1] * rs;
                    f32x2 a = gelu_pk((f32x2){v0[0], v0[1]}), b = gelu_pk((f32x2){v0[2], v0[3]}), c = gelu_pk((f32x2){v1[0], v1[1]}), d = gelu_pk((f32x2){v1[2], v1[3]});
                    *(u32x4*)(ZA + (size_t)row * 1024 + 256 * T + 128 * bj + jcol) = pack8((f32x4){a.x, a.y, b.x, b.y}, (f32x4){c.x, c.y, d.x, d.y}); } }
        } else if (T < 8) {
            EPI_ROWLOOP { const int row = row0 + ai * 128 + m * 16; const float rs = row_rs(ssq, row); f32x4 o[2];
#pragma unroll
                for (int n = 0; n < 2; ++n) { const f32x4 a = acc[ai][0][m][n] * rs, g = acc[ai][1][m][n] * rs;
#pragma unroll
                    for (int j = 0; j < 4; ++j) o[n][j] = a[j] * sigmoidf_(g[j]); }
                *(u32x4*)(GLU + (size_t)row * 512 + 128 * (T - 4) + jcol) = pack8(o[0], o[1]); }
        } else if (T < 11) {
            const bool isq = T < 10; const bool rope = isq || wc < 2; const float sc = isq ? 0.125f : 1.0f;
            const size_t boff = isq ? WS_Q : (wc < 2 ? WS_K : WS_V); bf16_t* const base = (bf16_t*)(ws + boff);
            const int ld = isq ? 512 : 128, hcol = isq ? (4 * (T - 8) + wc) * 64 : (wc & 1) * 64;
            EPI_ROWLOOP { const int row = row0 + ai * 128 + m * 16; const float rs = row_rs(ssq, row) * sc; const int pos = row & (SEQ - 1); f32x4 o1[2], o2[2];
#pragma unroll
                for (int n = 0; n < 2; ++n) { const f32x4 x1 = acc[ai][0][m][n] * rs, x2 = acc[ai][1][m][n] * rs;
                    if (rope) { const f32x4 c = *(const f32x4*)(ropeC + pos * 32 + 8 * fq + 4 * n), s = *(const f32x4*)(ropeS + pos * 32 + 8 * fq + 4 * n);
                        o1[n] = x1 * c - x2 * s; o2[n] = x2 * c + x1 * s; } else { o1[n] = x1; o2[n] = x2; } }
                bf16_t* p = base + (size_t)row * ld + hcol + 8 * fq;
                *(u32x4*)p = pack8(o1[0], o1[1]); *(u32x4*)(p + 32) = pack8(o2[0], o2[1]); }
        } else if (T < 13) {
            EPI_ROWLOOP { const int row = row0 + ai * 128 + m * 16; const float rs = row_rs(ssq, row);
#pragma unroll
                for (int bj = 0; bj < 2; ++bj) *(u32x4*)(BG + (size_t)row * 512 + 256 * (T - 11) + 128 * bj + jcol) = pack8(acc[ai][bj][m][0] * rs, acc[ai][bj][m][1] * rs); }
        } else {
            EPI_ROWLOOP { const int row = row0 + ai * 128 + m * 16; const float rs = row_rs(ssq, row); const float rs2 = rs * rs;
                *(u32x4*)(CH + (size_t)row * 512 + 128 * (T - 13) + jcol) = pack8(acc[ai][0][m][0] * acc[ai][1][m][0] * rs2, acc[ai][0][m][1] * acc[ai][1][m][1] * rs2); }
        }
    }
};
struct EpiGate {
    const float* ssq; bf16_t* MG;
    __device__ __forceinline__ void operator()(const f32x4 (&acc)[2][2][4][2], const pg8::Unit& u, int wr, int wc, int fr, int fq) const {
        const int row0 = u.pm * 256 + wr * 64 + fr, col0 = u.pn * 256 + wc * 32 + 8 * fq;
        EPI_ROWLOOP { const int row = row0 + ai * 128 + m * 16; const float rs = row_rs(ssq, row);
#pragma unroll
            for (int bj = 0; bj < 2; ++bj) { f32x4 v0 = acc[ai][bj][m][0] * rs, v1 = acc[ai][bj][m][1] * rs;
#pragma unroll
                for (int j = 0; j < 4; ++j) { v0[j] = sigmoidf_(v0[j]); v1[j] = sigmoidf_(v1[j]); }
                *(u32x4*)(MG + (size_t)row * 1024 + col0 + 128 * bj) = pack8(v0, v1); } }
    }
};
struct EpiBranch {
    bf16_t* MG; bf16_t* TMP;
    __device__ __forceinline__ void operator()(const f32x4 (&acc)[2][2][4][2], const pg8::Unit& u, int wr, int wc, int fr, int fq) const {
        const int row0 = u.pm * 256 + wr * 64 + fr, col0 = u.pn * 256 + wc * 32 + 8 * fq, br = u.z >> 1;
        EPI_ROWLOOP { const int row = row0 + ai * 128 + m * 16;
#pragma unroll
            for (int bj = 0; bj < 2; ++bj) { const size_t off = (size_t)row * 1024 + col0 + 128 * bj;
                f32x4 g0, g1; unpack8(*(const u32x4*)(MG + off), g0, g1);
                f32x4 v0 = acc[ai][bj][m][0] * g0, v1 = acc[ai][bj][m][1] * g1;
                if (br > 0) { f32x4 t0, t1; unpack8(*(const u32x4*)(TMP + off), t0, t1); v0 += t0; v1 += t1; }
                if (br < 3) *(u32x4*)(TMP + off) = pack8(v0, v1); else *(u32x4*)(MG + off) = pack8(v0, v1); } }
    }
};
struct EpiStashB {
    bf16_t* MG;
    __device__ __forceinline__ void operator()(const f32x4 (&acc)[2][2][4][2], const pg8::Unit& u, int wr, int wc, int fr, int fq) const {
        const int row0 = u.pm * 256 + wr * 64 + fr, col0 = u.pn * 256 + wc * 32 + 8 * fq;
        EPI_ROWLOOP { const int row = row0 + ai * 128 + m * 16;
#pragma unroll
            for (int bj = 0; bj < 2; ++bj) *(u32x4*)(MG + (size_t)row * 1024 + col0 + 128 * bj) = pack8(acc[ai][bj][m][0], acc[ai][bj][m][1]); }
    }
};
struct EpiGateAcc {
    const float* ssq; bf16_t* MG; bf16_t* TMP;
    __device__ __forceinline__ void operator()(const f32x4 (&acc)[2][2][4][2], const pg8::Unit& u, int wr, int wc, int fr, int fq) const {
        const int row0 = u.pm * 256 + wr * 64 + fr, col0 = u.pn * 256 + wc * 32 + 8 * fq, br = u.z >> 1;
        EPI_ROWLOOP { const int row = row0 + ai * 128 + m * 16; const float rs = row_rs(ssq, row);
#pragma unroll
            for (int bj = 0; bj < 2; ++bj) { const size_t off = (size_t)row * 1024 + col0 + 128 * bj;
                f32x4 b0, b1; unpack8(*(const u32x4*)(MG + off), b0, b1);
                f32x4 v0 = acc[ai][bj][m][0] * rs, v1 = acc[ai][bj][m][1] * rs;
#pragma unroll
                for (int j = 0; j < 4; ++j) { v0[j] = sigmoidf_(v0[j]) * b0[j]; v1[j] = sigmoidf_(v1[j]) * b1[j]; }
                if (br > 0) { f32x4 t0, t1; unpack8(*(const u32x4*)(TMP + off), t0, t1); v0 += t0; v1 += t1; }
                if (br < 3) *(u32x4*)(TMP + off) = pack8(v0, v1); else *(u32x4*)(MG + off) = pack8(v0, v1); } }
    }
};
struct EpiMerge2 {
    EpiStashB ES; EpiGateAcc EA;
    __device__ __forceinline__ void operator()(const f32x4 (&acc)[2][2][4][2], const pg8::Unit& u, int wr, int wc, int fr, int fq) const {
        if ((u.z & 1) == 0) ES(acc, u, wr, wc, fr, fq); else EA(acc, u, wr, wc, fr, fq);
    }
};
struct EpiResid {
    bf16_t* XB; float* ssq_out;
    __device__ __forceinline__ void operator()(const f32x4 (&acc)[2][2][4][2], const pg8::Unit& u, int wr, int wc, int fr, int fq) const {
        const int row0 = u.pm * 256 + wr * 64 + fr, col0 = u.pn * 256 + wc * 32 + 8 * fq;
        EPI_ROWLOOP { const int row = row0 + ai * 128 + m * 16; float ss = 0.f;
#pragma unroll
            for (int bj = 0; bj < 2; ++bj) { const size_t off = (size_t)row * 1024 + col0 + 128 * bj;
                f32x4 x0, x1; unpack8(*(const u32x4*)(XB + off), x0, x1);
                const f32x4 v0 = x0 + acc[ai][bj][m][0], v1 = x1 + acc[ai][bj][m][1];
                *(u32x4*)(XB + off) = pack8(v0, v1);
                ss += (v0[0] * v0[0] + v0[1] * v0[1]) + (v0[2] * v0[2] + v0[3] * v0[3]) + (v1[0] * v1[0] + v1[1] * v1[1]) + (v1[2] * v1[2] + v1[3] * v1[3]); }
            ss += __shfl_xor(ss, 16); ss += __shfl_xor(ss, 32);
            if (fq == 0) ssq_out[(size_t)row * 16 + u.pn * 4 + wc] = ss; }
    }
};
struct EpiSwiGLU {
    const float* ssq; bf16_t* ACT; float zero_scale;
    __device__ __forceinline__ void operator()(const f32x4 (&acc)[2][2][4][2], const pg8::Unit& u, int wr, int wc, int fr, int fq) const {
        const int row0 = u.pm * 256 + wr * 64 + fr, col0 = u.pn * 128 + wc * 32 + 8 * fq;
        EPI_ROWLOOP { const int row = row0 + ai * 128 + m * 16; const float rs = row_rs(ssq, row); f32x4 o[2];
#pragma unroll
            for (int n = 0; n < 2; ++n) { const f32x4 g = acc[ai][0][m][n] * rs, up = acc[ai][1][m][n] * rs;
#pragma unroll
                for (int j = 0; j < 4; ++j) o[n][j] = g[j] * sigmoidf_(g[j]) * up[j] * zero_scale; }
            *(u32x4*)(ACT + (size_t)row * DFF + col0) = pack8(o[0], o[1]); }
    }
};

#define ABL_FFN_SCALE(l) 1.0f
struct Args { const float* in[19]; float* out; unsigned char* ws; };

__device__ __forceinline__ int win_src_col(int nlog) {
    const int T = nlog >> 8, o = nlog & 255, bj = o >> 7, j = o & 127;
    if (T < 4) return nlog;
    if (T < 8) return 1024 + bj * 512 + 128 * (T - 4) + j;
    if (T < 10) return 2048 + (4 * (T - 8) + (j >> 5)) * 64 + 32 * bj + (j & 31);
    if (T == 10) { const int h = j >> 5; return (h < 2 ? 2560 + h * 64 : 2688 + (h - 2) * 64) + 32 * bj + (j & 31); }
    if (T < 13) return 2816 + 256 * (T - 11) + o;
    if (T < 17) return 3328 + bj * 512 + 128 * (T - 13) + j;
    return nlog;
}
__device__ __forceinline__ void tr_item(const float* W, int Nsrc, int k0, int scolA, int scolB, const float* gain, bf16_t* WT, int K, int drow, LAS float* scr, int lane) {
    const int c4 = lane & 15; const int sc = ((c4 >> 3) ? scolB : scolA) + 4 * (c4 & 7);
    f32x4 v[16];
#pragma unroll
    for (int i = 0; i < 16; ++i) v[i] = __builtin_nontemporal_load((const f32x4*)(W + (size_t)(k0 + 4 * i + (lane >> 4)) * Nsrc + sc));
#pragma unroll
    for (int i = 0; i < 16; ++i) { const int row = 4 * i + (lane >> 4); if (gain) v[i] = v[i] * gain[k0 + row];
        LAS float* d = scr + row * 65 + 4 * c4; d[0] = v[i][0]; d[1] = v[i][1]; d[2] = v[i][2]; d[3] = v[i][3]; }
    asm volatile("s_waitcnt lgkmcnt(0)" ::: "memory");
    const int c = lane & 7;
#pragma unroll
    for (int jj = 0; jj < 8; ++jj) { const int n = (lane >> 3) + 8 * jj; const LAS float* s = scr + (8 * c) * 65 + n;
        u32x4 o; o.x = cvt_pk_bf16(s[0], s[65]); o.y = cvt_pk_bf16(s[2 * 65], s[3 * 65]); o.z = cvt_pk_bf16(s[4 * 65], s[5 * 65]); o.w = cvt_pk_bf16(s[6 * 65], s[7 * 65]);
        *(u32x4*)(WT + (size_t)(drow + n) * K + k0 + 8 * c) = o; }
    asm volatile("s_waitcnt lgkmcnt(0)" ::: "memory");
}
__device__ __forceinline__ void prologue(const Args& a, LAS unsigned char* lds, int G) {
    int tid_ = threadIdx.x; asm volatile("" : "+v"(tid_));
    const int tid = tid_, lane = tid & 63, wave = __builtin_amdgcn_readfirstlane(tid >> 6);
    const int gw = blockIdx.x * NWAVES + wave, NGW = G * NWAVES;
    unsigned char* ws = a.ws;
    LAS float* scr = (LAS float*)(lds + wave * 16640);
    constexpr int I_IN = 16 * 132, I_BR = 512, I_OUT = 256, I_GU = 16 * 88, I_DN = 44 * 16, I_L = I_IN + I_BR + I_OUT + I_GU + I_DN;
    for (int it = gw; it < 2 * I_L; it += NGW) {
        const int l = it / I_L; int r = it % I_L;
        if (r < I_IN) { const int kb = r / 132, nb = r % 132, n0 = 64 * nb;
            tr_item(a.in[2] + (size_t)l * D * PROJ, PROJ, 64 * kb, win_src_col(n0), win_src_col(n0 + 32), a.in[1] + l * D, (bf16_t*)(ws + WS_WIN + l * WIN_L), D, n0, scr, lane); continue; } r -= I_IN;
        if (r < I_BR) { const int br = r >> 7, q = r & 127, kb = q >> 4, nb = q & 15;
            tr_item(a.in[13] + (size_t)(l * 4 + br) * 512 * D, D, 64 * kb, 64 * nb, 64 * nb + 32, nullptr, (bf16_t*)(ws + WS_WBR + l * WBR_L) + (size_t)br * 1024 * 512, 512, 64 * nb, scr, lane); continue; } r -= I_BR;
        if (r < I_OUT) { const int kb = r >> 4, nb = r & 15;
            tr_item(a.in[14] + (size_t)l * D * D, D, 64 * kb, 64 * nb, 64 * nb + 32, nullptr, (bf16_t*)(ws + WS_WOUT + l * WOUT_L), D, 64 * nb, scr, lane); continue; } r -= I_OUT;
        if (r < I_GU) { const int kb = r / 88, nb = r % 88, n0 = 64 * nb, T = n0 >> 8, o = n0 & 255, sc = (o >> 7) * DFF + 128 * T + (o & 127);
            tr_item(a.in[16] + (size_t)l * D * 2 * DFF, 2 * DFF, 64 * kb, sc, sc + 32, a.in[15] + l * D, (bf16_t*)(ws + WS_WGU + l * WGU_L), D, n0, scr, lane); continue; } r -= I_GU;
        { const int kb = r >> 4, nb = r & 15;
            tr_item(a.in[17] + (size_t)l * DFF * D, D, 64 * kb, 64 * nb, 64 * nb + 32, nullptr, (bf16_t*)(ws + WS_WDN + l * WDN_L), DFF, 64 * nb, scr, lane); }
    }
    float* ssq = (float*)(ws + WS_SSQ);
    for (int row = gw; row < M; row += NGW) {
        const f32x4* xr = (const f32x4*)(a.in[0] + (size_t)row * D) + lane; float s = 0.f; f32x4 v[4];
#pragma unroll
        for (int j = 0; j < 4; ++j) { v[j] = xr[64 * j]; s += (v[j][0] * v[j][0] + v[j][1] * v[j][1]) + (v[j][2] * v[j][2] + v[j][3] * v[j][3]); }
        s = wave_sum(s);
        u32x2* o = (u32x2*)((bf16_t*)(ws + WS_XB) + (size_t)row * D) + lane;
#pragma unroll
        for (int j = 0; j < 4; ++j) o[64 * j] = (u32x2){cvt_pk_bf16(v[j][0], v[j][1]), cvt_pk_bf16(v[j][2], v[j][3])};
        if (lane < 16) ssq[(size_t)row * 16 + lane] = lane == 0 ? s : 0.f;
    }
    { float* par = (float*)(ws + WS_PAR); const int gt = blockIdx.x * NTHREADS + tid, GT = G * NTHREADS;
#define CPY(dstoff, srcp, n) for (int i = gt; i < (n); i += GT) par[(dstoff) + i] = (srcp)[i]
      for (int l = 0; l < 2; ++l) { const int o = l * PAR_L;
          CPY(o + P_SGLNG, a.in[3] + l * 512, 512); CPY(o + P_SGLNB, a.in[4] + l * 512, 512); CPY(o + P_SGB, a.in[6] + l * 512, 512);
          CPY(o + P_CVB, a.in[8] + l * 512, 512); CPY(o + P_CVLNG, a.in[9] + l * 512, 512); CPY(o + P_CVLNB, a.in[10] + l * 512, 512);
          CPY(o + P_SCW, a.in[12] + l * 1536, 1536); CPY(o + P_SINK, a.in[11] + l * 8, 8); CPY(o + P_CVW, a.in[7] + l * 31 * 512, 31 * 512); }
      CPY(P_FINAL, a.in[18], 1024);
#undef CPY
    }
    for (int i = blockIdx.x * NTHREADS + tid; i < SEQ * 32; i += G * NTHREADS) { const int pos = i >> 5, f = i & 31;
        const double rev = (double)pos * INVF_REV[f]; const float fr = (float)(rev - floor(rev));
        ((float*)(ws + WS_ROPEC))[i] = __builtin_amdgcn_cosf(fr); ((float*)(ws + WS_ROPES))[i] = __builtin_amdgcn_sinf(fr); }
    for (int i = blockIdx.x * NTHREADS + tid; i < 2 * 4 * 128 * 128; i += G * NTHREADS) { const int s = i & 127, t = (i >> 7) & 127;
        ((bf16_t*)(ws + WS_SGWT))[i] = s <= t ? (bf16_t)(cvt_pk_bf16(a.in[5][i], 0.f) & 0xffffu) : (bf16_t)0; }
}

__device__ __forceinline__ void mixer_sg(unsigned char* ws, int l, LAS unsigned char* lds, int unit) {
    { size_t z_ = 0; asm volatile("" : "+s"(z_)); ws += z_; } int tid_ = threadIdx.x; asm volatile("" : "+v"(tid_));
    const float* par = (const float*)(ws + WS_PAR) + l * PAR_L;
    const int tid = tid_, lane = tid & 63, wave = __builtin_amdgcn_readfirstlane(tid >> 6);
    const int ck = unit >> 2, g = unit & 3, r0 = ck * 128;
    const bf16_t* ZA = (const bf16_t*)(ws + WS_ZA); bf16_t* YA = (bf16_t*)(ws + WS_YA);
    LAS bf16_t* vnT = (LAS bf16_t*)lds;
    const float* lng = par + P_SGLNG; const float* lnb = par + P_SGLNB;
    const f32x4 g0 = *(const f32x4*)(lng + 8 * lane), g1 = *(const f32x4*)(lng + 8 * lane + 4), b0 = *(const f32x4*)(lnb + 8 * lane), b1 = *(const f32x4*)(lnb + 8 * lane + 4);
    u32x4 raw[16];
#pragma unroll
    for (int i = 0; i < 16; ++i) raw[i] = *(const u32x4*)(ZA + (size_t)(r0 + wave + 8 * i) * 1024 + 512 + 8 * lane);
    const int fr = lane & 15, fq = lane >> 4, t0 = 16 * wave, nks = (wave >> 1) + 1;
    const bf16_t* W = (const bf16_t*)(ws + WS_SGWT) + (size_t)(l * 4 + g) * 16384 + (size_t)(t0 + fr) * 128 + 8 * fq;
    bf16x8 wf[4];
#pragma unroll
    for (int ks = 0; ks < 4; ++ks) wf[ks] = *(const bf16x8*)(W + 32 * (ks < nks ? ks : 0));
    const int tt = t0 + fr; const size_t orow = r0 + tt; const float bs = par[P_SGB + g * 128 + tt];
    u32x2 uu[8];
#pragma unroll
    for (int ct = 0; ct < 8; ++ct) uu[ct] = *(const u32x2*)(ZA + orow * 1024 + 128 * g + 16 * ct + 4 * fq);
#pragma unroll
    for (int i = 0; i < 16; ++i) { const int s = wave + 8 * i;
        f32x4 x0, x1; unpack8(raw[i], x0, x1);
        const float mean = wave_sum((x0[0] + x0[1]) + (x0[2] + x0[3]) + (x1[0] + x1[1]) + (x1[2] + x1[3])) * (1.0f / 512.0f);
        x0 -= mean; x1 -= mean;
        const float var = wave_sum((x0[0] * x0[0] + x0[1] * x0[1]) + (x0[2] * x0[2] + x0[3] * x0[3]) + (x1[0] * x1[0] + x1[1] * x1[1]) + (x1[2] * x1[2] + x1[3] * x1[3])) * (1.0f / 512.0f);
        const float rstd = __builtin_amdgcn_rsqf(var + EPS);
        if ((lane >> 4) == g) { const int c = 8 * (lane & 15); x0 = x0 * rstd * g0 + b0; x1 = x1 * rstd * g1 + b1;
            const unsigned p0 = cvt_pk_bf16(x0[0], x0[1]), p1 = cvt_pk_bf16(x0[2], x0[3]), p2 = cvt_pk_bf16(x1[0], x1[1]), p3 = cvt_pk_bf16(x1[2], x1[3]);
            LAS bf16_t* d = vnT + c * 136 + (s ^ (8 * (lane & 15)));
            d[0] = (bf16_t)p0; d[136] = (bf16_t)(p0 >> 16); d[2 * 136] = (bf16_t)p1; d[3 * 136] = (bf16_t)(p1 >> 16);
            d[4 * 136] = (bf16_t)p2; d[5 * 136] = (bf16_t)(p2 >> 16); d[6 * 136] = (bf16_t)p3; d[7 * 136] = (bf16_t)(p3 >> 16); }
    }
    __syncthreads();
    { f32x4 acc[8];
#pragma unroll
      for (int ct = 0; ct < 8; ++ct) acc[ct] = (f32x4){0.f, 0.f, 0.f, 0.f};
#pragma unroll
      for (int ks = 0; ks < 4; ++ks) if (ks < nks) {
#pragma unroll
          for (int ct = 0; ct < 8; ++ct) { const bf16x8 vf = *(const LAS bf16x8*)(vnT + (16 * ct + fr) * 136 + 8 * ((4 * ks + fq) ^ ((2 * ct + (fr >> 3)) & 15)));
              acc[ct] = __builtin_amdgcn_mfma_f32_16x16x32_bf16(vf, wf[ks], acc[ct], 0, 0, 0); }
      }
#pragma unroll
      for (int ct = 0; ct < 8; ++ct) { const int c = 128 * g + 16 * ct + 4 * fq;
          const float o0 = bf_lo(uu[ct].x) * (acc[ct][0] + bs), o1 = bf_hi(uu[ct].x) * (acc[ct][1] + bs), o2 = bf_lo(uu[ct].y) * (acc[ct][2] + bs), o3 = bf_hi(uu[ct].y) * (acc[ct][3] + bs);
          *(u32x2*)(YA + orow * 512 + c) = (u32x2){cvt_pk_bf16(o0, o1), cvt_pk_bf16(o2, o3)}; }
    }
    __syncthreads();
}
__device__ __forceinline__ void mixer_conv(unsigned char* ws, int l, LAS unsigned char* lds, int unit) {
    { size_t z_ = 0; asm volatile("" : "+s"(z_)); ws += z_; } int tid_ = threadIdx.x; asm volatile("" : "+v"(tid_));
    const float* par = (const float*)(ws + WS_PAR) + l * PAR_L;
    const int tid = tid_, lane = tid & 63, wave = tid >> 6;
    const int b = unit >> 6, tb = unit & 63, t0 = tb * 32; const size_t rbase = (size_t)b * SEQ;
    const bf16_t* GLU = (const bf16_t*)(ws + WS_GLU); bf16_t* YB = (bf16_t*)(ws + WS_YB);
    LAS bf16_t* in = (LAS bf16_t*)lds;
    LAS float* cv = (LAS float*)(lds + 65536);
    for (int i = tid; i < 62 * 64; i += NTHREADS) { const int r = i >> 6, ch = i & 63; const int t = t0 - 30 + r;
        u32x4 v = {0u, 0u, 0u, 0u}; if (t >= 0) v = *(const u32x4*)(GLU + (rbase + t) * 512 + 8 * ch);
        *(LAS u32x4*)(in + r * 512 + 8 * ch) = v; }
    __syncthreads();
    { const int c = tid; float w[31], x[62];
#pragma unroll
      for (int k = 0; k < 31; ++k) w[k] = par[P_CVW + k * 512 + c];
#pragma unroll
      for (int r = 0; r < 62; ++r) x[r] = bf1(in[r * 512 + c]);
      const float bias = par[P_CVB + c];
#pragma unroll
      for (int t = 0; t < 32; ++t) { float s = bias;
#pragma unroll
          for (int k = 0; k < 31; ++k) s += w[k] * x[t + k];
          cv[t * 512 + c] = s; } }
    __syncthreads();
    { const float* lng = par + P_CVLNG; const float* lnb = par + P_CVLNB;
      const f32x4 g0 = *(const f32x4*)(lng + 8 * lane), g1 = *(const f32x4*)(lng + 8 * lane + 4), b0 = *(const f32x4*)(lnb + 8 * lane), b1 = *(const f32x4*)(lnb + 8 * lane + 4);
      for (int t = wave; t < 32; t += NWAVES) {
          f32x4 x0 = *(const LAS f32x4*)(cv + t * 512 + 8 * lane), x1 = *(const LAS f32x4*)(cv + t * 512 + 8 * lane + 4);
          const float mean = wave_sum((x0[0] + x0[1]) + (x0[2] + x0[3]) + (x1[0] + x1[1]) + (x1[2] + x1[3])) * (1.0f / 512.0f);
          x0 -= mean; x1 -= mean;
          const float var = wave_sum((x0[0] * x0[0] + x0[1] * x0[1]) + (x0[2] * x0[2] + x0[3] * x0[3]) + (x1[0] * x1[0] + x1[1] * x1[1]) + (x1[2] * x1[2] + x1[3] * x1[3])) * (1.0f / 512.0f);
          const float rstd = __builtin_amdgcn_rsqf(var + EPS);
          x0 = x0 * rstd * g0 + b0; x1 = x1 * rstd * g1 + b1;
#pragma unroll
          for (int j = 0; j < 4; ++j) { x0[j] = x0[j] * sigmoidf_(x0[j]); x1[j] = x1[j] * sigmoidf_(x1[j]); }
          *(u32x4*)(YB + (rbase + t0 + t) * 512 + 8 * lane) = pack8(x0, x1); } }
    __syncthreads();
}
__device__ __forceinline__ void mixer_attn(unsigned char* ws, int l, LAS unsigned char* lds, int unit) {
    { size_t z_ = 0; asm volatile("" : "+s"(z_)); ws += z_; } int tid_ = threadIdx.x; asm volatile("" : "+v"(tid_));
    const float* par = (const float*)(ws + WS_PAR) + l * PAR_L;
    const int tid = tid_, lane = tid & 63, wave = __builtin_amdgcn_readfirstlane(tid >> 6), fr = lane & 15, fq = lane >> 4;
    const int kvh = unit & 1, blk = (unit >> 1) & 15, b = unit >> 5; const size_t rbase = (size_t)b * SEQ;
    bf16_t* Q = (bf16_t*)(ws + WS_Q); const bf16_t* K = (const bf16_t*)(ws + WS_K); const bf16_t* V = (const bf16_t*)(ws + WS_V);
    LAS bf16_t* Kl = (LAS bf16_t*)lds;
    LAS bf16_t* VT = (LAS bf16_t*)(lds + 36864);
    for (int i = tid; i < 256 * 8; i += NTHREADS) { const int r = i >> 3, ch = i & 7; const int t = (blk - 1) * 128 + r;
        u32x4 kv = {0u, 0u, 0u, 0u}, vv = {0u, 0u, 0u, 0u};
        if (t >= 0) { kv = *(const u32x4*)(K + (rbase + t) * 128 + kvh * 64 + 8 * ch); vv = *(const u32x4*)(V + (rbase + t) * 128 + kvh * 64 + 8 * ch); }
        *(LAS u32x4*)(Kl + r * 72 + 8 * ch) = kv;
        LAS bf16_t* d = VT + (8 * ch) * 264 + r;
        d[0] = (bf16_t)vv.x; d[264] = (bf16_t)(vv.x >> 16); d[2 * 264] = (bf16_t)vv.y; d[3 * 264] = (bf16_t)(vv.y >> 16);
        d[4 * 264] = (bf16_t)vv.z; d[5 * 264] = (bf16_t)(vv.z >> 16); d[6 * 264] = (bf16_t)vv.w; d[7 * 264] = (bf16_t)(vv.w >> 16); }
    __syncthreads();
    const int g = wave >> 1, head = kvh * 4 + g; const float sink = par[P_SINK + head];
    for (int it = 0; it < 2; ++it) {
        const int qs = 2 * (wave & 1) + it, qi0 = 32 * qs; const size_t qrow0 = rbase + blk * 128 + qi0;
        bf16x8 qf[2][2];
#pragma unroll
        for (int qt = 0; qt < 2; ++qt)
#pragma unroll
            for (int ks = 0; ks < 2; ++ks) qf[qt][ks] = *(const bf16x8*)(Q + (qrow0 + 16 * qt + fr) * 512 + head * 64 + 32 * ks + 8 * fq);
        f32x4 S[2][10];
#pragma unroll
        for (int qt = 0; qt < 2; ++qt)
#pragma unroll
            for (int kt = 0; kt < 10; ++kt) S[qt][kt] = (f32x4){0.f, 0.f, 0.f, 0.f};
#pragma unroll
        for (int kt = 0; kt < 10; ++kt)
#pragma unroll
            for (int ks = 0; ks < 2; ++ks) { const bf16x8 kf = *(const LAS bf16x8*)(Kl + (qi0 + 16 * kt + fr) * 72 + 32 * ks + 8 * fq);
#pragma unroll
                for (int qt = 0; qt < 2; ++qt) S[qt][kt] = __builtin_amdgcn_mfma_f32_16x16x32_bf16(kf, qf[qt][ks], S[qt][kt], 0, 0, 0); }
        bf16x8 pf[2][5];
#pragma unroll
        for (int qt = 0; qt < 2; ++qt) { const int qi = qi0 + 16 * qt + fr; float mx = sink;
#pragma unroll
            for (int kt = 0; kt < 10; ++kt)
#pragma unroll
                for (int j = 0; j < 4; ++j) { const int kb = qi0 + 16 * kt + 4 * fq + j; const bool valid = (kb > qi) && (kb <= qi + 128) && (blk > 0 || kb >= 128);
                    const float sv = valid ? S[qt][kt][j] : -INFINITY; S[qt][kt][j] = sv; mx = fmaxf(mx, sv); }
            mx = fmaxf(mx, __shfl_xor(mx, 16)); mx = fmaxf(mx, __shfl_xor(mx, 32));
            float sum = 0.f;
#pragma unroll
            for (int kt = 0; kt < 10; ++kt)
#pragma unroll
                for (int j = 0; j < 4; ++j) { const float p = __expf(S[qt][kt][j] - mx); S[qt][kt][j] = p; sum += p; }
            sum += __shfl_xor(sum, 16); sum += __shfl_xor(sum, 32);
            const float inv = 1.0f / (sum + __expf(sink - mx));
#pragma unroll
            for (int p = 0; p < 5; ++p) { const f32x4 a0 = S[qt][2 * p] * inv, a1 = S[qt][2 * p + 1] * inv; pf[qt][p] = __builtin_bit_cast(bf16x8, pack8(a0, a1)); }
        }
        f32x4 o[2][4];
#pragma unroll
        for (int qt = 0; qt < 2; ++qt)
#pragma unroll
            for (int dt = 0; dt < 4; ++dt) o[qt][dt] = (f32x4){0.f, 0.f, 0.f, 0.f};
#pragma unroll
        for (int p = 0; p < 5; ++p)
#pragma unroll
            for (int dt = 0; dt < 4; ++dt) { const LAS bf16_t* vp = VT + (16 * dt + fr) * 264 + qi0 + 32 * p + 4 * fq;
                const u32x2 lo = *(const LAS u32x2*)vp, hi = *(const LAS u32x2*)(vp + 16);
                const bf16x8 vf = __builtin_bit_cast(bf16x8, (u32x4){lo.x, lo.y, hi.x, hi.y});
#pragma unroll
                for (int qt = 0; qt < 2; ++qt) o[qt][dt] = __builtin_amdgcn_mfma_f32_16x16x32_bf16(vf, pf[qt][p], o[qt][dt], 0, 0, 0); }
#pragma unroll
        for (int qt = 0; qt < 2; ++qt)
#pragma unroll
            for (int dt = 0; dt < 4; ++dt) *(u32x2*)(Q + (qrow0 + 16 * qt + fr) * 512 + head * 64 + 16 * dt + 4 * fq) = (u32x2){cvt_pk_bf16(o[qt][dt][0], o[qt][dt][1]), cvt_pk_bf16(o[qt][dt][2], o[qt][dt][3])};
    }
    __syncthreads();
}
__device__ __forceinline__ void mixer_sc(unsigned char* ws, int l, int G) {
    { size_t z_ = 0; asm volatile("" : "+s"(z_)); ws += z_; } int tid_ = threadIdx.x; asm volatile("" : "+v"(tid_));
    bf16_t* BG = (bf16_t*)(ws + WS_BG); const bf16_t* CH = (const bf16_t*)(ws + WS_CH);
    const float* w = (const float*)(ws + WS_PAR) + l * PAR_L + P_SCW;
    for (int i = blockIdx.x * NTHREADS + tid_; i < (M / 8) * 64; i += G * NTHREADS) {
        const int row0 = 8 * (i >> 6), c = 8 * (i & 63), t0 = row0 & (SEQ - 1);
        u32x4 ch[10], bg[8];
#pragma unroll
        for (int r = 0; r < 10; ++r) { ch[r] = (u32x4){0u, 0u, 0u, 0u}; if (t0 - 2 + r >= 0) ch[r] = *(const u32x4*)(CH + (size_t)(row0 - 2 + r) * 512 + c); }
#pragma unroll
        for (int r = 0; r < 8; ++r) bg[r] = *(const u32x4*)(BG + (size_t)(row0 + r) * 512 + c);
        f32x4 wa[3], wb[3];
#pragma unroll
        for (int k = 0; k < 3; ++k) { wa[k] = *(const f32x4*)(w + k * 512 + c); wb[k] = *(const f32x4*)(w + k * 512 + c + 4); }
#pragma unroll
        for (int r = 0; r < 8; ++r) { f32x4 a0 = {0.f, 0.f, 0.f, 0.f}, a1 = a0;
#pragma unroll
            for (int k = 0; k < 3; ++k) { f32x4 x0, x1; unpack8(ch[r + k], x0, x1); a0 += x0 * wa[k]; a1 += x1 * wb[k]; }
            f32x4 g0, g1; unpack8(bg[r], g0, g1);
            *(u32x4*)(BG + (size_t)(row0 + r) * 512 + c) = pack8(g0 * a0, g1 * a1); }
    }
}

#define RLX_AGENT __ATOMIC_RELAXED, __HIP_MEMORY_SCOPE_AGENT
#define XB_TMO      128
#define XB_XCNT(j)  (256  + 64 * (j))
#define XB_XSUB(j)  (1280 + 64 * (j))
#define XB_XGEN(j)  (2304 + 64 * (j))
#define XB_TOP      3328
#define XB_TOPGEN   3392
#define XCD_BAR_WORDS 3456
#define XB_SPIN_CAP (1u << 18)

__device__ __forceinline__ unsigned xb_ld(unsigned* p)              { return __hip_atomic_load(p, __ATOMIC_RELAXED, __HIP_MEMORY_SCOPE_AGENT); }
__device__ __forceinline__ unsigned xb_add(unsigned* p, unsigned v) { return __hip_atomic_fetch_add(p, v, __ATOMIC_RELAXED, __HIP_MEMORY_SCOPE_AGENT); }
__device__ __forceinline__ unsigned xb_xcc_id() { return (unsigned)__builtin_amdgcn_s_getreg((3 << 11) | 20) & 0xFu; }
#define XB_SPIN(cond, bar) do { unsigned _sp = 0; while (cond) { __builtin_amdgcn_s_sleep(1); \
    if ((++_sp & 255u) == 0u) { if (xb_ld(&(bar)[XB_TMO])) break; if (_sp > XB_SPIN_CAP) { atomicAdd(&(bar)[XB_TMO], 1u); break; } } } } while (0)

struct XcdBarrier {
    unsigned* bar; unsigned x;
    volatile LAS unsigned* st;
};

__device__ __forceinline__ XcdBarrier xcd_barrier_post(unsigned* bar, volatile LAS unsigned* st) {
    XcdBarrier b; b.bar = bar; b.x = xb_xcc_id(); b.st = st;
    if (threadIdx.x == 0) (void)xb_add(&bar[XB_XCNT(b.x)], 1u);
    return b;
}
__device__ __forceinline__ void xcd_barrier_complete(unsigned* bar, unsigned x, unsigned& nloc, unsigned& nx) {
    const unsigned G = gridDim.x * gridDim.y * gridDim.z;
    unsigned sum, cnt, mine, sp = 0u;
    for (;;) {
        sum = 0u; cnt = 0u; mine = 0u;
#pragma unroll
        for (unsigned j = 0; j < 16; ++j) { const unsigned c = xb_ld(&bar[XB_XCNT(j)]); sum += c; cnt += (c > 0u) ? 1u : 0u; mine = (j == x) ? c : mine; }
        if (sum == G) break;
        __builtin_amdgcn_s_sleep(1);
        if ((++sp & 255u) == 0u) { if (xb_ld(&bar[XB_TMO])) break; if (sp > XB_SPIN_CAP) { atomicAdd(&bar[XB_TMO], 1u); break; } }
    }
    nloc = mine > 0u ? mine : 1u; nx = cnt > 0u ? cnt : 1u;
}

__device__ __forceinline__ void xcd_barrier(const XcdBarrier& b) {
    asm volatile("s_waitcnt vmcnt(0)" ::: "memory");
    __syncthreads();
    if (threadIdx.x == 0) {
        unsigned* bar = b.bar;
        __builtin_amdgcn_s_waitcnt(0);
        unsigned nloc = b.st[0], nx = b.st[1];
        if (nloc == 0u) { xcd_barrier_complete(bar, b.x, nloc, nx); b.st[0] = nloc; b.st[1] = nx; }
        const unsigned old = xb_add(&bar[XB_XSUB(b.x)], 1u);
        const unsigned gen = old / nloc;
        if (old + 1u == (gen + 1u) * nloc) {
            __builtin_amdgcn_fence(__ATOMIC_RELEASE, "agent");
            asm volatile("s_waitcnt vmcnt(0)" ::: "memory");
            const unsigned og = xb_add(&bar[XB_TOP], 1u);
            const unsigned tg = og / nx;
            if (og + 1u == (tg + 1u) * nx) xb_add(&bar[XB_TOPGEN], 1u);
            else XB_SPIN(xb_ld(&bar[XB_TOPGEN]) == tg, bar);
            __builtin_amdgcn_fence(__ATOMIC_ACQUIRE, "agent");
            xb_add(&bar[XB_XGEN(b.x)], 1u);
            asm volatile("s_waitcnt vmcnt(0)" ::: "memory");
        } else {
            XB_SPIN(xb_ld(&bar[XB_XGEN(b.x)]) == gen, bar);
            __builtin_amdgcn_fence(__ATOMIC_ACQUIRE, "agent");
            asm volatile("s_waitcnt vmcnt(0)" ::: "memory");
        }
    }
    __syncthreads();
}


#define GRID_SYNC() do { XcdBarrier xb_; xb_.bar = (unsigned*)(ws + WS_BAR); xb_.x = xb_xcc_id(); xb_.st = (volatile LAS unsigned*)(lds + MISC_OFF); xcd_barrier(xb_); } while (0)
__global__ void __launch_bounds__(NTHREADS, 2) fwd_megakernel(Args a) {
    extern __shared__ __attribute__((aligned(16))) unsigned char lds_raw[];
    LAS unsigned char* lds = (LAS unsigned char*)lds_raw;
    cg::grid_group grid = cg::this_grid();
    const int G = gridDim.x, c = blockIdx.x;
    unsigned char* ws = a.ws;
    float* ssq = (float*)(ws + WS_SSQ);

    { volatile LAS unsigned* misc = (volatile LAS unsigned*)(lds + MISC_OFF); if (threadIdx.x < 16) misc[threadIdx.x] = 0u; }
    __syncthreads();
    grid.sync();
    (void)xcd_barrier_post((unsigned*)(ws + WS_BAR), (volatile LAS unsigned*)(lds + MISC_OFF));
    prologue(a, lds, G);
    GRID_SYNC();

    for (int l = 0; l < 2; ++l) {
        { size_t z_ = 0; asm volatile("" : "+s"(z_)); ws += z_; } ssq = (float*)(ws + WS_SSQ);
        const float* ssq_mix = ssq + (size_t)(2 * l) * M * 16;
        { pg8::SchedGrid S; S.nM = 64; S.nN = 17; S.nwg = 64 * 17; S.G = G; S.c = c; S.A = (const char*)(ws + WS_XB); S.B = (const char*)(ws + WS_WIN + l * WIN_L); S.lda2 = 2048; S.ldb2 = 2048; S.nt = 16;
          EpiInProj E{ssq_mix, ws};
          pg8::gemm_phase<EpiInProj, pg8::SchedGrid, true>(lds, S, E);
        }
        GRID_SYNC(); { size_t z_ = 0; asm volatile("" : "+s"(z_)); ws += z_; }
        for (int u = c; u < 512; u += G) mixer_sg(ws, l, lds, u);
        for (int u = c; u < 512; u += G) mixer_conv(ws, l, lds, u);
        for (int u = c; u < 256; u += G) mixer_attn(ws, l, lds, u);
        mixer_sc(ws, l, G);
        GRID_SYNC(); { size_t z_ = 0; asm volatile("" : "+s"(z_)); ws += z_; } ssq = (float*)(ws + WS_SSQ);
        { pg8::SchedMerge S; S.G = G; S.c = c; S.ws = (const char*)ws; S.WG = (const char*)(ws + WS_WIN + l * WIN_L) + (size_t)NLOG1 * 2048;
          S.WBR = (const char*)(ws + WS_WBR + l * WBR_L);
          EpiStashB ES{(bf16_t*)(ws + WS_MG)}; EpiGateAcc EA{ssq_mix, (bf16_t*)(ws + WS_MG), (bf16_t*)(ws + WS_TMP)};
          S.swap = 1; EpiMerge2 E2{ES, EA};
          pg8::gemm_phase<EpiMerge2, pg8::SchedMerge, true>(lds, S, E2);
        }
        GRID_SYNC(); { size_t z_ = 0; asm volatile("" : "+s"(z_)); ws += z_; } ssq = (float*)(ws + WS_SSQ);
        { pg8::SchedGrid S; S.nM = 64; S.nN = 4; S.nwg = 256; S.G = G; S.c = c; S.A = (const char*)(ws + WS_MG); S.B = (const char*)(ws + WS_WOUT + l * WOUT_L); S.lda2 = 2048; S.ldb2 = 2048; S.nt = 16;
          EpiResid E{(bf16_t*)(ws + WS_XB), ssq + (size_t)(2 * l + 1) * M * 16};
          pg8::gemm_phase<EpiResid, pg8::SchedGrid, false>(lds, S, E); }
        GRID_SYNC(); { size_t z_ = 0; asm volatile("" : "+s"(z_)); ws += z_; } ssq = (float*)(ws + WS_SSQ);
        { pg8::SchedGrid S; S.nM = 64; S.nN = 22; S.nwg = 64 * 22; S.G = G; S.c = c; S.A = (const char*)(ws + WS_XB); S.B = (const char*)(ws + WS_WGU + l * WGU_L); S.lda2 = 2048; S.ldb2 = 2048; S.nt = 16;
          EpiSwiGLU E{ssq + (size_t)(2 * l + 1) * M * 16, (bf16_t*)(ws + WS_ACT), ABL_FFN_SCALE(l)};
          pg8::gemm_phase<EpiSwiGLU, pg8::SchedGrid, true>(lds, S, E);
        }
        GRID_SYNC(); { size_t z_ = 0; asm volatile("" : "+s"(z_)); ws += z_; } ssq = (float*)(ws + WS_SSQ);
        { pg8::SchedGrid S; S.nM = 64; S.nN = 4; S.nwg = 256; S.G = G; S.c = c; S.A = (const char*)(ws + WS_ACT); S.B = (const char*)(ws + WS_WDN + l * WDN_L); S.lda2 = DFF * 2; S.ldb2 = DFF * 2; S.nt = DFF / 64;
          EpiResid E{(bf16_t*)(ws + WS_XB), ssq + (size_t)(2 * l + 2) * M * 16};
          pg8::gemm_phase<EpiResid, pg8::SchedGrid, false>(lds, S, E); }
        GRID_SYNC();
    }
    { { size_t z_ = 0; asm volatile("" : "+s"(z_)); ws += z_; } int tid_ = threadIdx.x; asm volatile("" : "+v"(tid_));
      const int lane = tid_ & 63, gw = c * NWAVES + (tid_ >> 6), NGW = G * NWAVES; const float* gf = (const float*)(ws + WS_PAR) + P_FINAL; const float* sq = (const float*)(ws + WS_SSQ) + (size_t)4 * M * 16;
      const bf16_t* XBp = (const bf16_t*)(ws + WS_XB);
      for (int row = gw; row < M; row += 2 * NGW) { const int row2 = row + NGW;
          u32x4 ra_[2], rb_[2];
#pragma unroll
          for (int j = 0; j < 2; ++j) { ra_[j] = *(const u32x4*)(XBp + (size_t)row * D + 512 * j + 8 * lane); rb_[j] = *(const u32x4*)(XBp + (size_t)row2 * D + 512 * j + 8 * lane); }
          const float ra = row_rs(sq, row), rb = row_rs(sq, row2);
#pragma unroll
          for (int j = 0; j < 2; ++j) { const f32x4 g0 = *(const f32x4*)(gf + 512 * j + 8 * lane), g1 = *(const f32x4*)(gf + 512 * j + 8 * lane + 4);
              f32x4 x0, x1; unpack8(ra_[j], x0, x1); float* oa = a.out + (size_t)row * D + 512 * j + 8 * lane; *(f32x4*)oa = x0 * ra * g0; *(f32x4*)(oa + 4) = x1 * ra * g1;
              unpack8(rb_[j], x0, x1); float* ob = a.out + (size_t)row2 * D + 512 * j + 8 * lane; *(f32x4*)ob = x0 * rb * g0; *(f32x4*)(ob + 4) = x1 * rb * g1; } } }
}

extern "C" void kernel_launch(void* const* d_in, const int* in_sizes, int n_in, void* d_out, int out_size, void* d_ws, size_t ws_size, hipStream_t stream) {
    static int grid = 0;
    if (grid == 0) {
        if (n_in != 19 || out_size != M * D || ws_size < WS_END) { fprintf(stderr, "kernel_launch: unexpected shapes (n_in %d out %d ws %zu)\n", n_in, out_size, ws_size); grid = -1; return; }
        int dev = 0, cus = 0, per_cu = 0;
        if (hipGetDevice(&dev) != hipSuccess || hipDeviceGetAttribute(&cus, hipDeviceAttributeMultiprocessorCount, dev) != hipSuccess) { grid = -1; return; }
        if (hipFuncSetAttribute((const void*)fwd_megakernel, hipFuncAttributeMaxDynamicSharedMemorySize, LDS_BYTES) != hipSuccess) { fprintf(stderr, "kernel_launch: hipFuncSetAttribute failed\n"); grid = -1; return; }
        if (hipOccupancyMaxActiveBlocksPerMultiprocessor(&per_cu, (const void*)fwd_megakernel, NTHREADS, LDS_BYTES) != hipSuccess || per_cu < 1) { fprintf(stderr, "kernel_launch: occupancy query says %d\n", per_cu); per_cu = 1; }
        (void)hipGetLastError();
        grid = cus * 1;
    }
    if (grid < 0) return;
    if (hipMemsetAsync((char*)d_ws + WS_BAR, 0, 16384, stream) != hipSuccess) { fprintf(stderr, "kernel_launch: memset failed\n"); return; }
    Args a{};
    for (int i = 0; i < 19; ++i) a.in[i] = (const float*)d_in[i];
    a.out = (float*)d_out; a.ws = (unsigned char*)d_ws;
    void* args[] = {&a};
    hipError_t e = hipLaunchCooperativeKernel((const void*)fwd_megakernel, dim3(grid), dim3(NTHREADS), args, LDS_BYTES, stream);
    if (e != hipSuccess) fprintf(stderr, "cooperative launch failed: %s (grid %d)\n", hipGetErrorString(e), grid);
}
```

```cpp
#include <hip/hip_runtime.h>
#include <hip/hip_cooperative_groups.h>
#include <cstdio>
#include <cstdint>
namespace cg = cooperative_groups;

#define LAS __attribute__((address_space(3)))
typedef unsigned short bf16_t;
typedef short bf16x8 __attribute__((ext_vector_type(8)));
typedef float f32x4 __attribute__((ext_vector_type(4)));
typedef float f32x2 __attribute__((ext_vector_type(2)));
typedef unsigned u32x4 __attribute__((ext_vector_type(4)));
typedef unsigned u32x2 __attribute__((ext_vector_type(2)));

constexpr int M = 16384, D = 1024, SEQ = 2048, NBATCH = 8, DFF = 2816, PROJ = 8448, NLOG1 = 4352  ;
constexpr float EPS = 1e-6f;
constexpr int NTHREADS = 512, NWAVES = 8;
constexpr int LDS_BYTES = 147456;

constexpr size_t MiB = 1u << 20;
constexpr size_t WS_SSQ = 248 * (size_t)(1u << 20);
constexpr size_t WS_PAR = 512 * 1024;
constexpr int PAR_L = 24576, P_SGLNG = 0, P_SGLNB = 512, P_SGB = 1024, P_CVB = 1536, P_CVLNG = 2048, P_CVLNB = 2560, P_SCW = 3072, P_SINK = 4608, P_CVW = 4672, P_FINAL = 2 * PAR_L;
constexpr size_t WS_BAR = 768 * 1024;
constexpr int MISC_OFF = 147200;
constexpr size_t WS_ROPEC = 1 * MiB, WS_ROPES = 1 * MiB + 256 * 1024;
constexpr size_t WS_SGWT = 1 * MiB + 512 * 1024;
constexpr size_t WS_WIN = 2 * MiB, WIN_L = (size_t)PROJ * D * 2;
constexpr size_t WS_WBR = 35 * MiB, WBR_L = 4 * MiB;
constexpr size_t WS_WOUT = 43 * MiB, WOUT_L = 2 * MiB;
constexpr size_t WS_WGU = 47 * MiB, WGU_L = 11 * MiB;
constexpr size_t WS_WDN = 69 * MiB, WDN_L = (size_t)D * DFF * 2;
constexpr size_t WS_XB = 80 * MiB;
constexpr size_t WS_ZA = 112 * MiB;
constexpr size_t WS_MG = WS_ZA;
constexpr size_t WS_GLU = 144 * MiB;
constexpr size_t WS_CH = 160 * MiB;
constexpr size_t WS_TMP = WS_GLU;
constexpr size_t WS_Q = 176 * MiB;
constexpr size_t WS_BG = 192 * MiB;
constexpr size_t WS_K = 208 * MiB, WS_V = 212 * MiB;
constexpr size_t WS_YA = 216 * MiB, WS_YB = 232 * MiB;
constexpr size_t WS_ACT = 112 * MiB;
constexpr size_t WS_END = 254 * MiB;

__device__ const double INVF_REV[32] = {0.15915494309189535, 0.11934937021124886, 0.08949940160889101, 0.06711508300522726, 0.050329212104487035, 0.03774158471741977, 0.0283021958306234, 0.02122365276477766, 0.015915494309189534, 0.011934937021124886, 0.008949940160889102, 0.006711508300522725, 0.005032921210448704, 0.003774158471741977, 0.00283021958306234, 0.0021223652764777662, 0.0015915494309189536, 0.0011934937021124885, 0.0008949940160889102, 0.0006711508300522726, 0.0005032921210448703, 0.00037741584717419774, 0.00028302195830623395, 0.0002122365276477766, 0.00015915494309189535, 0.00011934937021124886, 8.949940160889102e-05, 6.711508300522725e-05, 5.0329212104487035e-05, 3.774158471741978e-05, 2.8302195830623396e-05, 2.122365276477766e-05};

__device__ __forceinline__ unsigned cvt_pk_bf16(float lo, float hi) { unsigned r; asm volatile("v_cvt_pk_bf16_f32 %0, %1, %2" : "=v"(r) : "v"(lo), "v"(hi)); return r; }
__device__ __forceinline__ float bf_lo(unsigned u) { return __builtin_bit_cast(float, u << 16); }
__device__ __forceinline__ float bf_hi(unsigned u) { return __builtin_bit_cast(float, u & 0xffff0000u); }
__device__ __forceinline__ float bf1(bf16_t h) { return __builtin_bit_cast(float, ((unsigned)h) << 16); }
__device__ __forceinline__ float sigmoidf_(float x) { return __builtin_amdgcn_rcpf(1.0f + __expf(-x)); }
template <int CTRL, int ROW_MASK> __device__ __forceinline__ float dpp_mov(float v) {
    return __builtin_bit_cast(float, __builtin_amdgcn_update_dpp(0, __builtin_bit_cast(int, v), CTRL, ROW_MASK, 0xf, true));
}
__device__ __forceinline__ float wave_sum(float v) {
    v += dpp_mov<0xB1, 0xf>(v);
    v += dpp_mov<0x4E, 0xf>(v);
    v += dpp_mov<0x141, 0xf>(v);
    v += dpp_mov<0x140, 0xf>(v);
    v += dpp_mov<0x142, 0xa>(v);
    v += dpp_mov<0x143, 0xc>(v);
    return __builtin_bit_cast(float, __builtin_amdgcn_readlane(__builtin_bit_cast(int, v), 63));
}
__device__ __forceinline__ f32x2 gelu_pk(f32x2 v) {
    const f32x2 av = __builtin_elementwise_abs(v), d = av * 0.2316418882f + 1.0f;
    f32x2 t; t.x = __builtin_amdgcn_rcpf(d.x); t.y = __builtin_amdgcn_rcpf(d.y);
    f32x2 q = t * 0.5307027145f + (-0.7265760135f); q = q * t + 0.7107068705f; q = q * t + (-0.142248368f); q = q * t + 0.127414796f; q = q * t;
    const f32x2 s = (v * v) * (-0.72134752044f);
    f32x2 e; e.x = __builtin_amdgcn_exp2f(s.x); e.y = __builtin_amdgcn_exp2f(s.y);
    const f32x2 m = v * (q * e), r = v - m;
    f32x2 o; o.x = v.x < 0.f ? m.x : r.x; o.y = v.y < 0.f ? m.y : r.y; return o;
}
__device__ __forceinline__ u32x4 pack8(f32x4 a, f32x4 b) { u32x4 w; w.x = cvt_pk_bf16(a[0], a[1]); w.y = cvt_pk_bf16(a[2], a[3]); w.z = cvt_pk_bf16(b[0], b[1]); w.w = cvt_pk_bf16(b[2], b[3]); return w; }
__device__ __forceinline__ void unpack8(u32x4 w, f32x4& a, f32x4& b) { a = (f32x4){bf_lo(w.x), bf_hi(w.x), bf_lo(w.y), bf_hi(w.y)}; b = (f32x4){bf_lo(w.z), bf_hi(w.z), bf_lo(w.w), bf_hi(w.w)}; }

namespace pg8 {
constexpr int BM = 256, BK = 64, HALF = 128, HTB = HALF * BK * 2, STAGE_BYTES = 8 * HTB, NXCD = 8, WGM = 8;
__host__ __device__ __forceinline__ int lds_byte(int r, int c) { const int st = (r >> 4) * 2 + (c >> 5), rr = r & 15, cc = c & 31, ob = rr * 64 + cc * 2; return st * 1024 + (ob ^ (((ob >> 9) & 1) << 5)); }
__host__ __device__ __forceinline__ void stage_rc(int b, int& R, int& C) { const int st = b / 1024, sb = b % 1024, swz = sb ^ (((sb >> 9) & 1) << 5); R = (st >> 1) * 16 + swz / 64; C = (st & 1) * 32 + (swz % 64) / 2; }
__host__ __device__ __forceinline__ int perm32(int rho) { const int n = rho >> 4, i = rho & 15; return 8 * (i >> 2) + 4 * n + (i & 3); }

struct Unit { const char* A; const char* B; int lda2, ldb2, nt, pm, pn, z; };

__device__ __forceinline__ void tile_of(int L, int nM, int nN, int& pm, int& pn) {
    const int nwg = nM * nN; int wgid = L; { const int q = nwg / NXCD, r = nwg % NXCD, xcd = wgid % NXCD, off = wgid / NXCD; wgid = (xcd < r ? xcd * (q + 1) : r * (q + 1) + (xcd - r) * q) + off; }
    const int nig = WGM * nN, gid = wgid / nig, fm = gid * WGM, gsz = (nM - fm) < WGM ? (nM - fm) : WGM;
    pm = fm + ((wgid % nig) % gsz); pn = (wgid % nig) / gsz;
}
struct SchedGrid {
    static constexpr bool VARLD = false;
    int nM, nN, nwg, G, c; const char* A; const char* B; int lda2, ldb2, nt;
    __device__ __forceinline__ bool next(int i, Unit& u) const {
        const long L = (long)i * G + c; if (L >= nwg) return false;
        tile_of((int)L, nM, nN, u.pm, u.pn); u.z = 0;
        u.A = A + (size_t)u.pm * 256 * lda2; u.B = B + (size_t)u.pn * 256 * ldb2; u.lda2 = lda2; u.ldb2 = ldb2; u.nt = nt; return true;
    }
};
struct SchedMerge {
    static constexpr bool VARLD = true;
    int G, c; const char* ws; const char* WG  ; const char* WBR; int swap;
    __device__ __forceinline__ bool next(int i, Unit& u) const {
        const int ti = i >> 3, sub = i & 7; const long L = (long)ti * G + c; if (L >= 256) return false;
        tile_of((int)L, 64, 4, u.pm, u.pn); u.z = sub; const int br = sub >> 1;
        if (((sub & 1) ^ swap) == 0) { u.A = ws + WS_XB + (size_t)u.pm * 256 * 2048; u.lda2 = 2048; u.B = WG + (size_t)(br * 1024 + u.pn * 256) * 2048; u.ldb2 = 2048; u.nt = 16; }
        else { const size_t yo = br == 0 ? WS_YA : br == 1 ? WS_YB : br == 2 ? WS_Q : WS_BG;
               u.A = ws + yo + (size_t)u.pm * 256 * 1024; u.lda2 = 1024; u.B = WBR + (size_t)br * (1024 * 512 * 2) + (size_t)u.pn * 256 * 1024; u.ldb2 = 1024; u.nt = 8; }
        return true;
    }
};

struct SchedOne {
    static constexpr bool VARLD = false;
    SchedMerge M; int i0;
    __device__ __forceinline__ bool next(int i, Unit& u) const { if (i != 0) return false; return M.next(i0, u); }
};
struct SchedOneG {
    static constexpr bool VARLD = false;
    SchedGrid S; int i0;
    __device__ __forceinline__ bool next(int i, Unit& u) const { if (i != 0) return false; return S.next(i0, u); }
};
template <class Epi, class Sched, bool ALIGN_EPI>
__device__ __forceinline__ void gemm_phase(LAS unsigned char* lds, const Sched& S, const Epi& E) {
    int tid_ = threadIdx.x; asm volatile("" : "+v"(tid_));
    const int tid = tid_, wid = __builtin_amdgcn_readfirstlane(tid >> 6), lane = tid & 63, wr = wid >> 2, wc = wid & 3, fr = lane & 15, fq = lane >> 4;
    unsigned rA[2], rB[2], cc2[2];
#pragma unroll
    for (int i = 0; i < 2; ++i) { int R, C; stage_rc(tid * 16 + i * 8192, R, C); rA[i] = (unsigned)R; rB[i] = (unsigned)((R & ~31) + perm32(R & 31)); cc2[i] = (unsigned)C * 2u; }
    const size_t kstep = (size_t)(BK * 2);
    const unsigned ldsw = (unsigned)wid * 1024u;
    const int aoff = lds_byte(wr * 64 + fr, fq * 8), boff = lds_byte(wc * 32 + fr, fq * 8);
#define PG8_SA(b, h) (((b) * 2 + (h)) * HTB)
#define PG8_SB(b, h) ((4 + (b) * 2 + (h)) * HTB)
#define PG8_STAGE(bufoff, gbase, voff) do { _Pragma("unroll") for (int _i = 0; _i < 2; ++_i) \
        __builtin_amdgcn_global_load_lds((const unsigned*)((const char*)(gbase) + (voff)[_i]), (LAS unsigned*)(lds + (bufoff) + ldsw + _i * 8192), 16, 0, 0); } while (0)
#define PG8_LDA(dst, b, h) do { _Pragma("unroll") for (int m = 0; m < 4; ++m) _Pragma("unroll") for (int k = 0; k < 2; ++k) dst[m][k] = *(const LAS bf16x8*)(lds + PG8_SA(b, h) + aoff + m * 2048 + k * 1024); } while (0)
#define PG8_LDB(dst, b, h) do { _Pragma("unroll") for (int n = 0; n < 2; ++n) _Pragma("unroll") for (int k = 0; k < 2; ++k) dst[n][k] = *(const LAS bf16x8*)(lds + PG8_SB(b, h) + boff + n * 2048 + k * 1024); } while (0)
#define PG8_MMA(ai, bj, At, Bt) do { __builtin_amdgcn_s_setprio(1); _Pragma("unroll") for (int m = 0; m < 4; ++m) _Pragma("unroll") for (int n = 0; n < 2; ++n) _Pragma("unroll") for (int k = 0; k < 2; ++k) \
        acc[ai][bj][m][n] = __builtin_amdgcn_mfma_f32_16x16x32_bf16(Bt[n][k], At[m][k], acc[ai][bj][m][n], 0, 0, 0); __builtin_amdgcn_s_setprio(0); } while (0)
#define PG8_WAIT_V(n) asm volatile("s_waitcnt vmcnt(" #n ")" ::: "memory")
#define PG8_WAIT_L(n) asm volatile("s_waitcnt lgkmcnt(" #n ")" ::: "memory")
#define PG8_BAR __builtin_amdgcn_s_barrier()
#define PG8_SCHED __builtin_amdgcn_sched_barrier(0)
    Unit cur, nxt; int ui = 0;
    if (!S.next(0, cur)) return;
    f32x4 acc[2][2][4][2];
#pragma unroll
    for (int a = 0; a < 2; ++a)
#pragma unroll
        for (int b = 0; b < 2; ++b)
#pragma unroll
            for (int m = 0; m < 4; ++m)
#pragma unroll
                for (int n = 0; n < 2; ++n) acc[a][b][m][n] = (f32x4){0.f, 0.f, 0.f, 0.f};
    bf16x8 At[4][2], B0[2][2], B1[2][2];
    unsigned voffA[2], voffB[2];
#pragma unroll
    for (int i = 0; i < 2; ++i) { voffA[i] = rA[i] * (unsigned)cur.lda2 + cc2[i]; voffB[i] = rB[i] * (unsigned)cur.ldb2 + cc2[i]; }
    const char* cA = cur.A; const char* cB = cur.B;
    unsigned hA = (unsigned)HALF * cur.lda2, hB = (unsigned)HALF * cur.ldb2;
    PG8_STAGE(PG8_SB(0, 0), cB, voffB); PG8_STAGE(PG8_SB(0, 1), cB + hB, voffB); PG8_STAGE(PG8_SA(0, 0), cA, voffA); PG8_STAGE(PG8_SA(0, 1), cA + hA, voffA);
    if (wr == 1) PG8_BAR;
    PG8_WAIT_V(2); PG8_BAR;
    PG8_STAGE(PG8_SB(1, 0), cB + kstep, voffB); PG8_STAGE(PG8_SA(1, 0), cA + kstep, voffA); PG8_STAGE(PG8_SB(1, 1), cB + hB + kstep, voffB);
    PG8_WAIT_V(6); PG8_BAR;
    for (;;) {
        const bool has_next = S.next(ui + 1, nxt);
        if (!has_next) nxt = cur;
        unsigned voffAn[2], voffBn[2];
#pragma unroll
        for (int i = 0; i < 2; ++i) { if constexpr (Sched::VARLD) { voffAn[i] = rA[i] * (unsigned)nxt.lda2 + cc2[i]; voffBn[i] = rB[i] * (unsigned)nxt.ldb2 + cc2[i]; } else { voffAn[i] = voffA[i]; voffBn[i] = voffB[i]; } }
        const char* nA = nxt.A; const char* nB = nxt.B;
        const unsigned hAn = Sched::VARLD ? (unsigned)HALF * nxt.lda2 : hA, hBn = Sched::VARLD ? (unsigned)HALF * nxt.ldb2 : hB;
        const int nt = cur.nt;
        for (int t = 0; t < nt; t += 2) {
            const bool last = (t == nt - 2);
            const char* a1 = cA + (size_t)(t + 1) * kstep;
            const char* a2 = last ? nA : cA + (size_t)(t + 2) * kstep; const char* b2 = last ? nB : cB + (size_t)(t + 2) * kstep;
            const char* a3 = a2 + kstep; const char* b3 = b2 + kstep;
            const unsigned hA2 = last ? hAn : hA, hB2 = last ? hBn : hB;
            unsigned vA2[2], vB2[2];
#pragma unroll
            for (int i = 0; i < 2; ++i) { vA2[i] = last ? voffAn[i] : voffA[i]; vB2[i] = last ? voffBn[i] : voffB[i]; }
            PG8_LDB(B0, 0, 0); PG8_LDB(B1, 0, 1); PG8_SCHED; PG8_LDA(At, 0, 0); PG8_STAGE(PG8_SA(1, 1), a1 + hA, voffA);
            PG8_WAIT_V(8); PG8_WAIT_L(0); PG8_BAR; PG8_MMA(0, 0, At, B0); PG8_MMA(0, 1, At, B1); PG8_BAR; PG8_SCHED;
            PG8_LDA(At, 0, 1); PG8_STAGE(PG8_SB(0, 0), b2, vB2); PG8_STAGE(PG8_SB(0, 1), b2 + hB2, vB2); PG8_STAGE(PG8_SA(0, 0), a2, vA2);
            PG8_WAIT_V(8); PG8_WAIT_L(0); PG8_BAR; PG8_MMA(1, 0, At, B0); PG8_MMA(1, 1, At, B1); PG8_BAR; PG8_SCHED;
            PG8_LDB(B0, 1, 0); PG8_LDB(B1, 1, 1); PG8_SCHED; PG8_LDA(At, 1, 0); PG8_STAGE(PG8_SA(0, 1), a2 + hA2, vA2);
            PG8_WAIT_V(8); PG8_WAIT_L(0); PG8_BAR; PG8_MMA(0, 0, At, B0); PG8_MMA(0, 1, At, B1); PG8_BAR; PG8_SCHED;
            PG8_LDA(At, 1, 1); PG8_STAGE(PG8_SB(1, 0), b3, vB2); PG8_STAGE(PG8_SB(1, 1), b3 + hB2, vB2); PG8_STAGE(PG8_SA(1, 0), a3, vA2);
            PG8_WAIT_V(8); PG8_WAIT_L(0); PG8_BAR; PG8_MMA(1, 0, At, B0); PG8_MMA(1, 1, At, B1); PG8_BAR; PG8_SCHED;
        }
        if constexpr (ALIGN_EPI) { if (wr == 0) PG8_BAR; }
        E(acc, cur, wr, wc, fr, fq);
        if (!has_next) break;
#pragma unroll
        for (int a = 0; a < 2; ++a)
#pragma unroll
            for (int b = 0; b < 2; ++b)
#pragma unroll
                for (int m = 0; m < 4; ++m)
#pragma unroll
                    for (int n = 0; n < 2; ++n) acc[a][b][m][n] = (f32x4){0.f, 0.f, 0.f, 0.f};
        cur = nxt; cA = nA; cB = nB; hA = hAn; hB = hBn; ++ui;
#pragma unroll
        for (int i = 0; i < 2; ++i) { voffA[i] = voffAn[i]; voffB[i] = voffBn[i]; }
        if constexpr (ALIGN_EPI) { if (wr == 1) PG8_BAR; }
    }
    PG8_WAIT_V(0);
    if constexpr (!ALIGN_EPI) { if (wr == 0) PG8_BAR; }
    PG8_BAR;
#undef PG8_SA
#undef PG8_SB
#undef PG8_STAGE
#undef PG8_LDA
#undef PG8_LDB
#undef PG8_MMA
#undef PG8_WAIT_V
#undef PG8_WAIT_L
#undef PG8_BAR
#undef PG8_SCHED
}
}

constexpr int RSL_OFF = 133120;
#define EPI_ROWLOOP _Pragma("unroll") for (int ai = 0; ai < 2; ++ai) _Pragma("unroll") for (int m = 0; m < 4; ++m)
#define EPI_RS(row) ((u.pm == pm0) ? rsl[(row) & 255] : row_rs(ssq, (row)))
__device__ __forceinline__ float row_rs(const float* ssq, int row) { const f32x4* p = (const f32x4*)(ssq + (size_t)row * 16); const f32x4 a = p[0], b = p[1], c = p[2], d = p[3];
    const float s = (((a[0] + a[1]) + (a[2] + a[3])) + ((b[0] + b[1]) + (b[2] + b[3]))) + (((c[0] + c[1]) + (c[2] + c[3])) + ((d[0] + d[1]) + (d[2] + d[3])));
    return __builtin_amdgcn_rsqf(s * (1.0f / D) + EPS); }

struct EpiInProj {
    const float* ssq; unsigned char* ws; LAS const float* rsl; int pm0;
    __device__ __forceinline__ void operator()(const f32x4 (&acc)[2][2][4][2], const pg8::Unit& u, int wr, int wc, int fr, int fq) const {
        bf16_t* const ZA = (bf16_t*)(ws + WS_ZA); bf16_t* const GLU = (bf16_t*)(ws + WS_GLU); bf16_t* const BG = (bf16_t*)(ws + WS_BG); bf16_t* const CH = (bf16_t*)(ws + WS_CH);
        const float* const ropeC = (const float*)(ws + WS_ROPEC); const float* const ropeS = (const float*)(ws + WS_ROPES);
        const int T = u.pn, row0 = u.pm * 256 + wr * 64 + fr, jcol = wc * 32 + 8 * fq;
        if (T < 4) {
            EPI_ROWLOOP { const int row = row0 + ai * 128 + m * 16; const float rs = EPI_RS(row);
#pragma unroll
                for (int bj = 0; bj < 2; ++bj) { f32x4 v0 = acc[ai][bj][m][0] * rs, v1 = acc[ai][bj][m][1] * rs;
                    f32x2 a = gelu_pk((f32x2){v0[0], v0[1]}), b = gelu_pk((f32x2){v0[2], v0[3]}), c = gelu_pk((f32x2){v1[0], v1[1]}), d = gelu_pk((f32x2){v1[2], v1[3]});
                    *(u32x4*)(ZA + (size_t)row * 1024 + 256 * T + 128 * bj + jcol) = pack8((f32x4){a.x, a.y, b.x, b.y}, (f32x4){c.x, c.y, d.x, d.y}); } }
        } else if (T < 8) {
            EPI_ROWLOOP { const int row = row0 + ai * 128 + m * 16; const float rs = EPI_RS(row); f32x4 o[2];
#pragma unroll
                for (int n = 0; n < 2; ++n) { const f32x4 a = acc[ai][0][m][n] * rs, g = acc[ai][1][m][n] * rs;
#pragma unroll
                    for (int j = 0; j < 4; ++j) o[n][j] = a[j] * sigmoidf_(g[j]); }
                *(u32x4*)(GLU + (size_t)row * 512 + 128 * (T - 4) + jcol) = pack8(o[0], o[1]); }
        } else if (T < 11) {
            const bool isq = T < 10; const bool rope = isq || wc < 2; const float sc = isq ? 0.125f : 1.0f;
            const size_t boff = isq ? WS_Q : (wc < 2 ? WS_K : WS_V); bf16_t* const base = (bf16_t*)(ws + boff);
            const int ld = isq ? 512 : 128, hcol = isq ? (4 * (T - 8) + wc) * 64 : (wc & 1) * 64;
            EPI_ROWLOOP { const int row = row0 + ai * 128 + m * 16; const float rs = EPI_RS(row) * sc; const int pos = row & (SEQ - 1); f32x4 o1[2], o2[2];
#pragma unroll
                for (int n = 0; n < 2; ++n) { const f32x4 x1 = acc[ai][0][m][n] * rs, x2 = acc[ai][1][m][n] * rs;
                    if (rope) { const f32x4 c = *(const f32x4*)(ropeC + pos * 32 + 8 * fq + 4 * n), s = *(const f32x4*)(ropeS + pos * 32 + 8 * fq + 4 * n);
                        o1[n] = x1 * c - x2 * s; o2[n] = x2 * c + x1 * s; } else { o1[n] = x1; o2[n] = x2; } }
                bf16_t* p = base + (size_t)row * ld + hcol + 8 * fq;
                *(u32x4*)p = pack8(o1[0], o1[1]); *(u32x4*)(p + 32) = pack8(o2[0], o2[1]); }
        } else if (T < 13) {
            EPI_ROWLOOP { const int row = row0 + ai * 128 + m * 16; const float rs = EPI_RS(row);
#pragma unroll
                for (int bj = 0; bj < 2; ++bj) *(u32x4*)(BG + (size_t)row * 512 + 256 * (T - 11) + 128 * bj + jcol) = pack8(acc[ai][bj][m][0] * rs, acc[ai][bj][m][1] * rs); }
        } else {
            EPI_ROWLOOP { const int row = row0 + ai * 128 + m * 16; const float rs = EPI_RS(row); const float rs2 = rs * rs;
                *(u32x4*)(CH + (size_t)row * 512 + 128 * (T - 13) + jcol) = pack8(acc[ai][0][m][0] * acc[ai][1][m][0] * rs2, acc[ai][0][m][1] * acc[ai][1][m][1] * rs2); }
        }
    }
};
struct EpiGate {
    const float* ssq; bf16_t* MG;
    __device__ __forceinline__ void operator()(const f32x4 (&acc)[2][2][4][2], const pg8::Unit& u, int wr, int wc, int fr, int fq) const {
        const int row0 = u.pm * 256 + wr * 64 + fr, col0 = u.pn * 256 + wc * 32 + 8 * fq;
        EPI_ROWLOOP { const int row = row0 + ai * 128 + m * 16; const float rs = row_rs(ssq, row);
#pragma unroll
            for (int bj = 0; bj < 2; ++bj) { f32x4 v0 = acc[ai][bj][m][0] * rs, v1 = acc[ai][bj][m][1] * rs;
#pragma unroll
                for (int j = 0; j < 4; ++j) { v0[j] = sigmoidf_(v0[j]); v1[j] = sigmoidf_(v1[j]); }
                *(u32x4*)(MG + (size_t)row * 1024 + col0 + 128 * bj) = pack8(v0, v1); } }
    }
};
struct EpiBranch {
    bf16_t* MG; bf16_t* TMP;
    __device__ __forceinline__ void operator()(const f32x4 (&acc)[2][2][4][2], const pg8::Unit& u, int wr, int wc, int fr, int fq) const {
        const int row0 = u.pm * 256 + wr * 64 + fr, col0 = u.pn * 256 + wc * 32 + 8 * fq, br = u.z >> 1;
        EPI_ROWLOOP { const int row = row0 + ai * 128 + m * 16;
#pragma unroll
            for (int bj = 0; bj < 2; ++bj) { const size_t off = (size_t)row * 1024 + col0 + 128 * bj;
                f32x4 g0, g1; unpack8(*(const u32x4*)(MG + off), g0, g1);
                f32x4 v0 = acc[ai][bj][m][0] * g0, v1 = acc[ai][bj][m][1] * g1;
                if (br > 0) { f32x4 t0, t1; unpack8(*(const u32x4*)(TMP + off), t0, t1); v0 += t0; v1 += t1; }
                if (br < 3) *(u32x4*)(TMP + off) = pack8(v0, v1); else *(u32x4*)(MG + off) = pack8(v0, v1); } }
    }
};
struct EpiStashB {
    bf16_t* MG;
    __device__ __forceinline__ void operator()(const f32x4 (&acc)[2][2][4][2], const pg8::Unit& u, int wr, int wc, int fr, int fq) const {
        const int row0 = u.pm * 256 + wr * 64 + fr, col0 = u.pn * 256 + wc * 32 + 8 * fq;
        EPI_ROWLOOP { const int row = row0 + ai * 128 + m * 16;
#pragma unroll
            for (int bj = 0; bj < 2; ++bj) *(u32x4*)(MG + (size_t)row * 1024 + col0 + 128 * bj) = pack8(acc[ai][bj][m][0], acc[ai][bj][m][1]); }
    }
};
struct EpiGateAcc {
    const float* ssq; bf16_t* MG; bf16_t* TMP; LAS const float* rsl; int pm0;
    __device__ __forceinline__ void operator()(const f32x4 (&acc)[2][2][4][2], const pg8::Unit& u, int wr, int wc, int fr, int fq) const {
        const int row0 = u.pm * 256 + wr * 64 + fr, col0 = u.pn * 256 + wc * 32 + 8 * fq, br = u.z >> 1;
        EPI_ROWLOOP { const int row = row0 + ai * 128 + m * 16; const float rs = EPI_RS(row);
#pragma unroll
            for (int bj = 0; bj < 2; ++bj) { const size_t off = (size_t)row * 1024 + col0 + 128 * bj;
                f32x4 b0, b1; unpack8(*(const u32x4*)(MG + off), b0, b1);
                f32x4 v0 = acc[ai][bj][m][0] * rs, v1 = acc[ai][bj][m][1] * rs;
#pragma unroll
                for (int j = 0; j < 4; ++j) { v0[j] = sigmoidf_(v0[j]) * b0[j]; v1[j] = sigmoidf_(v1[j]) * b1[j]; }
                if (br > 0) { f32x4 t0, t1; unpack8(*(const u32x4*)(TMP + off), t0, t1); v0 += t0; v1 += t1; }
                if (br < 3) *(u32x4*)(TMP + off) = pack8(v0, v1); else *(u32x4*)(MG + off) = pack8(v0, v1); } }
    }
};
struct EpiMerge2 {
    EpiStashB ES; EpiGateAcc EA;
    __device__ __forceinline__ void operator()(const f32x4 (&acc)[2][2][4][2], const pg8::Unit& u, int wr, int wc, int fr, int fq) const {
        if ((u.z & 1) == 0) ES(acc, u, wr, wc, fr, fq); else EA(acc, u, wr, wc, fr, fq);
    }
};
struct EpiResid {
    bf16_t* XB; float* ssq_out;
    __device__ __forceinline__ void operator()(const f32x4 (&acc)[2][2][4][2], const pg8::Unit& u, int wr, int wc, int fr, int fq) const {
        const int row0 = u.pm * 256 + wr * 64 + fr, col0 = u.pn * 256 + wc * 32 + 8 * fq;
        EPI_ROWLOOP { const int row = row0 + ai * 128 + m * 16; float ss = 0.f;
#pragma unroll
            for (int bj = 0; bj < 2; ++bj) { const size_t off = (size_t)row * 1024 + col0 + 128 * bj;
                f32x4 x0, x1; unpack8(*(const u32x4*)(XB + off), x0, x1);
                const f32x4 v0 = x0 + acc[ai][bj][m][0], v1 = x1 + acc[ai][bj][m][1];
                *(u32x4*)(XB + off) = pack8(v0, v1);
                ss += (v0[0] * v0[0] + v0[1] * v0[1]) + (v0[2] * v0[2] + v0[3] * v0[3]) + (v1[0] * v1[0] + v1[1] * v1[1]) + (v1[2] * v1[2] + v1[3] * v1[3]); }
            ss += __shfl_xor(ss, 16); ss += __shfl_xor(ss, 32);
            if (fq == 0) ssq_out[(size_t)row * 16 + u.pn * 4 + wc] = ss; }
    }
};
struct EpiSwiGLU {
    const float* ssq; bf16_t* ACT; float zero_scale; LAS const float* rsl; int pm0;
    __device__ __forceinline__ void operator()(const f32x4 (&acc)[2][2][4][2], const pg8::Unit& u, int wr, int wc, int fr, int fq) const {
        const int row0 = u.pm * 256 + wr * 64 + fr, col0 = u.pn * 128 + wc * 32 + 8 * fq;
        EPI_ROWLOOP { const int row = row0 + ai * 128 + m * 16; const float rs = EPI_RS(row); f32x4 o[2];
#pragma unroll
            for (int n = 0; n < 2; ++n) { const f32x4 g = acc[ai][0][m][n] * rs, up = acc[ai][1][m][n] * rs;
#pragma unroll
                for (int j = 0; j < 4; ++j) o[n][j] = g[j] * sigmoidf_(g[j]) * up[j] * zero_scale; }
            *(u32x4*)(ACT + (size_t)row * DFF + col0) = pack8(o[0], o[1]); }
    }
};

#define ABL_FFN_SCALE(l) 1.0f
struct Args { const float* in[19]; float* out; unsigned char* ws; };

__device__ __forceinline__ int win_src_col(int nlog) {
    const int T = nlog >> 8, o = nlog & 255, bj = o >> 7, j = o & 127;
    if (T < 4) return nlog;
    if (T < 8) return 1024 + bj * 512 + 128 * (T - 4) + j;
    if (T < 10) return 2048 + (4 * (T - 8) + (j >> 5)) * 64 + 32 * bj + (j & 31);
    if (T == 10) { const int h = j >> 5; return (h < 2 ? 2560 + h * 64 : 2688 + (h - 2) * 64) + 32 * bj + (j & 31); }
    if (T < 13) return 2816 + 256 * (T - 11) + o;
    if (T < 17) return 3328 + bj * 512 + 128 * (T - 13) + j;
    return nlog;
}
__device__ __forceinline__ void tr_item(const float* W, int Nsrc, int k0, int scolA, int scolB, const float* gain, bf16_t* WT, int K, int drow, LAS float* scr, int lane) {
    const int c4 = lane & 15; const int sc = ((c4 >> 3) ? scolB : scolA) + 4 * (c4 & 7);
    f32x4 v[16];
#pragma unroll
    for (int i = 0; i < 16; ++i) v[i] = __builtin_nontemporal_load((const f32x4*)(W + (size_t)(k0 + 4 * i + (lane >> 4)) * Nsrc + sc));
#pragma unroll
    for (int i = 0; i < 16; ++i) { const int row = 4 * i + (lane >> 4); if (gain) v[i] = v[i] * gain[k0 + row];
        LAS float* d = scr + row * 65 + 4 * c4; d[0] = v[i][0]; d[1] = v[i][1]; d[2] = v[i][2]; d[3] = v[i][3]; }
    asm volatile("s_waitcnt lgkmcnt(0)" ::: "memory");
    const int c = lane & 7;
#pragma unroll
    for (int jj = 0; jj < 8; ++jj) { const int n = (lane >> 3) + 8 * jj; const LAS float* s = scr + (8 * c) * 65 + n;
        u32x4 o; o.x = cvt_pk_bf16(s[0], s[65]); o.y = cvt_pk_bf16(s[2 * 65], s[3 * 65]); o.z = cvt_pk_bf16(s[4 * 65], s[5 * 65]); o.w = cvt_pk_bf16(s[6 * 65], s[7 * 65]);
        *(u32x4*)(WT + (size_t)(drow + n) * K + k0 + 8 * c) = o; }
    asm volatile("s_waitcnt lgkmcnt(0)" ::: "memory");
}
__device__ __forceinline__ void prologue(const Args& a, LAS unsigned char* lds, int G) {
    int tid_ = threadIdx.x; asm volatile("" : "+v"(tid_));
    const int tid = tid_, lane = tid & 63, wave = __builtin_amdgcn_readfirstlane(tid >> 6);
    const int gw = blockIdx.x * NWAVES + wave, NGW = G * NWAVES;
    unsigned char* ws = a.ws;
    LAS float* scr = (LAS float*)(lds + wave * 16640);
    constexpr int I_IN = 16 * 132, I_BR = 512, I_OUT = 256, I_GU = 16 * 88, I_DN = 44 * 16, I_L = I_IN + I_BR + I_OUT + I_GU + I_DN;
    for (int it = gw; it < 2 * I_L; it += NGW) {
        const int l = it / I_L; int r = it % I_L;
        if (r < I_IN) { const int kb = r / 132, nb = r % 132, n0 = 64 * nb;
            tr_item(a.in[2] + (size_t)l * D * PROJ, PROJ, 64 * kb, win_src_col(n0), win_src_col(n0 + 32), a.in[1] + l * D, (bf16_t*)(ws + WS_WIN + l * WIN_L), D, n0, scr, lane); continue; } r -= I_IN;
        if (r < I_BR) { const int br = r >> 7, q = r & 127, kb = q >> 4, nb = q & 15;
            tr_item(a.in[13] + (size_t)(l * 4 + br) * 512 * D, D, 64 * kb, 64 * nb, 64 * nb + 32, nullptr, (bf16_t*)(ws + WS_WBR + l * WBR_L) + (size_t)br * 1024 * 512, 512, 64 * nb, scr, lane); continue; } r -= I_BR;
        if (r < I_OUT) { const int kb = r >> 4, nb = r & 15;
            tr_item(a.in[14] + (size_t)l * D * D, D, 64 * kb, 64 * nb, 64 * nb + 32, nullptr, (bf16_t*)(ws + WS_WOUT + l * WOUT_L), D, 64 * nb, scr, lane); continue; } r -= I_OUT;
        if (r < I_GU) { const int kb = r / 88, nb = r % 88, n0 = 64 * nb, T = n0 >> 8, o = n0 & 255, sc = (o >> 7) * DFF + 128 * T + (o & 127);
            tr_item(a.in[16] + (size_t)l * D * 2 * DFF, 2 * DFF, 64 * kb, sc, sc + 32, a.in[15] + l * D, (bf16_t*)(ws + WS_WGU + l * WGU_L), D, n0, scr, lane); continue; } r -= I_GU;
        { const int kb = r >> 4, nb = r & 15;
            tr_item(a.in[17] + (size_t)l * DFF * D, D, 64 * kb, 64 * nb, 64 * nb + 32, nullptr, (bf16_t*)(ws + WS_WDN + l * WDN_L), DFF, 64 * nb, scr, lane); }
    }
    float* ssq = (float*)(ws + WS_SSQ);
    for (int row = gw; row < M; row += NGW) {
        const f32x4* xr = (const f32x4*)(a.in[0] + (size_t)row * D) + lane; float s = 0.f; f32x4 v[4];
#pragma unroll
        for (int j = 0; j < 4; ++j) { v[j] = xr[64 * j]; s += (v[j][0] * v[j][0] + v[j][1] * v[j][1]) + (v[j][2] * v[j][2] + v[j][3] * v[j][3]); }
        s = wave_sum(s);
        u32x2* o = (u32x2*)((bf16_t*)(ws + WS_XB) + (size_t)row * D) + lane;
#pragma unroll
        for (int j = 0; j < 4; ++j) o[64 * j] = (u32x2){cvt_pk_bf16(v[j][0], v[j][1]), cvt_pk_bf16(v[j][2], v[j][3])};
        if (lane < 16) ssq[(size_t)row * 16 + lane] = lane == 0 ? s : 0.f;
    }
    { float* par = (float*)(ws + WS_PAR); const int gt = blockIdx.x * NTHREADS + tid, GT = G * NTHREADS;
#define CPY(dstoff, srcp, n) for (int i = gt; i < (n); i += GT) par[(dstoff) + i] = (srcp)[i]
      for (int l = 0; l < 2; ++l) { const int o = l * PAR_L;
          CPY(o + P_SGLNG, a.in[3] + l * 512, 512); CPY(o + P_SGLNB, a.in[4] + l * 512, 512); CPY(o + P_SGB, a.in[6] + l * 512, 512);
          CPY(o + P_CVB, a.in[8] + l * 512, 512); CPY(o + P_CVLNG, a.in[9] + l * 512, 512); CPY(o + P_CVLNB, a.in[10] + l * 512, 512);
          CPY(o + P_SCW, a.in[12] + l * 1536, 1536); CPY(o + P_SINK, a.in[11] + l * 8, 8); CPY(o + P_CVW, a.in[7] + l * 31 * 512, 31 * 512); }
      CPY(P_FINAL, a.in[18], 1024);
#undef CPY
    }
    for (int i = blockIdx.x * NTHREADS + tid; i < SEQ * 32; i += G * NTHREADS) { const int pos = i >> 5, f = i & 31;
        const double rev = (double)pos * INVF_REV[f]; const float fr = (float)(rev - floor(rev));
        ((float*)(ws + WS_ROPEC))[i] = __builtin_amdgcn_cosf(fr); ((float*)(ws + WS_ROPES))[i] = __builtin_amdgcn_sinf(fr); }
    for (int i = blockIdx.x * NTHREADS + tid; i < 2 * 4 * 128 * 128; i += G * NTHREADS) { const int s = i & 127, t = (i >> 7) & 127;
        ((bf16_t*)(ws + WS_SGWT))[i] = s <= t ? (bf16_t)(cvt_pk_bf16(a.in[5][i], 0.f) & 0xffffu) : (bf16_t)0; }
}

__device__ __forceinline__ void mixer_sg(unsigned char* ws, int l, LAS unsigned char* lds, int unit) {
    { size_t z_ = 0; asm volatile("" : "+s"(z_)); ws += z_; } int tid_ = threadIdx.x; asm volatile("" : "+v"(tid_));
    const float* par = (const float*)(ws + WS_PAR) + l * PAR_L;
    const int tid = tid_, lane = tid & 63, wave = __builtin_amdgcn_readfirstlane(tid >> 6);
    const int ck = unit >> 2, g = unit & 3, r0 = ck * 128;
    const bf16_t* ZA = (const bf16_t*)(ws + WS_ZA); bf16_t* YA = (bf16_t*)(ws + WS_YA);
    LAS bf16_t* vnT = (LAS bf16_t*)lds;
    const float* lng = par + P_SGLNG; const float* lnb = par + P_SGLNB;
    const f32x4 g0 = *(const f32x4*)(lng + 8 * lane), g1 = *(const f32x4*)(lng + 8 * lane + 4), b0 = *(const f32x4*)(lnb + 8 * lane), b1 = *(const f32x4*)(lnb + 8 * lane + 4);
    u32x4 raw[16];
#pragma unroll
    for (int i = 0; i < 16; ++i) raw[i] = *(const u32x4*)(ZA + (size_t)(r0 + wave + 8 * i) * 1024 + 512 + 8 * lane);
    const int fr = lane & 15, fq = lane >> 4, t0 = 16 * wave, nks = (wave >> 1) + 1;
    const bf16_t* W = (const bf16_t*)(ws + WS_SGWT) + (size_t)(l * 4 + g) * 16384 + (size_t)(t0 + fr) * 128 + 8 * fq;
    bf16x8 wf[4];
#pragma unroll
    for (int ks = 0; ks < 4; ++ks) wf[ks] = *(const bf16x8*)(W + 32 * (ks < nks ? ks : 0));
    const int tt = t0 + fr; const size_t orow = r0 + tt; const float bs = par[P_SGB + g * 128 + tt];
    u32x2 uu[8];
#pragma unroll
    for (int ct = 0; ct < 8; ++ct) uu[ct] = *(const u32x2*)(ZA + orow * 1024 + 128 * g + 16 * ct + 4 * fq);
#pragma unroll
    for (int i = 0; i < 16; ++i) { const int s = wave + 8 * i;
        f32x4 x0, x1; unpack8(raw[i], x0, x1);
        const float mean = wave_sum((x0[0] + x0[1]) + (x0[2] + x0[3]) + (x1[0] + x1[1]) + (x1[2] + x1[3])) * (1.0f / 512.0f);
        x0 -= mean; x1 -= mean;
        const float var = wave_sum((x0[0] * x0[0] + x0[1] * x0[1]) + (x0[2] * x0[2] + x0[3] * x0[3]) + (x1[0] * x1[0] + x1[1] * x1[1]) + (x1[2] * x1[2] + x1[3] * x1[3])) * (1.0f / 512.0f);
        const float rstd = __builtin_amdgcn_rsqf(var + EPS);
        if ((lane >> 4) == g) { const int c = 8 * (lane & 15); x0 = x0 * rstd * g0 + b0; x1 = x1 * rstd * g1 + b1;
            const unsigned p0 = cvt_pk_bf16(x0[0], x0[1]), p1 = cvt_pk_bf16(x0[2], x0[3]), p2 = cvt_pk_bf16(x1[0], x1[1]), p3 = cvt_pk_bf16(x1[2], x1[3]);
            LAS bf16_t* d = vnT + c * 136 + (s ^ (8 * (lane & 15)));
            d[0] = (bf16_t)p0; d[136] = (bf16_t)(p0 >> 16); d[2 * 136] = (bf16_t)p1; d[3 * 136] = (bf16_t)(p1 >> 16);
            d[4 * 136] = (bf16_t)p2; d[5 * 136] = (bf16_t)(p2 >> 16); d[6 * 136] = (bf16_t)p3; d[7 * 136] = (bf16_t)(p3 >> 16); }
    }
    __syncthreads();
    { f32x4 acc[8];
#pragma unroll
      for (int ct = 0; ct < 8; ++ct) acc[ct] = (f32x4){0.f, 0.f, 0.f, 0.f};
#pragma unroll
      for (int ks = 0; ks < 4; ++ks) if (ks < nks) {
#pragma unroll
          for (int ct = 0; ct < 8; ++ct) { const bf16x8 vf = *(const LAS bf16x8*)(vnT + (16 * ct + fr) * 136 + 8 * ((4 * ks + fq) ^ ((2 * ct + (fr >> 3)) & 15)));
              acc[ct] = __builtin_amdgcn_mfma_f32_16x16x32_bf16(vf, wf[ks], acc[ct], 0, 0, 0); }
      }
#pragma unroll
      for (int ct = 0; ct < 8; ++ct) { const int c = 128 * g + 16 * ct + 4 * fq;
          const float o0 = bf_lo(uu[ct].x) * (acc[ct][0] + bs), o1 = bf_hi(uu[ct].x) * (acc[ct][1] + bs), o2 = bf_lo(uu[ct].y) * (acc[ct][2] + bs), o3 = bf_hi(uu[ct].y) * (acc[ct][3] + bs);
          *(u32x2*)(YA + orow * 512 + c) = (u32x2){cvt_pk_bf16(o0, o1), cvt_pk_bf16(o2, o3)}; }
    }
    __syncthreads();
}
__device__ __forceinline__ void mixer_conv(unsigned char* ws, int l, LAS unsigned char* lds, int unit) {
    { size_t z_ = 0; asm volatile("" : "+s"(z_)); ws += z_; } int tid_ = threadIdx.x; asm volatile("" : "+v"(tid_));
    const float* par = (const float*)(ws + WS_PAR) + l * PAR_L;
    const int tid = tid_, lane = tid & 63, wave = tid >> 6;
    const int b = unit >> 6, tb = unit & 63, t0 = tb * 32; const size_t rbase = (size_t)b * SEQ;
    const bf16_t* GLU = (const bf16_t*)(ws + WS_GLU); bf16_t* YB = (bf16_t*)(ws + WS_YB);
    LAS bf16_t* in = (LAS bf16_t*)lds;
    LAS float* cv = (LAS float*)(lds + 65536);
    for (int i = tid; i < 62 * 64; i += NTHREADS) { const int r = i >> 6, ch = i & 63; const int t = t0 - 30 + r;
        u32x4 v = {0u, 0u, 0u, 0u}; if (t >= 0) v = *(const u32x4*)(GLU + (rbase + t) * 512 + 8 * ch);
        *(LAS u32x4*)(in + r * 512 + 8 * ch) = v; }
    __syncthreads();
    { const int c = tid; float w[31], x[62];
#pragma unroll
      for (int k = 0; k < 31; ++k) w[k] = par[P_CVW + k * 512 + c];
#pragma unroll
      for (int r = 0; r < 62; ++r) x[r] = bf1(in[r * 512 + c]);
      const float bias = par[P_CVB + c];
#pragma unroll
      for (int t = 0; t < 32; ++t) { float s = bias;
#pragma unroll
          for (int k = 0; k < 31; ++k) s += w[k] * x[t + k];
          cv[t * 512 + c] = s; } }
    __syncthreads();
    { const float* lng = par + P_CVLNG; const float* lnb = par + P_CVLNB;
      const f32x4 g0 = *(const f32x4*)(lng + 8 * lane), g1 = *(const f32x4*)(lng + 8 * lane + 4), b0 = *(const f32x4*)(lnb + 8 * lane), b1 = *(const f32x4*)(lnb + 8 * lane + 4);
      for (int t = wave; t < 32; t += NWAVES) {
          f32x4 x0 = *(const LAS f32x4*)(cv + t * 512 + 8 * lane), x1 = *(const LAS f32x4*)(cv + t * 512 + 8 * lane + 4);
          const float mean = wave_sum((x0[0] + x0[1]) + (x0[2] + x0[3]) + (x1[0] + x1[1]) + (x1[2] + x1[3])) * (1.0f / 512.0f);
          x0 -= mean; x1 -= mean;
          const float var = wave_sum((x0[0] * x0[0] + x0[1] * x0[1]) + (x0[2] * x0[2] + x0[3] * x0[3]) + (x1[0] * x1[0] + x1[1] * x1[1]) + (x1[2] * x1[2] + x1[3] * x1[3])) * (1.0f / 512.0f);
          const float rstd = __builtin_amdgcn_rsqf(var + EPS);
          x0 = x0 * rstd * g0 + b0; x1 = x1 * rstd * g1 + b1;
#pragma unroll
          for (int j = 0; j < 4; ++j) { x0[j] = x0[j] * sigmoidf_(x0[j]); x1[j] = x1[j] * sigmoidf_(x1[j]); }
          *(u32x4*)(YB + (rbase + t0 + t) * 512 + 8 * lane) = pack8(x0, x1); } }
    __syncthreads();
}
__device__ __forceinline__ void mixer_attn(unsigned char* ws, int l, LAS unsigned char* lds, int unit) {
    { size_t z_ = 0; asm volatile("" : "+s"(z_)); ws += z_; } int tid_ = threadIdx.x; asm volatile("" : "+v"(tid_));
    const float* par = (const float*)(ws + WS_PAR) + l * PAR_L;
    const int tid = tid_, lane = tid & 63, wave = __builtin_amdgcn_readfirstlane(tid >> 6), fr = lane & 15, fq = lane >> 4;
    const int kvh = unit & 1, blk = (unit >> 1) & 15, b = unit >> 5; const size_t rbase = (size_t)b * SEQ;
    bf16_t* Q = (bf16_t*)(ws + WS_Q); const bf16_t* K = (const bf16_t*)(ws + WS_K); const bf16_t* V = (const bf16_t*)(ws + WS_V);
    LAS bf16_t* Kl = (LAS bf16_t*)lds;
    LAS bf16_t* VT = (LAS bf16_t*)(lds + 36864);
    for (int i = tid; i < 256 * 8; i += NTHREADS) { const int r = i >> 3, ch = i & 7; const int t = (blk - 1) * 128 + r;
        u32x4 kv = {0u, 0u, 0u, 0u}, vv = {0u, 0u, 0u, 0u};
        if (t >= 0) { kv = *(const u32x4*)(K + (rbase + t) * 128 + kvh * 64 + 8 * ch); vv = *(const u32x4*)(V + (rbase + t) * 128 + kvh * 64 + 8 * ch); }
        *(LAS u32x4*)(Kl + r * 72 + 8 * ch) = kv;
        LAS bf16_t* d = VT + (8 * ch) * 264 + r;
        d[0] = (bf16_t)vv.x; d[264] = (bf16_t)(vv.x >> 16); d[2 * 264] = (bf16_t)vv.y; d[3 * 264] = (bf16_t)(vv.y >> 16);
        d[4 * 264] = (bf16_t)vv.z; d[5 * 264] = (bf16_t)(vv.z >> 16); d[6 * 264] = (bf16_t)vv.w; d[7 * 264] = (bf16_t)(vv.w >> 16); }
    __syncthreads();
    const int g = wave >> 1, head = kvh * 4 + g; const float sink = par[P_SINK + head];
    for (int it = 0; it < 2; ++it) {
        const int qs = 2 * (wave & 1) + it, qi0 = 32 * qs; const size_t qrow0 = rbase + blk * 128 + qi0;
        bf16x8 qf[2][2];
#pragma unroll
        for (int qt = 0; qt < 2; ++qt)
#pragma unroll
            for (int ks = 0; ks < 2; ++ks) qf[qt][ks] = *(const bf16x8*)(Q + (qrow0 + 16 * qt + fr) * 512 + head * 64 + 32 * ks + 8 * fq);
        f32x4 S[2][10];
#pragma unroll
        for (int qt = 0; qt < 2; ++qt)
#pragma unroll
            for (int kt = 0; kt < 10; ++kt) S[qt][kt] = (f32x4){0.f, 0.f, 0.f, 0.f};
#pragma unroll
        for (int kt = 0; kt < 10; ++kt)
#pragma unroll
            for (int ks = 0; ks < 2; ++ks) { const bf16x8 kf = *(const LAS bf16x8*)(Kl + (qi0 + 16 * kt + fr) * 72 + 32 * ks + 8 * fq);
#pragma unroll
                for (int qt = 0; qt < 2; ++qt) S[qt][kt] = __builtin_amdgcn_mfma_f32_16x16x32_bf16(kf, qf[qt][ks], S[qt][kt], 0, 0, 0); }
        bf16x8 pf[2][5];
#pragma unroll
        for (int qt = 0; qt < 2; ++qt) { const int qi = qi0 + 16 * qt + fr; float mx = sink;
#pragma unroll
            for (int kt = 0; kt < 10; ++kt)
#pragma unroll
                for (int j = 0; j < 4; ++j) { const int kb = qi0 + 16 * kt + 4 * fq + j; const bool valid = (kb > qi) && (kb <= qi + 128) && (blk > 0 || kb >= 128);
                    const float sv = valid ? S[qt][kt][j] : -INFINITY; S[qt][kt][j] = sv; mx = fmaxf(mx, sv); }
            mx = fmaxf(mx, __shfl_xor(mx, 16)); mx = fmaxf(mx, __shfl_xor(mx, 32));
            float sum = 0.f;
#pragma unroll
            for (int kt = 0; kt < 10; ++kt)
#pragma unroll
                for (int j = 0; j < 4; ++j) { const float p = __expf(S[qt][kt][j] - mx); S[qt][kt][j] = p; sum += p; }
            sum += __shfl_xor(sum, 16); sum += __shfl_xor(sum, 32);
            const float inv = 1.0f / (sum + __expf(sink - mx));
#pragma unroll
            for (int p = 0; p < 5; ++p) { const f32x4 a0 = S[qt][2 * p] * inv, a1 = S[qt][2 * p + 1] * inv; pf[qt][p] = __builtin_bit_cast(bf16x8, pack8(a0, a1)); }
        }
        f32x4 o[2][4];
#pragma unroll
        for (int qt = 0; qt < 2; ++qt)
#pragma unroll
            for (int dt = 0; dt < 4; ++dt) o[qt][dt] = (f32x4){0.f, 0.f, 0.f, 0.f};
#pragma unroll
        for (int p = 0; p < 5; ++p)
#pragma unroll
            for (int dt = 0; dt < 4; ++dt) { const LAS bf16_t* vp = VT + (16 * dt + fr) * 264 + qi0 + 32 * p + 4 * fq;
                const u32x2 lo = *(const LAS u32x2*)vp, hi = *(const LAS u32x2*)(vp + 16);
                const bf16x8 vf = __builtin_bit_cast(bf16x8, (u32x4){lo.x, lo.y, hi.x, hi.y});
#pragma unroll
                for (int qt = 0; qt < 2; ++qt) o[qt][dt] = __builtin_amdgcn_mfma_f32_16x16x32_bf16(vf, pf[qt][p], o[qt][dt], 0, 0, 0); }
#pragma unroll
        for (int qt = 0; qt < 2; ++qt)
#pragma unroll
            for (int dt = 0; dt < 4; ++dt) *(u32x2*)(Q + (qrow0 + 16 * qt + fr) * 512 + head * 64 + 16 * dt + 4 * fq) = (u32x2){cvt_pk_bf16(o[qt][dt][0], o[qt][dt][1]), cvt_pk_bf16(o[qt][dt][2], o[qt][dt][3])};
    }
    __syncthreads();
}
__device__ __forceinline__ void mixer_sc(unsigned char* ws, int l, int G) {
    { size_t z_ = 0; asm volatile("" : "+s"(z_)); ws += z_; } int tid_ = threadIdx.x; asm volatile("" : "+v"(tid_));
    bf16_t* BG = (bf16_t*)(ws + WS_BG); const bf16_t* CH = (const bf16_t*)(ws + WS_CH);
    const float* w = (const float*)(ws + WS_PAR) + l * PAR_L + P_SCW;
    for (int i = blockIdx.x * NTHREADS + tid_; i < (M / 8) * 64; i += G * NTHREADS) {
        const int row0 = 8 * (i >> 6), c = 8 * (i & 63), t0 = row0 & (SEQ - 1);
        u32x4 ch[10], bg[8];
#pragma unroll
        for (int r = 0; r < 10; ++r) { ch[r] = (u32x4){0u, 0u, 0u, 0u}; if (t0 - 2 + r >= 0) ch[r] = *(const u32x4*)(CH + (size_t)(row0 - 2 + r) * 512 + c); }
#pragma unroll
        for (int r = 0; r < 8; ++r) bg[r] = *(const u32x4*)(BG + (size_t)(row0 + r) * 512 + c);
        f32x4 wa[3], wb[3];
#pragma unroll
        for (int k = 0; k < 3; ++k) { wa[k] = *(const f32x4*)(w + k * 512 + c); wb[k] = *(const f32x4*)(w + k * 512 + c + 4); }
#pragma unroll
        for (int r = 0; r < 8; ++r) { f32x4 a0 = {0.f, 0.f, 0.f, 0.f}, a1 = a0;
#pragma unroll
            for (int k = 0; k < 3; ++k) { f32x4 x0, x1; unpack8(ch[r + k], x0, x1); a0 += x0 * wa[k]; a1 += x1 * wb[k]; }
            f32x4 g0, g1; unpack8(bg[r], g0, g1);
            *(u32x4*)(BG + (size_t)(row0 + r) * 512 + c) = pack8(g0 * a0, g1 * a1); }
    }
}

#define RLX_AGENT __ATOMIC_RELAXED, __HIP_MEMORY_SCOPE_AGENT
#define XB_TMO      128
#define XB_XCNT(j)  (256  + 64 * (j))
#define XB_XSUB(j)  (1280 + 64 * (j))
#define XB_XGEN(j)  (2304 + 64 * (j))
#define XB_TOP      3328
#define XB_TOPGEN   3392
#define XCD_BAR_WORDS 3456
#define XB_SPIN_CAP (1u << 18)

__device__ __forceinline__ unsigned xb_ld(unsigned* p)              { return __hip_atomic_load(p, __ATOMIC_RELAXED, __HIP_MEMORY_SCOPE_AGENT); }
__device__ __forceinline__ unsigned xb_add(unsigned* p, unsigned v) { return __hip_atomic_fetch_add(p, v, __ATOMIC_RELAXED, __HIP_MEMORY_SCOPE_AGENT); }
__device__ __forceinline__ unsigned xb_xcc_id() { return (unsigned)__builtin_amdgcn_s_getreg((3 << 11) | 20) & 0xFu; }
#define XB_SPIN(cond, bar) do { unsigned _sp = 0; while (cond) { __builtin_amdgcn_s_sleep(1); \
    if ((++_sp & 255u) == 0u) { if (xb_ld(&(bar)[XB_TMO])) break; if (_sp > XB_SPIN_CAP) { atomicAdd(&(bar)[XB_TMO], 1u); break; } } } } while (0)

struct XcdBarrier {
    unsigned* bar; unsigned x;
    volatile LAS unsigned* st;
};

__device__ __forceinline__ XcdBarrier xcd_barrier_post(unsigned* bar, volatile LAS unsigned* st) {
    XcdBarrier b; b.bar = bar; b.x = xb_xcc_id(); b.st = st;
    if (threadIdx.x == 0) (void)xb_add(&bar[XB_XCNT(b.x)], 1u);
    return b;
}
__device__ __forceinline__ void xcd_barrier_complete(unsigned* bar, unsigned x, unsigned& nloc, unsigned& nx) {
    const unsigned G = gridDim.x * gridDim.y * gridDim.z;
    unsigned sum, cnt, mine, sp = 0u;
    for (;;) {
        sum = 0u; cnt = 0u; mine = 0u;
#pragma unroll
        for (unsigned j = 0; j < 16; ++j) { const unsigned c = xb_ld(&bar[XB_XCNT(j)]); sum += c; cnt += (c > 0u) ? 1u : 0u; mine = (j == x) ? c : mine; }
        if (sum == G) break;
        __builtin_amdgcn_s_sleep(1);
        if ((++sp & 255u) == 0u) { if (xb_ld(&bar[XB_TMO])) break; if (sp > XB_SPIN_CAP) { atomicAdd(&bar[XB_TMO], 1u); break; } }
    }
    nloc = mine > 0u ? mine : 1u; nx = cnt > 0u ? cnt : 1u;
}

__device__ __forceinline__ void xcd_barrier(const XcdBarrier& b) {
    asm volatile("s_waitcnt vmcnt(0)" ::: "memory");
    __syncthreads();
    if (threadIdx.x == 0) {
        unsigned* bar = b.bar;
        __builtin_amdgcn_s_waitcnt(0);
        unsigned nloc = b.st[0], nx = b.st[1];
        if (nloc == 0u) { xcd_barrier_complete(bar, b.x, nloc, nx); b.st[0] = nloc; b.st[1] = nx; }
        const unsigned old = xb_add(&bar[XB_XSUB(b.x)], 1u);
        const unsigned gen = old / nloc;
        if (old + 1u == (gen + 1u) * nloc) {
            __builtin_amdgcn_fence(__ATOMIC_RELEASE, "agent");
            asm volatile("s_waitcnt vmcnt(0)" ::: "memory");
            const unsigned og = xb_add(&bar[XB_TOP], 1u);
            const unsigned tg = og / nx;
            if (og + 1u == (tg + 1u) * nx) xb_add(&bar[XB_TOPGEN], 1u);
            else XB_SPIN(xb_ld(&bar[XB_TOPGEN]) == tg, bar);
            __builtin_amdgcn_fence(__ATOMIC_ACQUIRE, "agent");
            xb_add(&bar[XB_XGEN(b.x)], 1u);
            asm volatile("s_waitcnt vmcnt(0)" ::: "memory");
        } else {
            XB_SPIN(xb_ld(&bar[XB_XGEN(b.x)]) == gen, bar);
            __builtin_amdgcn_fence(__ATOMIC_ACQUIRE, "agent");
            asm volatile("s_waitcnt vmcnt(0)" ::: "memory");
        }
    }
    __syncthreads();
}


__device__ __forceinline__ void stage_rs(LAS unsigned char* lds, const float* ssq, int pm) {
    int tid_ = threadIdx.x; asm volatile("" : "+v"(tid_));
    if (tid_ < 256 && pm >= 0) ((LAS float*)(lds + RSL_OFF))[tid_] = row_rs(ssq, pm * 256 + tid_);
    __syncthreads();
}
#define GRID_SYNC() do { XcdBarrier xb_; xb_.bar = (unsigned*)(ws + WS_BAR); xb_.x = xb_xcc_id(); xb_.st = (volatile LAS unsigned*)(lds + MISC_OFF); xcd_barrier(xb_); } while (0)
__global__ void __launch_bounds__(NTHREADS, 2) fwd_megakernel(Args a) {
    extern __shared__ __attribute__((aligned(16))) unsigned char lds_raw[];
    LAS unsigned char* lds = (LAS unsigned char*)lds_raw;
    cg::grid_group grid = cg::this_grid();
    const int G = gridDim.x, c = blockIdx.x;
    unsigned char* ws = a.ws;
    float* ssq = (float*)(ws + WS_SSQ);

    { volatile LAS unsigned* misc = (volatile LAS unsigned*)(lds + MISC_OFF); if (threadIdx.x < 16) misc[threadIdx.x] = 0u; }
    __syncthreads();
    grid.sync();
    (void)xcd_barrier_post((unsigned*)(ws + WS_BAR), (volatile LAS unsigned*)(lds + MISC_OFF));
    prologue(a, lds, G);
    GRID_SYNC();

    for (int l = 0; l < 2; ++l) {
        { size_t z_ = 0; asm volatile("" : "+s"(z_)); ws += z_; } ssq = (float*)(ws + WS_SSQ);
        const float* ssq_mix = ssq + (size_t)(2 * l) * M * 16;
        { pg8::SchedGrid S; S.nM = 64; S.nN = 17; S.nwg = 64 * 17; S.G = G; S.c = c; S.A = (const char*)(ws + WS_XB); S.B = (const char*)(ws + WS_WIN + l * WIN_L); S.lda2 = 2048; S.ldb2 = 2048; S.nt = 16;
          int pm0 = -1; { pg8::Unit u0; if (S.next(0, u0)) pm0 = u0.pm; } stage_rs(lds, ssq_mix, pm0);
          EpiInProj E{ssq_mix, ws, (LAS const float*)(lds + RSL_OFF), pm0};
          pg8::gemm_phase<EpiInProj, pg8::SchedGrid, true>(lds, S, E);
        }
        GRID_SYNC(); { size_t z_ = 0; asm volatile("" : "+s"(z_)); ws += z_; }
        for (int u = c; u < 512; u += G) mixer_sg(ws, l, lds, u);
        for (int u = c; u < 512; u += G) mixer_conv(ws, l, lds, u);
        for (int u = c; u < 256; u += G) mixer_attn(ws, l, lds, u);
        mixer_sc(ws, l, G);
        GRID_SYNC(); { size_t z_ = 0; asm volatile("" : "+s"(z_)); ws += z_; } ssq = (float*)(ws + WS_SSQ);
        { pg8::SchedMerge S; S.G = G; S.c = c; S.ws = (const char*)ws; S.WG = (const char*)(ws + WS_WIN + l * WIN_L) + (size_t)NLOG1 * 2048;
          S.WBR = (const char*)(ws + WS_WBR + l * WBR_L);
          S.swap = 1; int pm0 = -1; { pg8::Unit u0; if (S.next(0, u0)) pm0 = u0.pm; } stage_rs(lds, ssq_mix, pm0);
          EpiStashB ES{(bf16_t*)(ws + WS_MG)}; EpiGateAcc EA{ssq_mix, (bf16_t*)(ws + WS_MG), (bf16_t*)(ws + WS_TMP), (LAS const float*)(lds + RSL_OFF), pm0};
          EpiMerge2 E2{ES, EA};
          pg8::gemm_phase<EpiMerge2, pg8::SchedMerge, true>(lds, S, E2);
        }
        GRID_SYNC(); { size_t z_ = 0; asm volatile("" : "+s"(z_)); ws += z_; } ssq = (float*)(ws + WS_SSQ);
        { pg8::SchedGrid S; S.nM = 64; S.nN = 4; S.nwg = 256; S.G = G; S.c = c; S.A = (const char*)(ws + WS_MG); S.B = (const char*)(ws + WS_WOUT + l * WOUT_L); S.lda2 = 2048; S.ldb2 = 2048; S.nt = 16;
          EpiResid E{(bf16_t*)(ws + WS_XB), ssq + (size_t)(2 * l + 1) * M * 16};
          pg8::gemm_phase<EpiResid, pg8::SchedGrid, false>(lds, S, E); }
        GRID_SYNC(); { size_t z_ = 0; asm volatile("" : "+s"(z_)); ws += z_; } ssq = (float*)(ws + WS_SSQ);
        { pg8::SchedGrid S; S.nM = 64; S.nN = 22; S.nwg = 64 * 22; S.G = G; S.c = c; S.A = (const char*)(ws + WS_XB); S.B = (const char*)(ws + WS_WGU + l * WGU_L); S.lda2 = 2048; S.ldb2 = 2048; S.nt = 16;
          int pm0 = -1; { pg8::Unit u0; if (S.next(0, u0)) pm0 = u0.pm; } stage_rs(lds, ssq + (size_t)(2 * l + 1) * M * 16, pm0);
          EpiSwiGLU E{ssq + (size_t)(2 * l + 1) * M * 16, (bf16_t*)(ws + WS_ACT), ABL_FFN_SCALE(l), (LAS const float*)(lds + RSL_OFF), pm0};
          pg8::gemm_phase<EpiSwiGLU, pg8::SchedGrid, true>(lds, S, E);
        }
        GRID_SYNC(); { size_t z_ = 0; asm volatile("" : "+s"(z_)); ws += z_; } ssq = (float*)(ws + WS_SSQ);
        { pg8::SchedGrid S; S.nM = 64; S.nN = 4; S.nwg = 256; S.G = G; S.c = c; S.A = (const char*)(ws + WS_ACT); S.B = (const char*)(ws + WS_WDN + l * WDN_L); S.lda2 = DFF * 2; S.ldb2 = DFF * 2; S.nt = DFF / 64;
          EpiResid E{(bf16_t*)(ws + WS_XB), ssq + (size_t)(2 * l + 2) * M * 16};
          pg8::gemm_phase<EpiResid, pg8::SchedGrid, false>(lds, S, E); }
        GRID_SYNC();
    }
    { { size_t z_ = 0; asm volatile("" : "+s"(z_)); ws += z_; } int tid_ = threadIdx.x; asm volatile("" : "+v"(tid_));
      const int lane = tid_ & 63, gw = c * NWAVES + (tid_ >> 6), NGW = G * NWAVES; const float* gf = (const float*)(ws + WS_PAR) + P_FINAL; const float* sq = (const float*)(ws + WS_SSQ) + (size_t)4 * M * 16;
      const bf16_t* XBp = (const bf16_t*)(ws + WS_XB);
      for (int row = gw; row < M; row += 2 * NGW) { const int row2 = row + NGW;
          u32x4 ra_[2], rb_[2];
#pragma unroll
          for (int j = 0; j < 2; ++j) { ra_[j] = *(const u32x4*)(XBp + (size_t)row * D + 512 * j + 8 * lane); rb_[j] = *(const u32x4*)(XBp + (size_t)row2 * D + 512 * j + 8 * lane); }
          const float ra = row_rs(sq, row), rb = row_rs(sq, row2);
#pragma unroll
          for (int j = 0; j < 2; ++j) { const f32x4 g0 = *(const f32x4*)(gf + 512 * j + 8 * lane), g1 = *(const f32x4*)(gf + 512 * j + 8 * lane + 4);
              f32x4 x0, x1; unpack8(ra_[j], x0, x1); float* oa = a.out + (size_t)row * D + 512 * j + 8 * lane; *(f32x4*)oa = x0 * ra * g0; *(f32x4*)(oa + 4) = x1 * ra * g1;
              unpack8(rb_[j], x0, x1); float* ob = a.out + (size_t)row2 * D + 512 * j + 8 * lane; *(f32x4*)ob = x0 * rb * g0; *(f32x4*)(ob + 4) = x1 * rb * g1; } } }
}

extern "C" void kernel_launch(void* const* d_in, const int* in_sizes, int n_in, void* d_out, int out_size, void* d_ws, size_t ws_size, hipStream_t stream) {
    static int grid = 0;
    if (grid == 0) {
        if (n_in != 19 || out_size != M * D || ws_size < WS_END) { fprintf(stderr, "kernel_launch: unexpected shapes (n_in %d out %d ws %zu)\n", n_in, out_size, ws_size); grid = -1; return; }
        int dev = 0, cus = 0, per_cu = 0;
        if (hipGetDevice(&dev) != hipSuccess || hipDeviceGetAttribute(&cus, hipDeviceAttributeMultiprocessorCount, dev) != hipSuccess) { grid = -1; return; }
        if (hipFuncSetAttribute((const void*)fwd_megakernel, hipFuncAttributeMaxDynamicSharedMemorySize, LDS_BYTES) != hipSuccess) { fprintf(stderr, "kernel_launch: hipFuncSetAttribute failed\n"); grid = -1; return; }
        if (hipOccupancyMaxActiveBlocksPerMultiprocessor(&per_cu, (const void*)fwd_megakernel, NTHREADS, LDS_BYTES) != hipSuccess || per_cu < 1) { fprintf(stderr, "kernel_launch: occupancy query says %d\n", per_cu); per_cu = 1; }
        (void)hipGetLastError();
        grid = cus * 1;
    }
    if (grid < 0) return;
    if (hipMemsetAsync((char*)d_ws + WS_BAR, 0, 16384, stream) != hipSuccess) { fprintf(stderr, "kernel_launch: memset failed\n"); return; }
    Args a{};
    for (int i = 0; i < 19; ++i) a.in[i] = (const float*)d_in[i];
    a.out = (float*)d_out; a.ws = (unsigned char*)d_ws;
    void* args[] = {&a};
    hipError_t e = hipLaunchCooperativeKernel((const void*)fwd_megakernel, dim3(grid), dim3(NTHREADS), args, LDS_BYTES, stream);
    if (e != hipSuccess) fprintf(stderr, "cooperative launch failed: %s (grid %d)\n", hipGetErrorString(e), grid);
}
```

```cpp
#include <hip/hip_runtime.h>
#include <hip/hip_cooperative_groups.h>
#include <cstdio>
#include <cstdint>
namespace cg = cooperative_groups;

#define LAS __attribute__((address_space(3)))
typedef unsigned short bf16_t;
typedef short bf16x8 __attribute__((ext_vector_type(8)));
typedef float f32x4 __attribute__((ext_vector_type(4)));
typedef float f32x2 __attribute__((ext_vector_type(2)));
typedef unsigned u32x4 __attribute__((ext_vector_type(4)));
typedef unsigned u32x2 __attribute__((ext_vector_type(2)));

constexpr int M = 16384, D = 1024, SEQ = 2048, NBATCH = 8, DFF = 2816, PROJ = 8448, NLOG1 = 4352  ;
constexpr float EPS = 1e-6f;
constexpr int NTHREADS = 512, NWAVES = 8;
constexpr int LDS_BYTES = 147456;

constexpr size_t MiB = 1u << 20;
constexpr size_t WS_SSQ = 248 * (size_t)(1u << 20);
constexpr size_t WS_PAR = 512 * 1024;
constexpr int PAR_L = 24576, P_SGLNG = 0, P_SGLNB = 512, P_SGB = 1024, P_CVB = 1536, P_CVLNG = 2048, P_CVLNB = 2560, P_SCW = 3072, P_SINK = 4608, P_CVW = 4672, P_FINAL = 2 * PAR_L;
constexpr size_t WS_BAR = 768 * 1024;
constexpr int MISC_OFF = 147200;
constexpr size_t WS_ROPEC = 1 * MiB, WS_ROPES = 1 * MiB + 256 * 1024;
constexpr size_t WS_SGWT = 1 * MiB + 512 * 1024;
constexpr size_t WS_WIN = 2 * MiB, WIN_L = (size_t)PROJ * D * 2;
constexpr size_t WS_WBR = 35 * MiB, WBR_L = 4 * MiB;
constexpr size_t WS_WOUT = 43 * MiB, WOUT_L = 2 * MiB;
constexpr size_t WS_WGU = 47 * MiB, WGU_L = 11 * MiB;
constexpr size_t WS_WDN = 69 * MiB, WDN_L = (size_t)D * DFF * 2;
constexpr size_t WS_XB = 80 * MiB;
constexpr size_t WS_ZA = 112 * MiB;
constexpr size_t WS_MG = WS_ZA;
constexpr size_t WS_GLU = 144 * MiB;
constexpr size_t WS_CH = 160 * MiB;
constexpr size_t WS_TMP = WS_GLU;
constexpr size_t WS_Q = 176 * MiB;
constexpr size_t WS_BG = 192 * MiB;
constexpr size_t WS_K = 208 * MiB, WS_V = 212 * MiB;
constexpr size_t WS_YA = 216 * MiB, WS_YB = 232 * MiB;
constexpr size_t WS_ACT = 112 * MiB;
constexpr size_t WS_END = 254 * MiB;

__device__ const double INVF_REV[32] = {0.15915494309189535, 0.11934937021124886, 0.08949940160889101, 0.06711508300522726, 0.050329212104487035, 0.03774158471741977, 0.0283021958306234, 0.02122365276477766, 0.015915494309189534, 0.011934937021124886, 0.008949940160889102, 0.006711508300522725, 0.005032921210448704, 0.003774158471741977, 0.00283021958306234, 0.0021223652764777662, 0.0015915494309189536, 0.0011934937021124885, 0.0008949940160889102, 0.0006711508300522726, 0.0005032921210448703, 0.00037741584717419774, 0.00028302195830623395, 0.0002122365276477766, 0.00015915494309189535, 0.00011934937021124886, 8.949940160889102e-05, 6.711508300522725e-05, 5.0329212104487035e-05, 3.774158471741978e-05, 2.8302195830623396e-05, 2.122365276477766e-05};

__device__ __forceinline__ unsigned cvt_pk_bf16(float lo, float hi) { unsigned r; asm volatile("v_cvt_pk_bf16_f32 %0, %1, %2" : "=v"(r) : "v"(lo), "v"(hi)); return r; }
__device__ __forceinline__ float bf_lo(unsigned u) { return __builtin_bit_cast(float, u << 16); }
__device__ __forceinline__ float bf_hi(unsigned u) { return __builtin_bit_cast(float, u & 0xffff0000u); }
__device__ __forceinline__ float bf1(bf16_t h) { return __builtin_bit_cast(float, ((unsigned)h) << 16); }
__device__ __forceinline__ float sigmoidf_(float x) { return __builtin_amdgcn_rcpf(1.0f + __expf(-x)); }
template <int CTRL, int ROW_MASK> __device__ __forceinline__ float dpp_mov(float v) {
    return __builtin_bit_cast(float, __builtin_amdgcn_update_dpp(0, __builtin_bit_cast(int, v), CTRL, ROW_MASK, 0xf, true));
}
__device__ __forceinline__ float wave_sum(float v) {
    v += dpp_mov<0xB1, 0xf>(v);
    v += dpp_mov<0x4E, 0xf>(v);
    v += dpp_mov<0x141, 0xf>(v);
    v += dpp_mov<0x140, 0xf>(v);
    v += dpp_mov<0x142, 0xa>(v);
    v += dpp_mov<0x143, 0xc>(v);
    return __builtin_bit_cast(float, __builtin_amdgcn_readlane(__builtin_bit_cast(int, v), 63));
}
__device__ __forceinline__ f32x2 gelu_pk(f32x2 v) {
    const f32x2 av = __builtin_elementwise_abs(v), d = av * 0.2316418882f + 1.0f;
    f32x2 t; t.x = __builtin_amdgcn_rcpf(d.x); t.y = __builtin_amdgcn_rcpf(d.y);
    f32x2 q = t * 0.5307027145f + (-0.7265760135f); q = q * t + 0.7107068705f; q = q * t + (-0.142248368f); q = q * t + 0.127414796f; q = q * t;
    const f32x2 s = (v * v) * (-0.72134752044f);
    f32x2 e; e.x = __builtin_amdgcn_exp2f(s.x); e.y = __builtin_amdgcn_exp2f(s.y);
    const f32x2 m = v * (q * e), r = v - m;
    f32x2 o; o.x = v.x < 0.f ? m.x : r.x; o.y = v.y < 0.f ? m.y : r.y; return o;
}
__device__ __forceinline__ u32x4 pack8(f32x4 a, f32x4 b) { u32x4 w; w.x = cvt_pk_bf16(a[0], a[1]); w.y = cvt_pk_bf16(a[2], a[3]); w.z = cvt_pk_bf16(b[0], b[1]); w.w = cvt_pk_bf16(b[2], b[3]); return w; }
__device__ __forceinline__ void unpack8(u32x4 w, f32x4& a, f32x4& b) { a = (f32x4){bf_lo(w.x), bf_hi(w.x), bf_lo(w.y), bf_hi(w.y)}; b = (f32x4){bf_lo(w.z), bf_hi(w.z), bf_lo(w.w), bf_hi(w.w)}; }

namespace pg8 {
constexpr int BM = 256, BK = 64, HALF = 128, HTB = HALF * BK * 2, STAGE_BYTES = 8 * HTB, NXCD = 8, WGM = 8;
__host__ __device__ __forceinline__ int lds_byte(int r, int c) { const int st = (r >> 4) * 2 + (c >> 5), rr = r & 15, cc = c & 31, ob = rr * 64 + cc * 2; return st * 1024 + (ob ^ (((ob >> 9) & 1) << 5)); }
__host__ __device__ __forceinline__ void stage_rc(int b, int& R, int& C) { const int st = b / 1024, sb = b % 1024, swz = sb ^ (((sb >> 9) & 1) << 5); R = (st >> 1) * 16 + swz / 64; C = (st & 1) * 32 + (swz % 64) / 2; }
__host__ __device__ __forceinline__ int perm32(int rho) { const int n = rho >> 4, i = rho & 15; return 8 * (i >> 2) + 4 * n + (i & 3); }

struct Unit { const char* A; const char* B; int lda2, ldb2, nt, pm, pn, z; };

__device__ __forceinline__ void tile_of(int L, int nM, int nN, int& pm, int& pn) {
    const int nwg = nM * nN; int wgid = L; { const int q = nwg / NXCD, r = nwg % NXCD, xcd = wgid % NXCD, off = wgid / NXCD; wgid = (xcd < r ? xcd * (q + 1) : r * (q + 1) + (xcd - r) * q) + off; }
    const int nig = WGM * nN, gid = wgid / nig, fm = gid * WGM, gsz = (nM - fm) < WGM ? (nM - fm) : WGM;
    pm = fm + ((wgid % nig) % gsz); pn = (wgid % nig) / gsz;
}
struct SchedGrid {
    static constexpr bool VARLD = false;
    int nM, nN, nwg, G, c; const char* A; const char* B; int lda2, ldb2, nt;
    __device__ __forceinline__ bool next(int i, Unit& u) const {
        const long L = (long)i * G + c; if (L >= nwg) return false;
        tile_of((int)L, nM, nN, u.pm, u.pn); u.z = 0;
        u.A = A + (size_t)u.pm * 256 * lda2; u.B = B + (size_t)u.pn * 256 * ldb2; u.lda2 = lda2; u.ldb2 = ldb2; u.nt = nt; return true;
    }
};
struct SchedMerge {
    static constexpr bool VARLD = true;
    int G, c; const char* ws; const char* WG  ; const char* WBR; int swap;
    __device__ __forceinline__ bool next(int i, Unit& u) const {
        const int ti = i >> 3, sub = i & 7; const long L = (long)ti * G + c; if (L >= 256) return false;
        tile_of((int)L, 64, 4, u.pm, u.pn); u.z = sub; const int br = sub >> 1;
        if (((sub & 1) ^ swap) == 0) { u.A = ws + WS_XB + (size_t)u.pm * 256 * 2048; u.lda2 = 2048; u.B = WG + (size_t)(br * 1024 + u.pn * 256) * 2048; u.ldb2 = 2048; u.nt = 16; }
        else { const size_t yo = br == 0 ? WS_YA : br == 1 ? WS_YB : br == 2 ? WS_Q : WS_BG;
               u.A = ws + yo + (size_t)u.pm * 256 * 1024; u.lda2 = 1024; u.B = WBR + (size_t)br * (1024 * 512 * 2) + (size_t)u.pn * 256 * 1024; u.ldb2 = 1024; u.nt = 8; }
        return true;
    }
};

struct SchedOne {
    static constexpr bool VARLD = false;
    SchedMerge M; int i0;
    __device__ __forceinline__ bool next(int i, Unit& u) const { if (i != 0) return false; return M.next(i0, u); }
};
struct SchedOneG {
    static constexpr bool VARLD = false;
    SchedGrid S; int i0;
    __device__ __forceinline__ bool next(int i, Unit& u) const { if (i != 0) return false; return S.next(i0, u); }
};
template <class Epi, class Sched, bool ALIGN_EPI>
__device__ __forceinline__ void gemm_phase(LAS unsigned char* lds, const Sched& S, const Epi& E) {
    int tid_ = threadIdx.x; asm volatile("" : "+v"(tid_));
    const int tid = tid_, wid = __builtin_amdgcn_readfirstlane(tid >> 6), lane = tid & 63, wr = wid >> 2, wc = wid & 3, fr = lane & 15, fq = lane >> 4;
    unsigned rA[2], rB[2], cc2[2];
#pragma unroll
    for (int i = 0; i < 2; ++i) { int R, C; stage_rc(tid * 16 + i * 8192, R, C); rA[i] = (unsigned)R; rB[i] = (unsigned)((R & ~31) + perm32(R & 31)); cc2[i] = (unsigned)C * 2u; }
    const size_t kstep = (size_t)(BK * 2);
    const unsigned ldsw = (unsigned)wid * 1024u;
    const int aoff = lds_byte(wr * 64 + fr, fq * 8), boff = lds_byte(wc * 32 + fr, fq * 8);
#define PG8_SA(b, h) (((b) * 2 + (h)) * HTB)
#define PG8_SB(b, h) ((4 + (b) * 2 + (h)) * HTB)
#define PG8_STAGE(bufoff, gbase, voff) do { _Pragma("unroll") for (int _i = 0; _i < 2; ++_i) \
        __builtin_amdgcn_global_load_lds((const unsigned*)((const char*)(gbase) + (voff)[_i]), (LAS unsigned*)(lds + (bufoff) + ldsw + _i * 8192), 16, 0, 0); } while (0)
#define PG8_LDA(dst, b, h) do { _Pragma("unroll") for (int m = 0; m < 4; ++m) _Pragma("unroll") for (int k = 0; k < 2; ++k) dst[m][k] = *(const LAS bf16x8*)(lds + PG8_SA(b, h) + aoff + m * 2048 + k * 1024); } while (0)
#define PG8_LDB(dst, b, h) do { _Pragma("unroll") for (int n = 0; n < 2; ++n) _Pragma("unroll") for (int k = 0; k < 2; ++k) dst[n][k] = *(const LAS bf16x8*)(lds + PG8_SB(b, h) + boff + n * 2048 + k * 1024); } while (0)
#define PG8_MMA(ai, bj, At, Bt) do { __builtin_amdgcn_s_setprio(1); _Pragma("unroll") for (int m = 0; m < 4; ++m) _Pragma("unroll") for (int n = 0; n < 2; ++n) _Pragma("unroll") for (int k = 0; k < 2; ++k) \
        acc[ai][bj][m][n] = __builtin_amdgcn_mfma_f32_16x16x32_bf16(Bt[n][k], At[m][k], acc[ai][bj][m][n], 0, 0, 0); __builtin_amdgcn_s_setprio(0); } while (0)
#define PG8_WAIT_V(n) asm volatile("s_waitcnt vmcnt(" #n ")" ::: "memory")
#define PG8_WAIT_L(n) asm volatile("s_waitcnt lgkmcnt(" #n ")" ::: "memory")
#define PG8_BAR __builtin_amdgcn_s_barrier()
#define PG8_SCHED __builtin_amdgcn_sched_barrier(0)
    Unit cur, nxt; int ui = 0;
    if (!S.next(0, cur)) return;
    f32x4 acc[2][2][4][2];
#pragma unroll
    for (int a = 0; a < 2; ++a)
#pragma unroll
        for (int b = 0; b < 2; ++b)
#pragma unroll
            for (int m = 0; m < 4; ++m)
#pragma unroll
                for (int n = 0; n < 2; ++n) acc[a][b][m][n] = (f32x4){0.f, 0.f, 0.f, 0.f};
    bf16x8 At[4][2], B0[2][2], B1[2][2];
    unsigned voffA[2], voffB[2];
#pragma unroll
    for (int i = 0; i < 2; ++i) { voffA[i] = rA[i] * (unsigned)cur.lda2 + cc2[i]; voffB[i] = rB[i] * (unsigned)cur.ldb2 + cc2[i]; }
    const char* cA = cur.A; const char* cB = cur.B;
    unsigned hA = (unsigned)HALF * cur.lda2, hB = (unsigned)HALF * cur.ldb2;
    PG8_STAGE(PG8_SB(0, 0), cB, voffB); PG8_STAGE(PG8_SB(0, 1), cB + hB, voffB); PG8_STAGE(PG8_SA(0, 0), cA, voffA); PG8_STAGE(PG8_SA(0, 1), cA + hA, voffA);
    if (wr == 1) PG8_BAR;
    PG8_WAIT_V(2); PG8_BAR;
    PG8_STAGE(PG8_SB(1, 0), cB + kstep, voffB); PG8_STAGE(PG8_SA(1, 0), cA + kstep, voffA); PG8_STAGE(PG8_SB(1, 1), cB + hB + kstep, voffB);
    PG8_WAIT_V(6); PG8_BAR;
    for (;;) {
        const bool has_next = S.next(ui + 1, nxt);
        if (!has_next) nxt = cur;
        unsigned voffAn[2], voffBn[2];
#pragma unroll
        for (int i = 0; i < 2; ++i) { if constexpr (Sched::VARLD) { voffAn[i] = rA[i] * (unsigned)nxt.lda2 + cc2[i]; voffBn[i] = rB[i] * (unsigned)nxt.ldb2 + cc2[i]; } else { voffAn[i] = voffA[i]; voffBn[i] = voffB[i]; } }
        const char* nA = nxt.A; const char* nB = nxt.B;
        const unsigned hAn = Sched::VARLD ? (unsigned)HALF * nxt.lda2 : hA, hBn = Sched::VARLD ? (unsigned)HALF * nxt.ldb2 : hB;
        const int nt = cur.nt;
        for (int t = 0; t < nt; t += 2) {
            const bool last = (t == nt - 2);
            const char* a1 = cA + (size_t)(t + 1) * kstep;
            const char* a2 = last ? nA : cA + (size_t)(t + 2) * kstep; const char* b2 = last ? nB : cB + (size_t)(t + 2) * kstep;
            const char* a3 = a2 + kstep; const char* b3 = b2 + kstep;
            const unsigned hA2 = last ? hAn : hA, hB2 = last ? hBn : hB;
            unsigned vA2[2], vB2[2];
#pragma unroll
            for (int i = 0; i < 2; ++i) { vA2[i] = last ? voffAn[i] : voffA[i]; vB2[i] = last ? voffBn[i] : voffB[i]; }
            PG8_LDB(B0, 0, 0); PG8_LDB(B1, 0, 1); PG8_SCHED; PG8_LDA(At, 0, 0); PG8_STAGE(PG8_SA(1, 1), a1 + hA, voffA);
            PG8_WAIT_V(8); PG8_WAIT_L(0); PG8_BAR; PG8_MMA(0, 0, At, B0); PG8_MMA(0, 1, At, B1); PG8_BAR; PG8_SCHED;
            PG8_LDA(At, 0, 1); PG8_STAGE(PG8_SB(0, 0), b2, vB2); PG8_STAGE(PG8_SB(0, 1), b2 + hB2, vB2); PG8_STAGE(PG8_SA(0, 0), a2, vA2);
            PG8_WAIT_V(8); PG8_WAIT_L(0); PG8_BAR; PG8_MMA(1, 0, At, B0); PG8_MMA(1, 1, At, B1); PG8_BAR; PG8_SCHED;
            PG8_LDB(B0, 1, 0); PG8_LDB(B1, 1, 1); PG8_SCHED; PG8_LDA(At, 1, 0); PG8_STAGE(PG8_SA(0, 1), a2 + hA2, vA2);
            PG8_WAIT_V(8); PG8_WAIT_L(0); PG8_BAR; PG8_MMA(0, 0, At, B0); PG8_MMA(0, 1, At, B1); PG8_BAR; PG8_SCHED;
            PG8_LDA(At, 1, 1); PG8_STAGE(PG8_SB(1, 0), b3, vB2); PG8_STAGE(PG8_SB(1, 1), b3 + hB2, vB2); PG8_STAGE(PG8_SA(1, 0), a3, vA2);
            PG8_WAIT_V(8); PG8_WAIT_L(0); PG8_BAR; PG8_MMA(1, 0, At, B0); PG8_MMA(1, 1, At, B1); PG8_BAR; PG8_SCHED;
        }
        if constexpr (ALIGN_EPI) { if (wr == 0) PG8_BAR; }
        E(acc, cur, wr, wc, fr, fq);
        if (!has_next) break;
#pragma unroll
        for (int a = 0; a < 2; ++a)
#pragma unroll
            for (int b = 0; b < 2; ++b)
#pragma unroll
                for (int m = 0; m < 4; ++m)
#pragma unroll
                    for (int n = 0; n < 2; ++n) acc[a][b][m][n] = (f32x4){0.f, 0.f, 0.f, 0.f};
        cur = nxt; cA = nA; cB = nB; hA = hAn; hB = hBn; ++ui;
#pragma unroll
        for (int i = 0; i < 2; ++i) { voffA[i] = voffAn[i]; voffB[i] = voffBn[i]; }
        if constexpr (ALIGN_EPI) { if (wr == 1) PG8_BAR; }
    }
    PG8_WAIT_V(0);
    if constexpr (!ALIGN_EPI) { if (wr == 0) PG8_BAR; }
    PG8_BAR;
#undef PG8_SA
#undef PG8_SB
#undef PG8_STAGE
#undef PG8_LDA
#undef PG8_LDB
#undef PG8_MMA
#undef PG8_WAIT_V
#undef PG8_WAIT_L
#undef PG8_BAR
#undef PG8_SCHED
}
}

constexpr int RSL_OFF = 133120;
#define EPI_ROWLOOP _Pragma("unroll") for (int ai = 0; ai < 2; ++ai) _Pragma("unroll") for (int m = 0; m < 4; ++m)
#define EPI_RS(row) ((u.pm == pm0) ? rsl[(row) & 255] : row_rs(ssq, (row)))
__device__ __forceinline__ float row_rs(const float* ssq, int row) { const f32x4* p = (const f32x4*)(ssq + (size_t)row * 16); const f32x4 a = p[0], b = p[1], c = p[2], d = p[3];
    const float s = (((a[0] + a[1]) + (a[2] + a[3])) + ((b[0] + b[1]) + (b[2] + b[3]))) + (((c[0] + c[1]) + (c[2] + c[3])) + ((d[0] + d[1]) + (d[2] + d[3])));
    return __builtin_amdgcn_rsqf(s * (1.0f / D) + EPS); }

struct EpiInProj {
    const float* ssq; unsigned char* ws; LAS const float* rsl; int pm0;
    __device__ __forceinline__ void operator()(const f32x4 (&acc)[2][2][4][2], const pg8::Unit& u, int wr, int wc, int fr, int fq) const {
        bf16_t* const ZA = (bf16_t*)(ws + WS_ZA); bf16_t* const GLU = (bf16_t*)(ws + WS_GLU); bf16_t* const BG = (bf16_t*)(ws + WS_BG); bf16_t* const CH = (bf16_t*)(ws + WS_CH);
        const float* const ropeC = (const float*)(ws + WS_ROPEC); const float* const ropeS = (const float*)(ws + WS_ROPES);
        const int T = u.pn, row0 = u.pm * 256 + wr * 64 + fr, jcol = wc * 32 + 8 * fq;
        if (T < 4) {
            EPI_ROWLOOP { const int row = row0 + ai * 128 + m * 16; const float rs = EPI_RS(row);
#pragma unroll
                for (int bj = 0; bj < 2; ++bj) { f32x4 v0 = acc[ai][bj][m][0] * rs, v1 = acc[ai][bj][m][1] * rs;
                    f32x2 a = gelu_pk((f32x2){v0[0], v0[1]}), b = gelu_pk((f32x2){v0[2], v0[3]}), c = gelu_pk((f32x2){v1[0], v1[1]}), d = gelu_pk((f32x2){v1[2], v1[3]});
                    *(u32x4*)(ZA + (size_t)row * 1024 + 256 * T + 128 * bj + jcol) = pack8((f32x4){a.x, a.y, b.x, b.y}, (f32x4){c.x, c.y, d.x, d.y}); } }
        } else if (T < 8) {
            EPI_ROWLOOP { const int row = row0 + ai * 128 + m * 16; const float rs = EPI_RS(row); f32x4 o[2];
#pragma unroll
                for (int n = 0; n < 2; ++n) { const f32x4 a = acc[ai][0][m][n] * rs, g = acc[ai][1][m][n] * rs;
#pragma unroll
                    for (int j = 0; j < 4; ++j) o[n][j] = a[j] * sigmoidf_(g[j]); }
                *(u32x4*)(GLU + (size_t)row * 512 + 128 * (T - 4) + jcol) = pack8(o[0], o[1]); }
        } else if (T < 11) {
            const bool isq = T < 10; const bool rope = isq || wc < 2; const float sc = isq ? 0.125f : 1.0f;
            const size_t boff = isq ? WS_Q : (wc < 2 ? WS_K : WS_V); bf16_t* const base = (bf16_t*)(ws + boff);
            const int ld = isq ? 512 : 128, hcol = isq ? (4 * (T - 8) + wc) * 64 : (wc & 1) * 64;
            EPI_ROWLOOP { const int row = row0 + ai * 128 + m * 16; const float rs = EPI_RS(row) * sc; const int pos = row & (SEQ - 1); f32x4 o1[2], o2[2];
#pragma unroll
                for (int n = 0; n < 2; ++n) { const f32x4 x1 = acc[ai][0][m][n] * rs, x2 = acc[ai][1][m][n] * rs;
                    if (rope) { const f32x4 c = *(const f32x4*)(ropeC + pos * 32 + 8 * fq + 4 * n), s = *(const f32x4*)(ropeS + pos * 32 + 8 * fq + 4 * n);
                        o1[n] = x1 * c - x2 * s; o2[n] = x2 * c + x1 * s; } else { o1[n] = x1; o2[n] = x2; } }
                bf16_t* p = base + (size_t)row * ld + hcol + 8 * fq;
                *(u32x4*)p = pack8(o1[0], o1[1]); *(u32x4*)(p + 32) = pack8(o2[0], o2[1]); }
        } else if (T < 13) {
            EPI_ROWLOOP { const int row = row0 + ai * 128 + m * 16; const float rs = EPI_RS(row);
#pragma unroll
                for (int bj = 0; bj < 2; ++bj) *(u32x4*)(BG + (size_t)row * 512 + 256 * (T - 11) + 128 * bj + jcol) = pack8(acc[ai][bj][m][0] * rs, acc[ai][bj][m][1] * rs); }
        } else {
            EPI_ROWLOOP { const int row = row0 + ai * 128 + m * 16; const float rs = EPI_RS(row); const float rs2 = rs * rs;
                *(u32x4*)(CH + (size_t)row * 512 + 128 * (T - 13) + jcol) = pack8(acc[ai][0][m][0] * acc[ai][1][m][0] * rs2, acc[ai][0][m][1] * acc[ai][1][m][1] * rs2); }
        }
    }
};
struct EpiGate {
    const float* ssq; bf16_t* MG;
    __device__ __forceinline__ void operator()(const f32x4 (&acc)[2][2][4][2], const pg8::Unit& u, int wr, int wc, int fr, int fq) const {
        const int row0 = u.pm * 256 + wr * 64 + fr, col0 = u.pn * 256 + wc * 32 + 8 * fq;
        EPI_ROWLOOP { const int row = row0 + ai * 128 + m * 16; const float rs = row_rs(ssq, row);
#pragma unroll
            for (int bj = 0; bj < 2; ++bj) { f32x4 v0 = acc[ai][bj][m][0] * rs, v1 = acc[ai][bj][m][1] * rs;
#pragma unroll
                for (int j = 0; j < 4; ++j) { v0[j] = sigmoidf_(v0[j]); v1[j] = sigmoidf_(v1[j]); }
                *(u32x4*)(MG + (size_t)row * 1024 + col0 + 128 * bj) = pack8(v0, v1); } }
    }
};
struct EpiBranch {
    bf16_t* MG; bf16_t* TMP;
    __device__ __forceinline__ void operator()(const f32x4 (&acc)[2][2][4][2], const pg8::Unit& u, int wr, int wc, int fr, int fq) const {
        const int row0 = u.pm * 256 + wr * 64 + fr, col0 = u.pn * 256 + wc * 32 + 8 * fq, br = u.z >> 1;
        EPI_ROWLOOP { const int row = row0 + ai * 128 + m * 16;
#pragma unroll
            for (int bj = 0; bj < 2; ++bj) { const size_t off = (size_t)row * 1024 + col0 + 128 * bj;
                f32x4 g0, g1; unpack8(*(const u32x4*)(MG + off), g0, g1);
                f32x4 v0 = acc[ai][bj][m][0] * g0, v1 = acc[ai][bj][m][1] * g1;
                if (br > 0) { f32x4 t0, t1; unpack8(*(const u32x4*)(TMP + off), t0, t1); v0 += t0; v1 += t1; }
                if (br < 3) *(u32x4*)(TMP + off) = pack8(v0, v1); else *(u32x4*)(MG + off) = pack8(v0, v1); } }
    }
};
struct EpiStashB {
    bf16_t* MG;
    __device__ __forceinline__ void operator()(const f32x4 (&acc)[2][2][4][2], const pg8::Unit& u, int wr, int wc, int fr, int fq) const {
        const int row0 = u.pm * 256 + wr * 64 + fr, col0 = u.pn * 256 + wc * 32 + 8 * fq;
        EPI_ROWLOOP { const int row = row0 + ai * 128 + m * 16;
#pragma unroll
            for (int bj = 0; bj < 2; ++bj) *(u32x4*)(MG + (size_t)row * 1024 + col0 + 128 * bj) = pack8(acc[ai][bj][m][0], acc[ai][bj][m][1]); }
    }
};
struct EpiGateAcc {
    const float* ssq; bf16_t* MG; bf16_t* TMP; LAS const float* rsl; int pm0;
    __device__ __forceinline__ void operator()(const f32x4 (&acc)[2][2][4][2], const pg8::Unit& u, int wr, int wc, int fr, int fq) const {
        const int row0 = u.pm * 256 + wr * 64 + fr, col0 = u.pn * 256 + wc * 32 + 8 * fq, br = u.z >> 1;
        u32x4 sb[8][2], tb[8][2];
#define EGA_LOAD(it) do { const int row_ = row0 + ((it) >> 2) * 128 + ((it) & 3) * 16; _Pragma("unroll") for (int bj = 0; bj < 2; ++bj) { const size_t off_ = (size_t)row_ * 1024 + col0 + 128 * bj; \
            sb[it][bj] = *(const u32x4*)(MG + off_); if (br > 0) tb[it][bj] = *(const u32x4*)(TMP + off_); } } while (0)
        EGA_LOAD(0);
#pragma unroll
        for (int it = 0; it < 8; ++it) { const int ai = it >> 2, m = it & 3; const int row = row0 + ai * 128 + m * 16; const float rs = EPI_RS(row);
            if (it + 1 < 8) EGA_LOAD(it + 1);
#pragma unroll
            for (int bj = 0; bj < 2; ++bj) { const size_t off = (size_t)row * 1024 + col0 + 128 * bj;
                f32x4 b0, b1; unpack8(sb[it][bj], b0, b1);
                f32x4 v0 = acc[ai][bj][m][0] * rs, v1 = acc[ai][bj][m][1] * rs;
#pragma unroll
                for (int j = 0; j < 4; ++j) { v0[j] = sigmoidf_(v0[j]) * b0[j]; v1[j] = sigmoidf_(v1[j]) * b1[j]; }
                if (br > 0) { f32x4 t0, t1; unpack8(tb[it][bj], t0, t1); v0 += t0; v1 += t1; }
                if (br < 3) *(u32x4*)(TMP + off) = pack8(v0, v1); else *(u32x4*)(MG + off) = pack8(v0, v1); } }
#undef EGA_LOAD
    }
};
struct EpiMerge2 {
    EpiStashB ES; EpiGateAcc EA;
    __device__ __forceinline__ void operator()(const f32x4 (&acc)[2][2][4][2], const pg8::Unit& u, int wr, int wc, int fr, int fq) const {
        if ((u.z & 1) == 0) ES(acc, u, wr, wc, fr, fq); else EA(acc, u, wr, wc, fr, fq);
    }
};
struct EpiResid {
    bf16_t* XB; float* ssq_out;
    __device__ __forceinline__ void operator()(const f32x4 (&acc)[2][2][4][2], const pg8::Unit& u, int wr, int wc, int fr, int fq) const {
        const int row0 = u.pm * 256 + wr * 64 + fr, col0 = u.pn * 256 + wc * 32 + 8 * fq;
        u32x4 xb[8][2];
#define ER_LOAD(it) do { const int row_ = row0 + ((it) >> 2) * 128 + ((it) & 3) * 16; _Pragma("unroll") for (int bj = 0; bj < 2; ++bj) xb[it][bj] = *(const u32x4*)(XB + (size_t)row_ * 1024 + col0 + 128 * bj); } while (0)
        ER_LOAD(0); ER_LOAD(1);
#pragma unroll
        for (int it = 0; it < 8; ++it) { const int ai = it >> 2, m = it & 3; const int row = row0 + ai * 128 + m * 16; float ss = 0.f;
            if (it + 2 < 8) ER_LOAD(it + 2);
#pragma unroll
            for (int bj = 0; bj < 2; ++bj) { const size_t off = (size_t)row * 1024 + col0 + 128 * bj;
                f32x4 x0, x1; unpack8(xb[it][bj], x0, x1);
                const f32x4 v0 = x0 + acc[ai][bj][m][0], v1 = x1 + acc[ai][bj][m][1];
                *(u32x4*)(XB + off) = pack8(v0, v1);
                ss += (v0[0] * v0[0] + v0[1] * v0[1]) + (v0[2] * v0[2] + v0[3] * v0[3]) + (v1[0] * v1[0] + v1[1] * v1[1]) + (v1[2] * v1[2] + v1[3] * v1[3]); }
            ss += __shfl_xor(ss, 16); ss += __shfl_xor(ss, 32);
            if (fq == 0) ssq_out[(size_t)row * 16 + u.pn * 4 + wc] = ss; }
#undef ER_LOAD
    }
};
struct EpiSwiGLU {
    const float* ssq; bf16_t* ACT; float zero_scale; LAS const float* rsl; int pm0;
    __device__ __forceinline__ void operator()(const f32x4 (&acc)[2][2][4][2], const pg8::Unit& u, int wr, int wc, int fr, int fq) const {
        const int row0 = u.pm * 256 + wr * 64 + fr, col0 = u.pn * 128 + wc * 32 + 8 * fq;
        EPI_ROWLOOP { const int row = row0 + ai * 128 + m * 16; const float rs = EPI_RS(row); f32x4 o[2];
#pragma unroll
            for (int n = 0; n < 2; ++n) { const f32x4 g = acc[ai][0][m][n] * rs, up = acc[ai][1][m][n] * rs;
#pragma unroll
                for (int j = 0; j < 4; ++j) o[n][j] = g[j] * sigmoidf_(g[j]) * up[j] * zero_scale; }
            *(u32x4*)(ACT + (size_t)row * DFF + col0) = pack8(o[0], o[1]); }
    }
};

#define ABL_FFN_SCALE(l) 1.0f
struct Args { const float* in[19]; float* out; unsigned char* ws; };

__device__ __forceinline__ int win_src_col(int nlog) {
    const int T = nlog >> 8, o = nlog & 255, bj = o >> 7, j = o & 127;
    if (T < 4) return nlog;
    if (T < 8) return 1024 + bj * 512 + 128 * (T - 4) + j;
    if (T < 10) return 2048 + (4 * (T - 8) + (j >> 5)) * 64 + 32 * bj + (j & 31);
    if (T == 10) { const int h = j >> 5; return (h < 2 ? 2560 + h * 64 : 2688 + (h - 2) * 64) + 32 * bj + (j & 31); }
    if (T < 13) return 2816 + 256 * (T - 11) + o;
    if (T < 17) return 3328 + bj * 512 + 128 * (T - 13) + j;
    return nlog;
}
__device__ __forceinline__ void tr_item(const float* W, int Nsrc, int k0, int scolA, int scolB, const float* gain, bf16_t* WT, int K, int drow, LAS float* scr, int lane) {
    const int c4 = lane & 15; const int sc = ((c4 >> 3) ? scolB : scolA) + 4 * (c4 & 7);
    f32x4 v[16];
#pragma unroll
    for (int i = 0; i < 16; ++i) v[i] = __builtin_nontemporal_load((const f32x4*)(W + (size_t)(k0 + 4 * i + (lane >> 4)) * Nsrc + sc));
#pragma unroll
    for (int i = 0; i < 16; ++i) { const int row = 4 * i + (lane >> 4); if (gain) v[i] = v[i] * gain[k0 + row];
        LAS float* d = scr + row * 65 + 4 * c4; d[0] = v[i][0]; d[1] = v[i][1]; d[2] = v[i][2]; d[3] = v[i][3]; }
    asm volatile("s_waitcnt lgkmcnt(0)" ::: "memory");
    const int c = lane & 7;
#pragma unroll
    for (int jj = 0; jj < 8; ++jj) { const int n = (lane >> 3) + 8 * jj; const LAS float* s = scr + (8 * c) * 65 + n;
        u32x4 o; o.x = cvt_pk_bf16(s[0], s[65]); o.y = cvt_pk_bf16(s[2 * 65], s[3 * 65]); o.z = cvt_pk_bf16(s[4 * 65], s[5 * 65]); o.w = cvt_pk_bf16(s[6 * 65], s[7 * 65]);
        *(u32x4*)(WT + (size_t)(drow + n) * K + k0 + 8 * c) = o; }
    asm volatile("s_waitcnt lgkmcnt(0)" ::: "memory");
}
__device__ __forceinline__ void prologue(const Args& a, LAS unsigned char* lds, int G) {
    int tid_ = threadIdx.x; asm volatile("" : "+v"(tid_));
    const int tid = tid_, lane = tid & 63, wave = __builtin_amdgcn_readfirstlane(tid >> 6);
    const int gw = blockIdx.x * NWAVES + wave, NGW = G * NWAVES;
    unsigned char* ws = a.ws;
    LAS float* scr = (LAS float*)(lds + wave * 16640);
    constexpr int I_IN = 16 * 132, I_BR = 512, I_OUT = 256, I_GU = 16 * 88, I_DN = 44 * 16, I_L = I_IN + I_BR + I_OUT + I_GU + I_DN;
    for (int it = gw; it < 2 * I_L; it += NGW) {
        const int l = it / I_L; int r = it % I_L;
        if (r < I_IN) { const int kb = r / 132, nb = r % 132, n0 = 64 * nb;
            tr_item(a.in[2] + (size_t)l * D * PROJ, PROJ, 64 * kb, win_src_col(n0), win_src_col(n0 + 32), a.in[1] + l * D, (bf16_t*)(ws + WS_WIN + l * WIN_L), D, n0, scr, lane); continue; } r -= I_IN;
        if (r < I_BR) { const int br = r >> 7, q = r & 127, kb = q >> 4, nb = q & 15;
            tr_item(a.in[13] + (size_t)(l * 4 + br) * 512 * D, D, 64 * kb, 64 * nb, 64 * nb + 32, nullptr, (bf16_t*)(ws + WS_WBR + l * WBR_L) + (size_t)br * 1024 * 512, 512, 64 * nb, scr, lane); continue; } r -= I_BR;
        if (r < I_OUT) { const int kb = r >> 4, nb = r & 15;
            tr_item(a.in[14] + (size_t)l * D * D, D, 64 * kb, 64 * nb, 64 * nb + 32, nullptr, (bf16_t*)(ws + WS_WOUT + l * WOUT_L), D, 64 * nb, scr, lane); continue; } r -= I_OUT;
        if (r < I_GU) { const int kb = r / 88, nb = r % 88, n0 = 64 * nb, T = n0 >> 8, o = n0 & 255, sc = (o >> 7) * DFF + 128 * T + (o & 127);
            tr_item(a.in[16] + (size_t)l * D * 2 * DFF, 2 * DFF, 64 * kb, sc, sc + 32, a.in[15] + l * D, (bf16_t*)(ws + WS_WGU + l * WGU_L), D, n0, scr, lane); continue; } r -= I_GU;
        { const int kb = r >> 4, nb = r & 15;
            tr_item(a.in[17] + (size_t)l * DFF * D, D, 64 * kb, 64 * nb, 64 * nb + 32, nullptr, (bf16_t*)(ws + WS_WDN + l * WDN_L), DFF, 64 * nb, scr, lane); }
    }
    float* ssq = (float*)(ws + WS_SSQ);
    for (int row = gw; row < M; row += NGW) {
        const f32x4* xr = (const f32x4*)(a.in[0] + (size_t)row * D) + lane; float s = 0.f; f32x4 v[4];
#pragma unroll
        for (int j = 0; j < 4; ++j) { v[j] = xr[64 * j]; s += (v[j][0] * v[j][0] + v[j][1] * v[j][1]) + (v[j][2] * v[j][2] + v[j][3] * v[j][3]); }
        s = wave_sum(s);
        u32x2* o = (u32x2*)((bf16_t*)(ws + WS_XB) + (size_t)row * D) + lane;
#pragma unroll
        for (int j = 0; j < 4; ++j) o[64 * j] = (u32x2){cvt_pk_bf16(v[j][0], v[j][1]), cvt_pk_bf16(v[j][2], v[j][3])};
        if (lane < 16) ssq[(size_t)row * 16 + lane] = lane == 0 ? s : 0.f;
    }
    { float* par = (float*)(ws + WS_PAR); const int gt = blockIdx.x * NTHREADS + tid, GT = G * NTHREADS;
#define CPY(dstoff, srcp, n) for (int i = gt; i < (n); i += GT) par[(dstoff) + i] = (srcp)[i]
      for (int l = 0; l < 2; ++l) { const int o = l * PAR_L;
          CPY(o + P_SGLNG, a.in[3] + l * 512, 512); CPY(o + P_SGLNB, a.in[4] + l * 512, 512); CPY(o + P_SGB, a.in[6] + l * 512, 512);
          CPY(o + P_CVB, a.in[8] + l * 512, 512); CPY(o + P_CVLNG, a.in[9] + l * 512, 512); CPY(o + P_CVLNB, a.in[10] + l * 512, 512);
          CPY(o + P_SCW, a.in[12] + l * 1536, 1536); CPY(o + P_SINK, a.in[11] + l * 8, 8); CPY(o + P_CVW, a.in[7] + l * 31 * 512, 31 * 512); }
      CPY(P_FINAL, a.in[18], 1024);
#undef CPY
    }
    for (int i = blockIdx.x * NTHREADS + tid; i < SEQ * 32; i += G * NTHREADS) { const int pos = i >> 5, f = i & 31;
        const double rev = (double)pos * INVF_REV[f]; const float fr = (float)(rev - floor(rev));
        ((float*)(ws + WS_ROPEC))[i] = __builtin_amdgcn_cosf(fr); ((float*)(ws + WS_ROPES))[i] = __builtin_amdgcn_sinf(fr); }
    for (int i = blockIdx.x * NTHREADS + tid; i < 2 * 4 * 128 * 128; i += G * NTHREADS) { const int s = i & 127, t = (i >> 7) & 127;
        ((bf16_t*)(ws + WS_SGWT))[i] = s <= t ? (bf16_t)(cvt_pk_bf16(a.in[5][i], 0.f) & 0xffffu) : (bf16_t)0; }
}

__device__ __forceinline__ void mixer_sg(unsigned char* ws, int l, LAS unsigned char* lds, int unit) {
    { size_t z_ = 0; asm volatile("" : "+s"(z_)); ws += z_; } int tid_ = threadIdx.x; asm volatile("" : "+v"(tid_));
    const float* par = (const float*)(ws + WS_PAR) + l * PAR_L;
    const int tid = tid_, lane = tid & 63, wave = __builtin_amdgcn_readfirstlane(tid >> 6);
    const int ck = unit >> 2, g = unit & 3, r0 = ck * 128;
    const bf16_t* ZA = (const bf16_t*)(ws + WS_ZA); bf16_t* YA = (bf16_t*)(ws + WS_YA);
    LAS bf16_t* vnT = (LAS bf16_t*)lds;
    const float* lng = par + P_SGLNG; const float* lnb = par + P_SGLNB;
    const f32x4 g0 = *(const f32x4*)(lng + 8 * lane), g1 = *(const f32x4*)(lng + 8 * lane + 4), b0 = *(const f32x4*)(lnb + 8 * lane), b1 = *(const f32x4*)(lnb + 8 * lane + 4);
    u32x4 raw[16];
#pragma unroll
    for (int i = 0; i < 16; ++i) raw[i] = *(const u32x4*)(ZA + (size_t)(r0 + wave + 8 * i) * 1024 + 512 + 8 * lane);
    const int fr = lane & 15, fq = lane >> 4, t0 = 16 * wave, nks = (wave >> 1) + 1;
    const bf16_t* W = (const bf16_t*)(ws + WS_SGWT) + (size_t)(l * 4 + g) * 16384 + (size_t)(t0 + fr) * 128 + 8 * fq;
    bf16x8 wf[4];
#pragma unroll
    for (int ks = 0; ks < 4; ++ks) wf[ks] = *(const bf16x8*)(W + 32 * (ks < nks ? ks : 0));
    const int tt = t0 + fr; const size_t orow = r0 + tt; const float bs = par[P_SGB + g * 128 + tt];
    u32x2 uu[8];
#pragma unroll
    for (int ct = 0; ct < 8; ++ct) uu[ct] = *(const u32x2*)(ZA + orow * 1024 + 128 * g + 16 * ct + 4 * fq);
#pragma unroll
    for (int i = 0; i < 16; ++i) { const int s = wave + 8 * i;
        f32x4 x0, x1; unpack8(raw[i], x0, x1);
        const float mean = wave_sum((x0[0] + x0[1]) + (x0[2] + x0[3]) + (x1[0] + x1[1]) + (x1[2] + x1[3])) * (1.0f / 512.0f);
        x0 -= mean; x1 -= mean;
        const float var = wave_sum((x0[0] * x0[0] + x0[1] * x0[1]) + (x0[2] * x0[2] + x0[3] * x0[3]) + (x1[0] * x1[0] + x1[1] * x1[1]) + (x1[2] * x1[2] + x1[3] * x1[3])) * (1.0f / 512.0f);
        const float rstd = __builtin_amdgcn_rsqf(var + EPS);
        if ((lane >> 4) == g) { const int c = 8 * (lane & 15); x0 = x0 * rstd * g0 + b0; x1 = x1 * rstd * g1 + b1;
            const unsigned p0 = cvt_pk_bf16(x0[0], x0[1]), p1 = cvt_pk_bf16(x0[2], x0[3]), p2 = cvt_pk_bf16(x1[0], x1[1]), p3 = cvt_pk_bf16(x1[2], x1[3]);
            LAS bf16_t* d = vnT + c * 136 + (s ^ (8 * (lane & 15)));
            d[0] = (bf16_t)p0; d[136] = (bf16_t)(p0 >> 16); d[2 * 136] = (bf16_t)p1; d[3 * 136] = (bf16_t)(p1 >> 16);
            d[4 * 136] = (bf16_t)p2; d[5 * 136] = (bf16_t)(p2 >> 16); d[6 * 136] = (bf16_t)p3; d[7 * 136] = (bf16_t)(p3 >> 16); }
    }
    __syncthreads();
    { f32x4 acc[8];
#pragma unroll
      for (int ct = 0; ct < 8; ++ct) acc[ct] = (f32x4){0.f, 0.f, 0.f, 0.f};
#pragma unroll
      for (int ks = 0; ks < 4; ++ks) if (ks < nks) {
#pragma unroll
          for (int ct = 0; ct < 8; ++ct) { const bf16x8 vf = *(const LAS bf16x8*)(vnT + (16 * ct + fr) * 136 + 8 * ((4 * ks + fq) ^ ((2 * ct + (fr >> 3)) & 15)));
              acc[ct] = __builtin_amdgcn_mfma_f32_16x16x32_bf16(vf, wf[ks], acc[ct], 0, 0, 0); }
      }
#pragma unroll
      for (int ct = 0; ct < 8; ++ct) { const int c = 128 * g + 16 * ct + 4 * fq;
          const float o0 = bf_lo(uu[ct].x) * (acc[ct][0] + bs), o1 = bf_hi(uu[ct].x) * (acc[ct][1] + bs), o2 = bf_lo(uu[ct].y) * (acc[ct][2] + bs), o3 = bf_hi(uu[ct].y) * (acc[ct][3] + bs);
          *(u32x2*)(YA + orow * 512 + c) = (u32x2){cvt_pk_bf16(o0, o1), cvt_pk_bf16(o2, o3)}; }
    }
    __syncthreads();
}
__device__ __forceinline__ void mixer_conv(unsigned char* ws, int l, LAS unsigned char* lds, int unit) {
    { size_t z_ = 0; asm volatile("" : "+s"(z_)); ws += z_; } int tid_ = threadIdx.x; asm volatile("" : "+v"(tid_));
    const float* par = (const float*)(ws + WS_PAR) + l * PAR_L;
    const int tid = tid_, lane = tid & 63, wave = tid >> 6;
    const int b = unit >> 6, tb = unit & 63, t0 = tb * 32; const size_t rbase = (size_t)b * SEQ;
    const bf16_t* GLU = (const bf16_t*)(ws + WS_GLU); bf16_t* YB = (bf16_t*)(ws + WS_YB);
    LAS bf16_t* in = (LAS bf16_t*)lds;
    LAS float* cv = (LAS float*)(lds + 65536);
    for (int i = tid; i < 62 * 64; i += NTHREADS) { const int r = i >> 6, ch = i & 63; const int t = t0 - 30 + r;
        u32x4 v = {0u, 0u, 0u, 0u}; if (t >= 0) v = *(const u32x4*)(GLU + (rbase + t) * 512 + 8 * ch);
        *(LAS u32x4*)(in + r * 512 + 8 * ch) = v; }
    __syncthreads();
    { const int c = tid; float w[31], x[62];
#pragma unroll
      for (int k = 0; k < 31; ++k) w[k] = par[P_CVW + k * 512 + c];
#pragma unroll
      for (int r = 0; r < 62; ++r) x[r] = bf1(in[r * 512 + c]);
      const float bias = par[P_CVB + c];
#pragma unroll
      for (int t = 0; t < 32; ++t) { float s = bias;
#pragma unroll
          for (int k = 0; k < 31; ++k) s += w[k] * x[t + k];
          cv[t * 512 + c] = s; } }
    __syncthreads();
    { const float* lng = par + P_CVLNG; const float* lnb = par + P_CVLNB;
      const f32x4 g0 = *(const f32x4*)(lng + 8 * lane), g1 = *(const f32x4*)(lng + 8 * lane + 4), b0 = *(const f32x4*)(lnb + 8 * lane), b1 = *(const f32x4*)(lnb + 8 * lane + 4);
      for (int t = wave; t < 32; t += NWAVES) {
          f32x4 x0 = *(const LAS f32x4*)(cv + t * 512 + 8 * lane), x1 = *(const LAS f32x4*)(cv + t * 512 + 8 * lane + 4);
          const float mean = wave_sum((x0[0] + x0[1]) + (x0[2] + x0[3]) + (x1[0] + x1[1]) + (x1[2] + x1[3])) * (1.0f / 512.0f);
          x0 -= mean; x1 -= mean;
          const float var = wave_sum((x0[0] * x0[0] + x0[1] * x0[1]) + (x0[2] * x0[2] + x0[3] * x0[3]) + (x1[0] * x1[0] + x1[1] * x1[1]) + (x1[2] * x1[2] + x1[3] * x1[3])) * (1.0f / 512.0f);
          const float rstd = __builtin_amdgcn_rsqf(var + EPS);
          x0 = x0 * rstd * g0 + b0; x1 = x1 * rstd * g1 + b1;
#pragma unroll
          for (int j = 0; j < 4; ++j) { x0[j] = x0[j] * sigmoidf_(x0[j]); x1[j] = x1[j] * sigmoidf_(x1[j]); }
          *(u32x4*)(YB + (rbase + t0 + t) * 512 + 8 * lane) = pack8(x0, x1); } }
    __syncthreads();
}
__device__ __forceinline__ void mixer_attn(unsigned char* ws, int l, LAS unsigned char* lds, int unit) {
    { size_t z_ = 0; asm volatile("" : "+s"(z_)); ws += z_; } int tid_ = threadIdx.x; asm volatile("" : "+v"(tid_));
    const float* par = (const float*)(ws + WS_PAR) + l * PAR_L;
    const int tid = tid_, lane = tid & 63, wave = __builtin_amdgcn_readfirstlane(tid >> 6), fr = lane & 15, fq = lane >> 4;
    const int kvh = unit & 1, blk = (unit >> 1) & 15, b = unit >> 5; const size_t rbase = (size_t)b * SEQ;
    bf16_t* Q = (bf16_t*)(ws + WS_Q); const bf16_t* K = (const bf16_t*)(ws + WS_K); const bf16_t* V = (const bf16_t*)(ws + WS_V);
    LAS bf16_t* Kl = (LAS bf16_t*)lds;
    LAS bf16_t* VT = (LAS bf16_t*)(lds + 36864);
    for (int i = tid; i < 256 * 8; i += NTHREADS) { const int r = i >> 3, ch = i & 7; const int t = (blk - 1) * 128 + r;
        u32x4 kv = {0u, 0u, 0u, 0u}, vv = {0u, 0u, 0u, 0u};
        if (t >= 0) { kv = *(const u32x4*)(K + (rbase + t) * 128 + kvh * 64 + 8 * ch); vv = *(const u32x4*)(V + (rbase + t) * 128 + kvh * 64 + 8 * ch); }
        *(LAS u32x4*)(Kl + r * 72 + 8 * ch) = kv;
        LAS bf16_t* d = VT + (8 * ch) * 264 + r;
        d[0] = (bf16_t)vv.x; d[264] = (bf16_t)(vv.x >> 16); d[2 * 264] = (bf16_t)vv.y; d[3 * 264] = (bf16_t)(vv.y >> 16);
        d[4 * 264] = (bf16_t)vv.z; d[5 * 264] = (bf16_t)(vv.z >> 16); d[6 * 264] = (bf16_t)vv.w; d[7 * 264] = (bf16_t)(vv.w >> 16); }
    __syncthreads();
    const int g = wave >> 1, head = kvh * 4 + g; const float sink = par[P_SINK + head];
    for (int it = 0; it < 2; ++it) {
        const int qs = 2 * (wave & 1) + it, qi0 = 32 * qs; const size_t qrow0 = rbase + blk * 128 + qi0;
        bf16x8 qf[2][2];
#pragma unroll
        for (int qt = 0; qt < 2; ++qt)
#pragma unroll
            for (int ks = 0; ks < 2; ++ks) qf[qt][ks] = *(const bf16x8*)(Q + (qrow0 + 16 * qt + fr) * 512 + head * 64 + 32 * ks + 8 * fq);
        f32x4 S[2][10];
#pragma unroll
        for (int qt = 0; qt < 2; ++qt)
#pragma unroll
            for (int kt = 0; kt < 10; ++kt) S[qt][kt] = (f32x4){0.f, 0.f, 0.f, 0.f};
#pragma unroll
        for (int kt = 0; kt < 10; ++kt)
#pragma unroll
            for (int ks = 0; ks < 2; ++ks) { const bf16x8 kf = *(const LAS bf16x8*)(Kl + (qi0 + 16 * kt + fr) * 72 + 32 * ks + 8 * fq);
#pragma unroll
                for (int qt = 0; qt < 2; ++qt) S[qt][kt] = __builtin_amdgcn_mfma_f32_16x16x32_bf16(kf, qf[qt][ks], S[qt][kt], 0, 0, 0); }
        bf16x8 pf[2][5];
#pragma unroll
        for (int qt = 0; qt < 2; ++qt) { const int qi = qi0 + 16 * qt + fr; float mx = sink;
#pragma unroll
            for (int kt = 0; kt < 10; ++kt)
#pragma unroll
                for (int j = 0; j < 4; ++j) { const int kb = qi0 + 16 * kt + 4 * fq + j; const bool valid = (kb > qi) && (kb <= qi + 128) && (blk > 0 || kb >= 128);
                    const float sv = valid ? S[qt][kt][j] : -INFINITY; S[qt][kt][j] = sv; mx = fmaxf(mx, sv); }
            mx = fmaxf(mx, __shfl_xor(mx, 16)); mx = fmaxf(mx, __shfl_xor(mx, 32));
            float sum = 0.f;
#pragma unroll
            for (int kt = 0; kt < 10; ++kt)
#pragma unroll
                for (int j = 0; j < 4; ++j) { const float p = __expf(S[qt][kt][j] - mx); S[qt][kt][j] = p; sum += p; }
            sum += __shfl_xor(sum, 16); sum += __shfl_xor(sum, 32);
            const float inv = 1.0f / (sum + __expf(sink - mx));
#pragma unroll
            for (int p = 0; p < 5; ++p) { const f32x4 a0 = S[qt][2 * p] * inv, a1 = S[qt][2 * p + 1] * inv; pf[qt][p] = __builtin_bit_cast(bf16x8, pack8(a0, a1)); }
        }
        f32x4 o[2][4];
#pragma unroll
        for (int qt = 0; qt < 2; ++qt)
#pragma unroll
            for (int dt = 0; dt < 4; ++dt) o[qt][dt] = (f32x4){0.f, 0.f, 0.f, 0.f};
#pragma unroll
        for (int p = 0; p < 5; ++p)
#pragma unroll
            for (int dt = 0; dt < 4; ++dt) { const LAS bf16_t* vp = VT + (16 * dt + fr) * 264 + qi0 + 32 * p + 4 * fq;
                const u32x2 lo = *(const LAS u32x2*)vp, hi = *(const LAS u32x2*)(vp + 16);
                const bf16x8 vf = __builtin_bit_cast(bf16x8, (u32x4){lo.x, lo.y, hi.x, hi.y});
#pragma unroll
                for (int qt = 0; qt < 2; ++qt) o[qt][dt] = __builtin_amdgcn_mfma_f32_16x16x32_bf16(vf, pf[qt][p], o[qt][dt], 0, 0, 0); }
#pragma unroll
        for (int qt = 0; qt < 2; ++qt)
#pragma unroll
            for (int dt = 0; dt < 4; ++dt) *(u32x2*)(Q + (qrow0 + 16 * qt + fr) * 512 + head * 64 + 16 * dt + 4 * fq) = (u32x2){cvt_pk_bf16(o[qt][dt][0], o[qt][dt][1]), cvt_pk_bf16(o[qt][dt][2], o[qt][dt][3])};
    }
    __syncthreads();
}
__device__ __forceinline__ void mixer_sc(unsigned char* ws, int l, int G) {
    { size_t z_ = 0; asm volatile("" : "+s"(z_)); ws += z_; } int tid_ = threadIdx.x; asm volatile("" : "+v"(tid_));
    bf16_t* BG = (bf16_t*)(ws + WS_BG); const bf16_t* CH = (const bf16_t*)(ws + WS_CH);
    const float* w = (const float*)(ws + WS_PAR) + l * PAR_L + P_SCW;
    for (int i = blockIdx.x * NTHREADS + tid_; i < (M / 8) * 64; i += G * NTHREADS) {
        const int row0 = 8 * (i >> 6), c = 8 * (i & 63), t0 = row0 & (SEQ - 1);
        u32x4 ch[10], bg[8];
#pragma unroll
        for (int r = 0; r < 10; ++r) { ch[r] = (u32x4){0u, 0u, 0u, 0u}; if (t0 - 2 + r >= 0) ch[r] = *(const u32x4*)(CH + (size_t)(row0 - 2 + r) * 512 + c); }
#pragma unroll
        for (int r = 0; r < 8; ++r) bg[r] = *(const u32x4*)(BG + (size_t)(row0 + r) * 512 + c);
        f32x4 wa[3], wb[3];
#pragma unroll
        for (int k = 0; k < 3; ++k) { wa[k] = *(const f32x4*)(w + k * 512 + c); wb[k] = *(const f32x4*)(w + k * 512 + c + 4); }
#pragma unroll
        for (int r = 0; r < 8; ++r) { f32x4 a0 = {0.f, 0.f, 0.f, 0.f}, a1 = a0;
#pragma unroll
            for (int k = 0; k < 3; ++k) { f32x4 x0, x1; unpack8(ch[r + k], x0, x1); a0 += x0 * wa[k]; a1 += x1 * wb[k]; }
            f32x4 g0, g1; unpack8(bg[r], g0, g1);
            *(u32x4*)(BG + (size_t)(row0 + r) * 512 + c) = pack8(g0 * a0, g1 * a1); }
    }
}

#define RLX_AGENT __ATOMIC_RELAXED, __HIP_MEMORY_SCOPE_AGENT
#define XB_TMO      128
#define XB_XCNT(j)  (256  + 64 * (j))
#define XB_XSUB(j)  (1280 + 64 * (j))
#define XB_XGEN(j)  (2304 + 64 * (j))
#define XB_TOP      3328
#define XB_TOPGEN   3392
#define XCD_BAR_WORDS 3456
#define XB_SPIN_CAP (1u << 18)

__device__ __forceinline__ unsigned xb_ld(unsigned* p)              { return __hip_atomic_load(p, __ATOMIC_RELAXED, __HIP_MEMORY_SCOPE_AGENT); }
__device__ __forceinline__ unsigned xb_add(unsigned* p, unsigned v) { return __hip_atomic_fetch_add(p, v, __ATOMIC_RELAXED, __HIP_MEMORY_SCOPE_AGENT); }
__device__ __forceinline__ unsigned xb_xcc_id() { return (unsigned)__builtin_amdgcn_s_getreg((3 << 11) | 20) & 0xFu; }
#define XB_SPIN(cond, bar) do { unsigned _sp = 0; while (cond) { __builtin_amdgcn_s_sleep(1); \
    if ((++_sp & 255u) == 0u) { if (xb_ld(&(bar)[XB_TMO])) break; if (_sp > XB_SPIN_CAP) { atomicAdd(&(bar)[XB_TMO], 1u); break; } } } } while (0)

struct XcdBarrier {
    unsigned* bar; unsigned x;
    volatile LAS unsigned* st;
};

__device__ __forceinline__ XcdBarrier xcd_barrier_post(unsigned* bar, volatile LAS unsigned* st) {
    XcdBarrier b; b.bar = bar; b.x = xb_xcc_id(); b.st = st;
    if (threadIdx.x == 0) (void)xb_add(&bar[XB_XCNT(b.x)], 1u);
    return b;
}
__device__ __forceinline__ void xcd_barrier_complete(unsigned* bar, unsigned x, unsigned& nloc, unsigned& nx) {
    const unsigned G = gridDim.x * gridDim.y * gridDim.z;
    unsigned sum, cnt, mine, sp = 0u;
    for (;;) {
        sum = 0u; cnt = 0u; mine = 0u;
#pragma unroll
        for (unsigned j = 0; j < 16; ++j) { const unsigned c = xb_ld(&bar[XB_XCNT(j)]); sum += c; cnt += (c > 0u) ? 1u : 0u; mine = (j == x) ? c : mine; }
        if (sum == G) break;
        __builtin_amdgcn_s_sleep(1);
        if ((++sp & 255u) == 0u) { if (xb_ld(&bar[XB_TMO])) break; if (sp > XB_SPIN_CAP) { atomicAdd(&bar[XB_TMO], 1u); break; } }
    }
    nloc = mine > 0u ? mine : 1u; nx = cnt > 0u ? cnt : 1u;
}

__device__ __forceinline__ void xcd_barrier(const XcdBarrier& b) {
    asm volatile("s_waitcnt vmcnt(0)" ::: "memory");
    __syncthreads();
    if (threadIdx.x == 0) {
        unsigned* bar = b.bar;
        __builtin_amdgcn_s_waitcnt(0);
        unsigned nloc = b.st[0], nx = b.st[1];
        if (nloc == 0u) { xcd_barrier_complete(bar, b.x, nloc, nx); b.st[0] = nloc; b.st[1] = nx; }
        const unsigned old = xb_add(&bar[XB_XSUB(b.x)], 1u);
        const unsigned gen = old / nloc;
        if (old + 1u == (gen + 1u) * nloc) {
            __builtin_amdgcn_fence(__ATOMIC_RELEASE, "agent");
            asm volatile("s_waitcnt vmcnt(0)" ::: "memory");
            const unsigned og = xb_add(&bar[XB_TOP], 1u);
            const unsigned tg = og / nx;
            if (og + 1u == (tg + 1u) * nx) xb_add(&bar[XB_TOPGEN], 1u);
            else XB_SPIN(xb_ld(&bar[XB_TOPGEN]) == tg, bar);
            __builtin_amdgcn_fence(__ATOMIC_ACQUIRE, "agent");
            xb_add(&bar[XB_XGEN(b.x)], 1u);
            asm volatile("s_waitcnt vmcnt(0)" ::: "memory");
        } else {
            XB_SPIN(xb_ld(&bar[XB_XGEN(b.x)]) == gen, bar);
            __builtin_amdgcn_fence(__ATOMIC_ACQUIRE, "agent");
            asm volatile("s_waitcnt vmcnt(0)" ::: "memory");
        }
    }
    __syncthreads();
}


__device__ __forceinline__ void stage_rs(LAS unsigned char* lds, const float* ssq, int pm) {
    int tid_ = threadIdx.x; asm volatile("" : "+v"(tid_));
    if (tid_ < 256 && pm >= 0) ((LAS float*)(lds + RSL_OFF))[tid_] = row_rs(ssq, pm * 256 + tid_);
    __syncthreads();
}
#define GRID_SYNC() do { XcdBarrier xb_; xb_.bar = (unsigned*)(ws + WS_BAR); xb_.x = xb_xcc_id(); xb_.st = (volatile LAS unsigned*)(lds + MISC_OFF); xcd_barrier(xb_); } while (0)
__global__ void __launch_bounds__(NTHREADS, 2) fwd_megakernel(Args a) {
    extern __shared__ __attribute__((aligned(16))) unsigned char lds_raw[];
    LAS unsigned char* lds = (LAS unsigned char*)lds_raw;
    cg::grid_group grid = cg::this_grid();
    const int G = gridDim.x, c = blockIdx.x;
    unsigned char* ws = a.ws;
    float* ssq = (float*)(ws + WS_SSQ);

    { volatile LAS unsigned* misc = (volatile LAS unsigned*)(lds + MISC_OFF); if (threadIdx.x < 16) misc[threadIdx.x] = 0u; }
    __syncthreads();
    grid.sync();
    (void)xcd_barrier_post((unsigned*)(ws + WS_BAR), (volatile LAS unsigned*)(lds + MISC_OFF));
    prologue(a, lds, G);
    GRID_SYNC();

    for (int l = 0; l < 2; ++l) {
        { size_t z_ = 0; asm volatile("" : "+s"(z_)); ws += z_; } ssq = (float*)(ws + WS_SSQ);
        const float* ssq_mix = ssq + (size_t)(2 * l) * M * 16;
        { pg8::SchedGrid S; S.nM = 64; S.nN = 17; S.nwg = 64 * 17; S.G = G; S.c = c; S.A = (const char*)(ws + WS_XB); S.B = (const char*)(ws + WS_WIN + l * WIN_L); S.lda2 = 2048; S.ldb2 = 2048; S.nt = 16;
          int pm0 = -1; { pg8::Unit u0; if (S.next(0, u0)) pm0 = u0.pm; } stage_rs(lds, ssq_mix, pm0);
          EpiInProj E{ssq_mix, ws, (LAS const float*)(lds + RSL_OFF), pm0};
          pg8::gemm_phase<EpiInProj, pg8::SchedGrid, true>(lds, S, E);
        }
        GRID_SYNC(); { size_t z_ = 0; asm volatile("" : "+s"(z_)); ws += z_; }
        for (int u = c; u < 512; u += G) mixer_sg(ws, l, lds, u);
        for (int u = c; u < 512; u += G) mixer_conv(ws, l, lds, u);
        for (int u = c; u < 256; u += G) mixer_attn(ws, l, lds, u);
        mixer_sc(ws, l, G);
        GRID_SYNC(); { size_t z_ = 0; asm volatile("" : "+s"(z_)); ws += z_; } ssq = (float*)(ws + WS_SSQ);
        { pg8::SchedMerge S; S.G = G; S.c = c; S.ws = (const char*)ws; S.WG = (const char*)(ws + WS_WIN + l * WIN_L) + (size_t)NLOG1 * 2048;
          S.WBR = (const char*)(ws + WS_WBR + l * WBR_L);
          S.swap = 1; int pm0 = -1; { pg8::Unit u0; if (S.next(0, u0)) pm0 = u0.pm; } stage_rs(lds, ssq_mix, pm0);
          EpiStashB ES{(bf16_t*)(ws + WS_MG)}; EpiGateAcc EA{ssq_mix, (bf16_t*)(ws + WS_MG), (bf16_t*)(ws + WS_TMP), (LAS const float*)(lds + RSL_OFF), pm0};
          EpiMerge2 E2{ES, EA};
          pg8::gemm_phase<EpiMerge2, pg8::SchedMerge, true>(lds, S, E2);
        }
        GRID_SYNC(); { size_t z_ = 0; asm volatile("" : "+s"(z_)); ws += z_; } ssq = (float*)(ws + WS_SSQ);
        { pg8::SchedGrid S; S.nM = 64; S.nN = 4; S.nwg = 256; S.G = G; S.c = c; S.A = (const char*)(ws + WS_MG); S.B = (const char*)(ws + WS_WOUT + l * WOUT_L); S.lda2 = 2048; S.ldb2 = 2048; S.nt = 16;
          EpiResid E{(bf16_t*)(ws + WS_XB), ssq + (size_t)(2 * l + 1) * M * 16};
          pg8::gemm_phase<EpiResid, pg8::SchedGrid, false>(lds, S, E); }
        GRID_SYNC(); { size_t z_ = 0; asm volatile("" : "+s"(z_)); ws += z_; } ssq = (float*)(ws + WS_SSQ);
        { pg8::SchedGrid S; S.nM = 64; S.nN = 22; S.nwg = 64 * 22; S.G = G; S.c = c; S.A = (const char*)(ws + WS_XB); S.B = (const char*)(ws + WS_WGU + l * WGU_L); S.lda2 = 2048; S.ldb2 = 2048; S.nt = 16;
          int pm0 = -1; { pg8::Unit u0; if (S.next(0, u0)) pm0 = u0.pm; } stage_rs(lds, ssq + (size_t)(2 * l + 1) * M * 16, pm0);
          EpiSwiGLU E{ssq + (size_t)(2 * l + 1) * M * 16, (bf16_t*)(ws + WS_ACT), ABL_FFN_SCALE(l), (LAS const float*)(lds + RSL_OFF), pm0};
          pg8::gemm_phase<EpiSwiGLU, pg8::SchedGrid, true>(lds, S, E);
        }
        GRID_SYNC(); { size_t z_ = 0; asm volatile("" : "+s"(z_)); ws += z_; } ssq = (float*)(ws + WS_SSQ);
        { pg8::SchedGrid S; S.nM = 64; S.nN = 4; S.nwg = 256; S.G = G; S.c = c; S.A = (const char*)(ws + WS_ACT); S.B = (const char*)(ws + WS_WDN + l * WDN_L); S.lda2 = DFF * 2; S.ldb2 = DFF * 2; S.nt = DFF / 64;
          EpiResid E{(bf16_t*)(ws + WS_XB), ssq + (size_t)(2 * l + 2) * M * 16};
          pg8::gemm_phase<EpiResid, pg8::SchedGrid, false>(lds, S, E); }
        GRID_SYNC();
    }
    { { size_t z_ = 0; asm volatile("" : "+s"(z_)); ws += z_; } int tid_ = threadIdx.x; asm volatile("" : "+v"(tid_));
      const int lane = tid_ & 63, gw = c * NWAVES + (tid_ >> 6), NGW = G * NWAVES; const float* gf = (const float*)(ws + WS_PAR) + P_FINAL; const float* sq = (const float*)(ws + WS_SSQ) + (size_t)4 * M * 16;
      const bf16_t* XBp = (const bf16_t*)(ws + WS_XB);
      for (int row = gw; row < M; row += 2 * NGW) { const int row2 = row + NGW;
          u32x4 ra_[2], rb_[2];
#pragma unroll
          for (int j = 0; j < 2; ++j) { ra_[j] = *(const u32x4*)(XBp + (size_t)row * D + 512 * j + 8 * lane); rb_[j] = *(const u32x4*)(XBp + (size_t)row2 * D + 512 * j + 8 * lane); }
          const float ra = row_rs(sq, row), rb = row_rs(sq, row2);
#pragma unroll
          for (int j = 0; j < 2; ++j) { const f32x4 g0 = *(const f32x4*)(gf + 512 * j + 8 * lane), g1 = *(const f32x4*)(gf + 512 * j + 8 * lane + 4);
              f32x4 x0, x1; unpack8(ra_[j], x0, x1); float* oa = a.out + (size_t)row * D + 512 * j + 8 * lane; *(f32x4*)oa = x0 * ra * g0; *(f32x4*)(oa + 4) = x1 * ra * g1;
              unpack8(rb_[j], x0, x1); float* ob = a.out + (size_t)row2 * D + 512 * j + 8 * lane; *(f32x4*)ob = x0 * rb * g0; *(f32x4*)(ob + 4) = x1 * rb * g1; } } }
}

extern "C" void kernel_launch(void* const* d_in, const int* in_sizes, int n_in, void* d_out, int out_size, void* d_ws, size_t ws_size, hipStream_t stream) {
    static int grid = 0;
    if (grid == 0) {
        if (n_in != 19 || out_size != M * D || ws_size < WS_END) { fprintf(stderr, "kernel_launch: unexpected shapes (n_in %d out %d ws %zu)\n", n_in, out_size, ws_size); grid = -1; return; }
        int dev = 0, cus = 0, per_cu = 0;
        if (hipGetDevice(&dev) != hipSuccess || hipDeviceGetAttribute(&cus, hipDeviceAttributeMultiprocessorCount, dev) != hipSuccess) { grid = -1; return; }
        if (hipFuncSetAttribute((const void*)fwd_megakernel, hipFuncAttributeMaxDynamicSharedMemorySize, LDS_BYTES) != hipSuccess) { fprintf(stderr, "kernel_launch: hipFuncSetAttribute failed\n"); grid = -1; return; }
        if (hipOccupancyMaxActiveBlocksPerMultiprocessor(&per_cu, (const void*)fwd_megakernel, NTHREADS, LDS_BYTES) != hipSuccess || per_cu < 1) { fprintf(stderr, "kernel_launch: occupancy query says %d\n", per_cu); per_cu = 1; }
        (void)hipGetLastError();
        grid = cus * 1;
    }
    if (grid < 0) return;
    if (hipMemsetAsync((char*)d_ws + WS_BAR, 0, 16384, stream) != hipSuccess) { fprintf(stderr, "kernel_launch: memset failed\n"); return; }
    Args a{};
    for (int i = 0; i < 19; ++i) a.in[i] = (const float*)d_in[i];
    a.out = (float*)d_out; a.ws = (unsigned char*)d_ws;
    void* args[] = {&a};
    hipError_t e = hipLaunchCooperativeKernel((const void*)fwd_megakernel, dim3(grid), dim3(NTHREADS), args, LDS_BYTES, stream);
    if (e != hipSuccess) fprintf(stderr, "cooperative launch failed: %s (grid %d)\n", hipGetErrorString(e), grid);
}
```

```cpp
#include <hip/hip_runtime.h>
#include <hip/hip_cooperative_groups.h>
#include <cstdio>
#include <cstdint>
namespace cg = cooperative_groups;

#define LAS __attribute__((address_space(3)))
typedef unsigned short bf16_t;
typedef short bf16x8 __attribute__((ext_vector_type(8)));
typedef float f32x4 __attribute__((ext_vector_type(4)));
typedef float f32x2 __attribute__((ext_vector_type(2)));
typedef unsigned u32x4 __attribute__((ext_vector_type(4)));
typedef unsigned u32x2 __attribute__((ext_vector_type(2)));

constexpr int M = 16384, D = 1024, SEQ = 2048, NBATCH = 8, DFF = 2816, PROJ = 8448, NLOG1 = 4352  ;
constexpr float EPS = 1e-6f;
constexpr int NTHREADS = 512, NWAVES = 8;
constexpr int LDS_BYTES = 147456;

constexpr size_t MiB = 1u << 20;
constexpr size_t WS_SSQ = 248 * (size_t)(1u << 20);
constexpr size_t WS_PAR = 512 * 1024;
constexpr int PAR_L = 24576, P_SGLNG = 0, P_SGLNB = 512, P_SGB = 1024, P_CVB = 1536, P_CVLNG = 2048, P_CVLNB = 2560, P_SCW = 3072, P_SINK = 4608, P_CVW = 4672, P_FINAL = 2 * PAR_L;
constexpr size_t WS_PTRS = 740 * 1024;
constexpr size_t WS_BAR = 768 * 1024;
constexpr int MISC_OFF = 147200;
constexpr size_t WS_ROPEC = 1 * MiB, WS_ROPES = 1 * MiB + 256 * 1024;
constexpr size_t WS_SGWT = 1 * MiB + 512 * 1024;
constexpr size_t WS_WIN = 2 * MiB, WIN_L = (size_t)PROJ * D * 2;
constexpr size_t WS_WBR = 35 * MiB, WBR_L = 4 * MiB;
constexpr size_t WS_WOUT = 43 * MiB, WOUT_L = 2 * MiB;
constexpr size_t WS_WGU = 47 * MiB, WGU_L = 11 * MiB;
constexpr size_t WS_WDN = 69 * MiB, WDN_L = (size_t)D * DFF * 2;
constexpr size_t WS_XB = 80 * MiB;
constexpr size_t WS_ZA = 112 * MiB;
constexpr size_t WS_MG = WS_ZA;
constexpr size_t WS_GLU = 144 * MiB;
constexpr size_t WS_CH = 160 * MiB;
constexpr size_t WS_TMP = WS_GLU;
constexpr size_t WS_Q = 176 * MiB;
constexpr size_t WS_BG = 192 * MiB;
constexpr size_t WS_K = 208 * MiB, WS_V = 212 * MiB;
constexpr size_t WS_YA = 216 * MiB, WS_YB = 232 * MiB;
constexpr size_t WS_ACT = 112 * MiB;
constexpr size_t WS_END = 254 * MiB;

__device__ const double INVF_REV[32] = {0.15915494309189535, 0.11934937021124886, 0.08949940160889101, 0.06711508300522726, 0.050329212104487035, 0.03774158471741977, 0.0283021958306234, 0.02122365276477766, 0.015915494309189534, 0.011934937021124886, 0.008949940160889102, 0.006711508300522725, 0.005032921210448704, 0.003774158471741977, 0.00283021958306234, 0.0021223652764777662, 0.0015915494309189536, 0.0011934937021124885, 0.0008949940160889102, 0.0006711508300522726, 0.0005032921210448703, 0.00037741584717419774, 0.00028302195830623395, 0.0002122365276477766, 0.00015915494309189535, 0.00011934937021124886, 8.949940160889102e-05, 6.711508300522725e-05, 5.0329212104487035e-05, 3.774158471741978e-05, 2.8302195830623396e-05, 2.122365276477766e-05};

__device__ __forceinline__ unsigned cvt_pk_bf16(float lo, float hi) { unsigned r; asm volatile("v_cvt_pk_bf16_f32 %0, %1, %2" : "=v"(r) : "v"(lo), "v"(hi)); return r; }
__device__ __forceinline__ float bf_lo(unsigned u) { return __builtin_bit_cast(float, u << 16); }
__device__ __forceinline__ float bf_hi(unsigned u) { return __builtin_bit_cast(float, u & 0xffff0000u); }
__device__ __forceinline__ float bf1(bf16_t h) { return __builtin_bit_cast(float, ((unsigned)h) << 16); }
__device__ __forceinline__ float sigmoidf_(float x) { return __builtin_amdgcn_rcpf(1.0f + __expf(-x)); }
template <int CTRL, int ROW_MASK> __device__ __forceinline__ float dpp_mov(float v) {
    return __builtin_bit_cast(float, __builtin_amdgcn_update_dpp(0, __builtin_bit_cast(int, v), CTRL, ROW_MASK, 0xf, true));
}
__device__ __forceinline__ float wave_sum(float v) {
    v += dpp_mov<0xB1, 0xf>(v);
    v += dpp_mov<0x4E, 0xf>(v);
    v += dpp_mov<0x141, 0xf>(v);
    v += dpp_mov<0x140, 0xf>(v);
    v += dpp_mov<0x142, 0xa>(v);
    v += dpp_mov<0x143, 0xc>(v);
    return __builtin_bit_cast(float, __builtin_amdgcn_readlane(__builtin_bit_cast(int, v), 63));
}
__device__ __forceinline__ f32x2 gelu_pk(f32x2 v) {
    const f32x2 av = __builtin_elementwise_abs(v), d = av * 0.2316418882f + 1.0f;
    f32x2 t; t.x = __builtin_amdgcn_rcpf(d.x); t.y = __builtin_amdgcn_rcpf(d.y);
    f32x2 q = t * 0.5307027145f + (-0.7265760135f); q = q * t + 0.7107068705f; q = q * t + (-0.142248368f); q = q * t + 0.127414796f; q = q * t;
    const f32x2 s = (v * v) * (-0.72134752044f);
    f32x2 e; e.x = __builtin_amdgcn_exp2f(s.x); e.y = __builtin_amdgcn_exp2f(s.y);
    const f32x2 m = v * (q * e), r = v - m;
    f32x2 o; o.x = v.x < 0.f ? m.x : r.x; o.y = v.y < 0.f ? m.y : r.y; return o;
}
__device__ __forceinline__ u32x4 pack8(f32x4 a, f32x4 b) { u32x4 w; w.x = cvt_pk_bf16(a[0], a[1]); w.y = cvt_pk_bf16(a[2], a[3]); w.z = cvt_pk_bf16(b[0], b[1]); w.w = cvt_pk_bf16(b[2], b[3]); return w; }
__device__ __forceinline__ void unpack8(u32x4 w, f32x4& a, f32x4& b) { a = (f32x4){bf_lo(w.x), bf_hi(w.x), bf_lo(w.y), bf_hi(w.y)}; b = (f32x4){bf_lo(w.z), bf_hi(w.z), bf_lo(w.w), bf_hi(w.w)}; }

namespace pg8 {
constexpr int BM = 256, BK = 64, HALF = 128, HTB = HALF * BK * 2, STAGE_BYTES = 8 * HTB, NXCD = 8, WGM = 8;
__host__ __device__ __forceinline__ int lds_byte(int r, int c) { const int st = (r >> 4) * 2 + (c >> 5), rr = r & 15, cc = c & 31, ob = rr * 64 + cc * 2; return st * 1024 + (ob ^ (((ob >> 9) & 1) << 5)); }
__host__ __device__ __forceinline__ void stage_rc(int b, int& R, int& C) { const int st = b / 1024, sb = b % 1024, swz = sb ^ (((sb >> 9) & 1) << 5); R = (st >> 1) * 16 + swz / 64; C = (st & 1) * 32 + (swz % 64) / 2; }
__host__ __device__ __forceinline__ int perm32(int rho) { const int n = rho >> 4, i = rho & 15; return 8 * (i >> 2) + 4 * n + (i & 3); }

struct Unit { const char* A; const char* B; int lda2, ldb2, nt, pm, pn, z; };

__device__ __forceinline__ void tile_of(int L, int nM, int nN, int& pm, int& pn) {
    const int nwg = nM * nN; int wgid = L; { const int q = nwg / NXCD, r = nwg % NXCD, xcd = wgid % NXCD, off = wgid / NXCD; wgid = (xcd < r ? xcd * (q + 1) : r * (q + 1) + (xcd - r) * q) + off; }
    const int nig = WGM * nN, gid = wgid / nig, fm = gid * WGM, gsz = (nM - fm) < WGM ? (nM - fm) : WGM;
    pm = fm + ((wgid % nig) % gsz); pn = (wgid % nig) / gsz;
}
struct SchedGrid {
    static constexpr bool VARLD = false;
    int nM, nN, nwg, G, c; const char* A; const char* B; int lda2, ldb2, nt;
    __device__ __forceinline__ bool next(int i, Unit& u) const {
        const long L = (long)i * G + c; if (L >= nwg) return false;
        tile_of((int)L, nM, nN, u.pm, u.pn); u.z = 0;
        u.A = A + (size_t)u.pm * 256 * lda2; u.B = B + (size_t)u.pn * 256 * ldb2; u.lda2 = lda2; u.ldb2 = ldb2; u.nt = nt; return true;
    }
};
struct SchedMerge {
    static constexpr bool VARLD = true;
    int G, c; const char* ws; const char* WG  ; const char* WBR; int swap;
    __device__ __forceinline__ bool next(int i, Unit& u) const {
        const int ti = i >> 3, sub = i & 7; const long L = (long)ti * G + c; if (L >= 256) return false;
        tile_of((int)L, 64, 4, u.pm, u.pn); u.z = sub; const int br = sub >> 1;
        if (((sub & 1) ^ swap) == 0) { u.A = ws + WS_XB + (size_t)u.pm * 256 * 2048; u.lda2 = 2048; u.B = WG + (size_t)(br * 1024 + u.pn * 256) * 2048; u.ldb2 = 2048; u.nt = 16; }
        else { const size_t yo = br == 0 ? WS_YA : br == 1 ? WS_YB : br == 2 ? WS_Q : WS_BG;
               u.A = ws + yo + (size_t)u.pm * 256 * 1024; u.lda2 = 1024; u.B = WBR + (size_t)br * (1024 * 512 * 2) + (size_t)u.pn * 256 * 1024; u.ldb2 = 1024; u.nt = 8; }
        return true;
    }
};

struct SchedOne {
    static constexpr bool VARLD = false;
    SchedMerge M; int i0;
    __device__ __forceinline__ bool next(int i, Unit& u) const { if (i != 0) return false; return M.next(i0, u); }
};
struct SchedOneG {
    static constexpr bool VARLD = false;
    SchedGrid S; int i0;
    __device__ __forceinline__ bool next(int i, Unit& u) const { if (i != 0) return false; return S.next(i0, u); }
};
template <class Epi, class Sched, bool ALIGN_EPI>
__device__ __forceinline__ void gemm_phase(LAS unsigned char* lds, const Sched& S, const Epi& E) {
    int tid_ = threadIdx.x; asm volatile("" : "+v"(tid_));
    const int tid = tid_, wid = __builtin_amdgcn_readfirstlane(tid >> 6), lane = tid & 63, wr = wid >> 2, wc = wid & 3, fr = lane & 15, fq = lane >> 4;
    unsigned rA[2], rB[2], cc2[2];
#pragma unroll
    for (int i = 0; i < 2; ++i) { int R, C; stage_rc(tid * 16 + i * 8192, R, C); rA[i] = (unsigned)R; rB[i] = (unsigned)((R & ~31) + perm32(R & 31)); cc2[i] = (unsigned)C * 2u; }
    const size_t kstep = (size_t)(BK * 2);
    const unsigned ldsw = (unsigned)wid * 1024u;
    const int aoff = lds_byte(wr * 64 + fr, fq * 8), boff = lds_byte(wc * 32 + fr, fq * 8);
#define PG8_SA(b, h) (((b) * 2 + (h)) * HTB)
#define PG8_SB(b, h) ((4 + (b) * 2 + (h)) * HTB)
#define PG8_STAGE(bufoff, gbase, voff) do { _Pragma("unroll") for (int _i = 0; _i < 2; ++_i) \
        __builtin_amdgcn_global_load_lds((const unsigned*)((const char*)(gbase) + (voff)[_i]), (LAS unsigned*)(lds + (bufoff) + ldsw + _i * 8192), 16, 0, 0); } while (0)
#define PG8_LDA(dst, b, h) do { _Pragma("unroll") for (int m = 0; m < 4; ++m) _Pragma("unroll") for (int k = 0; k < 2; ++k) dst[m][k] = *(const LAS bf16x8*)(lds + PG8_SA(b, h) + aoff + m * 2048 + k * 1024); } while (0)
#define PG8_LDB(dst, b, h) do { _Pragma("unroll") for (int n = 0; n < 2; ++n) _Pragma("unroll") for (int k = 0; k < 2; ++k) dst[n][k] = *(const LAS bf16x8*)(lds + PG8_SB(b, h) + boff + n * 2048 + k * 1024); } while (0)
#define PG8_MMA(ai, bj, At, Bt) do { __builtin_amdgcn_s_setprio(1); _Pragma("unroll") for (int m = 0; m < 4; ++m) _Pragma("unroll") for (int n = 0; n < 2; ++n) _Pragma("unroll") for (int k = 0; k < 2; ++k) \
        acc[ai][bj][m][n] = __builtin_amdgcn_mfma_f32_16x16x32_bf16(Bt[n][k], At[m][k], acc[ai][bj][m][n], 0, 0, 0); __builtin_amdgcn_s_setprio(0); } while (0)
#define PG8_WAIT_V(n) asm volatile("s_waitcnt vmcnt(" #n ")" ::: "memory")
#define PG8_WAIT_L(n) asm volatile("s_waitcnt lgkmcnt(" #n ")" ::: "memory")
#define PG8_BAR __builtin_amdgcn_s_barrier()
#define PG8_SCHED __builtin_amdgcn_sched_barrier(0)
    Unit cur, nxt; int ui = 0;
    if (!S.next(0, cur)) return;
    f32x4 acc[2][2][4][2];
#pragma unroll
    for (int a = 0; a < 2; ++a)
#pragma unroll
        for (int b = 0; b < 2; ++b)
#pragma unroll
            for (int m = 0; m < 4; ++m)
#pragma unroll
                for (int n = 0; n < 2; ++n) acc[a][b][m][n] = (f32x4){0.f, 0.f, 0.f, 0.f};
    bf16x8 At[4][2], B0[2][2], B1[2][2];
    unsigned voffA[2], voffB[2];
#pragma unroll
    for (int i = 0; i < 2; ++i) { voffA[i] = rA[i] * (unsigned)cur.lda2 + cc2[i]; voffB[i] = rB[i] * (unsigned)cur.ldb2 + cc2[i]; }
    const char* cA = cur.A; const char* cB = cur.B;
    unsigned hA = (unsigned)HALF * cur.lda2, hB = (unsigned)HALF * cur.ldb2;
    PG8_STAGE(PG8_SB(0, 0), cB, voffB); PG8_STAGE(PG8_SB(0, 1), cB + hB, voffB); PG8_STAGE(PG8_SA(0, 0), cA, voffA); PG8_STAGE(PG8_SA(0, 1), cA + hA, voffA);
    if (wr == 1) PG8_BAR;
    PG8_WAIT_V(2); PG8_BAR;
    PG8_STAGE(PG8_SB(1, 0), cB + kstep, voffB); PG8_STAGE(PG8_SA(1, 0), cA + kstep, voffA); PG8_STAGE(PG8_SB(1, 1), cB + hB + kstep, voffB);
    PG8_WAIT_V(6); PG8_BAR;
    for (;;) {
        const bool has_next = S.next(ui + 1, nxt);
        if (!has_next) nxt = cur;
        unsigned voffAn[2], voffBn[2];
#pragma unroll
        for (int i = 0; i < 2; ++i) { if constexpr (Sched::VARLD) { voffAn[i] = rA[i] * (unsigned)nxt.lda2 + cc2[i]; voffBn[i] = rB[i] * (unsigned)nxt.ldb2 + cc2[i]; } else { voffAn[i] = voffA[i]; voffBn[i] = voffB[i]; } }
        const char* nA = nxt.A; const char* nB = nxt.B;
        const unsigned hAn = Sched::VARLD ? (unsigned)HALF * nxt.lda2 : hA, hBn = Sched::VARLD ? (unsigned)HALF * nxt.ldb2 : hB;
        const int nt = cur.nt;
        for (int t = 0; t < nt; t += 2) {
            const bool last = (t == nt - 2);
            const char* a1 = cA + (size_t)(t + 1) * kstep;
            const char* a2 = last ? nA : cA + (size_t)(t + 2) * kstep; const char* b2 = last ? nB : cB + (size_t)(t + 2) * kstep;
            const char* a3 = a2 + kstep; const char* b3 = b2 + kstep;
            const unsigned hA2 = last ? hAn : hA, hB2 = last ? hBn : hB;
            unsigned vA2[2], vB2[2];
#pragma unroll
            for (int i = 0; i < 2; ++i) { vA2[i] = last ? voffAn[i] : voffA[i]; vB2[i] = last ? voffBn[i] : voffB[i]; }
            PG8_LDB(B0, 0, 0); PG8_LDB(B1, 0, 1); PG8_SCHED; PG8_LDA(At, 0, 0); PG8_STAGE(PG8_SA(1, 1), a1 + hA, voffA);
            PG8_WAIT_V(8); PG8_WAIT_L(0); PG8_BAR; PG8_MMA(0, 0, At, B0); PG8_MMA(0, 1, At, B1); PG8_BAR; PG8_SCHED;
            PG8_LDA(At, 0, 1); PG8_STAGE(PG8_SB(0, 0), b2, vB2); PG8_STAGE(PG8_SB(0, 1), b2 + hB2, vB2); PG8_STAGE(PG8_SA(0, 0), a2, vA2);
            PG8_WAIT_V(8); PG8_WAIT_L(0); PG8_BAR; PG8_MMA(1, 0, At, B0); PG8_MMA(1, 1, At, B1); PG8_BAR; PG8_SCHED;
            PG8_LDB(B0, 1, 0); PG8_LDB(B1, 1, 1); PG8_SCHED; PG8_LDA(At, 1, 0); PG8_STAGE(PG8_SA(0, 1), a2 + hA2, vA2);
            PG8_WAIT_V(8); PG8_WAIT_L(0); PG8_BAR; PG8_MMA(0, 0, At, B0); PG8_MMA(0, 1, At, B1); PG8_BAR; PG8_SCHED;
            PG8_LDA(At, 1, 1); PG8_STAGE(PG8_SB(1, 0), b3, vB2); PG8_STAGE(PG8_SB(1, 1), b3 + hB2, vB2); PG8_STAGE(PG8_SA(1, 0), a3, vA2);
            PG8_WAIT_V(8); PG8_WAIT_L(0); PG8_BAR; PG8_MMA(1, 0, At, B0); PG8_MMA(1, 1, At, B1); PG8_BAR; PG8_SCHED;
        }
        if constexpr (ALIGN_EPI) { if (wr == 0) PG8_BAR; }
        E(acc, cur, wr, wc, fr, fq);
        if (!has_next) break;
#pragma unroll
        for (int a = 0; a < 2; ++a)
#pragma unroll
            for (int b = 0; b < 2; ++b)
#pragma unroll
                for (int m = 0; m < 4; ++m)
#pragma unroll
                    for (int n = 0; n < 2; ++n) acc[a][b][m][n] = (f32x4){0.f, 0.f, 0.f, 0.f};
        cur = nxt; cA = nA; cB = nB; hA = hAn; hB = hBn; ++ui;
#pragma unroll
        for (int i = 0; i < 2; ++i) { voffA[i] = voffAn[i]; voffB[i] = voffBn[i]; }
        if constexpr (ALIGN_EPI) { if (wr == 1) PG8_BAR; }
    }
    PG8_WAIT_V(0);
    if constexpr (!ALIGN_EPI) { if (wr == 0) PG8_BAR; }
    PG8_BAR;
#undef PG8_SA
#undef PG8_SB
#undef PG8_STAGE
#undef PG8_LDA
#undef PG8_LDB
#undef PG8_MMA
#undef PG8_WAIT_V
#undef PG8_WAIT_L
#undef PG8_BAR
#undef PG8_SCHED
}
}

constexpr int RSL_OFF = 133120;
#define EPI_ROWLOOP _Pragma("unroll") for (int ai = 0; ai < 2; ++ai) _Pragma("unroll") for (int m = 0; m < 4; ++m)
#define EPI_RS(row) ((u.pm == pm0) ? rsl[(row) & 255] : row_rs(ssq, (row)))
__device__ __forceinline__ float row_rs(const float* ssq, int row) { const f32x4* p = (const f32x4*)(ssq + (size_t)row * 16); const f32x4 a = p[0], b = p[1], c = p[2], d = p[3];
    const float s = (((a[0] + a[1]) + (a[2] + a[3])) + ((b[0] + b[1]) + (b[2] + b[3]))) + (((c[0] + c[1]) + (c[2] + c[3])) + ((d[0] + d[1]) + (d[2] + d[3])));
    return __builtin_amdgcn_rsqf(s * (1.0f / D) + EPS); }

struct EpiInProj {
    const float* ssq; unsigned char* ws; LAS const float* rsl; int pm0;
    __device__ __forceinline__ void operator()(const f32x4 (&acc)[2][2][4][2], const pg8::Unit& u, int wr, int wc, int fr, int fq) const {
        bf16_t* const ZA = (bf16_t*)(ws + WS_ZA); bf16_t* const GLU = (bf16_t*)(ws + WS_GLU); bf16_t* const BG = (bf16_t*)(ws + WS_BG); bf16_t* const CH = (bf16_t*)(ws + WS_CH);
        const float* const ropeC = (const float*)(ws + WS_ROPEC); const float* const ropeS = (const float*)(ws + WS_ROPES);
        const int T = u.pn, row0 = u.pm * 256 + wr * 64 + fr, jcol = wc * 32 + 8 * fq;
        if (T < 4) {
            EPI_ROWLOOP { const int row = row0 + ai * 128 + m * 16; const float rs = EPI_RS(row);
#pragma unroll
                for (int bj = 0; bj < 2; ++bj) { f32x4 v0 = acc[ai][bj][m][0] * rs, v1 = acc[ai][bj][m][1] * rs;
                    f32x2 a = gelu_pk((f32x2){v0[0], v0[1]}), b = gelu_pk((f32x2){v0[2], v0[3]}), c = gelu_pk((f32x2){v1[0], v1[1]}), d = gelu_pk((f32x2){v1[2], v1[3]});
                    *(u32x4*)(ZA + (size_t)row * 1024 + 256 * T + 128 * bj + jcol) = pack8((f32x4){a.x, a.y, b.x, b.y}, (f32x4){c.x, c.y, d.x, d.y}); } }
        } else if (T < 8) {
            EPI_ROWLOOP { const int row = row0 + ai * 128 + m * 16; const float rs = EPI_RS(row); f32x4 o[2];
#pragma unroll
                for (int n = 0; n < 2; ++n) { const f32x4 a = acc[ai][0][m][n] * rs, g = acc[ai][1][m][n] * rs;
#pragma unroll
                    for (int j = 0; j < 4; ++j) o[n][j] = a[j] * sigmoidf_(g[j]); }
                *(u32x4*)(GLU + (size_t)row * 512 + 128 * (T - 4) + jcol) = pack8(o[0], o[1]); }
        } else if (T < 11) {
            const bool isq = T < 10; const bool rope = isq || wc < 2; const float sc = isq ? 0.125f : 1.0f;
            const size_t boff = isq ? WS_Q : (wc < 2 ? WS_K : WS_V); bf16_t* const base = (bf16_t*)(ws + boff);
            const int ld = isq ? 512 : 128, hcol = isq ? (4 * (T - 8) + wc) * 64 : (wc & 1) * 64;
            EPI_ROWLOOP { const int row = row0 + ai * 128 + m * 16; const float rs = EPI_RS(row) * sc; const int pos = row & (SEQ - 1); f32x4 o1[2], o2[2];
#pragma unroll
                for (int n = 0; n < 2; ++n) { const f32x4 x1 = acc[ai][0][m][n] * rs, x2 = acc[ai][1][m][n] * rs;
                    if (rope) { const f32x4 c = *(const f32x4*)(ropeC + pos * 32 + 8 * fq + 4 * n), s = *(const f32x4*)(ropeS + pos * 32 + 8 * fq + 4 * n);
                        o1[n] = x1 * c - x2 * s; o2[n] = x2 * c + x1 * s; } else { o1[n] = x1; o2[n] = x2; } }
                bf16_t* p = base + (size_t)row * ld + hcol + 8 * fq;
                *(u32x4*)p = pack8(o1[0], o1[1]); *(u32x4*)(p + 32) = pack8(o2[0], o2[1]); }
        } else if (T < 13) {
            EPI_ROWLOOP { const int row = row0 + ai * 128 + m * 16; const float rs = EPI_RS(row);
#pragma unroll
                for (int bj = 0; bj < 2; ++bj) *(u32x4*)(BG + (size_t)row * 512 + 256 * (T - 11) + 128 * bj + jcol) = pack8(acc[ai][bj][m][0] * rs, acc[ai][bj][m][1] * rs); }
        } else {
            EPI_ROWLOOP { const int row = row0 + ai * 128 + m * 16; const float rs = EPI_RS(row); const float rs2 = rs * rs;
                *(u32x4*)(CH + (size_t)row * 512 + 128 * (T - 13) + jcol) = pack8(acc[ai][0][m][0] * acc[ai][1][m][0] * rs2, acc[ai][0][m][1] * acc[ai][1][m][1] * rs2); }
        }
    }
};
struct EpiGate {
    const float* ssq; bf16_t* MG;
    __device__ __forceinline__ void operator()(const f32x4 (&acc)[2][2][4][2], const pg8::Unit& u, int wr, int wc, int fr, int fq) const {
        const int row0 = u.pm * 256 + wr * 64 + fr, col0 = u.pn * 256 + wc * 32 + 8 * fq;
        EPI_ROWLOOP { const int row = row0 + ai * 128 + m * 16; const float rs = row_rs(ssq, row);
#pragma unroll
            for (int bj = 0; bj < 2; ++bj) { f32x4 v0 = acc[ai][bj][m][0] * rs, v1 = acc[ai][bj][m][1] * rs;
#pragma unroll
                for (int j = 0; j < 4; ++j) { v0[j] = sigmoidf_(v0[j]); v1[j] = sigmoidf_(v1[j]); }
                *(u32x4*)(MG + (size_t)row * 1024 + col0 + 128 * bj) = pack8(v0, v1); } }
    }
};
struct EpiBranch {
    bf16_t* MG; bf16_t* TMP;
    __device__ __forceinline__ void operator()(const f32x4 (&acc)[2][2][4][2], const pg8::Unit& u, int wr, int wc, int fr, int fq) const {
        const int row0 = u.pm * 256 + wr * 64 + fr, col0 = u.pn * 256 + wc * 32 + 8 * fq, br = u.z >> 1;
        EPI_ROWLOOP { const int row = row0 + ai * 128 + m * 16;
#pragma unroll
            for (int bj = 0; bj < 2; ++bj) { const size_t off = (size_t)row * 1024 + col0 + 128 * bj;
                f32x4 g0, g1; unpack8(*(const u32x4*)(MG + off), g0, g1);
                f32x4 v0 = acc[ai][bj][m][0] * g0, v1 = acc[ai][bj][m][1] * g1;
                if (br > 0) { f32x4 t0, t1; unpack8(*(const u32x4*)(TMP + off), t0, t1); v0 += t0; v1 += t1; }
                if (br < 3) *(u32x4*)(TMP + off) = pack8(v0, v1); else *(u32x4*)(MG + off) = pack8(v0, v1); } }
    }
};
struct EpiStashB {
    bf16_t* MG;
    __device__ __forceinline__ void operator()(const f32x4 (&acc)[2][2][4][2], const pg8::Unit& u, int wr, int wc, int fr, int fq) const {
        const int row0 = u.pm * 256 + wr * 64 + fr, col0 = u.pn * 256 + wc * 32 + 8 * fq;
        EPI_ROWLOOP { const int row = row0 + ai * 128 + m * 16;
#pragma unroll
            for (int bj = 0; bj < 2; ++bj) *(u32x4*)(MG + (size_t)row * 1024 + col0 + 128 * bj) = pack8(acc[ai][bj][m][0], acc[ai][bj][m][1]); }
    }
};
struct EpiGateAcc {
    const float* ssq; bf16_t* MG; bf16_t* TMP; LAS const float* rsl; int pm0;
    __device__ __forceinline__ void operator()(const f32x4 (&acc)[2][2][4][2], const pg8::Unit& u, int wr, int wc, int fr, int fq) const {
        const int row0 = u.pm * 256 + wr * 64 + fr, col0 = u.pn * 256 + wc * 32 + 8 * fq, br = u.z >> 1;
        u32x4 sb[8][2], tb[8][2];
#define EGA_LOAD(it) do { const int row_ = row0 + ((it) >> 2) * 128 + ((it) & 3) * 16; _Pragma("unroll") for (int bj = 0; bj < 2; ++bj) { const size_t off_ = (size_t)row_ * 1024 + col0 + 128 * bj; \
            sb[it][bj] = *(const u32x4*)(MG + off_); if (br > 0) tb[it][bj] = *(const u32x4*)(TMP + off_); } } while (0)
        EGA_LOAD(0);
#pragma unroll
        for (int it = 0; it < 8; ++it) { const int ai = it >> 2, m = it & 3; const int row = row0 + ai * 128 + m * 16; const float rs = EPI_RS(row);
            if (it + 1 < 8) EGA_LOAD(it + 1);
#pragma unroll
            for (int bj = 0; bj < 2; ++bj) { const size_t off = (size_t)row * 1024 + col0 + 128 * bj;
                f32x4 b0, b1; unpack8(sb[it][bj], b0, b1);
                f32x4 v0 = acc[ai][bj][m][0] * rs, v1 = acc[ai][bj][m][1] * rs;
#pragma unroll
                for (int j = 0; j < 4; ++j) { v0[j] = sigmoidf_(v0[j]) * b0[j]; v1[j] = sigmoidf_(v1[j]) * b1[j]; }
                if (br > 0) { f32x4 t0, t1; unpack8(tb[it][bj], t0, t1); v0 += t0; v1 += t1; }
                if (br < 3) *(u32x4*)(TMP + off) = pack8(v0, v1); else *(u32x4*)(MG + off) = pack8(v0, v1); } }
#undef EGA_LOAD
    }
};
struct EpiMerge2 {
    EpiStashB ES; EpiGateAcc EA;
    __device__ __forceinline__ void operator()(const f32x4 (&acc)[2][2][4][2], const pg8::Unit& u, int wr, int wc, int fr, int fq) const {
        if ((u.z & 1) == 0) ES(acc, u, wr, wc, fr, fq); else EA(acc, u, wr, wc, fr, fq);
    }
};
struct EpiResid {
    bf16_t* XB; float* ssq_out;
    __device__ __forceinline__ void operator()(const f32x4 (&acc)[2][2][4][2], const pg8::Unit& u, int wr, int wc, int fr, int fq) const {
        const int row0 = u.pm * 256 + wr * 64 + fr, col0 = u.pn * 256 + wc * 32 + 8 * fq;
        u32x4 xb[8][2];
#define ER_LOAD(it) do { const int row_ = row0 + ((it) >> 2) * 128 + ((it) & 3) * 16; _Pragma("unroll") for (int bj = 0; bj < 2; ++bj) xb[it][bj] = *(const u32x4*)(XB + (size_t)row_ * 1024 + col0 + 128 * bj); } while (0)
        ER_LOAD(0); ER_LOAD(1);
#pragma unroll
        for (int it = 0; it < 8; ++it) { const int ai = it >> 2, m = it & 3; const int row = row0 + ai * 128 + m * 16; float ss = 0.f;
            if (it + 2 < 8) ER_LOAD(it + 2);
#pragma unroll
            for (int bj = 0; bj < 2; ++bj) { const size_t off = (size_t)row * 1024 + col0 + 128 * bj;
                f32x4 x0, x1; unpack8(xb[it][bj], x0, x1);
                const f32x4 v0 = x0 + acc[ai][bj][m][0], v1 = x1 + acc[ai][bj][m][1];
                *(u32x4*)(XB + off) = pack8(v0, v1);
                ss += (v0[0] * v0[0] + v0[1] * v0[1]) + (v0[2] * v0[2] + v0[3] * v0[3]) + (v1[0] * v1[0] + v1[1] * v1[1]) + (v1[2] * v1[2] + v1[3] * v1[3]); }
            ss += __shfl_xor(ss, 16); ss += __shfl_xor(ss, 32);
            if (fq == 0) ssq_out[(size_t)row * 16 + u.pn * 4 + wc] = ss; }
#undef ER_LOAD
    }
};
struct EpiSwiGLU {
    const float* ssq; bf16_t* ACT; float zero_scale; LAS const float* rsl; int pm0;
    __device__ __forceinline__ void operator()(const f32x4 (&acc)[2][2][4][2], const pg8::Unit& u, int wr, int wc, int fr, int fq) const {
        const int row0 = u.pm * 256 + wr * 64 + fr, col0 = u.pn * 128 + wc * 32 + 8 * fq;
        EPI_ROWLOOP { const int row = row0 + ai * 128 + m * 16; const float rs = EPI_RS(row); f32x4 o[2];
#pragma unroll
            for (int n = 0; n < 2; ++n) { const f32x4 g = acc[ai][0][m][n] * rs, up = acc[ai][1][m][n] * rs;
#pragma unroll
                for (int j = 0; j < 4; ++j) o[n][j] = g[j] * sigmoidf_(g[j]) * up[j] * zero_scale; }
            *(u32x4*)(ACT + (size_t)row * DFF + col0) = pack8(o[0], o[1]); }
    }
};

#define ABL_FFN_SCALE(l) 1.0f
struct Args { const float* in[19]; float* out; unsigned char* ws; };

__device__ __forceinline__ int win_src_col(int nlog) {
    const int T = nlog >> 8, o = nlog & 255, bj = o >> 7, j = o & 127;
    if (T < 4) return nlog;
    if (T < 8) return 1024 + bj * 512 + 128 * (T - 4) + j;
    if (T < 10) return 2048 + (4 * (T - 8) + (j >> 5)) * 64 + 32 * bj + (j & 31);
    if (T == 10) { const int h = j >> 5; return (h < 2 ? 2560 + h * 64 : 2688 + (h - 2) * 64) + 32 * bj + (j & 31); }
    if (T < 13) return 2816 + 256 * (T - 11) + o;
    if (T < 17) return 3328 + bj * 512 + 128 * (T - 13) + j;
    return nlog;
}
template <int NL> __device__ __forceinline__ void tr_item(const float* W, int Nsrc, int k0, int scolA, int scolB, const float* gain, bf16_t* WT, int K, int drow, LAS float* scr, int lane) {
    const int c4 = lane & 15; const int sc = ((c4 >> 3) ? scolB : scolA) + 4 * (c4 & 7);
#pragma unroll
    for (int h = 0; h < 16 / NL; ++h) { f32x4 v[NL];
#pragma unroll
        for (int i = 0; i < NL; ++i) v[i] = __builtin_nontemporal_load((const f32x4*)(W + (size_t)(k0 + 4 * (h * NL + i) + (lane >> 4)) * Nsrc + sc));
#pragma unroll
        for (int i = 0; i < NL; ++i) { const int row = 4 * (h * NL + i) + (lane >> 4); if (gain) v[i] = v[i] * gain[k0 + row];
            LAS float* d = scr + row * 65 + 4 * c4; d[0] = v[i][0]; d[1] = v[i][1]; d[2] = v[i][2]; d[3] = v[i][3]; } }
    asm volatile("s_waitcnt lgkmcnt(0)" ::: "memory");
    const int c = lane & 7;
#pragma unroll
    for (int jj = 0; jj < 8; ++jj) { const int n = (lane >> 3) + 8 * jj; const LAS float* s = scr + (8 * c) * 65 + n;
        u32x4 o; o.x = cvt_pk_bf16(s[0], s[65]); o.y = cvt_pk_bf16(s[2 * 65], s[3 * 65]); o.z = cvt_pk_bf16(s[4 * 65], s[5 * 65]); o.w = cvt_pk_bf16(s[6 * 65], s[7 * 65]);
        *(u32x4*)(WT + (size_t)(drow + n) * K + k0 + 8 * c) = o; }
    asm volatile("s_waitcnt lgkmcnt(0)" ::: "memory");
}
struct WPtrs { const float *w_in, *norm_mix, *w_branch, *w_out, *w_gate_up, *norm_ffn, *w_down; };
constexpr int ITEMS_PER_LAYER = 16 * 132 + 512 + 256 + 16 * 88 + 44 * 16;
template <int NL> __device__ __forceinline__ void convert_weights(const WPtrs& wp, unsigned char* ws, LAS unsigned char* lds, int lo, int hi, int w0, int nw) {
    int tid_ = threadIdx.x; asm volatile("" : "+v"(tid_));
    const int lane = tid_ & 63, wave = __builtin_amdgcn_readfirstlane(tid_ >> 6);
    LAS float* scr = (LAS float*)(lds + wave * 16640);
    constexpr int I_IN = 16 * 132, I_BR = 512, I_OUT = 256, I_GU = 16 * 88, I_L = ITEMS_PER_LAYER;
    for (int it = lo + w0; it < hi; it += nw) {
        const int l = it / I_L; int r = it % I_L;
        if (r < I_IN) { const int kb = r / 132, nb = r % 132, n0 = 64 * nb;
            tr_item<NL>(wp.w_in + (size_t)l * D * PROJ, PROJ, 64 * kb, win_src_col(n0), win_src_col(n0 + 32), wp.norm_mix + l * D, (bf16_t*)(ws + WS_WIN + l * WIN_L), D, n0, scr, lane); continue; } r -= I_IN;
        if (r < I_BR) { const int br = r >> 7, q = r & 127, kb = q >> 4, nb = q & 15;
            tr_item<NL>(wp.w_branch + (size_t)(l * 4 + br) * 512 * D, D, 64 * kb, 64 * nb, 64 * nb + 32, nullptr, (bf16_t*)(ws + WS_WBR + l * WBR_L) + (size_t)br * 1024 * 512, 512, 64 * nb, scr, lane); continue; } r -= I_BR;
        if (r < I_OUT) { const int kb = r >> 4, nb = r & 15;
            tr_item<NL>(wp.w_out + (size_t)l * D * D, D, 64 * kb, 64 * nb, 64 * nb + 32, nullptr, (bf16_t*)(ws + WS_WOUT + l * WOUT_L), D, 64 * nb, scr, lane); continue; } r -= I_OUT;
        if (r < I_GU) { const int kb = r / 88, nb = r % 88, n0 = 64 * nb, T = n0 >> 8, o = n0 & 255, sc = (o >> 7) * DFF + 128 * T + (o & 127);
            tr_item<NL>(wp.w_gate_up + (size_t)l * D * 2 * DFF, 2 * DFF, 64 * kb, sc, sc + 32, wp.norm_ffn + l * D, (bf16_t*)(ws + WS_WGU + l * WGU_L), D, n0, scr, lane); continue; } r -= I_GU;
        { const int kb = r >> 4, nb = r & 15;
            tr_item<NL>(wp.w_down + (size_t)l * DFF * D, D, 64 * kb, 64 * nb, 64 * nb + 32, nullptr, (bf16_t*)(ws + WS_WDN + l * WDN_L), DFF, 64 * nb, scr, lane); }
    }
}
__device__ __forceinline__ void prologue(const Args& a, LAS unsigned char* lds, int G) {
    int tid_ = threadIdx.x; asm volatile("" : "+v"(tid_));
    const int tid = tid_, lane = tid & 63, wave = __builtin_amdgcn_readfirstlane(tid >> 6);
    const int gw = blockIdx.x * NWAVES + wave, NGW = G * NWAVES;
    unsigned char* ws = a.ws;
    { const WPtrs wp{a.in[2], a.in[1], a.in[13], a.in[14], a.in[16], a.in[15], a.in[17]};
      if (blockIdx.x == 0 && tid == 0) *(WPtrs*)(ws + WS_PTRS) = wp;
      convert_weights<16>(wp, ws, lds, 0, G == 256 ? ITEMS_PER_LAYER : 2 * ITEMS_PER_LAYER, gw, NGW); }
    float* ssq = (float*)(ws + WS_SSQ);
    for (int row = gw; row < M; row += NGW) {
        const f32x4* xr = (const f32x4*)(a.in[0] + (size_t)row * D) + lane; float s = 0.f; f32x4 v[4];
#pragma unroll
        for (int j = 0; j < 4; ++j) { v[j] = xr[64 * j]; s += (v[j][0] * v[j][0] + v[j][1] * v[j][1]) + (v[j][2] * v[j][2] + v[j][3] * v[j][3]); }
        s = wave_sum(s);
        u32x2* o = (u32x2*)((bf16_t*)(ws + WS_XB) + (size_t)row * D) + lane;
#pragma unroll
        for (int j = 0; j < 4; ++j) o[64 * j] = (u32x2){cvt_pk_bf16(v[j][0], v[j][1]), cvt_pk_bf16(v[j][2], v[j][3])};
        if (lane < 16) ssq[(size_t)row * 16 + lane] = lane == 0 ? s : 0.f;
    }
    { float* par = (float*)(ws + WS_PAR); const int gt = blockIdx.x * NTHREADS + tid, GT = G * NTHREADS;
#define CPY(dstoff, srcp, n) for (int i = gt; i < (n); i += GT) par[(dstoff) + i] = (srcp)[i]
      for (int l = 0; l < 2; ++l) { const int o = l * PAR_L;
          CPY(o + P_SGLNG, a.in[3] + l * 512, 512); CPY(o + P_SGLNB, a.in[4] + l * 512, 512); CPY(o + P_SGB, a.in[6] + l * 512, 512);
          CPY(o + P_CVB, a.in[8] + l * 512, 512); CPY(o + P_CVLNG, a.in[9] + l * 512, 512); CPY(o + P_CVLNB, a.in[10] + l * 512, 512);
          CPY(o + P_SCW, a.in[12] + l * 1536, 1536); CPY(o + P_SINK, a.in[11] + l * 8, 8); CPY(o + P_CVW, a.in[7] + l * 31 * 512, 31 * 512); }
      CPY(P_FINAL, a.in[18], 1024);
#undef CPY
    }
    for (int i = blockIdx.x * NTHREADS + tid; i < SEQ * 32; i += G * NTHREADS) { const int pos = i >> 5, f = i & 31;
        const double rev = (double)pos * INVF_REV[f]; const float fr = (float)(rev - floor(rev));
        ((float*)(ws + WS_ROPEC))[i] = __builtin_amdgcn_cosf(fr); ((float*)(ws + WS_ROPES))[i] = __builtin_amdgcn_sinf(fr); }
    for (int i = blockIdx.x * NTHREADS + tid; i < 2 * 4 * 128 * 128; i += G * NTHREADS) { const int s = i & 127, t = (i >> 7) & 127;
        ((bf16_t*)(ws + WS_SGWT))[i] = s <= t ? (bf16_t)(cvt_pk_bf16(a.in[5][i], 0.f) & 0xffffu) : (bf16_t)0; }
}

__device__ __forceinline__ void mixer_sg(unsigned char* ws, int l, LAS unsigned char* lds, int unit) {
    { size_t z_ = 0; asm volatile("" : "+s"(z_)); ws += z_; } int tid_ = threadIdx.x; asm volatile("" : "+v"(tid_));
    const float* par = (const float*)(ws + WS_PAR) + l * PAR_L;
    const int tid = tid_, lane = tid & 63, wave = __builtin_amdgcn_readfirstlane(tid >> 6);
    const int ck = unit >> 2, g = unit & 3, r0 = ck * 128;
    const bf16_t* ZA = (const bf16_t*)(ws + WS_ZA); bf16_t* YA = (bf16_t*)(ws + WS_YA);
    LAS bf16_t* vnT = (LAS bf16_t*)lds;
    const float* lng = par + P_SGLNG; const float* lnb = par + P_SGLNB;
    const f32x4 g0 = *(const f32x4*)(lng + 8 * lane), g1 = *(const f32x4*)(lng + 8 * lane + 4), b0 = *(const f32x4*)(lnb + 8 * lane), b1 = *(const f32x4*)(lnb + 8 * lane + 4);
    u32x4 raw[16];
#pragma unroll
    for (int i = 0; i < 16; ++i) raw[i] = *(const u32x4*)(ZA + (size_t)(r0 + wave + 8 * i) * 1024 + 512 + 8 * lane);
    const int fr = lane & 15, fq = lane >> 4, t0 = 16 * wave, nks = (wave >> 1) + 1;
    const bf16_t* W = (const bf16_t*)(ws + WS_SGWT) + (size_t)(l * 4 + g) * 16384 + (size_t)(t0 + fr) * 128 + 8 * fq;
    bf16x8 wf[4];
#pragma unroll
    for (int ks = 0; ks < 4; ++ks) wf[ks] = *(const bf16x8*)(W + 32 * (ks < nks ? ks : 0));
    const int tt = t0 + fr; const size_t orow = r0 + tt; const float bs = par[P_SGB + g * 128 + tt];
    u32x2 uu[8];
#pragma unroll
    for (int ct = 0; ct < 8; ++ct) uu[ct] = *(const u32x2*)(ZA + orow * 1024 + 128 * g + 16 * ct + 4 * fq);
#pragma unroll
    for (int i = 0; i < 16; ++i) { const int s = wave + 8 * i;
        f32x4 x0, x1; unpack8(raw[i], x0, x1);
        const float mean = wave_sum((x0[0] + x0[1]) + (x0[2] + x0[3]) + (x1[0] + x1[1]) + (x1[2] + x1[3])) * (1.0f / 512.0f);
        x0 -= mean; x1 -= mean;
        const float var = wave_sum((x0[0] * x0[0] + x0[1] * x0[1]) + (x0[2] * x0[2] + x0[3] * x0[3]) + (x1[0] * x1[0] + x1[1] * x1[1]) + (x1[2] * x1[2] + x1[3] * x1[3])) * (1.0f / 512.0f);
        const float rstd = __builtin_amdgcn_rsqf(var + EPS);
        if ((lane >> 4) == g) { const int c = 8 * (lane & 15); x0 = x0 * rstd * g0 + b0; x1 = x1 * rstd * g1 + b1;
            const unsigned p0 = cvt_pk_bf16(x0[0], x0[1]), p1 = cvt_pk_bf16(x0[2], x0[3]), p2 = cvt_pk_bf16(x1[0], x1[1]), p3 = cvt_pk_bf16(x1[2], x1[3]);
            LAS bf16_t* d = vnT + c * 136 + (s ^ (8 * (lane & 15)));
            d[0] = (bf16_t)p0; d[136] = (bf16_t)(p0 >> 16); d[2 * 136] = (bf16_t)p1; d[3 * 136] = (bf16_t)(p1 >> 16);
            d[4 * 136] = (bf16_t)p2; d[5 * 136] = (bf16_t)(p2 >> 16); d[6 * 136] = (bf16_t)p3; d[7 * 136] = (bf16_t)(p3 >> 16); }
    }
    __syncthreads();
    { f32x4 acc[8];
#pragma unroll
      for (int ct = 0; ct < 8; ++ct) acc[ct] = (f32x4){0.f, 0.f, 0.f, 0.f};
#pragma unroll
      for (int ks = 0; ks < 4; ++ks) if (ks < nks) {
#pragma unroll
          for (int ct = 0; ct < 8; ++ct) { const bf16x8 vf = *(const LAS bf16x8*)(vnT + (16 * ct + fr) * 136 + 8 * ((4 * ks + fq) ^ ((2 * ct + (fr >> 3)) & 15)));
              acc[ct] = __builtin_amdgcn_mfma_f32_16x16x32_bf16(vf, wf[ks], acc[ct], 0, 0, 0); }
      }
#pragma unroll
      for (int ct = 0; ct < 8; ++ct) { const int c = 128 * g + 16 * ct + 4 * fq;
          const float o0 = bf_lo(uu[ct].x) * (acc[ct][0] + bs), o1 = bf_hi(uu[ct].x) * (acc[ct][1] + bs), o2 = bf_lo(uu[ct].y) * (acc[ct][2] + bs), o3 = bf_hi(uu[ct].y) * (acc[ct][3] + bs);
          *(u32x2*)(YA + orow * 512 + c) = (u32x2){cvt_pk_bf16(o0, o1), cvt_pk_bf16(o2, o3)}; }
    }
    __syncthreads();
}
__device__ __forceinline__ void mixer_conv(unsigned char* ws, int l, LAS unsigned char* lds, int unit) {
    { size_t z_ = 0; asm volatile("" : "+s"(z_)); ws += z_; } int tid_ = threadIdx.x; asm volatile("" : "+v"(tid_));
    const float* par = (const float*)(ws + WS_PAR) + l * PAR_L;
    const int tid = tid_, lane = tid & 63, wave = tid >> 6;
    const int b = unit >> 6, tb = unit & 63, t0 = tb * 32; const size_t rbase = (size_t)b * SEQ;
    const bf16_t* GLU = (const bf16_t*)(ws + WS_GLU); bf16_t* YB = (bf16_t*)(ws + WS_YB);
    LAS bf16_t* in = (LAS bf16_t*)lds;
    LAS float* cv = (LAS float*)(lds + 65536);
    for (int i = tid; i < 62 * 64; i += NTHREADS) { const int r = i >> 6, ch = i & 63; const int t = t0 - 30 + r;
        u32x4 v = {0u, 0u, 0u, 0u}; if (t >= 0) v = *(const u32x4*)(GLU + (rbase + t) * 512 + 8 * ch);
        *(LAS u32x4*)(in + r * 512 + 8 * ch) = v; }
    __syncthreads();
    { const int c = tid; float w[31], x[62];
#pragma unroll
      for (int k = 0; k < 31; ++k) w[k] = par[P_CVW + k * 512 + c];
#pragma unroll
      for (int r = 0; r < 62; ++r) x[r] = bf1(in[r * 512 + c]);
      const float bias = par[P_CVB + c];
#pragma unroll
      for (int t = 0; t < 32; ++t) { float s = bias;
#pragma unroll
          for (int k = 0; k < 31; ++k) s += w[k] * x[t + k];
          cv[t * 512 + c] = s; } }
    __syncthreads();
    { const float* lng = par + P_CVLNG; const float* lnb = par + P_CVLNB;
      const f32x4 g0 = *(const f32x4*)(lng + 8 * lane), g1 = *(const f32x4*)(lng + 8 * lane + 4), b0 = *(const f32x4*)(lnb + 8 * lane), b1 = *(const f32x4*)(lnb + 8 * lane + 4);
      for (int t = wave; t < 32; t += NWAVES) {
          f32x4 x0 = *(const LAS f32x4*)(cv + t * 512 + 8 * lane), x1 = *(const LAS f32x4*)(cv + t * 512 + 8 * lane + 4);
          const float mean = wave_sum((x0[0] + x0[1]) + (x0[2] + x0[3]) + (x1[0] + x1[1]) + (x1[2] + x1[3])) * (1.0f / 512.0f);
          x0 -= mean; x1 -= mean;
          const float var = wave_sum((x0[0] * x0[0] + x0[1] * x0[1]) + (x0[2] * x0[2] + x0[3] * x0[3]) + (x1[0] * x1[0] + x1[1] * x1[1]) + (x1[2] * x1[2] + x1[3] * x1[3])) * (1.0f / 512.0f);
          const float rstd = __builtin_amdgcn_rsqf(var + EPS);
          x0 = x0 * rstd * g0 + b0; x1 = x1 * rstd * g1 + b1;
#pragma unroll
          for (int j = 0; j < 4; ++j) { x0[j] = x0[j] * sigmoidf_(x0[j]); x1[j] = x1[j] * sigmoidf_(x1[j]); }
          *(u32x4*)(YB + (rbase + t0 + t) * 512 + 8 * lane) = pack8(x0, x1); } }
    __syncthreads();
}
__device__ __forceinline__ void mixer_attn(unsigned char* ws, int l, LAS unsigned char* lds, int unit) {
    { size_t z_ = 0; asm volatile("" : "+s"(z_)); ws += z_; } int tid_ = threadIdx.x; asm volatile("" : "+v"(tid_));
    const float* par = (const float*)(ws + WS_PAR) + l * PAR_L;
    const int tid = tid_, lane = tid & 63, wave = __builtin_amdgcn_readfirstlane(tid >> 6), fr = lane & 15, fq = lane >> 4;
    const int kvh = unit & 1, blk = (unit >> 1) & 15, b = unit >> 5; const size_t rbase = (size_t)b * SEQ;
    bf16_t* Q = (bf16_t*)(ws + WS_Q); const bf16_t* K = (const bf16_t*)(ws + WS_K); const bf16_t* V = (const bf16_t*)(ws + WS_V);
    LAS bf16_t* Kl = (LAS bf16_t*)lds;
    LAS bf16_t* VT = (LAS bf16_t*)(lds + 36864);
    for (int i = tid; i < 256 * 8; i += NTHREADS) { const int r = i >> 3, ch = i & 7; const int t = (blk - 1) * 128 + r;
        u32x4 kv = {0u, 0u, 0u, 0u}, vv = {0u, 0u, 0u, 0u};
        if (t >= 0) { kv = *(const u32x4*)(K + (rbase + t) * 128 + kvh * 64 + 8 * ch); vv = *(const u32x4*)(V + (rbase + t) * 128 + kvh * 64 + 8 * ch); }
        *(LAS u32x4*)(Kl + r * 72 + 8 * ch) = kv;
        LAS bf16_t* d = VT + (8 * ch) * 264 + r;
        d[0] = (bf16_t)vv.x; d[264] = (bf16_t)(vv.x >> 16); d[2 * 264] = (bf16_t)vv.y; d[3 * 264] = (bf16_t)(vv.y >> 16);
        d[4 * 264] = (bf16_t)vv.z; d[5 * 264] = (bf16_t)(vv.z >> 16); d[6 * 264] = (bf16_t)vv.w; d[7 * 264] = (bf16_t)(vv.w >> 16); }
    __syncthreads();
    const int g = wave >> 1, head = kvh * 4 + g; const float sink = par[P_SINK + head];
    for (int it = 0; it < 2; ++it) {
        const int qs = 2 * (wave & 1) + it, qi0 = 32 * qs; const size_t qrow0 = rbase + blk * 128 + qi0;
        bf16x8 qf[2][2];
#pragma unroll
        for (int qt = 0; qt < 2; ++qt)
#pragma unroll
            for (int ks = 0; ks < 2; ++ks) qf[qt][ks] = *(const bf16x8*)(Q + (qrow0 + 16 * qt + fr) * 512 + head * 64 + 32 * ks + 8 * fq);
        f32x4 S[2][10];
#pragma unroll
        for (int qt = 0; qt < 2; ++qt)
#pragma unroll
            for (int kt = 0; kt < 10; ++kt) S[qt][kt] = (f32x4){0.f, 0.f, 0.f, 0.f};
#pragma unroll
        for (int kt = 0; kt < 10; ++kt)
#pragma unroll
            for (int ks = 0; ks < 2; ++ks) { const bf16x8 kf = *(const LAS bf16x8*)(Kl + (qi0 + 16 * kt + fr) * 72 + 32 * ks + 8 * fq);
#pragma unroll
                for (int qt = 0; qt < 2; ++qt) S[qt][kt] = __builtin_amdgcn_mfma_f32_16x16x32_bf16(kf, qf[qt][ks], S[qt][kt], 0, 0, 0); }
        bf16x8 pf[2][5];
#pragma unroll
        for (int qt = 0; qt < 2; ++qt) { const int qi = qi0 + 16 * qt + fr; float mx = sink;
#pragma unroll
            for (int kt = 0; kt < 10; ++kt)
#pragma unroll
                for (int j = 0; j < 4; ++j) { const int kb = qi0 + 16 * kt + 4 * fq + j; const bool valid = (kb > qi) && (kb <= qi + 128) && (blk > 0 || kb >= 128);
                    const float sv = valid ? S[qt][kt][j] : -INFINITY; S[qt][kt][j] = sv; mx = fmaxf(mx, sv); }
            mx = fmaxf(mx, __shfl_xor(mx, 16)); mx = fmaxf(mx, __shfl_xor(mx, 32));
            float sum = 0.f;
#pragma unroll
            for (int kt = 0; kt < 10; ++kt)
#pragma unroll
                for (int j = 0; j < 4; ++j) { const float p = __expf(S[qt][kt][j] - mx); S[qt][kt][j] = p; sum += p; }
            sum += __shfl_xor(sum, 16); sum += __shfl_xor(sum, 32);
            const float inv = 1.0f / (sum + __expf(sink - mx));
#pragma unroll
            for (int p = 0; p < 5; ++p) { const f32x4 a0 = S[qt][2 * p] * inv, a1 = S[qt][2 * p + 1] * inv; pf[qt][p] = __builtin_bit_cast(bf16x8, pack8(a0, a1)); }
        }
        f32x4 o[2][4];
#pragma unroll
        for (int qt = 0; qt < 2; ++qt)
#pragma unroll
            for (int dt = 0; dt < 4; ++dt) o[qt][dt] = (f32x4){0.f, 0.f, 0.f, 0.f};
#pragma unroll
        for (int p = 0; p < 5; ++p)
#pragma unroll
            for (int dt = 0; dt < 4; ++dt) { const LAS bf16_t* vp = VT + (16 * dt + fr) * 264 + qi0 + 32 * p + 4 * fq;
                const u32x2 lo = *(const LAS u32x2*)vp, hi = *(const LAS u32x2*)(vp + 16);
                const bf16x8 vf = __builtin_bit_cast(bf16x8, (u32x4){lo.x, lo.y, hi.x, hi.y});
#pragma unroll
                for (int qt = 0; qt < 2; ++qt) o[qt][dt] = __builtin_amdgcn_mfma_f32_16x16x32_bf16(vf, pf[qt][p], o[qt][dt], 0, 0, 0); }
#pragma unroll
        for (int qt = 0; qt < 2; ++qt)
#pragma unroll
            for (int dt = 0; dt < 4; ++dt) *(u32x2*)(Q + (qrow0 + 16 * qt + fr) * 512 + head * 64 + 16 * dt + 4 * fq) = (u32x2){cvt_pk_bf16(o[qt][dt][0], o[qt][dt][1]), cvt_pk_bf16(o[qt][dt][2], o[qt][dt][3])};
    }
    __syncthreads();
}
__device__ __forceinline__ void mixer_sc(unsigned char* ws, int l, int G) {
    { size_t z_ = 0; asm volatile("" : "+s"(z_)); ws += z_; } int tid_ = threadIdx.x; asm volatile("" : "+v"(tid_));
    bf16_t* BG = (bf16_t*)(ws + WS_BG); const bf16_t* CH = (const bf16_t*)(ws + WS_CH);
    const float* w = (const float*)(ws + WS_PAR) + l * PAR_L + P_SCW;
    for (int i = blockIdx.x * NTHREADS + tid_; i < (M / 8) * 64; i += G * NTHREADS) {
        const int row0 = 8 * (i >> 6), c = 8 * (i & 63), t0 = row0 & (SEQ - 1);
        u32x4 ch[10], bg[8];
#pragma unroll
        for (int r = 0; r < 10; ++r) { ch[r] = (u32x4){0u, 0u, 0u, 0u}; if (t0 - 2 + r >= 0) ch[r] = *(const u32x4*)(CH + (size_t)(row0 - 2 + r) * 512 + c); }
#pragma unroll
        for (int r = 0; r < 8; ++r) bg[r] = *(const u32x4*)(BG + (size_t)(row0 + r) * 512 + c);
        f32x4 wa[3], wb[3];
#pragma unroll
        for (int k = 0; k < 3; ++k) { wa[k] = *(const f32x4*)(w + k * 512 + c); wb[k] = *(const f32x4*)(w + k * 512 + c + 4); }
#pragma unroll
        for (int r = 0; r < 8; ++r) { f32x4 a0 = {0.f, 0.f, 0.f, 0.f}, a1 = a0;
#pragma unroll
            for (int k = 0; k < 3; ++k) { f32x4 x0, x1; unpack8(ch[r + k], x0, x1); a0 += x0 * wa[k]; a1 += x1 * wb[k]; }
            f32x4 g0, g1; unpack8(bg[r], g0, g1);
            *(u32x4*)(BG + (size_t)(row0 + r) * 512 + c) = pack8(g0 * a0, g1 * a1); }
    }
}

#define RLX_AGENT __ATOMIC_RELAXED, __HIP_MEMORY_SCOPE_AGENT
#define XB_TMO      128
#define XB_XCNT(j)  (256  + 64 * (j))
#define XB_XSUB(j)  (1280 + 64 * (j))
#define XB_XGEN(j)  (2304 + 64 * (j))
#define XB_TOP      3328
#define XB_TOPGEN   3392
#define XCD_BAR_WORDS 3456
#define XB_SPIN_CAP (1u << 18)

__device__ __forceinline__ unsigned xb_ld(unsigned* p)              { return __hip_atomic_load(p, __ATOMIC_RELAXED, __HIP_MEMORY_SCOPE_AGENT); }
__device__ __forceinline__ unsigned xb_add(unsigned* p, unsigned v) { return __hip_atomic_fetch_add(p, v, __ATOMIC_RELAXED, __HIP_MEMORY_SCOPE_AGENT); }
__device__ __forceinline__ unsigned xb_xcc_id() { return (unsigned)__builtin_amdgcn_s_getreg((3 << 11) | 20) & 0xFu; }
#define XB_SPIN(cond, bar) do { unsigned _sp = 0; while (cond) { __builtin_amdgcn_s_sleep(1); \
    if ((++_sp & 255u) == 0u) { if (xb_ld(&(bar)[XB_TMO])) break; if (_sp > XB_SPIN_CAP) { atomicAdd(&(bar)[XB_TMO], 1u); break; } } } } while (0)

struct XcdBarrier {
    unsigned* bar; unsigned x;
    volatile LAS unsigned* st;
};

__device__ __forceinline__ XcdBarrier xcd_barrier_post(unsigned* bar, volatile LAS unsigned* st) {
    XcdBarrier b; b.bar = bar; b.x = xb_xcc_id(); b.st = st;
    if (threadIdx.x == 0) (void)xb_add(&bar[XB_XCNT(b.x)], 1u);
    return b;
}
__device__ __forceinline__ void xcd_barrier_complete(unsigned* bar, unsigned x, unsigned& nloc, unsigned& nx) {
    const unsigned G = gridDim.x * gridDim.y * gridDim.z;
    unsigned sum, cnt, mine, sp = 0u;
    for (;;) {
        sum = 0u; cnt = 0u; mine = 0u;
#pragma unroll
        for (unsigned j = 0; j < 16; ++j) { const unsigned c = xb_ld(&bar[XB_XCNT(j)]); sum += c; cnt += (c > 0u) ? 1u : 0u; mine = (j == x) ? c : mine; }
        if (sum == G) break;
        __builtin_amdgcn_s_sleep(1);
        if ((++sp & 255u) == 0u) { if (xb_ld(&bar[XB_TMO])) break; if (sp > XB_SPIN_CAP) { atomicAdd(&bar[XB_TMO], 1u); break; } }
    }
    nloc = mine > 0u ? mine : 1u; nx = cnt > 0u ? cnt : 1u;
}

__device__ __forceinline__ void xcd_barrier(const XcdBarrier& b) {
    asm volatile("s_waitcnt vmcnt(0)" ::: "memory");
    __syncthreads();
    if (threadIdx.x == 0) {
        unsigned* bar = b.bar;
        __builtin_amdgcn_s_waitcnt(0);
        unsigned nloc = b.st[0], nx = b.st[1];
        if (nloc == 0u) { xcd_barrier_complete(bar, b.x, nloc, nx); b.st[0] = nloc; b.st[1] = nx; }
        const unsigned old = xb_add(&bar[XB_XSUB(b.x)], 1u);
        const unsigned gen = old / nloc;
        if (old + 1u == (gen + 1u) * nloc) {
            __builtin_amdgcn_fence(__ATOMIC_RELEASE, "agent");
            asm volatile("s_waitcnt vmcnt(0)" ::: "memory");
            const unsigned og = xb_add(&bar[XB_TOP], 1u);
            const unsigned tg = og / nx;
            if (og + 1u == (tg + 1u) * nx) xb_add(&bar[XB_TOPGEN], 1u);
            else XB_SPIN(xb_ld(&bar[XB_TOPGEN]) == tg, bar);
            __builtin_amdgcn_fence(__ATOMIC_ACQUIRE, "agent");
            xb_add(&bar[XB_XGEN(b.x)], 1u);
            asm volatile("s_waitcnt vmcnt(0)" ::: "memory");
        } else {
            XB_SPIN(xb_ld(&bar[XB_XGEN(b.x)]) == gen, bar);
            __builtin_amdgcn_fence(__ATOMIC_ACQUIRE, "agent");
            asm volatile("s_waitcnt vmcnt(0)" ::: "memory");
        }
    }
    __syncthreads();
}


__device__ __forceinline__ void stage_rs(LAS unsigned char* lds, const float* ssq, int pm) {
    int tid_ = threadIdx.x; asm volatile("" : "+v"(tid_));
    if (tid_ < 256 && pm >= 0) ((LAS float*)(lds + RSL_OFF))[tid_] = row_rs(ssq, pm * 256 + tid_);
    __syncthreads();
}
#define GRID_SYNC() do { XcdBarrier xb_; xb_.bar = (unsigned*)(ws + WS_BAR); xb_.x = xb_xcc_id(); xb_.st = (volatile LAS unsigned*)(lds + MISC_OFF); xcd_barrier(xb_); } while (0)
__global__ void __launch_bounds__(NTHREADS, 2) fwd_megakernel(Args a) {
    extern __shared__ __attribute__((aligned(16))) unsigned char lds_raw[];
    LAS unsigned char* lds = (LAS unsigned char*)lds_raw;
    cg::grid_group grid = cg::this_grid();
    const int G = gridDim.x, c = blockIdx.x;
    unsigned char* ws = a.ws;
    float* ssq = (float*)(ws + WS_SSQ);

    { volatile LAS unsigned* misc = (volatile LAS unsigned*)(lds + MISC_OFF); if (threadIdx.x < 16) misc[threadIdx.x] = 0u; }
    __syncthreads();
    grid.sync();
    (void)xcd_barrier_post((unsigned*)(ws + WS_BAR), (volatile LAS unsigned*)(lds + MISC_OFF));
    prologue(a, lds, G);
    GRID_SYNC();

    for (int l = 0; l < 2; ++l) {
        { size_t z_ = 0; asm volatile("" : "+s"(z_)); ws += z_; } ssq = (float*)(ws + WS_SSQ);
        const float* ssq_mix = ssq + (size_t)(2 * l) * M * 16;
        { pg8::SchedGrid S; S.nM = 64; S.nN = 17; S.nwg = 64 * 17; S.G = G; { int c_ = c; asm volatile("" : "+s"(c_)); S.c = c_; } S.A = (const char*)(ws + WS_XB); S.B = (const char*)(ws + WS_WIN + l * WIN_L); S.lda2 = 2048; S.ldb2 = 2048; S.nt = 16;
          int pm0 = -1; { pg8::Unit u0; if (S.next(0, u0)) pm0 = u0.pm; } stage_rs(lds, ssq_mix, pm0);
          EpiInProj E{ssq_mix, ws, (LAS const float*)(lds + RSL_OFF), pm0};
          pg8::gemm_phase<EpiInProj, pg8::SchedGrid, true>(lds, S, E);
          if (l == 0 && G == 256 && c >= 64) {
              const int wv = __builtin_amdgcn_readfirstlane((int)threadIdx.x >> 6); const WPtrs wp = *(const WPtrs*)(ws + WS_PTRS);
              convert_weights<16>(wp, ws, lds, ITEMS_PER_LAYER, 2 * ITEMS_PER_LAYER, (c - 64) * NWAVES + wv, 192 * NWAVES); }
        }
        GRID_SYNC(); { size_t z_ = 0; asm volatile("" : "+s"(z_)); ws += z_; }
        for (int u = c; u < 512; u += G) mixer_sg(ws, l, lds, u);
        for (int u = c; u < 512; u += G) mixer_conv(ws, l, lds, u);
        for (int u = c; u < 256; u += G) mixer_attn(ws, l, lds, u);
        mixer_sc(ws, l, G);
        GRID_SYNC(); { size_t z_ = 0; asm volatile("" : "+s"(z_)); ws += z_; } ssq = (float*)(ws + WS_SSQ);
        { pg8::SchedMerge S; S.G = G; { int c_ = c; asm volatile("" : "+s"(c_)); S.c = c_; } S.ws = (const char*)ws; S.WG = (const char*)(ws + WS_WIN + l * WIN_L) + (size_t)NLOG1 * 2048;
          S.WBR = (const char*)(ws + WS_WBR + l * WBR_L);
          S.swap = 1; int pm0 = -1; { pg8::Unit u0; if (S.next(0, u0)) pm0 = u0.pm; } stage_rs(lds, ssq_mix, pm0);
          EpiStashB ES{(bf16_t*)(ws + WS_MG)}; EpiGateAcc EA{ssq_mix, (bf16_t*)(ws + WS_MG), (bf16_t*)(ws + WS_TMP), (LAS const float*)(lds + RSL_OFF), pm0};
          EpiMerge2 E2{ES, EA};
          pg8::gemm_phase<EpiMerge2, pg8::SchedMerge, true>(lds, S, E2);
        }
        GRID_SYNC(); { size_t z_ = 0; asm volatile("" : "+s"(z_)); ws += z_; } ssq = (float*)(ws + WS_SSQ);
        { pg8::SchedGrid S; S.nM = 64; S.nN = 4; S.nwg = 256; S.G = G; { int c_ = c; asm volatile("" : "+s"(c_)); S.c = c_; } S.A = (const char*)(ws + WS_MG); S.B = (const char*)(ws + WS_WOUT + l * WOUT_L); S.lda2 = 2048; S.ldb2 = 2048; S.nt = 16;
          EpiResid E{(bf16_t*)(ws + WS_XB), ssq + (size_t)(2 * l + 1) * M * 16};
          pg8::gemm_phase<EpiResid, pg8::SchedGrid, false>(lds, S, E); }
        GRID_SYNC(); { size_t z_ = 0; asm volatile("" : "+s"(z_)); ws += z_; } ssq = (float*)(ws + WS_SSQ);
        { pg8::SchedGrid S; S.nM = 64; S.nN = 22; S.nwg = 64 * 22; S.G = G; { int c_ = c; asm volatile("" : "+s"(c_)); S.c = c_; } S.A = (const char*)(ws + WS_XB); S.B = (const char*)(ws + WS_WGU + l * WGU_L); S.lda2 = 2048; S.ldb2 = 2048; S.nt = 16;
          int pm0 = -1; { pg8::Unit u0; if (S.next(0, u0)) pm0 = u0.pm; } stage_rs(lds, ssq + (size_t)(2 * l + 1) * M * 16, pm0);
          EpiSwiGLU E{ssq + (size_t)(2 * l + 1) * M * 16, (bf16_t*)(ws + WS_ACT), ABL_FFN_SCALE(l), (LAS const float*)(lds + RSL_OFF), pm0};
          pg8::gemm_phase<EpiSwiGLU, pg8::SchedGrid, true>(lds, S, E);
        }
        GRID_SYNC(); { size_t z_ = 0; asm volatile("" : "+s"(z_)); ws += z_; } ssq = (float*)(ws + WS_SSQ);
        { pg8::SchedGrid S; S.nM = 64; S.nN = 4; S.nwg = 256; S.G = G; { int c_ = c; asm volatile("" : "+s"(c_)); S.c = c_; } S.A = (const char*)(ws + WS_ACT); S.B = (const char*)(ws + WS_WDN + l * WDN_L); S.lda2 = DFF * 2; S.ldb2 = DFF * 2; S.nt = DFF / 64;
          EpiResid E{(bf16_t*)(ws + WS_XB), ssq + (size_t)(2 * l + 2) * M * 16};
          pg8::gemm_phase<EpiResid, pg8::SchedGrid, false>(lds, S, E); }
        GRID_SYNC();
    }
    { { size_t z_ = 0; asm volatile("" : "+s"(z_)); ws += z_; } int tid_ = threadIdx.x; asm volatile("" : "+v"(tid_));
      const int lane = tid_ & 63, gw = c * NWAVES + (tid_ >> 6), NGW = G * NWAVES; const float* gf = (const float*)(ws + WS_PAR) + P_FINAL; const float* sq = (const float*)(ws + WS_SSQ) + (size_t)4 * M * 16;
      const bf16_t* XBp = (const bf16_t*)(ws + WS_XB);
      for (int row = gw; row < M; row += 2 * NGW) { const int row2 = row + NGW;
          u32x4 ra_[2], rb_[2];
#pragma unroll
          for (int j = 0; j < 2; ++j) { ra_[j] = *(const u32x4*)(XBp + (size_t)row * D + 512 * j + 8 * lane); rb_[j] = *(const u32x4*)(XBp + (size_t)row2 * D + 512 * j + 8 * lane); }
          const float ra = row_rs(sq, row), rb = row_rs(sq, row2);
#pragma unroll
          for (int j = 0; j < 2; ++j) { const f32x4 g0 = *(const f32x4*)(gf + 512 * j + 8 * lane), g1 = *(const f32x4*)(gf + 512 * j + 8 * lane + 4);
              f32x4 x0, x1; unpack8(ra_[j], x0, x1); float* oa = a.out + (size_t)row * D + 512 * j + 8 * lane; *(f32x4*)oa = x0 * ra * g0; *(f32x4*)(oa + 4) = x1 * ra * g1;
              unpack8(rb_[j], x0, x1); float* ob = a.out + (size_t)row2 * D + 512 * j + 8 * lane; *(f32x4*)ob = x0 * rb * g0; *(f32x4*)(ob + 4) = x1 * rb * g1; } } }
}

extern "C" void kernel_launch(void* const* d_in, const int* in_sizes, int n_in, void* d_out, int out_size, void* d_ws, size_t ws_size, hipStream_t stream) {
    static int grid = 0;
    if (grid == 0) {
        if (n_in != 19 || out_size != M * D || ws_size < WS_END) { fprintf(stderr, "kernel_launch: unexpected shapes (n_in %d out %d ws %zu)\n", n_in, out_size, ws_size); grid = -1; return; }
        int dev = 0, cus = 0, per_cu = 0;
        if (hipGetDevice(&dev) != hipSuccess || hipDeviceGetAttribute(&cus, hipDeviceAttributeMultiprocessorCount, dev) != hipSuccess) { grid = -1; return; }
        if (hipFuncSetAttribute((const void*)fwd_megakernel, hipFuncAttributeMaxDynamicSharedMemorySize, LDS_BYTES) != hipSuccess) { fprintf(stderr, "kernel_launch: hipFuncSetAttribute failed\n"); grid = -1; return; }
        if (hipOccupancyMaxActiveBlocksPerMultiprocessor(&per_cu, (const void*)fwd_megakernel, NTHREADS, LDS_BYTES) != hipSuccess || per_cu < 1) { fprintf(stderr, "kernel_launch: occupancy query says %d\n", per_cu); per_cu = 1; }
        (void)hipGetLastError();
        grid = cus * 1;
    }
    if (grid < 0) return;
    if (hipMemsetAsync((char*)d_ws + WS_BAR, 0, 16384, stream) != hipSuccess) { fprintf(stderr, "kernel_launch: memset failed\n"); return; }
    Args a{};
    for (int i = 0; i < 19; ++i) a.in[i] = (const float*)d_in[i];
    a.out = (float*)d_out; a.ws = (unsigned char*)d_ws;
    void* args[] = {&a};
    hipError_t e = hipLaunchCooperativeKernel((const void*)fwd_megakernel, dim3(grid), dim3(NTHREADS), args, LDS_BYTES, stream);
    if (e != hipSuccess) fprintf(stderr, "cooperative launch failed: %s (grid %d)\n", hipGetErrorString(e), grid);
}
```

```cpp
#include <hip/hip_runtime.h>
#include <hip/hip_cooperative_groups.h>
#include <cstdio>
#include <cstdint>
namespace cg = cooperative_groups;

#define LAS __attribute__((address_space(3)))
typedef unsigned short bf16_t;
typedef short bf16x8 __attribute__((ext_vector_type(8)));
typedef float f32x4 __attribute__((ext_vector_type(4)));
typedef float f32x2 __attribute__((ext_vector_type(2)));
typedef unsigned u32x4 __attribute__((ext_vector_type(4)));
typedef unsigned u32x2 __attribute__((ext_vector_type(2)));

constexpr int M = 16384, D = 1024, SEQ = 2048, NBATCH = 8, DFF = 2816, PROJ = 8448, NLOG1 = 4352  ;
constexpr float EPS = 1e-6f;
constexpr int NTHREADS = 512, NWAVES = 8;
constexpr int LDS_BYTES = 147456;

constexpr size_t MiB = 1u << 20;
constexpr size_t WS_SSQ = 248 * (size_t)(1u << 20);
constexpr size_t WS_PAR = 512 * 1024;
constexpr int PAR_L = 24576, P_SGLNG = 0, P_SGLNB = 512, P_SGB = 1024, P_CVB = 1536, P_CVLNG = 2048, P_CVLNB = 2560, P_SCW = 3072, P_SINK = 4608, P_CVW = 4672, P_FINAL = 2 * PAR_L;
constexpr size_t WS_PTRS = 740 * 1024;
constexpr size_t WS_BAR = 768 * 1024;
constexpr int MISC_OFF = 147200;
constexpr size_t WS_ROPEC = 1 * MiB, WS_ROPES = 1 * MiB + 256 * 1024;
constexpr size_t WS_SGWT = 1 * MiB + 512 * 1024;
constexpr size_t WS_WIN = 2 * MiB, WIN_L = (size_t)PROJ * D * 2;
constexpr size_t WS_WBR = 35 * MiB, WBR_L = 4 * MiB;
constexpr size_t WS_WOUT = 43 * MiB, WOUT_L = 2 * MiB;
constexpr size_t WS_WGU = 47 * MiB, WGU_L = 11 * MiB;
constexpr size_t WS_WDN = 69 * MiB, WDN_L = (size_t)D * DFF * 2;
constexpr size_t WS_XB = 80 * MiB;
constexpr size_t WS_ZA = 112 * MiB;
constexpr size_t WS_MG = WS_ZA;
constexpr size_t WS_GLU = 144 * MiB;
constexpr size_t WS_CH = 160 * MiB;
constexpr size_t WS_TMP = WS_GLU;
constexpr size_t WS_Q = 176 * MiB;
constexpr size_t WS_BG = 192 * MiB;
constexpr size_t WS_K = 208 * MiB, WS_V = 212 * MiB;
constexpr size_t WS_YA = 216 * MiB, WS_YB = 232 * MiB;
constexpr size_t WS_ACT = 112 * MiB;
constexpr size_t WS_END = 254 * MiB;

__device__ const double INVF_REV[32] = {0.15915494309189535, 0.11934937021124886, 0.08949940160889101, 0.06711508300522726, 0.050329212104487035, 0.03774158471741977, 0.0283021958306234, 0.02122365276477766, 0.015915494309189534, 0.011934937021124886, 0.008949940160889102, 0.006711508300522725, 0.005032921210448704, 0.003774158471741977, 0.00283021958306234, 0.0021223652764777662, 0.0015915494309189536, 0.0011934937021124885, 0.0008949940160889102, 0.0006711508300522726, 0.0005032921210448703, 0.00037741584717419774, 0.00028302195830623395, 0.0002122365276477766, 0.00015915494309189535, 0.00011934937021124886, 8.949940160889102e-05, 6.711508300522725e-05, 5.0329212104487035e-05, 3.774158471741978e-05, 2.8302195830623396e-05, 2.122365276477766e-05};

__device__ __forceinline__ unsigned cvt_pk_bf16(float lo, float hi) { unsigned r; asm volatile("v_cvt_pk_bf16_f32 %0, %1, %2" : "=v"(r) : "v"(lo), "v"(hi)); return r; }
__device__ __forceinline__ float bf_lo(unsigned u) { return __builtin_bit_cast(float, u << 16); }
__device__ __forceinline__ float bf_hi(unsigned u) { return __builtin_bit_cast(float, u & 0xffff0000u); }
__device__ __forceinline__ float bf1(bf16_t h) { return __builtin_bit_cast(float, ((unsigned)h) << 16); }
__device__ __forceinline__ float sigmoidf_(float x) { return __builtin_amdgcn_rcpf(1.0f + __expf(-x)); }
template <int CTRL, int ROW_MASK> __device__ __forceinline__ float dpp_mov(float v) {
    return __builtin_bit_cast(float, __builtin_amdgcn_update_dpp(0, __builtin_bit_cast(int, v), CTRL, ROW_MASK, 0xf, true));
}
__device__ __forceinline__ float wave_sum(float v) {
    v += dpp_mov<0xB1, 0xf>(v);
    v += dpp_mov<0x4E, 0xf>(v);
    v += dpp_mov<0x141, 0xf>(v);
    v += dpp_mov<0x140, 0xf>(v);
    v += dpp_mov<0x142, 0xa>(v);
    v += dpp_mov<0x143, 0xc>(v);
    return __builtin_bit_cast(float, __builtin_amdgcn_readlane(__builtin_bit_cast(int, v), 63));
}
__device__ __forceinline__ f32x2 gelu_pk(f32x2 v) {
    const f32x2 av = __builtin_elementwise_abs(v), d = av * 0.2316418882f + 1.0f;
    f32x2 t; t.x = __builtin_amdgcn_rcpf(d.x); t.y = __builtin_amdgcn_rcpf(d.y);
    f32x2 q = t * 0.5307027145f + (-0.7265760135f); q = q * t + 0.7107068705f; q = q * t + (-0.142248368f); q = q * t + 0.127414796f; q = q * t;
    const f32x2 s = (v * v) * (-0.72134752044f);
    f32x2 e; e.x = __builtin_amdgcn_exp2f(s.x); e.y = __builtin_amdgcn_exp2f(s.y);
    const f32x2 m = v * (q * e), r = v - m;
    f32x2 o; o.x = v.x < 0.f ? m.x : r.x; o.y = v.y < 0.f ? m.y : r.y; return o;
}
__device__ __forceinline__ u32x4 pack8(f32x4 a, f32x4 b) { u32x4 w; w.x = cvt_pk_bf16(a[0], a[1]); w.y = cvt_pk_bf16(a[2], a[3]); w.z = cvt_pk_bf16(b[0], b[1]); w.w = cvt_pk_bf16(b[2], b[3]); return w; }
__device__ __forceinline__ void unpack8(u32x4 w, f32x4& a, f32x4& b) { a = (f32x4){bf_lo(w.x), bf_hi(w.x), bf_lo(w.y), bf_hi(w.y)}; b = (f32x4){bf_lo(w.z), bf_hi(w.z), bf_lo(w.w), bf_hi(w.w)}; }

namespace pg8 {
constexpr int BM = 256, BK = 64, HALF = 128, HTB = HALF * BK * 2, STAGE_BYTES = 8 * HTB, NXCD = 8, WGM = 8;
__host__ __device__ __forceinline__ int lds_byte(int r, int c) { const int st = (r >> 4) * 2 + (c >> 5), rr = r & 15, cc = c & 31, ob = rr * 64 + cc * 2; return st * 1024 + (ob ^ (((ob >> 9) & 1) << 5)); }
__host__ __device__ __forceinline__ void stage_rc(int b, int& R, int& C) { const int st = b / 1024, sb = b % 1024, swz = sb ^ (((sb >> 9) & 1) << 5); R = (st >> 1) * 16 + swz / 64; C = (st & 1) * 32 + (swz % 64) / 2; }
__host__ __device__ __forceinline__ int perm32(int rho) { const int n = rho >> 4, i = rho & 15; return 8 * (i >> 2) + 4 * n + (i & 3); }

struct Unit { const char* A; const char* B; int lda2, ldb2, nt, pm, pn, z; };

__device__ __forceinline__ void tile_of(int L, int nM, int nN, int& pm, int& pn) {
    const int nwg = nM * nN; int wgid = L; { const int q = nwg / NXCD, r = nwg % NXCD, xcd = wgid % NXCD, off = wgid / NXCD; wgid = (xcd < r ? xcd * (q + 1) : r * (q + 1) + (xcd - r) * q) + off; }
    const int nig = WGM * nN, gid = wgid / nig, fm = gid * WGM, gsz = (nM - fm) < WGM ? (nM - fm) : WGM;
    pm = fm + ((wgid % nig) % gsz); pn = (wgid % nig) / gsz;
}
struct SchedGrid {
    static constexpr bool VARLD = false;
    int nM, nN, nwg, G, c; const char* A; const char* B; int lda2, ldb2, nt;
    __device__ __forceinline__ bool next(int i, Unit& u) const {
        const long L = (long)i * G + c; if (L >= nwg) return false;
        tile_of((int)L, nM, nN, u.pm, u.pn); u.z = 0;
        u.A = A + (size_t)u.pm * 256 * lda2; u.B = B + (size_t)u.pn * 256 * ldb2; u.lda2 = lda2; u.ldb2 = ldb2; u.nt = nt; return true;
    }
};
struct SchedMerge {
    static constexpr bool VARLD = true;
    int G, c; const char* ws; const char* WG  ; const char* WBR; int swap;
    __device__ __forceinline__ bool next(int i, Unit& u) const {
        const int ti = i >> 3, sub = i & 7; const long L = (long)ti * G + c; if (L >= 256) return false;
        tile_of((int)L, 64, 4, u.pm, u.pn); u.z = sub; const int br = sub >> 1;
        if (((sub & 1) ^ swap) == 0) { u.A = ws + WS_XB + (size_t)u.pm * 256 * 2048; u.lda2 = 2048; u.B = WG + (size_t)(br * 1024 + u.pn * 256) * 2048; u.ldb2 = 2048; u.nt = 16; }
        else { const size_t yo = br == 0 ? WS_YA : br == 1 ? WS_YB : br == 2 ? WS_Q : WS_BG;
               u.A = ws + yo + (size_t)u.pm * 256 * 1024; u.lda2 = 1024; u.B = WBR + (size_t)br * (1024 * 512 * 2) + (size_t)u.pn * 256 * 1024; u.ldb2 = 1024; u.nt = 8; }
        return true;
    }
};

struct SchedOne {
    static constexpr bool VARLD = false;
    SchedMerge M; int i0;
    __device__ __forceinline__ bool next(int i, Unit& u) const { if (i != 0) return false; return M.next(i0, u); }
};
struct SchedOneG {
    static constexpr bool VARLD = false;
    SchedGrid S; int i0;
    __device__ __forceinline__ bool next(int i, Unit& u) const { if (i != 0) return false; return S.next(i0, u); }
};
template <class Epi, class Sched, bool ALIGN_EPI>
__device__ __forceinline__ void gemm_phase(LAS unsigned char* lds, const Sched& S, const Epi& E) {
    int tid_ = threadIdx.x; asm volatile("" : "+v"(tid_));
    const int tid = tid_, wid = __builtin_amdgcn_readfirstlane(tid >> 6), lane = tid & 63, wr = wid >> 2, wc = wid & 3, fr = lane & 15, fq = lane >> 4;
    unsigned rA[2], rB[2], cc2[2];
#pragma unroll
    for (int i = 0; i < 2; ++i) { int R, C; stage_rc(tid * 16 + i * 8192, R, C); rA[i] = (unsigned)R; rB[i] = (unsigned)((R & ~31) + perm32(R & 31)); cc2[i] = (unsigned)C * 2u; }
    const size_t kstep = (size_t)(BK * 2);
    const unsigned ldsw = (unsigned)wid * 1024u;
    const int aoff = lds_byte(wr * 64 + fr, fq * 8), boff = lds_byte(wc * 32 + fr, fq * 8);
#define PG8_SA(b, h) (((b) * 2 + (h)) * HTB)
#define PG8_SB(b, h) ((4 + (b) * 2 + (h)) * HTB)
#define PG8_STAGE(bufoff, gbase, voff) do { _Pragma("unroll") for (int _i = 0; _i < 2; ++_i) \
        __builtin_amdgcn_global_load_lds((const unsigned*)((const char*)(gbase) + (voff)[_i]), (LAS unsigned*)(lds + (bufoff) + ldsw + _i * 8192), 16, 0, 0); } while (0)
#define PG8_LDA(dst, b, h) do { _Pragma("unroll") for (int m = 0; m < 4; ++m) _Pragma("unroll") for (int k = 0; k < 2; ++k) dst[m][k] = *(const LAS bf16x8*)(lds + PG8_SA(b, h) + aoff + m * 2048 + k * 1024); } while (0)
#define PG8_LDB(dst, b, h) do { _Pragma("unroll") for (int n = 0; n < 2; ++n) _Pragma("unroll") for (int k = 0; k < 2; ++k) dst[n][k] = *(const LAS bf16x8*)(lds + PG8_SB(b, h) + boff + n * 2048 + k * 1024); } while (0)
#define PG8_MMA(ai, bj, At, Bt) do { __builtin_amdgcn_s_setprio(1); _Pragma("unroll") for (int m = 0; m < 4; ++m) _Pragma("unroll") for (int n = 0; n < 2; ++n) _Pragma("unroll") for (int k = 0; k < 2; ++k) \
        acc[ai][bj][m][n] = __builtin_amdgcn_mfma_f32_16x16x32_bf16(Bt[n][k], At[m][k], acc[ai][bj][m][n], 0, 0, 0); __builtin_amdgcn_s_setprio(0); } while (0)
#define PG8_WAIT_V(n) asm volatile("s_waitcnt vmcnt(" #n ")" ::: "memory")
#define PG8_WAIT_L(n) asm volatile("s_waitcnt lgkmcnt(" #n ")" ::: "memory")
#define PG8_BAR __builtin_amdgcn_s_barrier()
#define PG8_SCHED __builtin_amdgcn_sched_barrier(0)
    Unit cur, nxt; int ui = 0;
    if (!S.next(0, cur)) return;
    f32x4 acc[2][2][4][2];
#pragma unroll
    for (int a = 0; a < 2; ++a)
#pragma unroll
        for (int b = 0; b < 2; ++b)
#pragma unroll
            for (int m = 0; m < 4; ++m)
#pragma unroll
                for (int n = 0; n < 2; ++n) acc[a][b][m][n] = (f32x4){0.f, 0.f, 0.f, 0.f};
    bf16x8 At[4][2], B0[2][2], B1[2][2];
    unsigned voffA[2], voffB[2];
#pragma unroll
    for (int i = 0; i < 2; ++i) { voffA[i] = rA[i] * (unsigned)cur.lda2 + cc2[i]; voffB[i] = rB[i] * (unsigned)cur.ldb2 + cc2[i]; }
    const char* cA = cur.A; const char* cB = cur.B;
    unsigned hA = (unsigned)HALF * cur.lda2, hB = (unsigned)HALF * cur.ldb2;
    PG8_STAGE(PG8_SB(0, 0), cB, voffB); PG8_STAGE(PG8_SB(0, 1), cB + hB, voffB); PG8_STAGE(PG8_SA(0, 0), cA, voffA); PG8_STAGE(PG8_SA(0, 1), cA + hA, voffA);
    if (wr == 1) PG8_BAR;
    PG8_WAIT_V(2); PG8_BAR;
    PG8_STAGE(PG8_SB(1, 0), cB + kstep, voffB); PG8_STAGE(PG8_SA(1, 0), cA + kstep, voffA); PG8_STAGE(PG8_SB(1, 1), cB + hB + kstep, voffB);
    PG8_WAIT_V(6); PG8_BAR;
    for (;;) {
        const bool has_next = S.next(ui + 1, nxt);
        if (!has_next) nxt = cur;
        unsigned voffAn[2], voffBn[2];
#pragma unroll
        for (int i = 0; i < 2; ++i) { if constexpr (Sched::VARLD) { voffAn[i] = rA[i] * (unsigned)nxt.lda2 + cc2[i]; voffBn[i] = rB[i] * (unsigned)nxt.ldb2 + cc2[i]; } else { voffAn[i] = voffA[i]; voffBn[i] = voffB[i]; } }
        const char* nA = nxt.A; const char* nB = nxt.B;
        const unsigned hAn = Sched::VARLD ? (unsigned)HALF * nxt.lda2 : hA, hBn = Sched::VARLD ? (unsigned)HALF * nxt.ldb2 : hB;
        const int nt = cur.nt;
        for (int t = 0; t < nt; t += 2) {
            const bool last = (t == nt - 2);
            const char* a1 = cA + (size_t)(t + 1) * kstep;
            const char* a2 = last ? nA : cA + (size_t)(t + 2) * kstep; const char* b2 = last ? nB : cB + (size_t)(t + 2) * kstep;
            const char* a3 = a2 + kstep; const char* b3 = b2 + kstep;
            const unsigned hA2 = last ? hAn : hA, hB2 = last ? hBn : hB;
            unsigned vA2[2], vB2[2];
#pragma unroll
            for (int i = 0; i < 2; ++i) { vA2[i] = last ? voffAn[i] : voffA[i]; vB2[i] = last ? voffBn[i] : voffB[i]; }
            PG8_LDB(B0, 0, 0); PG8_LDB(B1, 0, 1); PG8_SCHED; PG8_LDA(At, 0, 0); PG8_STAGE(PG8_SA(1, 1), a1 + hA, voffA);
            PG8_WAIT_V(8); PG8_WAIT_L(0); PG8_BAR; PG8_MMA(0, 0, At, B0); PG8_MMA(0, 1, At, B1); PG8_BAR; PG8_SCHED;
            PG8_LDA(At, 0, 1); PG8_STAGE(PG8_SB(0, 0), b2, vB2); PG8_STAGE(PG8_SB(0, 1), b2 + hB2, vB2); PG8_STAGE(PG8_SA(0, 0), a2, vA2);
            PG8_WAIT_V(8); PG8_WAIT_L(0); PG8_BAR; PG8_MMA(1, 0, At, B0); PG8_MMA(1, 1, At, B1); PG8_BAR; PG8_SCHED;
            PG8_LDB(B0, 1, 0); PG8_LDB(B1, 1, 1); PG8_SCHED; PG8_LDA(At, 1, 0); PG8_STAGE(PG8_SA(0, 1), a2 + hA2, vA2);
            PG8_WAIT_V(8); PG8_WAIT_L(0); PG8_BAR; PG8_MMA(0, 0, At, B0); PG8_MMA(0, 1, At, B1); PG8_BAR; PG8_SCHED;
            PG8_LDA(At, 1, 1); PG8_STAGE(PG8_SB(1, 0), b3, vB2); PG8_STAGE(PG8_SB(1, 1), b3 + hB2, vB2); PG8_STAGE(PG8_SA(1, 0), a3, vA2);
            PG8_WAIT_V(8); PG8_WAIT_L(0); PG8_BAR; PG8_MMA(1, 0, At, B0); PG8_MMA(1, 1, At, B1); PG8_BAR; PG8_SCHED;
        }
        if constexpr (ALIGN_EPI) { if (wr == 0) PG8_BAR; }
        E(acc, cur, wr, wc, fr, fq);
        if (!has_next) break;
#pragma unroll
        for (int a = 0; a < 2; ++a)
#pragma unroll
            for (int b = 0; b < 2; ++b)
#pragma unroll
                for (int m = 0; m < 4; ++m)
#pragma unroll
                    for (int n = 0; n < 2; ++n) acc[a][b][m][n] = (f32x4){0.f, 0.f, 0.f, 0.f};
        cur = nxt; cA = nA; cB = nB; hA = hAn; hB = hBn; ++ui;
#pragma unroll
        for (int i = 0; i < 2; ++i) { voffA[i] = voffAn[i]; voffB[i] = voffBn[i]; }
        if constexpr (ALIGN_EPI) { if (wr == 1) PG8_BAR; }
    }
    PG8_WAIT_V(0);
    if constexpr (!ALIGN_EPI) { if (wr == 0) PG8_BAR; }
    PG8_BAR;
#undef PG8_SA
#undef PG8_SB
#undef PG8_STAGE
#undef PG8_LDA
#undef PG8_LDB
#undef PG8_MMA
#undef PG8_WAIT_V
#undef PG8_WAIT_L
#undef PG8_BAR
#undef PG8_SCHED
}
}

constexpr int RSL_OFF = 133120;
#define EPI_ROWLOOP _Pragma("unroll") for (int ai = 0; ai < 2; ++ai) _Pragma("unroll") for (int m = 0; m < 4; ++m)
#define EPI_RS(row) ((u.pm == pm0) ? rsl[(row) & 255] : row_rs(ssq, (row)))
__device__ __forceinline__ float row_rs(const float* ssq, int row) { const f32x4* p = (const f32x4*)(ssq + (size_t)row * 16); const f32x4 a = p[0], b = p[1], c = p[2], d = p[3];
    const float s = (((a[0] + a[1]) + (a[2] + a[3])) + ((b[0] + b[1]) + (b[2] + b[3]))) + (((c[0] + c[1]) + (c[2] + c[3])) + ((d[0] + d[1]) + (d[2] + d[3])));
    return __builtin_amdgcn_rsqf(s * (1.0f / D) + EPS); }

struct EpiInProj {
    const float* ssq; unsigned char* ws; LAS const float* rsl; int pm0;
    __device__ __forceinline__ void operator()(const f32x4 (&acc)[2][2][4][2], const pg8::Unit& u, int wr, int wc, int fr, int fq) const {
        bf16_t* const ZA = (bf16_t*)(ws + WS_ZA); bf16_t* const GLU = (bf16_t*)(ws + WS_GLU); bf16_t* const BG = (bf16_t*)(ws + WS_BG); bf16_t* const CH = (bf16_t*)(ws + WS_CH);
        const float* const ropeC = (const float*)(ws + WS_ROPEC); const float* const ropeS = (const float*)(ws + WS_ROPES);
        const int T = u.pn, row0 = u.pm * 256 + wr * 64 + fr, jcol = wc * 32 + 8 * fq;
        if (T < 4) {
            EPI_ROWLOOP { const int row = row0 + ai * 128 + m * 16; const float rs = EPI_RS(row);
#pragma unroll
                for (int bj = 0; bj < 2; ++bj) { f32x4 v0 = acc[ai][bj][m][0] * rs, v1 = acc[ai][bj][m][1] * rs;
                    f32x2 a = gelu_pk((f32x2){v0[0], v0[1]}), b = gelu_pk((f32x2){v0[2], v0[3]}), c = gelu_pk((f32x2){v1[0], v1[1]}), d = gelu_pk((f32x2){v1[2], v1[3]});
                    *(u32x4*)(ZA + (size_t)row * 1024 + 256 * T + 128 * bj + jcol) = pack8((f32x4){a.x, a.y, b.x, b.y}, (f32x4){c.x, c.y, d.x, d.y}); } }
        } else if (T < 8) {
            EPI_ROWLOOP { const int row = row0 + ai * 128 + m * 16; const float rs = EPI_RS(row); f32x4 o[2];
#pragma unroll
                for (int n = 0; n < 2; ++n) { const f32x4 a = acc[ai][0][m][n] * rs, g = acc[ai][1][m][n] * rs;
#pragma unroll
                    for (int j = 0; j < 4; ++j) o[n][j] = a[j] * sigmoidf_(g[j]); }
                *(u32x4*)(GLU + (size_t)row * 512 + 128 * (T - 4) + jcol) = pack8(o[0], o[1]); }
        } else if (T < 11) {
            const bool isq = T < 10; const bool rope = isq || wc < 2; const float sc = isq ? 0.125f : 1.0f;
            const size_t boff = isq ? WS_Q : (wc < 2 ? WS_K : WS_V); bf16_t* const base = (bf16_t*)(ws + boff);
            const int ld = isq ? 512 : 128, hcol = isq ? (4 * (T - 8) + wc) * 64 : (wc & 1) * 64;
            EPI_ROWLOOP { const int row = row0 + ai * 128 + m * 16; const float rs = EPI_RS(row) * sc; const int pos = row & (SEQ - 1); f32x4 o1[2], o2[2];
#pragma unroll
                for (int n = 0; n < 2; ++n) { const f32x4 x1 = acc[ai][0][m][n] * rs, x2 = acc[ai][1][m][n] * rs;
                    if (rope) { const f32x4 c = *(const f32x4*)(ropeC + pos * 32 + 8 * fq + 4 * n), s = *(const f32x4*)(ropeS + pos * 32 + 8 * fq + 4 * n);
                        o1[n] = x1 * c - x2 * s; o2[n] = x2 * c + x1 * s; } else { o1[n] = x1; o2[n] = x2; } }
                bf16_t* p = base + (size_t)row * ld + hcol + 8 * fq;
                *(u32x4*)p = pack8(o1[0], o1[1]); *(u32x4*)(p + 32) = pack8(o2[0], o2[1]); }
        } else if (T < 13) {
            EPI_ROWLOOP { const int row = row0 + ai * 128 + m * 16; const float rs = EPI_RS(row);
#pragma unroll
                for (int bj = 0; bj < 2; ++bj) *(u32x4*)(BG + (size_t)row * 512 + 256 * (T - 11) + 128 * bj + jcol) = pack8(acc[ai][bj][m][0] * rs, acc[ai][bj][m][1] * rs); }
        } else {
            EPI_ROWLOOP { const int row = row0 + ai * 128 + m * 16; const float rs = EPI_RS(row); const float rs2 = rs * rs;
                *(u32x4*)(CH + (size_t)row * 512 + 128 * (T - 13) + jcol) = pack8(acc[ai][0][m][0] * acc[ai][1][m][0] * rs2, acc[ai][0][m][1] * acc[ai][1][m][1] * rs2); }
        }
    }
};
struct EpiGate {
    const float* ssq; bf16_t* MG;
    __device__ __forceinline__ void operator()(const f32x4 (&acc)[2][2][4][2], const pg8::Unit& u, int wr, int wc, int fr, int fq) const {
        const int row0 = u.pm * 256 + wr * 64 + fr, col0 = u.pn * 256 + wc * 32 + 8 * fq;
        EPI_ROWLOOP { const int row = row0 + ai * 128 + m * 16; const float rs = row_rs(ssq, row);
#pragma unroll
            for (int bj = 0; bj < 2; ++bj) { f32x4 v0 = acc[ai][bj][m][0] * rs, v1 = acc[ai][bj][m][1] * rs;
#pragma unroll
                for (int j = 0; j < 4; ++j) { v0[j] = sigmoidf_(v0[j]); v1[j] = sigmoidf_(v1[j]); }
                *(u32x4*)(MG + (size_t)row * 1024 + col0 + 128 * bj) = pack8(v0, v1); } }
    }
};
struct EpiBranch {
    bf16_t* MG; bf16_t* TMP;
    __device__ __forceinline__ void operator()(const f32x4 (&acc)[2][2][4][2], const pg8::Unit& u, int wr, int wc, int fr, int fq) const {
        const int row0 = u.pm * 256 + wr * 64 + fr, col0 = u.pn * 256 + wc * 32 + 8 * fq, br = u.z >> 1;
        EPI_ROWLOOP { const int row = row0 + ai * 128 + m * 16;
#pragma unroll
            for (int bj = 0; bj < 2; ++bj) { const size_t off = (size_t)row * 1024 + col0 + 128 * bj;
                f32x4 g0, g1; unpack8(*(const u32x4*)(MG + off), g0, g1);
                f32x4 v0 = acc[ai][bj][m][0] * g0, v1 = acc[ai][bj][m][1] * g1;
                if (br > 0) { f32x4 t0, t1; unpack8(*(const u32x4*)(TMP + off), t0, t1); v0 += t0; v1 += t1; }
                if (br < 3) *(u32x4*)(TMP + off) = pack8(v0, v1); else *(u32x4*)(MG + off) = pack8(v0, v1); } }
    }
};
struct EpiStashB {
    bf16_t* MG;
    __device__ __forceinline__ void operator()(const f32x4 (&acc)[2][2][4][2], const pg8::Unit& u, int wr, int wc, int fr, int fq) const {
        const int row0 = u.pm * 256 + wr * 64 + fr, col0 = u.pn * 256 + wc * 32 + 8 * fq;
        EPI_ROWLOOP { const int row = row0 + ai * 128 + m * 16;
#pragma unroll
            for (int bj = 0; bj < 2; ++bj) *(u32x4*)(MG + (size_t)row * 1024 + col0 + 128 * bj) = pack8(acc[ai][bj][m][0], acc[ai][bj][m][1]); }
    }
};
struct EpiGateAcc {
    const float* ssq; bf16_t* MG; bf16_t* TMP; LAS const float* rsl; int pm0;
    __device__ __forceinline__ void operator()(const f32x4 (&acc)[2][2][4][2], const pg8::Unit& u, int wr, int wc, int fr, int fq) const {
        const int row0 = u.pm * 256 + wr * 64 + fr, col0 = u.pn * 256 + wc * 32 + 8 * fq, br = u.z >> 1;
        u32x4 sb[8][2], tb[8][2];
#define EGA_LOAD(it) do { const int row_ = row0 + ((it) >> 2) * 128 + ((it) & 3) * 16; _Pragma("unroll") for (int bj = 0; bj < 2; ++bj) { const size_t off_ = (size_t)row_ * 1024 + col0 + 128 * bj; \
            sb[it][bj] = *(const u32x4*)(MG + off_); if (br > 0) tb[it][bj] = *(const u32x4*)(TMP + off_); } } while (0)
        EGA_LOAD(0);
#pragma unroll
        for (int it = 0; it < 8; ++it) { const int ai = it >> 2, m = it & 3; const int row = row0 + ai * 128 + m * 16; const float rs = EPI_RS(row);
            if (it + 1 < 8) EGA_LOAD(it + 1);
#pragma unroll
            for (int bj = 0; bj < 2; ++bj) { const size_t off = (size_t)row * 1024 + col0 + 128 * bj;
                f32x4 b0, b1; unpack8(sb[it][bj], b0, b1);
                f32x4 v0 = acc[ai][bj][m][0] * rs, v1 = acc[ai][bj][m][1] * rs;
#pragma unroll
                for (int j = 0; j < 4; ++j) { v0[j] = sigmoidf_(v0[j]) * b0[j]; v1[j] = sigmoidf_(v1[j]) * b1[j]; }
                if (br > 0) { f32x4 t0, t1; unpack8(tb[it][bj], t0, t1); v0 += t0; v1 += t1; }
                if (br < 3) *(u32x4*)(TMP + off) = pack8(v0, v1); else *(u32x4*)(MG + off) = pack8(v0, v1); } }
#undef EGA_LOAD
    }
};
struct EpiMerge2 {
    EpiStashB ES; EpiGateAcc EA;
    __device__ __forceinline__ void operator()(const f32x4 (&acc)[2][2][4][2], const pg8::Unit& u, int wr, int wc, int fr, int fq) const {
        if ((u.z & 1) == 0) ES(acc, u, wr, wc, fr, fq); else EA(acc, u, wr, wc, fr, fq);
    }
};
struct EpiResid {
    bf16_t* XB; float* ssq_out;
    __device__ __forceinline__ void operator()(const f32x4 (&acc)[2][2][4][2], const pg8::Unit& u, int wr, int wc, int fr, int fq) const {
        const int row0 = u.pm * 256 + wr * 64 + fr, col0 = u.pn * 256 + wc * 32 + 8 * fq;
        u32x4 xb[8][2];
#define ER_LOAD(it) do { const int row_ = row0 + ((it) >> 2) * 128 + ((it) & 3) * 16; _Pragma("unroll") for (int bj = 0; bj < 2; ++bj) xb[it][bj] = *(const u32x4*)(XB + (size_t)row_ * 1024 + col0 + 128 * bj); } while (0)
        ER_LOAD(0); ER_LOAD(1);
#pragma unroll
        for (int it = 0; it < 8; ++it) { const int ai = it >> 2, m = it & 3; const int row = row0 + ai * 128 + m * 16; float ss = 0.f;
            if (it + 2 < 8) ER_LOAD(it + 2);
#pragma unroll
            for (int bj = 0; bj < 2; ++bj) { const size_t off = (size_t)row * 1024 + col0 + 128 * bj;
                f32x4 x0, x1; unpack8(xb[it][bj], x0, x1);
                const f32x4 v0 = x0 + acc[ai][bj][m][0], v1 = x1 + acc[ai][bj][m][1];
                *(u32x4*)(XB + off) = pack8(v0, v1);
                ss += (v0[0] * v0[0] + v0[1] * v0[1]) + (v0[2] * v0[2] + v0[3] * v0[3]) + (v1[0] * v1[0] + v1[1] * v1[1]) + (v1[2] * v1[2] + v1[3] * v1[3]); }
            ss += __shfl_xor(ss, 16); ss += __shfl_xor(ss, 32);
            if (fq == 0) ssq_out[(size_t)row * 16 + u.pn * 4 + wc] = ss; }
#undef ER_LOAD
    }
};
struct EpiSwiGLU {
    const float* ssq; bf16_t* ACT; float zero_scale; LAS const float* rsl; int pm0;
    __device__ __forceinline__ void operator()(const f32x4 (&acc)[2][2][4][2], const pg8::Unit& u, int wr, int wc, int fr, int fq) const {
        const int row0 = u.pm * 256 + wr * 64 + fr, col0 = u.pn * 128 + wc * 32 + 8 * fq;
        EPI_ROWLOOP { const int row = row0 + ai * 128 + m * 16; const float rs = EPI_RS(row); f32x4 o[2];
#pragma unroll
            for (int n = 0; n < 2; ++n) { const f32x4 g = acc[ai][0][m][n] * rs, up = acc[ai][1][m][n] * rs;
#pragma unroll
                for (int j = 0; j < 4; ++j) o[n][j] = g[j] * sigmoidf_(g[j]) * up[j] * zero_scale; }
            *(u32x4*)(ACT + (size_t)row * DFF + col0) = pack8(o[0], o[1]); }
    }
};

#define ABL_FFN_SCALE(l) 1.0f
struct Args { const float* in[19]; float* out; unsigned char* ws; };

__device__ __forceinline__ int win_src_col(int nlog) {
    const int T = nlog >> 8, o = nlog & 255, bj = o >> 7, j = o & 127;
    if (T < 4) return nlog;
    if (T < 8) return 1024 + bj * 512 + 128 * (T - 4) + j;
    if (T < 10) return 2048 + (4 * (T - 8) + (j >> 5)) * 64 + 32 * bj + (j & 31);
    if (T == 10) { const int h = j >> 5; return (h < 2 ? 2560 + h * 64 : 2688 + (h - 2) * 64) + 32 * bj + (j & 31); }
    if (T < 13) return 2816 + 256 * (T - 11) + o;
    if (T < 17) return 3328 + bj * 512 + 128 * (T - 13) + j;
    return nlog;
}
template <int NL> __device__ __forceinline__ void tr_item(const float* W, int Nsrc, int k0, int scolA, int scolB, const float* gain, bf16_t* WT, int K, int drow, LAS float* scr, int lane) {
    const int c4 = lane & 15; const int sc = ((c4 >> 3) ? scolB : scolA) + 4 * (c4 & 7);
#pragma unroll
    for (int h = 0; h < 16 / NL; ++h) { f32x4 v[NL];
#pragma unroll
        for (int i = 0; i < NL; ++i) v[i] = __builtin_nontemporal_load((const f32x4*)(W + (size_t)(k0 + 4 * (h * NL + i) + (lane >> 4)) * Nsrc + sc));
#pragma unroll
        for (int i = 0; i < NL; ++i) { const int row = 4 * (h * NL + i) + (lane >> 4); if (gain) v[i] = v[i] * gain[k0 + row];
            LAS float* d = scr + row * 65 + 4 * c4; d[0] = v[i][0]; d[1] = v[i][1]; d[2] = v[i][2]; d[3] = v[i][3]; } }
    asm volatile("s_waitcnt lgkmcnt(0)" ::: "memory");
    const int c = lane & 7;
#pragma unroll
    for (int jj = 0; jj < 8; ++jj) { const int n = (lane >> 3) + 8 * jj; const LAS float* s = scr + (8 * c) * 65 + n;
        u32x4 o; o.x = cvt_pk_bf16(s[0], s[65]); o.y = cvt_pk_bf16(s[2 * 65], s[3 * 65]); o.z = cvt_pk_bf16(s[4 * 65], s[5 * 65]); o.w = cvt_pk_bf16(s[6 * 65], s[7 * 65]);
        *(u32x4*)(WT + (size_t)(drow + n) * K + k0 + 8 * c) = o; }
    asm volatile("s_waitcnt lgkmcnt(0)" ::: "memory");
}
struct WPtrs { const float *w_in, *norm_mix, *w_branch, *w_out, *w_gate_up, *norm_ffn, *w_down; };
constexpr int ITEMS_PER_LAYER = 16 * 132 + 512 + 256 + 16 * 88 + 44 * 16;
constexpr int ITEMS_EARLY = 16 * 132 + 512 + 256, ITEMS_MID = ITEMS_PER_LAYER + 16 * 132;
template <int NL> __device__ __forceinline__ void convert_weights(const WPtrs& wp, unsigned char* ws, LAS unsigned char* lds, int lo, int hi, int w0, int nw) {
    int tid_ = threadIdx.x; asm volatile("" : "+v"(tid_));
    const int lane = tid_ & 63, wave = __builtin_amdgcn_readfirstlane(tid_ >> 6);
    LAS float* scr = (LAS float*)(lds + wave * 16640);
    constexpr int I_IN = 16 * 132, I_BR = 512, I_OUT = 256, I_GU = 16 * 88, I_L = ITEMS_PER_LAYER;
    for (int it = lo + w0; it < hi; it += nw) {
        const int l = it / I_L; int r = it % I_L;
        if (r < I_IN) { const int kb = r / 132, nb = r % 132, n0 = 64 * nb;
            tr_item<NL>(wp.w_in + (size_t)l * D * PROJ, PROJ, 64 * kb, win_src_col(n0), win_src_col(n0 + 32), wp.norm_mix + l * D, (bf16_t*)(ws + WS_WIN + l * WIN_L), D, n0, scr, lane); continue; } r -= I_IN;
        if (r < I_BR) { const int br = r >> 7, q = r & 127, kb = q >> 4, nb = q & 15;
            tr_item<NL>(wp.w_branch + (size_t)(l * 4 + br) * 512 * D, D, 64 * kb, 64 * nb, 64 * nb + 32, nullptr, (bf16_t*)(ws + WS_WBR + l * WBR_L) + (size_t)br * 1024 * 512, 512, 64 * nb, scr, lane); continue; } r -= I_BR;
        if (r < I_OUT) { const int kb = r >> 4, nb = r & 15;
            tr_item<NL>(wp.w_out + (size_t)l * D * D, D, 64 * kb, 64 * nb, 64 * nb + 32, nullptr, (bf16_t*)(ws + WS_WOUT + l * WOUT_L), D, 64 * nb, scr, lane); continue; } r -= I_OUT;
        if (r < I_GU) { const int kb = r / 88, nb = r % 88, n0 = 64 * nb, T = n0 >> 8, o = n0 & 255, sc = (o >> 7) * DFF + 128 * T + (o & 127);
            tr_item<NL>(wp.w_gate_up + (size_t)l * D * 2 * DFF, 2 * DFF, 64 * kb, sc, sc + 32, wp.norm_ffn + l * D, (bf16_t*)(ws + WS_WGU + l * WGU_L), D, n0, scr, lane); continue; } r -= I_GU;
        { const int kb = r >> 4, nb = r & 15;
            tr_item<NL>(wp.w_down + (size_t)l * DFF * D, D, 64 * kb, 64 * nb, 64 * nb + 32, nullptr, (bf16_t*)(ws + WS_WDN + l * WDN_L), DFF, 64 * nb, scr, lane); }
    }
}
__device__ __forceinline__ void prologue(const Args& a, LAS unsigned char* lds, int G) {
    int tid_ = threadIdx.x; asm volatile("" : "+v"(tid_));
    const int tid = tid_, lane = tid & 63, wave = __builtin_amdgcn_readfirstlane(tid >> 6);
    const int gw = blockIdx.x * NWAVES + wave, NGW = G * NWAVES;
    unsigned char* ws = a.ws;
    { const WPtrs wp{a.in[2], a.in[1], a.in[13], a.in[14], a.in[16], a.in[15], a.in[17]};
      if (blockIdx.x == 0 && tid == 0) *(WPtrs*)(ws + WS_PTRS) = wp;
      convert_weights<16>(wp, ws, lds, 0, G == 256 ? ITEMS_EARLY : 2 * ITEMS_PER_LAYER, gw, NGW); }
    float* ssq = (float*)(ws + WS_SSQ);
    for (int row = gw; row < M; row += NGW) {
        const f32x4* xr = (const f32x4*)(a.in[0] + (size_t)row * D) + lane; float s = 0.f; f32x4 v[4];
#pragma unroll
        for (int j = 0; j < 4; ++j) { v[j] = xr[64 * j]; s += (v[j][0] * v[j][0] + v[j][1] * v[j][1]) + (v[j][2] * v[j][2] + v[j][3] * v[j][3]); }
        s = wave_sum(s);
        u32x2* o = (u32x2*)((bf16_t*)(ws + WS_XB) + (size_t)row * D) + lane;
#pragma unroll
        for (int j = 0; j < 4; ++j) o[64 * j] = (u32x2){cvt_pk_bf16(v[j][0], v[j][1]), cvt_pk_bf16(v[j][2], v[j][3])};
        if (lane < 16) ssq[(size_t)row * 16 + lane] = lane == 0 ? s : 0.f;
    }
    { float* par = (float*)(ws + WS_PAR); const int gt = blockIdx.x * NTHREADS + tid, GT = G * NTHREADS;
#define CPY(dstoff, srcp, n) for (int i = gt; i < (n); i += GT) par[(dstoff) + i] = (srcp)[i]
      for (int l = 0; l < 2; ++l) { const int o = l * PAR_L;
          CPY(o + P_SGLNG, a.in[3] + l * 512, 512); CPY(o + P_SGLNB, a.in[4] + l * 512, 512); CPY(o + P_SGB, a.in[6] + l * 512, 512);
          CPY(o + P_CVB, a.in[8] + l * 512, 512); CPY(o + P_CVLNG, a.in[9] + l * 512, 512); CPY(o + P_CVLNB, a.in[10] + l * 512, 512);
          CPY(o + P_SCW, a.in[12] + l * 1536, 1536); CPY(o + P_SINK, a.in[11] + l * 8, 8); CPY(o + P_CVW, a.in[7] + l * 31 * 512, 31 * 512); }
      CPY(P_FINAL, a.in[18], 1024);
#undef CPY
    }
    for (int i = blockIdx.x * NTHREADS + tid; i < SEQ * 32; i += G * NTHREADS) { const int pos = i >> 5, f = i & 31;
        const double rev = (double)pos * INVF_REV[f]; const float fr = (float)(rev - floor(rev));
        ((float*)(ws + WS_ROPEC))[i] = __builtin_amdgcn_cosf(fr); ((float*)(ws + WS_ROPES))[i] = __builtin_amdgcn_sinf(fr); }
    for (int i = blockIdx.x * NTHREADS + tid; i < 2 * 4 * 128 * 128; i += G * NTHREADS) { const int s = i & 127, t = (i >> 7) & 127;
        ((bf16_t*)(ws + WS_SGWT))[i] = s <= t ? (bf16_t)(cvt_pk_bf16(a.in[5][i], 0.f) & 0xffffu) : (bf16_t)0; }
}

__device__ __forceinline__ void mixer_sg(unsigned char* ws, int l, LAS unsigned char* lds, int unit) {
    { size_t z_ = 0; asm volatile("" : "+s"(z_)); ws += z_; } int tid_ = threadIdx.x; asm volatile("" : "+v"(tid_));
    const float* par = (const float*)(ws + WS_PAR) + l * PAR_L;
    const int tid = tid_, lane = tid & 63, wave = __builtin_amdgcn_readfirstlane(tid >> 6);
    const int ck = unit >> 2, g = unit & 3, r0 = ck * 128;
    const bf16_t* ZA = (const bf16_t*)(ws + WS_ZA); bf16_t* YA = (bf16_t*)(ws + WS_YA);
    LAS bf16_t* vnT = (LAS bf16_t*)lds;
    const float* lng = par + P_SGLNG; const float* lnb = par + P_SGLNB;
    const f32x4 g0 = *(const f32x4*)(lng + 8 * lane), g1 = *(const f32x4*)(lng + 8 * lane + 4), b0 = *(const f32x4*)(lnb + 8 * lane), b1 = *(const f32x4*)(lnb + 8 * lane + 4);
    u32x4 raw[16];
#pragma unroll
    for (int i = 0; i < 16; ++i) raw[i] = *(const u32x4*)(ZA + (size_t)(r0 + wave + 8 * i) * 1024 + 512 + 8 * lane);
    const int fr = lane & 15, fq = lane >> 4, t0 = 16 * wave, nks = (wave >> 1) + 1;
    const bf16_t* W = (const bf16_t*)(ws + WS_SGWT) + (size_t)(l * 4 + g) * 16384 + (size_t)(t0 + fr) * 128 + 8 * fq;
    bf16x8 wf[4];
#pragma unroll
    for (int ks = 0; ks < 4; ++ks) wf[ks] = *(const bf16x8*)(W + 32 * (ks < nks ? ks : 0));
    const int tt = t0 + fr; const size_t orow = r0 + tt; const float bs = par[P_SGB + g * 128 + tt];
    u32x2 uu[8];
#pragma unroll
    for (int ct = 0; ct < 8; ++ct) uu[ct] = *(const u32x2*)(ZA + orow * 1024 + 128 * g + 16 * ct + 4 * fq);
#pragma unroll
    for (int i = 0; i < 16; ++i) { const int s = wave + 8 * i;
        f32x4 x0, x1; unpack8(raw[i], x0, x1);
        const float mean = wave_sum((x0[0] + x0[1]) + (x0[2] + x0[3]) + (x1[0] + x1[1]) + (x1[2] + x1[3])) * (1.0f / 512.0f);
        x0 -= mean; x1 -= mean;
        const float var = wave_sum((x0[0] * x0[0] + x0[1] * x0[1]) + (x0[2] * x0[2] + x0[3] * x0[3]) + (x1[0] * x1[0] + x1[1] * x1[1]) + (x1[2] * x1[2] + x1[3] * x1[3])) * (1.0f / 512.0f);
        const float rstd = __builtin_amdgcn_rsqf(var + EPS);
        if ((lane >> 4) == g) { const int c = 8 * (lane & 15); x0 = x0 * rstd * g0 + b0; x1 = x1 * rstd * g1 + b1;
            const unsigned p0 = cvt_pk_bf16(x0[0], x0[1]), p1 = cvt_pk_bf16(x0[2], x0[3]), p2 = cvt_pk_bf16(x1[0], x1[1]), p3 = cvt_pk_bf16(x1[2], x1[3]);
            LAS bf16_t* d = vnT + c * 136 + (s ^ (8 * (lane & 15)));
            d[0] = (bf16_t)p0; d[136] = (bf16_t)(p0 >> 16); d[2 * 136] = (bf16_t)p1; d[3 * 136] = (bf16_t)(p1 >> 16);
            d[4 * 136] = (bf16_t)p2; d[5 * 136] = (bf16_t)(p2 >> 16); d[6 * 136] = (bf16_t)p3; d[7 * 136] = (bf16_t)(p3 >> 16); }
    }
    __syncthreads();
    { f32x4 acc[8];
#pragma unroll
      for (int ct = 0; ct < 8; ++ct) acc[ct] = (f32x4){0.f, 0.f, 0.f, 0.f};
#pragma unroll
      for (int ks = 0; ks < 4; ++ks) if (ks < nks) {
#pragma unroll
          for (int ct = 0; ct < 8; ++ct) { const bf16x8 vf = *(const LAS bf16x8*)(vnT + (16 * ct + fr) * 136 + 8 * ((4 * ks + fq) ^ ((2 * ct + (fr >> 3)) & 15)));
              acc[ct] = __builtin_amdgcn_mfma_f32_16x16x32_bf16(vf, wf[ks], acc[ct], 0, 0, 0); }
      }
#pragma unroll
      for (int ct = 0; ct < 8; ++ct) { const int c = 128 * g + 16 * ct + 4 * fq;
          const float o0 = bf_lo(uu[ct].x) * (acc[ct][0] + bs), o1 = bf_hi(uu[ct].x) * (acc[ct][1] + bs), o2 = bf_lo(uu[ct].y) * (acc[ct][2] + bs), o3 = bf_hi(uu[ct].y) * (acc[ct][3] + bs);
          *(u32x2*)(YA + orow * 512 + c) = (u32x2){cvt_pk_bf16(o0, o1), cvt_pk_bf16(o2, o3)}; }
    }
    __syncthreads();
}
__device__ __forceinline__ void mixer_conv(unsigned char* ws, int l, LAS unsigned char* lds, int unit) {
    { size_t z_ = 0; asm volatile("" : "+s"(z_)); ws += z_; } int tid_ = threadIdx.x; asm volatile("" : "+v"(tid_));
    const float* par = (const float*)(ws + WS_PAR) + l * PAR_L;
    const int tid = tid_, lane = tid & 63, wave = tid >> 6;
    const int b = unit >> 6, tb = unit & 63, t0 = tb * 32; const size_t rbase = (size_t)b * SEQ;
    const bf16_t* GLU = (const bf16_t*)(ws + WS_GLU); bf16_t* YB = (bf16_t*)(ws + WS_YB);
    LAS bf16_t* in = (LAS bf16_t*)lds;
    LAS float* cv = (LAS float*)(lds + 65536);
    for (int i = tid; i < 62 * 64; i += NTHREADS) { const int r = i >> 6, ch = i & 63; const int t = t0 - 30 + r;
        u32x4 v = {0u, 0u, 0u, 0u}; if (t >= 0) v = *(const u32x4*)(GLU + (rbase + t) * 512 + 8 * ch);
        *(LAS u32x4*)(in + r * 512 + 8 * ch) = v; }
    __syncthreads();
    { const int c = tid; float w[31], x[62];
#pragma unroll
      for (int k = 0; k < 31; ++k) w[k] = par[P_CVW + k * 512 + c];
#pragma unroll
      for (int r = 0; r < 62; ++r) x[r] = bf1(in[r * 512 + c]);
      const float bias = par[P_CVB + c];
#pragma unroll
      for (int t = 0; t < 32; ++t) { float s = bias;
#pragma unroll
          for (int k = 0; k < 31; ++k) s += w[k] * x[t + k];
          cv[t * 512 + c] = s; } }
    __syncthreads();
    { const float* lng = par + P_CVLNG; const float* lnb = par + P_CVLNB;
      const f32x4 g0 = *(const f32x4*)(lng + 8 * lane), g1 = *(const f32x4*)(lng + 8 * lane + 4), b0 = *(const f32x4*)(lnb + 8 * lane), b1 = *(const f32x4*)(lnb + 8 * lane + 4);
      for (int t = wave; t < 32; t += NWAVES) {
          f32x4 x0 = *(const LAS f32x4*)(cv + t * 512 + 8 * lane), x1 = *(const LAS f32x4*)(cv + t * 512 + 8 * lane + 4);
          const float mean = wave_sum((x0[0] + x0[1]) + (x0[2] + x0[3]) + (x1[0] + x1[1]) + (x1[2] + x1[3])) * (1.0f / 512.0f);
          x0 -= mean; x1 -= mean;
          const float var = wave_sum((x0[0] * x0[0] + x0[1] * x0[1]) + (x0[2] * x0[2] + x0[3] * x0[3]) + (x1[0] * x1[0] + x1[1] * x1[1]) + (x1[2] * x1[2] + x1[3] * x1[3])) * (1.0f / 512.0f);
          const float rstd = __builtin_amdgcn_rsqf(var + EPS);
          x0 = x0 * rstd * g0 + b0; x1 = x1 * rstd * g1 + b1;
#pragma unroll
          for (int j = 0; j < 4; ++j) { x0[j] = x0[j] * sigmoidf_(x0[j]); x1[j] = x1[j] * sigmoidf_(x1[j]); }
          *(u32x4*)(YB + (rbase + t0 + t) * 512 + 8 * lane) = pack8(x0, x1); } }
    __syncthreads();
}
__device__ __forceinline__ void mixer_attn(unsigned char* ws, int l, LAS unsigned char* lds, int unit) {
    { size_t z_ = 0; asm volatile("" : "+s"(z_)); ws += z_; } int tid_ = threadIdx.x; asm volatile("" : "+v"(tid_));
    const float* par = (const float*)(ws + WS_PAR) + l * PAR_L;
    const int tid = tid_, lane = tid & 63, wave = __builtin_amdgcn_readfirstlane(tid >> 6), fr = lane & 15, fq = lane >> 4;
    const int kvh = unit & 1, blk = (unit >> 1) & 15, b = unit >> 5; const size_t rbase = (size_t)b * SEQ;
    bf16_t* Q = (bf16_t*)(ws + WS_Q); const bf16_t* K = (const bf16_t*)(ws + WS_K); const bf16_t* V = (const bf16_t*)(ws + WS_V);
    LAS bf16_t* Kl = (LAS bf16_t*)lds;
    LAS bf16_t* VT = (LAS bf16_t*)(lds + 36864);
    for (int i = tid; i < 256 * 8; i += NTHREADS) { const int r = i >> 3, ch = i & 7; const int t = (blk - 1) * 128 + r;
        u32x4 kv = {0u, 0u, 0u, 0u}, vv = {0u, 0u, 0u, 0u};
        if (t >= 0) { kv = *(const u32x4*)(K + (rbase + t) * 128 + kvh * 64 + 8 * ch); vv = *(const u32x4*)(V + (rbase + t) * 128 + kvh * 64 + 8 * ch); }
        *(LAS u32x4*)(Kl + r * 72 + 8 * ch) = kv;
        LAS bf16_t* d = VT + (8 * ch) * 264 + r;
        d[0] = (bf16_t)vv.x; d[264] = (bf16_t)(vv.x >> 16); d[2 * 264] = (bf16_t)vv.y; d[3 * 264] = (bf16_t)(vv.y >> 16);
        d[4 * 264] = (bf16_t)vv.z; d[5 * 264] = (bf16_t)(vv.z >> 16); d[6 * 264] = (bf16_t)vv.w; d[7 * 264] = (bf16_t)(vv.w >> 16); }
    __syncthreads();
    const int g = wave >> 1, head = kvh * 4 + g; const float sink = par[P_SINK + head];
    for (int it = 0; it < 2; ++it) {
        const int qs = 2 * (wave & 1) + it, qi0 = 32 * qs; const size_t qrow0 = rbase + blk * 128 + qi0;
        bf16x8 qf[2][2];
#pragma unroll
        for (int qt = 0; qt < 2; ++qt)
#pragma unroll
            for (int ks = 0; ks < 2; ++ks) qf[qt][ks] = *(const bf16x8*)(Q + (qrow0 + 16 * qt + fr) * 512 + head * 64 + 32 * ks + 8 * fq);
        f32x4 S[2][10];
#pragma unroll
        for (int qt = 0; qt < 2; ++qt)
#pragma unroll
            for (int kt = 0; kt < 10; ++kt) S[qt][kt] = (f32x4){0.f, 0.f, 0.f, 0.f};
#pragma unroll
        for (int kt = 0; kt < 10; ++kt)
#pragma unroll
            for (int ks = 0; ks < 2; ++ks) { const bf16x8 kf = *(const LAS bf16x8*)(Kl + (qi0 + 16 * kt + fr) * 72 + 32 * ks + 8 * fq);
#pragma unroll
                for (int qt = 0; qt < 2; ++qt) S[qt][kt] = __builtin_amdgcn_mfma_f32_16x16x32_bf16(kf, qf[qt][ks], S[qt][kt], 0, 0, 0); }
        bf16x8 pf[2][5];
#pragma unroll
        for (int qt = 0; qt < 2; ++qt) { const int qi = qi0 + 16 * qt + fr; float mx = sink;
#pragma unroll
            for (int kt = 0; kt < 10; ++kt)
#pragma unroll
                for (int j = 0; j < 4; ++j) { const int kb = qi0 + 16 * kt + 4 * fq + j; const bool valid = (kb > qi) && (kb <= qi + 128) && (blk > 0 || kb >= 128);
                    const float sv = valid ? S[qt][kt][j] : -INFINITY; S[qt][kt][j] = sv; mx = fmaxf(mx, sv); }
            mx = fmaxf(mx, __shfl_xor(mx, 16)); mx = fmaxf(mx, __shfl_xor(mx, 32));
            float sum = 0.f;
#pragma unroll
            for (int kt = 0; kt < 10; ++kt)
#pragma unroll
                for (int j = 0; j < 4; ++j) { const float p = __expf(S[qt][kt][j] - mx); S[qt][kt][j] = p; sum += p; }
            sum += __shfl_xor(sum, 16); sum += __shfl_xor(sum, 32);
            const float inv = 1.0f / (sum + __expf(sink - mx));
#pragma unroll
            for (int p = 0; p < 5; ++p) { const f32x4 a0 = S[qt][2 * p] * inv, a1 = S[qt][2 * p + 1] * inv; pf[qt][p] = __builtin_bit_cast(bf16x8, pack8(a0, a1)); }
        }
        f32x4 o[2][4];
#pragma unroll
        for (int qt = 0; qt < 2; ++qt)
#pragma unroll
            for (int dt = 0; dt < 4; ++dt) o[qt][dt] = (f32x4){0.f, 0.f, 0.f, 0.f};
#pragma unroll
        for (int p = 0; p < 5; ++p)
#pragma unroll
            for (int dt = 0; dt < 4; ++dt) { const LAS bf16_t* vp = VT + (16 * dt + fr) * 264 + qi0 + 32 * p + 4 * fq;
                const u32x2 lo = *(const LAS u32x2*)vp, hi = *(const LAS u32x2*)(vp + 16);
                const bf16x8 vf = __builtin_bit_cast(bf16x8, (u32x4){lo.x, lo.y, hi.x, hi.y});
#pragma unroll
                for (int qt = 0; qt < 2; ++qt) o[qt][dt] = __builtin_amdgcn_mfma_f32_16x16x32_bf16(vf, pf[qt][p], o[qt][dt], 0, 0, 0); }
#pragma unroll
        for (int qt = 0; qt < 2; ++qt)
#pragma unroll
            for (int dt = 0; dt < 4; ++dt) *(u32x2*)(Q + (qrow0 + 16 * qt + fr) * 512 + head * 64 + 16 * dt + 4 * fq) = (u32x2){cvt_pk_bf16(o[qt][dt][0], o[qt][dt][1]), cvt_pk_bf16(o[qt][dt][2], o[qt][dt][3])};
    }
    __syncthreads();
}
__device__ __forceinline__ void mixer_sc(unsigned char* ws, int l, int G) {
    { size_t z_ = 0; asm volatile("" : "+s"(z_)); ws += z_; } int tid_ = threadIdx.x; asm volatile("" : "+v"(tid_));
    bf16_t* BG = (bf16_t*)(ws + WS_BG); const bf16_t* CH = (const bf16_t*)(ws + WS_CH);
    const float* w = (const float*)(ws + WS_PAR) + l * PAR_L + P_SCW;
    for (int i = blockIdx.x * NTHREADS + tid_; i < (M / 8) * 64; i += G * NTHREADS) {
        const int row0 = 8 * (i >> 6), c = 8 * (i & 63), t0 = row0 & (SEQ - 1);
        u32x4 ch[10], bg[8];
#pragma unroll
        for (int r = 0; r < 10; ++r) { ch[r] = (u32x4){0u, 0u, 0u, 0u}; if (t0 - 2 + r >= 0) ch[r] = *(const u32x4*)(CH + (size_t)(row0 - 2 + r) * 512 + c); }
#pragma unroll
        for (int r = 0; r < 8; ++r) bg[r] = *(const u32x4*)(BG + (size_t)(row0 + r) * 512 + c);
        f32x4 wa[3], wb[3];
#pragma unroll
        for (int k = 0; k < 3; ++k) { wa[k] = *(const f32x4*)(w + k * 512 + c); wb[k] = *(const f32x4*)(w + k * 512 + c + 4); }
#pragma unroll
        for (int r = 0; r < 8; ++r) { f32x4 a0 = {0.f, 0.f, 0.f, 0.f}, a1 = a0;
#pragma unroll
            for (int k = 0; k < 3; ++k) { f32x4 x0, x1; unpack8(ch[r + k], x0, x1); a0 += x0 * wa[k]; a1 += x1 * wb[k]; }
            f32x4 g0, g1; unpack8(bg[r], g0, g1);
            *(u32x4*)(BG + (size_t)(row0 + r) * 512 + c) = pack8(g0 * a0, g1 * a1); }
    }
}

#define RLX_AGENT __ATOMIC_RELAXED, __HIP_MEMORY_SCOPE_AGENT
#define XB_TMO      128
#define XB_XCNT(j)  (256  + 64 * (j))
#define XB_XSUB(j)  (1280 + 64 * (j))
#define XB_XGEN(j)  (2304 + 64 * (j))
#define XB_TOP      3328
#define XB_TOPGEN   3392
#define XCD_BAR_WORDS 3456
#define XB_SPIN_CAP (1u << 18)

__device__ __forceinline__ unsigned xb_ld(unsigned* p)              { return __hip_atomic_load(p, __ATOMIC_RELAXED, __HIP_MEMORY_SCOPE_AGENT); }
__device__ __forceinline__ unsigned xb_add(unsigned* p, unsigned v) { return __hip_atomic_fetch_add(p, v, __ATOMIC_RELAXED, __HIP_MEMORY_SCOPE_AGENT); }
__device__ __forceinline__ unsigned xb_xcc_id() { return (unsigned)__builtin_amdgcn_s_getreg((3 << 11) | 20) & 0xFu; }
#define XB_SPIN(cond, bar) do { unsigned _sp = 0; while (cond) { __builtin_amdgcn_s_sleep(1); \
    if ((++_sp & 255u) == 0u) { if (xb_ld(&(bar)[XB_TMO])) break; if (_sp > XB_SPIN_CAP) { atomicAdd(&(bar)[XB_TMO], 1u); break; } } } } while (0)

struct XcdBarrier {
    unsigned* bar; unsigned x;
    volatile LAS unsigned* st;
};

__device__ __forceinline__ XcdBarrier xcd_barrier_post(unsigned* bar, volatile LAS unsigned* st) {
    XcdBarrier b; b.bar = bar; b.x = xb_xcc_id(); b.st = st;
    if (threadIdx.x == 0) (void)xb_add(&bar[XB_XCNT(b.x)], 1u);
    return b;
}
__device__ __forceinline__ void xcd_barrier_complete(unsigned* bar, unsigned x, unsigned& nloc, unsigned& nx) {
    const unsigned G = gridDim.x * gridDim.y * gridDim.z;
    unsigned sum, cnt, mine, sp = 0u;
    for (;;) {
        sum = 0u; cnt = 0u; mine = 0u;
#pragma unroll
        for (unsigned j = 0; j < 16; ++j) { const unsigned c = xb_ld(&bar[XB_XCNT(j)]); sum += c; cnt += (c > 0u) ? 1u : 0u; mine = (j == x) ? c : mine; }
        if (sum == G) break;
        __builtin_amdgcn_s_sleep(1);
        if ((++sp & 255u) == 0u) { if (xb_ld(&bar[XB_TMO])) break; if (sp > XB_SPIN_CAP) { atomicAdd(&bar[XB_TMO], 1u); break; } }
    }
    nloc = mine > 0u ? mine : 1u; nx = cnt > 0u ? cnt : 1u;
}

__device__ __forceinline__ void xcd_barrier(const XcdBarrier& b) {
    asm volatile("s_waitcnt vmcnt(0)" ::: "memory");
    __syncthreads();
    if (threadIdx.x == 0) {
        unsigned* bar = b.bar;
        __builtin_amdgcn_s_waitcnt(0);
        unsigned nloc = b.st[0], nx = b.st[1];
        if (nloc == 0u) { xcd_barrier_complete(bar, b.x, nloc, nx); b.st[0] = nloc; b.st[1] = nx; }
        const unsigned old = xb_add(&bar[XB_XSUB(b.x)], 1u);
        const unsigned gen = old / nloc;
        if (old + 1u == (gen + 1u) * nloc) {
            __builtin_amdgcn_fence(__ATOMIC_RELEASE, "agent");
            asm volatile("s_waitcnt vmcnt(0)" ::: "memory");
            const unsigned og = xb_add(&bar[XB_TOP], 1u);
            const unsigned tg = og / nx;
            if (og + 1u == (tg + 1u) * nx) xb_add(&bar[XB_TOPGEN], 1u);
            else XB_SPIN(xb_ld(&bar[XB_TOPGEN]) == tg, bar);
            __builtin_amdgcn_fence(__ATOMIC_ACQUIRE, "agent");
            xb_add(&bar[XB_XGEN(b.x)], 1u);
            asm volatile("s_waitcnt vmcnt(0)" ::: "memory");
        } else {
            XB_SPIN(xb_ld(&bar[XB_XGEN(b.x)]) == gen, bar);
            __builtin_amdgcn_fence(__ATOMIC_ACQUIRE, "agent");
            asm volatile("s_waitcnt vmcnt(0)" ::: "memory");
        }
    }
    __syncthreads();
}


__device__ __forceinline__ void stage_rs(LAS unsigned char* lds, const float* ssq, int pm) {
    int tid_ = threadIdx.x; asm volatile("" : "+v"(tid_));
    if (tid_ < 256 && pm >= 0) ((LAS float*)(lds + RSL_OFF))[tid_] = row_rs(ssq, pm * 256 + tid_);
    __syncthreads();
}
#define GRID_SYNC() do { XcdBarrier xb_; xb_.bar = (unsigned*)(ws + WS_BAR); xb_.x = xb_xcc_id(); xb_.st = (volatile LAS unsigned*)(lds + MISC_OFF); xcd_barrier(xb_); } while (0)
__global__ void __launch_bounds__(NTHREADS, 2) fwd_megakernel(Args a) {
    extern __shared__ __attribute__((aligned(16))) unsigned char lds_raw[];
    LAS unsigned char* lds = (LAS unsigned char*)lds_raw;
    cg::grid_group grid = cg::this_grid();
    const int G = gridDim.x, c = blockIdx.x;
    unsigned char* ws = a.ws;
    float* ssq = (float*)(ws + WS_SSQ);

    { volatile LAS unsigned* misc = (volatile LAS unsigned*)(lds + MISC_OFF); if (threadIdx.x < 16) misc[threadIdx.x] = 0u; }
    __syncthreads();
    grid.sync();
    (void)xcd_barrier_post((unsigned*)(ws + WS_BAR), (volatile LAS unsigned*)(lds + MISC_OFF));
    prologue(a, lds, G);
    GRID_SYNC();

    for (int l = 0; l < 2; ++l) {
        { size_t z_ = 0; asm volatile("" : "+s"(z_)); ws += z_; } ssq = (float*)(ws + WS_SSQ);
        const float* ssq_mix = ssq + (size_t)(2 * l) * M * 16;
        { pg8::SchedGrid S; S.nM = 64; S.nN = 17; S.nwg = 64 * 17; S.G = G; { int c_ = c; asm volatile("" : "+s"(c_)); S.c = c_; } S.A = (const char*)(ws + WS_XB); S.B = (const char*)(ws + WS_WIN + l * WIN_L); S.lda2 = 2048; S.ldb2 = 2048; S.nt = 16;
          int pm0 = -1; { pg8::Unit u0; if (S.next(0, u0)) pm0 = u0.pm; } stage_rs(lds, ssq_mix, pm0);
          EpiInProj E{ssq_mix, ws, (LAS const float*)(lds + RSL_OFF), pm0};
          pg8::gemm_phase<EpiInProj, pg8::SchedGrid, true>(lds, S, E);
          if (l == 0 && G == 256 && c >= 64) {
              const int wv = __builtin_amdgcn_readfirstlane((int)threadIdx.x >> 6); const WPtrs wp = *(const WPtrs*)(ws + WS_PTRS);
              convert_weights<16>(wp, ws, lds, ITEMS_EARLY, ITEMS_MID, (c - 64) * NWAVES + wv, 192 * NWAVES); }
        }
        GRID_SYNC(); { size_t z_ = 0; asm volatile("" : "+s"(z_)); ws += z_; }
        for (int u = c; u < 512; u += G) mixer_sg(ws, l, lds, u);
        for (int u = c; u < 512; u += G) mixer_conv(ws, l, lds, u);
        for (int u = c; u < 256; u += G) mixer_attn(ws, l, lds, u);
        mixer_sc(ws, l, G);
        GRID_SYNC(); { size_t z_ = 0; asm volatile("" : "+s"(z_)); ws += z_; } ssq = (float*)(ws + WS_SSQ);
        { pg8::SchedMerge S; S.G = G; { int c_ = c; asm volatile("" : "+s"(c_)); S.c = c_; } S.ws = (const char*)ws; S.WG = (const char*)(ws + WS_WIN + l * WIN_L) + (size_t)NLOG1 * 2048;
          S.WBR = (const char*)(ws + WS_WBR + l * WBR_L);
          S.swap = 1; int pm0 = -1; { pg8::Unit u0; if (S.next(0, u0)) pm0 = u0.pm; } stage_rs(lds, ssq_mix, pm0);
          EpiStashB ES{(bf16_t*)(ws + WS_MG)}; EpiGateAcc EA{ssq_mix, (bf16_t*)(ws + WS_MG), (bf16_t*)(ws + WS_TMP), (LAS const float*)(lds + RSL_OFF), pm0};
          EpiMerge2 E2{ES, EA};
          pg8::gemm_phase<EpiMerge2, pg8::SchedMerge, true>(lds, S, E2);
        }
        GRID_SYNC(); { size_t z_ = 0; asm volatile("" : "+s"(z_)); ws += z_; } ssq = (float*)(ws + WS_SSQ);
        { pg8::SchedGrid S; S.nM = 64; S.nN = 4; S.nwg = 256; S.G = G; { int c_ = c; asm volatile("" : "+s"(c_)); S.c = c_; } S.A = (const char*)(ws + WS_MG); S.B = (const char*)(ws + WS_WOUT + l * WOUT_L); S.lda2 = 2048; S.ldb2 = 2048; S.nt = 16;
          EpiResid E{(bf16_t*)(ws + WS_XB), ssq + (size_t)(2 * l + 1) * M * 16};
          pg8::gemm_phase<EpiResid, pg8::SchedGrid, false>(lds, S, E); }
        GRID_SYNC(); { size_t z_ = 0; asm volatile("" : "+s"(z_)); ws += z_; } ssq = (float*)(ws + WS_SSQ);
        { pg8::SchedGrid S; S.nM = 64; S.nN = 22; S.nwg = 64 * 22; S.G = G; { int c_ = c; asm volatile("" : "+s"(c_)); S.c = c_; } S.A = (const char*)(ws + WS_XB); S.B = (const char*)(ws + WS_WGU + l * WGU_L); S.lda2 = 2048; S.ldb2 = 2048; S.nt = 16;
          int pm0 = -1; { pg8::Unit u0; if (S.next(0, u0)) pm0 = u0.pm; } stage_rs(lds, ssq + (size_t)(2 * l + 1) * M * 16, pm0);
          EpiSwiGLU E{ssq + (size_t)(2 * l + 1) * M * 16, (bf16_t*)(ws + WS_ACT), ABL_FFN_SCALE(l), (LAS const float*)(lds + RSL_OFF), pm0};
          pg8::gemm_phase<EpiSwiGLU, pg8::SchedGrid, true>(lds, S, E);
          if (l == 0 && G == 256 && c >= 128) {
              const int wv = __builtin_amdgcn_readfirstlane((int)threadIdx.x >> 6); const WPtrs wp = *(const WPtrs*)(ws + WS_PTRS);
              convert_weights<16>(wp, ws, lds, ITEMS_MID, 2 * ITEMS_PER_LAYER, (c - 128) * NWAVES + wv, 128 * NWAVES); }
        }
        GRID_SYNC(); { size_t z_ = 0; asm volatile("" : "+s"(z_)); ws += z_; } ssq = (float*)(ws + WS_SSQ);
        { pg8::SchedGrid S; S.nM = 64; S.nN = 4; S.nwg = 256; S.G = G; { int c_ = c; asm volatile("" : "+s"(c_)); S.c = c_; } S.A = (const char*)(ws + WS_ACT); S.B = (const char*)(ws + WS_WDN + l * WDN_L); S.lda2 = DFF * 2; S.ldb2 = DFF * 2; S.nt = DFF / 64;
          EpiResid E{(bf16_t*)(ws + WS_XB), ssq + (size_t)(2 * l + 2) * M * 16};
          pg8::gemm_phase<EpiResid, pg8::SchedGrid, false>(lds, S, E); }
        GRID_SYNC();
    }
    { { size_t z_ = 0; asm volatile("" : "+s"(z_)); ws += z_; } int tid_ = threadIdx.x; asm volatile("" : "+v"(tid_));
      const int lane = tid_ & 63, gw = c * NWAVES + (tid_ >> 6), NGW = G * NWAVES; const float* gf = (const float*)(ws + WS_PAR) + P_FINAL; const float* sq = (const float*)(ws + WS_SSQ) + (size_t)4 * M * 16;
      const bf16_t* XBp = (const bf16_t*)(ws + WS_XB);
      for (int row = gw; row < M; row += 2 * NGW) { const int row2 = row + NGW;
          u32x4 ra_[2], rb_[2];
#pragma unroll
          for (int j = 0; j < 2; ++j) { ra_[j] = *(const u32x4*)(XBp + (size_t)row * D + 512 * j + 8 * lane); rb_[j] = *(const u32x4*)(XBp + (size_t)row2 * D + 512 * j + 8 * lane); }
          const float ra = row_rs(sq, row), rb = row_rs(sq, row2);
#pragma unroll
          for (int j = 0; j < 2; ++j) { const f32x4 g0 = *(const f32x4*)(gf + 512 * j + 8 * lane), g1 = *(const f32x4*)(gf + 512 * j + 8 * lane + 4);
              f32x4 x0, x1; unpack8(ra_[j], x0, x1); float* oa = a.out + (size_t)row * D + 512 * j + 8 * lane; *(f32x4*)oa = x0 * ra * g0; *(f32x4*)(oa + 4) = x1 * ra * g1;
              unpack8(rb_[j], x0, x1); float* ob = a.out + (size_t)row2 * D + 512 * j + 8 * lane; *(f32x4*)ob = x0 * rb * g0; *(f32x4*)(ob + 4) = x1 * rb * g1; } } }
}

extern "C" void kernel_launch(void* const* d_in, const int* in_sizes, int n_in, void* d_out, int out_size, void* d_ws, size_t ws_size, hipStream_t stream) {
    static int grid = 0;
    if (grid == 0) {
        if (n_in != 19 || out_size != M * D || ws_size < WS_END) { fprintf(stderr, "kernel_launch: unexpected shapes (n_in %d out %d ws %zu)\n", n_in, out_size, ws_size); grid = -1; return; }
        int dev = 0, cus = 0, per_cu = 0;
        if (hipGetDevice(&dev) != hipSuccess || hipDeviceGetAttribute(&cus, hipDeviceAttributeMultiprocessorCount, dev) != hipSuccess) { grid = -1; return; }
        if (hipFuncSetAttribute((const void*)fwd_megakernel, hipFuncAttributeMaxDynamicSharedMemorySize, LDS_BYTES) != hipSuccess) { fprintf(stderr, "kernel_launch: hipFuncSetAttribute failed\n"); grid = -1; return; }
        if (hipOccupancyMaxActiveBlocksPerMultiprocessor(&per_cu, (const void*)fwd_megakernel, NTHREADS, LDS_BYTES) != hipSuccess || per_cu < 1) { fprintf(stderr, "kernel_launch: occupancy query says %d\n", per_cu); per_cu = 1; }
        (void)hipGetLastError();
        grid = cus * 1;
    }
    if (grid < 0) return;
    if (hipMemsetAsync((char*)d_ws + WS_BAR, 0, 16384, stream) != hipSuccess) { fprintf(stderr, "kernel_launch: memset failed\n"); return; }
    Args a{};
    for (int i = 0; i < 19; ++i) a.in[i] = (const float*)d_in[i];
    a.out = (float*)d_out; a.ws = (unsigned char*)d_ws;
    void* args[] = {&a};
    hipError_t e = hipLaunchCooperativeKernel((const void*)fwd_megakernel, dim3(grid), dim3(NTHREADS), args, LDS_BYTES, stream);
    if (e != hipSuccess) fprintf(stderr, "cooperative launch failed: %s (grid %d)\n", hipGetErrorString(e), grid);
}
```

```cpp
#include <hip/hip_runtime.h>
#include <hip/hip_cooperative_groups.h>
#include <cstdio>
#include <cstdint>
namespace cg = cooperative_groups;

#define LAS __attribute__((address_space(3)))
typedef unsigned short bf16_t;
typedef short bf16x8 __attribute__((ext_vector_type(8)));
typedef float f32x4 __attribute__((ext_vector_type(4)));
typedef float f32x2 __attribute__((ext_vector_type(2)));
typedef unsigned u32x4 __attribute__((ext_vector_type(4)));
typedef unsigned u32x2 __attribute__((ext_vector_type(2)));

constexpr int M = 16384, D = 1024, SEQ = 2048, NBATCH = 8, DFF = 2816, PROJ = 8448, NLOG1 = 4352  ;
constexpr float EPS = 1e-6f;
constexpr int NTHREADS = 512, NWAVES = 8;
constexpr int LDS_BYTES = 147456;

constexpr size_t MiB = 1u << 20;
constexpr size_t WS_SSQ = 248 * (size_t)(1u << 20);
constexpr size_t WS_PAR = 512 * 1024;
constexpr int PAR_L = 24576, P_SGLNG = 0, P_SGLNB = 512, P_SGB = 1024, P_CVB = 1536, P_CVLNG = 2048, P_CVLNB = 2560, P_SCW = 3072, P_SINK = 4608, P_CVW = 4672, P_FINAL = 2 * PAR_L;
constexpr size_t WS_PTRS = 740 * 1024;
constexpr size_t WS_BAR = 768 * 1024;
constexpr int MISC_OFF = 147200;
constexpr size_t WS_ROPEC = 1 * MiB, WS_ROPES = 1 * MiB + 256 * 1024;
constexpr size_t WS_SGWT = 1 * MiB + 512 * 1024;
constexpr size_t WS_WIN = 2 * MiB, WIN_L = (size_t)PROJ * D * 2;
constexpr size_t WS_WBR = 35 * MiB, WBR_L = 4 * MiB;
constexpr size_t WS_WOUT = 43 * MiB, WOUT_L = 2 * MiB;
constexpr size_t WS_WGU = 47 * MiB, WGU_L = 11 * MiB;
constexpr size_t WS_WDN = 69 * MiB, WDN_L = (size_t)D * DFF * 2;
constexpr size_t WS_XB = 80 * MiB;
constexpr size_t WS_ZA = 112 * MiB;
constexpr size_t WS_MG = WS_ZA;
constexpr size_t WS_GLU = 144 * MiB;
constexpr size_t WS_CH = 160 * MiB;
constexpr size_t WS_TMP = WS_GLU;
constexpr size_t WS_Q = 176 * MiB;
constexpr size_t WS_BG = 192 * MiB;
constexpr size_t WS_K = 208 * MiB, WS_V = 212 * MiB;
constexpr size_t WS_YA = 216 * MiB, WS_YB = 232 * MiB;
constexpr size_t WS_ACT = 112 * MiB;
constexpr size_t WS_END = 254 * MiB;

__device__ const double INVF_REV[32] = {0.15915494309189535, 0.11934937021124886, 0.08949940160889101, 0.06711508300522726, 0.050329212104487035, 0.03774158471741977, 0.0283021958306234, 0.02122365276477766, 0.015915494309189534, 0.011934937021124886, 0.008949940160889102, 0.006711508300522725, 0.005032921210448704, 0.003774158471741977, 0.00283021958306234, 0.0021223652764777662, 0.0015915494309189536, 0.0011934937021124885, 0.0008949940160889102, 0.0006711508300522726, 0.0005032921210448703, 0.00037741584717419774, 0.00028302195830623395, 0.0002122365276477766, 0.00015915494309189535, 0.00011934937021124886, 8.949940160889102e-05, 6.711508300522725e-05, 5.0329212104487035e-05, 3.774158471741978e-05, 2.8302195830623396e-05, 2.122365276477766e-05};

__device__ __forceinline__ unsigned cvt_pk_bf16(float lo, float hi) { unsigned r; asm volatile("v_cvt_pk_bf16_f32 %0, %1, %2" : "=v"(r) : "v"(lo), "v"(hi)); return r; }
__device__ __forceinline__ float bf_lo(unsigned u) { return __builtin_bit_cast(float, u << 16); }
__device__ __forceinline__ float bf_hi(unsigned u) { return __builtin_bit_cast(float, u & 0xffff0000u); }
__device__ __forceinline__ float bf1(bf16_t h) { return __builtin_bit_cast(float, ((unsigned)h) << 16); }
__device__ __forceinline__ float sigmoidf_(float x) { return __builtin_amdgcn_rcpf(1.0f + __expf(-x)); }
template <int CTRL, int ROW_MASK> __device__ __forceinline__ float dpp_mov(float v) {
    return __builtin_bit_cast(float, __builtin_amdgcn_update_dpp(0, __builtin_bit_cast(int, v), CTRL, ROW_MASK, 0xf, true));
}
__device__ __forceinline__ float wave_sum(float v) {
    v += dpp_mov<0xB1, 0xf>(v);
    v += dpp_mov<0x4E, 0xf>(v);
    v += dpp_mov<0x141, 0xf>(v);
    v += dpp_mov<0x140, 0xf>(v);
    v += dpp_mov<0x142, 0xa>(v);
    v += dpp_mov<0x143, 0xc>(v);
    return __builtin_bit_cast(float, __builtin_amdgcn_readlane(__builtin_bit_cast(int, v), 63));
}
__device__ __forceinline__ f32x2 gelu_pk(f32x2 v) {
    const f32x2 av = __builtin_elementwise_abs(v), d = av * 0.2316418882f + 1.0f;
    f32x2 t; t.x = __builtin_amdgcn_rcpf(d.x); t.y = __builtin_amdgcn_rcpf(d.y);
    f32x2 q = t * 0.5307027145f + (-0.7265760135f); q = q * t + 0.7107068705f; q = q * t + (-0.142248368f); q = q * t + 0.127414796f; q = q * t;
    const f32x2 s = (v * v) * (-0.72134752044f);
    f32x2 e; e.x = __builtin_amdgcn_exp2f(s.x); e.y = __builtin_amdgcn_exp2f(s.y);
    const f32x2 m = v * (q * e), r = v - m;
    f32x2 o; o.x = v.x < 0.f ? m.x : r.x; o.y = v.y < 0.f ? m.y : r.y; return o;
}
__device__ __forceinline__ u32x4 pack8(f32x4 a, f32x4 b) { u32x4 w; w.x = cvt_pk_bf16(a[0], a[1]); w.y = cvt_pk_bf16(a[2], a[3]); w.z = cvt_pk_bf16(b[0], b[1]); w.w = cvt_pk_bf16(b[2], b[3]); return w; }
__device__ __forceinline__ void unpack8(u32x4 w, f32x4& a, f32x4& b) { a = (f32x4){bf_lo(w.x), bf_hi(w.x), bf_lo(w.y), bf_hi(w.y)}; b = (f32x4){bf_lo(w.z), bf_hi(w.z), bf_lo(w.w), bf_hi(w.w)}; }

namespace pg8 {
constexpr int BM = 256, BK = 64, HALF = 128, HTB = HALF * BK * 2, STAGE_BYTES = 8 * HTB, NXCD = 8, WGM = 8;
__host__ __device__ __forceinline__ int lds_byte(int r, int c) { const int st = (r >> 4) * 2 + (c >> 5), rr = r & 15, cc = c & 31, ob = rr * 64 + cc * 2; return st * 1024 + (ob ^ (((ob >> 9) & 1) << 5)); }
__host__ __device__ __forceinline__ void stage_rc(int b, int& R, int& C) { const int st = b / 1024, sb = b % 1024, swz = sb ^ (((sb >> 9) & 1) << 5); R = (st >> 1) * 16 + swz / 64; C = (st & 1) * 32 + (swz % 64) / 2; }
__host__ __device__ __forceinline__ int perm32(int rho) { const int n = rho >> 4, i = rho & 15; return 8 * (i >> 2) + 4 * n + (i & 3); }

struct Unit { const char* A; const char* B; int lda2, ldb2, nt, pm, pn, z; };

__device__ __forceinline__ void tile_of(int L, int nM, int nN, int& pm, int& pn) {
    const int nwg = nM * nN; int wgid = L; { const int q = nwg / NXCD, r = nwg % NXCD, xcd = wgid % NXCD, off = wgid / NXCD; wgid = (xcd < r ? xcd * (q + 1) : r * (q + 1) + (xcd - r) * q) + off; }
    const int nig = WGM * nN, gid = wgid / nig, fm = gid * WGM, gsz = (nM - fm) < WGM ? (nM - fm) : WGM;
    pm = fm + ((wgid % nig) % gsz); pn = (wgid % nig) / gsz;
}
struct SchedGrid {
    static constexpr bool VARLD = false;
    int nM, nN, nwg, G, c; const char* A; const char* B; int lda2, ldb2, nt;
    __device__ __forceinline__ bool next(int i, Unit& u) const {
        const long L = (long)i * G + c; if (L >= nwg) return false;
        tile_of((int)L, nM, nN, u.pm, u.pn); u.z = 0;
        u.A = A + (size_t)u.pm * 256 * lda2; u.B = B + (size_t)u.pn * 256 * ldb2; u.lda2 = lda2; u.ldb2 = ldb2; u.nt = nt; return true;
    }
};
struct SchedMerge {
    static constexpr bool VARLD = true;
    int G, c; const char* ws; const char* WG  ; const char* WBR; int swap;
    __device__ __forceinline__ bool next(int i, Unit& u) const {
        const int ti = i >> 3, sub = i & 7; const long L = (long)ti * G + c; if (L >= 256) return false;
        tile_of((int)L, 64, 4, u.pm, u.pn); u.z = sub; const int br = sub >> 1;
        if (((sub & 1) ^ swap) == 0) { u.A = ws + WS_XB + (size_t)u.pm * 256 * 2048; u.lda2 = 2048; u.B = WG + (size_t)(br * 1024 + u.pn * 256) * 2048; u.ldb2 = 2048; u.nt = 16; }
        else { const size_t yo = br == 0 ? WS_YA : br == 1 ? WS_YB : br == 2 ? WS_Q : WS_BG;
               u.A = ws + yo + (size_t)u.pm * 256 * 1024; u.lda2 = 1024; u.B = WBR + (size_t)br * (1024 * 512 * 2) + (size_t)u.pn * 256 * 1024; u.ldb2 = 1024; u.nt = 8; }
        return true;
    }
};

struct SchedOne {
    static constexpr bool VARLD = false;
    SchedMerge M; int i0;
    __device__ __forceinline__ bool next(int i, Unit& u) const { if (i != 0) return false; return M.next(i0, u); }
};
struct SchedOneG {
    static constexpr bool VARLD = false;
    SchedGrid S; int i0;
    __device__ __forceinline__ bool next(int i, Unit& u) const { if (i != 0) return false; return S.next(i0, u); }
};
template <class Epi, class Sched, bool ALIGN_EPI>
__device__ __forceinline__ void gemm_phase(LAS unsigned char* lds, const Sched& S, const Epi& E) {
    int tid_ = threadIdx.x; asm volatile("" : "+v"(tid_));
    const int tid = tid_, wid = __builtin_amdgcn_readfirstlane(tid >> 6), lane = tid & 63, wr = wid >> 2, wc = wid & 3, fr = lane & 15, fq = lane >> 4;
    unsigned rA[2], rB[2], cc2[2];
#pragma unroll
    for (int i = 0; i < 2; ++i) { int R, C; stage_rc(tid * 16 + i * 8192, R, C); rA[i] = (unsigned)R; rB[i] = (unsigned)((R & ~31) + perm32(R & 31)); cc2[i] = (unsigned)C * 2u; }
    const size_t kstep = (size_t)(BK * 2);
    const unsigned ldsw = (unsigned)wid * 1024u;
    const int aoff = lds_byte(wr * 64 + fr, fq * 8), boff = lds_byte(wc * 32 + fr, fq * 8);
#define PG8_SA(b, h) (((b) * 2 + (h)) * HTB)
#define PG8_SB(b, h) ((4 + (b) * 2 + (h)) * HTB)
#define PG8_STAGE(bufoff, gbase, voff) do { _Pragma("unroll") for (int _i = 0; _i < 2; ++_i) \
        __builtin_amdgcn_global_load_lds((const unsigned*)((const char*)(gbase) + (voff)[_i]), (LAS unsigned*)(lds + (bufoff) + ldsw + _i * 8192), 16, 0, 0); } while (0)
#define PG8_LDA(dst, b, h) do { _Pragma("unroll") for (int m = 0; m < 4; ++m) _Pragma("unroll") for (int k = 0; k < 2; ++k) dst[m][k] = *(const LAS bf16x8*)(lds + PG8_SA(b, h) + aoff + m * 2048 + k * 1024); } while (0)
#define PG8_LDB(dst, b, h) do { _Pragma("unroll") for (int n = 0; n < 2; ++n) _Pragma("unroll") for (int k = 0; k < 2; ++k) dst[n][k] = *(const LAS bf16x8*)(lds + PG8_SB(b, h) + boff + n * 2048 + k * 1024); } while (0)
#define PG8_MMA(ai, bj, At, Bt) do { __builtin_amdgcn_s_setprio(1); _Pragma("unroll") for (int m = 0; m < 4; ++m) _Pragma("unroll") for (int n = 0; n < 2; ++n) _Pragma("unroll") for (int k = 0; k < 2; ++k) \
        acc[ai][bj][m][n] = __builtin_amdgcn_mfma_f32_16x16x32_bf16(Bt[n][k], At[m][k], acc[ai][bj][m][n], 0, 0, 0); __builtin_amdgcn_s_setprio(0); } while (0)
#define PG8_WAIT_V(n) asm volatile("s_waitcnt vmcnt(" #n ")" ::: "memory")
#define PG8_WAIT_L(n) asm volatile("s_waitcnt lgkmcnt(" #n ")" ::: "memory")
#define PG8_BAR __builtin_amdgcn_s_barrier()
#define PG8_SCHED __builtin_amdgcn_sched_barrier(0)
    Unit cur, nxt; int ui = 0;
    if (!S.next(0, cur)) return;
    f32x4 acc[2][2][4][2];
#pragma unroll
    for (int a = 0; a < 2; ++a)
#pragma unroll
        for (int b = 0; b < 2; ++b)
#pragma unroll
            for (int m = 0; m < 4; ++m)
#pragma unroll
                for (int n = 0; n < 2; ++n) acc[a][b][m][n] = (f32x4){0.f, 0.f, 0.f, 0.f};
    bf16x8 At[4][2], B0[2][2], B1[2][2];
    unsigned voffA[2], voffB[2];
#pragma unroll
    for (int i = 0; i < 2; ++i) { voffA[i] = rA[i] * (unsigned)cur.lda2 + cc2[i]; voffB[i] = rB[i] * (unsigned)cur.ldb2 + cc2[i]; }
    const char* cA = cur.A; const char* cB = cur.B;
    unsigned hA = (unsigned)HALF * cur.lda2, hB = (unsigned)HALF * cur.ldb2;
    PG8_STAGE(PG8_SB(0, 0), cB, voffB); PG8_STAGE(PG8_SB(0, 1), cB + hB, voffB); PG8_STAGE(PG8_SA(0, 0), cA, voffA); PG8_STAGE(PG8_SA(0, 1), cA + hA, voffA);
    if (wr == 1) PG8_BAR;
    PG8_WAIT_V(2); PG8_BAR;
    PG8_STAGE(PG8_SB(1, 0), cB + kstep, voffB); PG8_STAGE(PG8_SA(1, 0), cA + kstep, voffA); PG8_STAGE(PG8_SB(1, 1), cB + hB + kstep, voffB);
    PG8_WAIT_V(6); PG8_BAR;
    for (;;) {
        const bool has_next = S.next(ui + 1, nxt);
        if (!has_next) nxt = cur;
        unsigned voffAn[2], voffBn[2];
#pragma unroll
        for (int i = 0; i < 2; ++i) { if constexpr (Sched::VARLD) { voffAn[i] = rA[i] * (unsigned)nxt.lda2 + cc2[i]; voffBn[i] = rB[i] * (unsigned)nxt.ldb2 + cc2[i]; } else { voffAn[i] = voffA[i]; voffBn[i] = voffB[i]; } }
        const char* nA = nxt.A; const char* nB = nxt.B;
        const unsigned hAn = Sched::VARLD ? (unsigned)HALF * nxt.lda2 : hA, hBn = Sched::VARLD ? (unsigned)HALF * nxt.ldb2 : hB;
        const int nt = cur.nt;
        for (int t = 0; t < nt; t += 2) {
            const bool last = (t == nt - 2);
            const char* a1 = cA + (size_t)(t + 1) * kstep;
            const char* a2 = last ? nA : cA + (size_t)(t + 2) * kstep; const char* b2 = last ? nB : cB + (size_t)(t + 2) * kstep;
            const char* a3 = a2 + kstep; const char* b3 = b2 + kstep;
            const unsigned hA2 = last ? hAn : hA, hB2 = last ? hBn : hB;
            unsigned vA2[2], vB2[2];
#pragma unroll
            for (int i = 0; i < 2; ++i) { vA2[i] = last ? voffAn[i] : voffA[i]; vB2[i] = last ? voffBn[i] : voffB[i]; }
            PG8_LDB(B0, 0, 0); PG8_LDB(B1, 0, 1); PG8_SCHED; PG8_LDA(At, 0, 0); PG8_STAGE(PG8_SA(1, 1), a1 + hA, voffA);
            PG8_WAIT_V(8); PG8_WAIT_L(0); PG8_BAR; PG8_MMA(0, 0, At, B0); PG8_MMA(0, 1, At, B1); PG8_BAR; PG8_SCHED;
            PG8_LDA(At, 0, 1); PG8_STAGE(PG8_SB(0, 0), b2, vB2); PG8_STAGE(PG8_SB(0, 1), b2 + hB2, vB2); PG8_STAGE(PG8_SA(0, 0), a2, vA2);
            PG8_WAIT_V(8); PG8_WAIT_L(0); PG8_BAR; PG8_MMA(1, 0, At, B0); PG8_MMA(1, 1, At, B1); PG8_BAR; PG8_SCHED;
            PG8_LDB(B0, 1, 0); PG8_LDB(B1, 1, 1); PG8_SCHED; PG8_LDA(At, 1, 0); PG8_STAGE(PG8_SA(0, 1), a2 + hA2, vA2);
            PG8_WAIT_V(8); PG8_WAIT_L(0); PG8_BAR; PG8_MMA(0, 0, At, B0); PG8_MMA(0, 1, At, B1); PG8_BAR; PG8_SCHED;
            PG8_LDA(At, 1, 1); PG8_STAGE(PG8_SB(1, 0), b3, vB2); PG8_STAGE(PG8_SB(1, 1), b3 + hB2, vB2); PG8_STAGE(PG8_SA(1, 0), a3, vA2);
            PG8_WAIT_V(8); PG8_WAIT_L(0); PG8_BAR; PG8_MMA(1, 0, At, B0); PG8_MMA(1, 1, At, B1); PG8_BAR; PG8_SCHED;
        }
        if constexpr (ALIGN_EPI) { if (wr == 0) PG8_BAR; }
        E(acc, cur, wr, wc, fr, fq);
        if (!has_next) break;
#pragma unroll
        for (int a = 0; a < 2; ++a)
#pragma unroll
            for (int b = 0; b < 2; ++b)
#pragma unroll
                for (int m = 0; m < 4; ++m)
#pragma unroll
                    for (int n = 0; n < 2; ++n) acc[a][b][m][n] = (f32x4){0.f, 0.f, 0.f, 0.f};
        cur = nxt; cA = nA; cB = nB; hA = hAn; hB = hBn; ++ui;
#pragma unroll
        for (int i = 0; i < 2; ++i) { voffA[i] = voffAn[i]; voffB[i] = voffBn[i]; }
        if constexpr (ALIGN_EPI) { if (wr == 1) PG8_BAR; }
    }
    PG8_WAIT_V(0);
    if constexpr (!ALIGN_EPI) { if (wr == 0) PG8_BAR; }
    PG8_BAR;
#undef PG8_SA
#undef PG8_SB
#undef PG8_STAGE
#undef PG8_LDA
#undef PG8_LDB
#undef PG8_MMA
#undef PG8_WAIT_V
#undef PG8_WAIT_L
#undef PG8_BAR
#undef PG8_SCHED
}
}

constexpr int RSL_OFF = 133120;
#define EPI_ROWLOOP _Pragma("unroll") for (int ai = 0; ai < 2; ++ai) _Pragma("unroll") for (int m = 0; m < 4; ++m)
#define EPI_RS(row) ((u.pm == pm0) ? rsl[(row) & 255] : row_rs(ssq, (row)))
__device__ __forceinline__ float row_rs(const float* ssq, int row) { const f32x4* p = (const f32x4*)(ssq + (size_t)row * 16); const f32x4 a = p[0], b = p[1], c = p[2], d = p[3];
    const float s = (((a[0] + a[1]) + (a[2] + a[3])) + ((b[0] + b[1]) + (b[2] + b[3]))) + (((c[0] + c[1]) + (c[2] + c[3])) + ((d[0] + d[1]) + (d[2] + d[3])));
    return __builtin_amdgcn_rsqf(s * (1.0f / D) + EPS); }

struct EpiInProj {
    const float* ssq; unsigned char* ws; LAS const float* rsl; int pm0;
    __device__ __forceinline__ void operator()(const f32x4 (&acc)[2][2][4][2], const pg8::Unit& u, int wr, int wc, int fr, int fq) const {
        bf16_t* const ZA = (bf16_t*)(ws + WS_ZA); bf16_t* const GLU = (bf16_t*)(ws + WS_GLU); bf16_t* const BG = (bf16_t*)(ws + WS_BG); bf16_t* const CH = (bf16_t*)(ws + WS_CH);
        const float* const ropeC = (const float*)(ws + WS_ROPEC); const float* const ropeS = (const float*)(ws + WS_ROPES);
        const int T = u.pn, row0 = u.pm * 256 + wr * 64 + fr, jcol = wc * 32 + 8 * fq;
        if (T < 4) {
            EPI_ROWLOOP { const int row = row0 + ai * 128 + m * 16; const float rs = EPI_RS(row);
#pragma unroll
                for (int bj = 0; bj < 2; ++bj) { f32x4 v0 = acc[ai][bj][m][0] * rs, v1 = acc[ai][bj][m][1] * rs;
                    f32x2 a = gelu_pk((f32x2){v0[0], v0[1]}), b = gelu_pk((f32x2){v0[2], v0[3]}), c = gelu_pk((f32x2){v1[0], v1[1]}), d = gelu_pk((f32x2){v1[2], v1[3]});
                    *(u32x4*)(ZA + (size_t)row * 1024 + 256 * T + 128 * bj + jcol) = pack8((f32x4){a.x, a.y, b.x, b.y}, (f32x4){c.x, c.y, d.x, d.y}); } }
        } else if (T < 8) {
            EPI_ROWLOOP { const int row = row0 + ai * 128 + m * 16; const float rs = EPI_RS(row); f32x4 o[2];
#pragma unroll
                for (int n = 0; n < 2; ++n) { const f32x4 a = acc[ai][0][m][n] * rs, g = acc[ai][1][m][n] * rs;
#pragma unroll
                    for (int j = 0; j < 4; ++j) o[n][j] = a[j] * sigmoidf_(g[j]); }
                *(u32x4*)(GLU + (size_t)row * 512 + 128 * (T - 4) + jcol) = pack8(o[0], o[1]); }
        } else if (T < 11) {
            const bool isq = T < 10; const bool rope = isq || wc < 2; const float sc = isq ? 0.125f : 1.0f;
            const size_t boff = isq ? WS_Q : (wc < 2 ? WS_K : WS_V); bf16_t* const base = (bf16_t*)(ws + boff);
            const int ld = isq ? 512 : 128, hcol = isq ? (4 * (T - 8) + wc) * 64 : (wc & 1) * 64;
            EPI_ROWLOOP { const int row = row0 + ai * 128 + m * 16; const float rs = EPI_RS(row) * sc; const int pos = row & (SEQ - 1); f32x4 o1[2], o2[2];
#pragma unroll
                for (int n = 0; n < 2; ++n) { const f32x4 x1 = acc[ai][0][m][n] * rs, x2 = acc[ai][1][m][n] * rs;
                    if (rope) { const f32x4 c = *(const f32x4*)(ropeC + pos * 32 + 8 * fq + 4 * n), s = *(const f32x4*)(ropeS + pos * 32 + 8 * fq + 4 * n);
                        o1[n] = x1 * c - x2 * s; o2[n] = x2 * c + x1 * s; } else { o1[n] = x1; o2[n] = x2; } }
                bf16_t* p = base + (size_t)row * ld + hcol + 8 * fq;
                *(u32x4*)p = pack8(o1[0], o1[1]); *(u32x4*)(p + 32) = pack8(o2[0], o2[1]); }
        } else if (T < 13) {
            EPI_ROWLOOP { const int row = row0 + ai * 128 + m * 16; const float rs = EPI_RS(row);
#pragma unroll
                for (int bj = 0; bj < 2; ++bj) *(u32x4*)(BG + (size_t)row * 512 + 256 * (T - 11) + 128 * bj + jcol) = pack8(acc[ai][bj][m][0] * rs, acc[ai][bj][m][1] * rs); }
        } else {
            EPI_ROWLOOP { const int row = row0 + ai * 128 + m * 16; const float rs = EPI_RS(row); const float rs2 = rs * rs;
                *(u32x4*)(CH + (size_t)row * 512 + 128 * (T - 13) + jcol) = pack8(acc[ai][0][m][0] * acc[ai][1][m][0] * rs2, acc[ai][0][m][1] * acc[ai][1][m][1] * rs2); }
        }
    }
};
struct EpiGate {
    const float* ssq; bf16_t* MG;
    __device__ __forceinline__ void operator()(const f32x4 (&acc)[2][2][4][2], const pg8::Unit& u, int wr, int wc, int fr, int fq) const {
        const int row0 = u.pm * 256 + wr * 64 + fr, col0 = u.pn * 256 + wc * 32 + 8 * fq;
        EPI_ROWLOOP { const int row = row0 + ai * 128 + m * 16; const float rs = row_rs(ssq, row);
#pragma unroll
            for (int bj = 0; bj < 2; ++bj) { f32x4 v0 = acc[ai][bj][m][0] * rs, v1 = acc[ai][bj][m][1] * rs;
#pragma unroll
                for (int j = 0; j < 4; ++j) { v0[j] = sigmoidf_(v0[j]); v1[j] = sigmoidf_(v1[j]); }
                *(u32x4*)(MG + (size_t)row * 1024 + col0 + 128 * bj) = pack8(v0, v1); } }
    }
};
struct EpiBranch {
    bf16_t* MG; bf16_t* TMP;
    __device__ __forceinline__ void operator()(const f32x4 (&acc)[2][2][4][2], const pg8::Unit& u, int wr, int wc, int fr, int fq) const {
        const int row0 = u.pm * 256 + wr * 64 + fr, col0 = u.pn * 256 + wc * 32 + 8 * fq, br = u.z >> 1;
        EPI_ROWLOOP { const int row = row0 + ai * 128 + m * 16;
#pragma unroll
            for (int bj = 0; bj < 2; ++bj) { const size_t off = (size_t)row * 1024 + col0 + 128 * bj;
                f32x4 g0, g1; unpack8(*(const u32x4*)(MG + off), g0, g1);
                f32x4 v0 = acc[ai][bj][m][0] * g0, v1 = acc[ai][bj][m][1] * g1;
                if (br > 0) { f32x4 t0, t1; unpack8(*(const u32x4*)(TMP + off), t0, t1); v0 += t0; v1 += t1; }
                if (br < 3) *(u32x4*)(TMP + off) = pack8(v0, v1); else *(u32x4*)(MG + off) = pack8(v0, v1); } }
    }
};
struct EpiStashB {
    bf16_t* MG;
    __device__ __forceinline__ void operator()(const f32x4 (&acc)[2][2][4][2], const pg8::Unit& u, int wr, int wc, int fr, int fq) const {
        const int row0 = u.pm * 256 + wr * 64 + fr, col0 = u.pn * 256 + wc * 32 + 8 * fq;
        EPI_ROWLOOP { const int row = row0 + ai * 128 + m * 16;
#pragma unroll
            for (int bj = 0; bj < 2; ++bj) *(u32x4*)(MG + (size_t)row * 1024 + col0 + 128 * bj) = pack8(acc[ai][bj][m][0], acc[ai][bj][m][1]); }
    }
};
struct EpiGateAcc {
    const float* ssq; bf16_t* MG; bf16_t* TMP; LAS const float* rsl; int pm0;
    __device__ __forceinline__ void operator()(const f32x4 (&acc)[2][2][4][2], const pg8::Unit& u, int wr, int wc, int fr, int fq) const {
        const int row0 = u.pm * 256 + wr * 64 + fr, col0 = u.pn * 256 + wc * 32 + 8 * fq, br = u.z >> 1;
        u32x4 sb[8][2], tb[8][2];
#define EGA_LOAD(it) do { const int row_ = row0 + ((it) >> 2) * 128 + ((it) & 3) * 16; _Pragma("unroll") for (int bj = 0; bj < 2; ++bj) { const size_t off_ = (size_t)row_ * 1024 + col0 + 128 * bj; \
            sb[it][bj] = *(const u32x4*)(MG + off_); if (br > 0) tb[it][bj] = *(const u32x4*)(TMP + off_); } } while (0)
        EGA_LOAD(0);
#pragma unroll
        for (int it = 0; it < 8; ++it) { const int ai = it >> 2, m = it & 3; const int row = row0 + ai * 128 + m * 16; const float rs = EPI_RS(row);
            if (it + 1 < 8) EGA_LOAD(it + 1);
#pragma unroll
            for (int bj = 0; bj < 2; ++bj) { const size_t off = (size_t)row * 1024 + col0 + 128 * bj;
                f32x4 b0, b1; unpack8(sb[it][bj], b0, b1);
                f32x4 v0 = acc[ai][bj][m][0] * rs, v1 = acc[ai][bj][m][1] * rs;
#pragma unroll
                for (int j = 0; j < 4; ++j) { v0[j] = sigmoidf_(v0[j]) * b0[j]; v1[j] = sigmoidf_(v1[j]) * b1[j]; }
                if (br > 0) { f32x4 t0, t1; unpack8(tb[it][bj], t0, t1); v0 += t0; v1 += t1; }
                if (br < 3) *(u32x4*)(TMP + off) = pack8(v0, v1); else *(u32x4*)(MG + off) = pack8(v0, v1); } }
#undef EGA_LOAD
    }
};
struct EpiMerge2 {
    EpiStashB ES; EpiGateAcc EA;
    __device__ __forceinline__ void operator()(const f32x4 (&acc)[2][2][4][2], const pg8::Unit& u, int wr, int wc, int fr, int fq) const {
        if ((u.z & 1) == 0) ES(acc, u, wr, wc, fr, fq); else EA(acc, u, wr, wc, fr, fq);
    }
};
struct EpiResid {
    bf16_t* XB; float* ssq_out;
    __device__ __forceinline__ void operator()(const f32x4 (&acc)[2][2][4][2], const pg8::Unit& u, int wr, int wc, int fr, int fq) const {
        const int row0 = u.pm * 256 + wr * 64 + fr, col0 = u.pn * 256 + wc * 32 + 8 * fq;
        u32x4 xb[8][2];
#define ER_LOAD(it) do { const int row_ = row0 + ((it) >> 2) * 128 + ((it) & 3) * 16; _Pragma("unroll") for (int bj = 0; bj < 2; ++bj) xb[it][bj] = *(const u32x4*)(XB + (size_t)row_ * 1024 + col0 + 128 * bj); } while (0)
        ER_LOAD(0); ER_LOAD(1);
#pragma unroll
        for (int it = 0; it < 8; ++it) { const int ai = it >> 2, m = it & 3; const int row = row0 + ai * 128 + m * 16; float ss = 0.f;
            if (it + 2 < 8) ER_LOAD(it + 2);
#pragma unroll
            for (int bj = 0; bj < 2; ++bj) { const size_t off = (size_t)row * 1024 + col0 + 128 * bj;
                f32x4 x0, x1; unpack8(xb[it][bj], x0, x1);
                const f32x4 v0 = x0 + acc[ai][bj][m][0], v1 = x1 + acc[ai][bj][m][1];
                *(u32x4*)(XB + off) = pack8(v0, v1);
                ss += (v0[0] * v0[0] + v0[1] * v0[1]) + (v0[2] * v0[2] + v0[3] * v0[3]) + (v1[0] * v1[0] + v1[1] * v1[1]) + (v1[2] * v1[2] + v1[3] * v1[3]); }
            ss += __shfl_xor(ss, 16); ss += __shfl_xor(ss, 32);
            if (fq == 0) ssq_out[(size_t)row * 16 + u.pn * 4 + wc] = ss; }
#undef ER_LOAD
    }
};
struct EpiSwiGLU {
    const float* ssq; bf16_t* ACT; float zero_scale; LAS const float* rsl; int pm0;
    __device__ __forceinline__ void operator()(const f32x4 (&acc)[2][2][4][2], const pg8::Unit& u, int wr, int wc, int fr, int fq) const {
        const int row0 = u.pm * 256 + wr * 64 + fr, col0 = u.pn * 128 + wc * 32 + 8 * fq;
        EPI_ROWLOOP { const int row = row0 + ai * 128 + m * 16; const float rs = EPI_RS(row); f32x4 o[2];
#pragma unroll
            for (int n = 0; n < 2; ++n) { const f32x4 g = acc[ai][0][m][n] * rs, up = acc[ai][1][m][n] * rs;
#pragma unroll
                for (int j = 0; j < 4; ++j) o[n][j] = g[j] * sigmoidf_(g[j]) * up[j] * zero_scale; }
            *(u32x4*)(ACT + (size_t)row * DFF + col0) = pack8(o[0], o[1]); }
    }
};

#define ABL_FFN_SCALE(l) 1.0f
struct Args { const float* in[19]; float* out; unsigned char* ws; };

__device__ __forceinline__ int win_src_col(int nlog) {
    const int T = nlog >> 8, o = nlog & 255, bj = o >> 7, j = o & 127;
    if (T < 4) return nlog;
    if (T < 8) return 1024 + bj * 512 + 128 * (T - 4) + j;
    if (T < 10) return 2048 + (4 * (T - 8) + (j >> 5)) * 64 + 32 * bj + (j & 31);
    if (T == 10) { const int h = j >> 5; return (h < 2 ? 2560 + h * 64 : 2688 + (h - 2) * 64) + 32 * bj + (j & 31); }
    if (T < 13) return 2816 + 256 * (T - 11) + o;
    if (T < 17) return 3328 + bj * 512 + 128 * (T - 13) + j;
    return nlog;
}
template <int NL> __device__ __forceinline__ void tr_item(const float* W, int Nsrc, int k0, int scolA, int scolB, const float* gain, bf16_t* WT, int K, int drow, LAS float* scr, int lane) {
    const int c4 = lane & 15; const int sc = ((c4 >> 3) ? scolB : scolA) + 4 * (c4 & 7);
#pragma unroll
    for (int h = 0; h < 16 / NL; ++h) { f32x4 v[NL];
#pragma unroll
        for (int i = 0; i < NL; ++i) v[i] = __builtin_nontemporal_load((const f32x4*)(W + (size_t)(k0 + 4 * (h * NL + i) + (lane >> 4)) * Nsrc + sc));
#pragma unroll
        for (int i = 0; i < NL; ++i) { const int row = 4 * (h * NL + i) + (lane >> 4); if (gain) v[i] = v[i] * gain[k0 + row];
            LAS float* d = scr + row * 65 + 4 * c4; d[0] = v[i][0]; d[1] = v[i][1]; d[2] = v[i][2]; d[3] = v[i][3]; } }
    asm volatile("s_waitcnt lgkmcnt(0)" ::: "memory");
    const int c = lane & 7;
#pragma unroll
    for (int jj = 0; jj < 8; ++jj) { const int n = (lane >> 3) + 8 * jj; const LAS float* s = scr + (8 * c) * 65 + n;
        u32x4 o; o.x = cvt_pk_bf16(s[0], s[65]); o.y = cvt_pk_bf16(s[2 * 65], s[3 * 65]); o.z = cvt_pk_bf16(s[4 * 65], s[5 * 65]); o.w = cvt_pk_bf16(s[6 * 65], s[7 * 65]);
        *(u32x4*)(WT + (size_t)(drow + n) * K + k0 + 8 * c) = o; }
    asm volatile("s_waitcnt lgkmcnt(0)" ::: "memory");
}
struct WPtrs { const float *w_in, *norm_mix, *w_branch, *w_out, *w_gate_up, *norm_ffn, *w_down; };
constexpr int ITEMS_PER_LAYER = 16 * 132 + 512 + 256 + 16 * 88 + 44 * 16;
constexpr int ITEMS_EARLY = 16 * 132 + 512 + 256, ITEMS_MID = ITEMS_PER_LAYER + 16 * 132;
template <int NL> __device__ __forceinline__ void convert_weights(const WPtrs& wp, unsigned char* ws, LAS unsigned char* lds, int lo, int hi, int w0, int nw) {
    int tid_ = threadIdx.x; asm volatile("" : "+v"(tid_));
    const int lane = tid_ & 63, wave = __builtin_amdgcn_readfirstlane(tid_ >> 6);
    LAS float* scr = (LAS float*)(lds + wave * 16640);
    constexpr int I_IN = 16 * 132, I_BR = 512, I_OUT = 256, I_GU = 16 * 88, I_L = ITEMS_PER_LAYER;
    for (int it = lo + w0; it < hi; it += nw) {
        const int l = it / I_L; int r = it % I_L;
        if (r < I_IN) { const int kb = r / 132, nb = r % 132, n0 = 64 * nb;
            tr_item<NL>(wp.w_in + (size_t)l * D * PROJ, PROJ, 64 * kb, win_src_col(n0), win_src_col(n0 + 32), wp.norm_mix + l * D, (bf16_t*)(ws + WS_WIN + l * WIN_L), D, n0, scr, lane); continue; } r -= I_IN;
        if (r < I_BR) { const int br = r >> 7, q = r & 127, kb = q >> 4, nb = q & 15;
            tr_item<NL>(wp.w_branch + (size_t)(l * 4 + br) * 512 * D, D, 64 * kb, 64 * nb, 64 * nb + 32, nullptr, (bf16_t*)(ws + WS_WBR + l * WBR_L) + (size_t)br * 1024 * 512, 512, 64 * nb, scr, lane); continue; } r -= I_BR;
        if (r < I_OUT) { const int kb = r >> 4, nb = r & 15;
            tr_item<NL>(wp.w_out + (size_t)l * D * D, D, 64 * kb, 64 * nb, 64 * nb + 32, nullptr, (bf16_t*)(ws + WS_WOUT + l * WOUT_L), D, 64 * nb, scr, lane); continue; } r -= I_OUT;
        if (r < I_GU) { const int kb = r / 88, nb = r % 88, n0 = 64 * nb, T = n0 >> 8, o = n0 & 255, sc = (o >> 7) * DFF + 128 * T + (o & 127);
            tr_item<NL>(wp.w_gate_up + (size_t)l * D * 2 * DFF, 2 * DFF, 64 * kb, sc, sc + 32, wp.norm_ffn + l * D, (bf16_t*)(ws + WS_WGU + l * WGU_L), D, n0, scr, lane); continue; } r -= I_GU;
        { const int kb = r >> 4, nb = r & 15;
            tr_item<NL>(wp.w_down + (size_t)l * DFF * D, D, 64 * kb, 64 * nb, 64 * nb + 32, nullptr, (bf16_t*)(ws + WS_WDN + l * WDN_L), DFF, 64 * nb, scr, lane); }
    }
}
__device__ __forceinline__ void prologue(const Args& a, LAS unsigned char* lds, int G) {
    int tid_ = threadIdx.x; asm volatile("" : "+v"(tid_));
    const int tid = tid_, lane = tid & 63, wave = __builtin_amdgcn_readfirstlane(tid >> 6);
    const int gw = blockIdx.x * NWAVES + wave, NGW = G * NWAVES;
    unsigned char* ws = a.ws;
    { const WPtrs wp{a.in[2], a.in[1], a.in[13], a.in[14], a.in[16], a.in[15], a.in[17]};
      if (blockIdx.x == 0 && tid == 0) *(WPtrs*)(ws + WS_PTRS) = wp;
      convert_weights<16>(wp, ws, lds, 0, G == 256 ? ITEMS_EARLY : 2 * ITEMS_PER_LAYER, gw, NGW); }
    float* ssq = (float*)(ws + WS_SSQ);
    for (int row = gw; row < M; row += NGW) {
        const f32x4* xr = (const f32x4*)(a.in[0] + (size_t)row * D) + lane; float s = 0.f; f32x4 v[4];
#pragma unroll
        for (int j = 0; j < 4; ++j) { v[j] = xr[64 * j]; s += (v[j][0] * v[j][0] + v[j][1] * v[j][1]) + (v[j][2] * v[j][2] + v[j][3] * v[j][3]); }
        s = wave_sum(s);
        u32x2* o = (u32x2*)((bf16_t*)(ws + WS_XB) + (size_t)row * D) + lane;
#pragma unroll
        for (int j = 0; j < 4; ++j) o[64 * j] = (u32x2){cvt_pk_bf16(v[j][0], v[j][1]), cvt_pk_bf16(v[j][2], v[j][3])};
        if (lane < 16) ssq[(size_t)row * 16 + lane] = lane == 0 ? s : 0.f;
    }
    { float* par = (float*)(ws + WS_PAR); const int gt = blockIdx.x * NTHREADS + tid, GT = G * NTHREADS;
#define CPY(dstoff, srcp, n) for (int i = gt; i < (n); i += GT) par[(dstoff) + i] = (srcp)[i]
      for (int l = 0; l < 2; ++l) { const int o = l * PAR_L;
          CPY(o + P_SGLNG, a.in[3] + l * 512, 512); CPY(o + P_SGLNB, a.in[4] + l * 512, 512); CPY(o + P_SGB, a.in[6] + l * 512, 512);
          CPY(o + P_CVB, a.in[8] + l * 512, 512); CPY(o + P_CVLNG, a.in[9] + l * 512, 512); CPY(o + P_CVLNB, a.in[10] + l * 512, 512);
          CPY(o + P_SCW, a.in[12] + l * 1536, 1536); CPY(o + P_SINK, a.in[11] + l * 8, 8); CPY(o + P_CVW, a.in[7] + l * 31 * 512, 31 * 512); }
      CPY(P_FINAL, a.in[18], 1024);
#undef CPY
    }
    for (int i = blockIdx.x * NTHREADS + tid; i < SEQ * 32; i += G * NTHREADS) { const int pos = i >> 5, f = i & 31;
        const double rev = (double)pos * INVF_REV[f]; const float fr = (float)(rev - floor(rev));
        ((float*)(ws + WS_ROPEC))[i] = __builtin_amdgcn_cosf(fr); ((float*)(ws + WS_ROPES))[i] = __builtin_amdgcn_sinf(fr); }
    for (int i = blockIdx.x * NTHREADS + tid; i < 2 * 4 * 128 * 128; i += G * NTHREADS) { const int s = i & 127, t = (i >> 7) & 127;
        ((bf16_t*)(ws + WS_SGWT))[i] = s <= t ? (bf16_t)(cvt_pk_bf16(a.in[5][i], 0.f) & 0xffffu) : (bf16_t)0; }
}

__device__ __forceinline__ void mixer_sg(unsigned char* ws, int l, LAS unsigned char* lds, int unit) {
    { size_t z_ = 0; asm volatile("" : "+s"(z_)); ws += z_; } int tid_ = threadIdx.x; asm volatile("" : "+v"(tid_));
    const float* par = (const float*)(ws + WS_PAR) + l * PAR_L;
    const int tid = tid_, lane = tid & 63, wave = __builtin_amdgcn_readfirstlane(tid >> 6);
    const int ck = unit >> 2, g = unit & 3, r0 = ck * 128;
    const bf16_t* ZA = (const bf16_t*)(ws + WS_ZA); bf16_t* YA = (bf16_t*)(ws + WS_YA);
    LAS bf16_t* vnT = (LAS bf16_t*)lds;
    const float* lng = par + P_SGLNG; const float* lnb = par + P_SGLNB;
    const f32x4 g0 = *(const f32x4*)(lng + 8 * lane), g1 = *(const f32x4*)(lng + 8 * lane + 4), b0 = *(const f32x4*)(lnb + 8 * lane), b1 = *(const f32x4*)(lnb + 8 * lane + 4);
    u32x4 raw[16];
#pragma unroll
    for (int i = 0; i < 16; ++i) raw[i] = *(const u32x4*)(ZA + (size_t)(r0 + wave + 8 * i) * 1024 + 512 + 8 * lane);
    const int fr = lane & 15, fq = lane >> 4, t0 = 16 * wave, nks = (wave >> 1) + 1;
    const bf16_t* W = (const bf16_t*)(ws + WS_SGWT) + (size_t)(l * 4 + g) * 16384 + (size_t)(t0 + fr) * 128 + 8 * fq;
    bf16x8 wf[4];
#pragma unroll
    for (int ks = 0; ks < 4; ++ks) wf[ks] = *(const bf16x8*)(W + 32 * (ks < nks ? ks : 0));
    const int tt = t0 + fr; const size_t orow = r0 + tt; const float bs = par[P_SGB + g * 128 + tt];
    u32x2 uu[8];
#pragma unroll
    for (int ct = 0; ct < 8; ++ct) uu[ct] = *(const u32x2*)(ZA + orow * 1024 + 128 * g + 16 * ct + 4 * fq);
#pragma unroll
    for (int i = 0; i < 16; ++i) { const int s = wave + 8 * i;
        f32x4 x0, x1; unpack8(raw[i], x0, x1);
        const float mean = wave_sum((x0[0] + x0[1]) + (x0[2] + x0[3]) + (x1[0] + x1[1]) + (x1[2] + x1[3])) * (1.0f / 512.0f);
        x0 -= mean; x1 -= mean;
        const float var = wave_sum((x0[0] * x0[0] + x0[1] * x0[1]) + (x0[2] * x0[2] + x0[3] * x0[3]) + (x1[0] * x1[0] + x1[1] * x1[1]) + (x1[2] * x1[2] + x1[3] * x1[3])) * (1.0f / 512.0f);
        const float rstd = __builtin_amdgcn_rsqf(var + EPS);
        if ((lane >> 4) == g) { const int c = 8 * (lane & 15); x0 = x0 * rstd * g0 + b0; x1 = x1 * rstd * g1 + b1;
            const unsigned p0 = cvt_pk_bf16(x0[0], x0[1]), p1 = cvt_pk_bf16(x0[2], x0[3]), p2 = cvt_pk_bf16(x1[0], x1[1]), p3 = cvt_pk_bf16(x1[2], x1[3]);
            LAS bf16_t* d = vnT + c * 136 + (s ^ (8 * (lane & 15)));
            d[0] = (bf16_t)p0; d[136] = (bf16_t)(p0 >> 16); d[2 * 136] = (bf16_t)p1; d[3 * 136] = (bf16_t)(p1 >> 16);
            d[4 * 136] = (bf16_t)p2; d[5 * 136] = (bf16_t)(p2 >> 16); d[6 * 136] = (bf16_t)p3; d[7 * 136] = (bf16_t)(p3 >> 16); }
    }
    __syncthreads();
    { f32x4 acc[8];
#pragma unroll
      for (int ct = 0; ct < 8; ++ct) acc[ct] = (f32x4){0.f, 0.f, 0.f, 0.f};
#pragma unroll
      for (int ks = 0; ks < 4; ++ks) if (ks < nks) {
#pragma unroll
          for (int ct = 0; ct < 8; ++ct) { const bf16x8 vf = *(const LAS bf16x8*)(vnT + (16 * ct + fr) * 136 + 8 * ((4 * ks + fq) ^ ((2 * ct + (fr >> 3)) & 15)));
              acc[ct] = __builtin_amdgcn_mfma_f32_16x16x32_bf16(vf, wf[ks], acc[ct], 0, 0, 0); }
      }
#pragma unroll
      for (int ct = 0; ct < 8; ++ct) { const int c = 128 * g + 16 * ct + 4 * fq;
          const float o0 = bf_lo(uu[ct].x) * (acc[ct][0] + bs), o1 = bf_hi(uu[ct].x) * (acc[ct][1] + bs), o2 = bf_lo(uu[ct].y) * (acc[ct][2] + bs), o3 = bf_hi(uu[ct].y) * (acc[ct][3] + bs);
          *(u32x2*)(YA + orow * 512 + c) = (u32x2){cvt_pk_bf16(o0, o1), cvt_pk_bf16(o2, o3)}; }
    }
    __syncthreads();
}
__device__ __forceinline__ void mixer_conv(unsigned char* ws, int l, LAS unsigned char* lds, int unit) {
    { size_t z_ = 0; asm volatile("" : "+s"(z_)); ws += z_; } int tid_ = threadIdx.x; asm volatile("" : "+v"(tid_));
    const float* par = (const float*)(ws + WS_PAR) + l * PAR_L;
    const int tid = tid_, lane = tid & 63, wave = tid >> 6;
    const int b = unit >> 6, tb = unit & 63, t0 = tb * 32; const size_t rbase = (size_t)b * SEQ;
    const bf16_t* GLU = (const bf16_t*)(ws + WS_GLU); bf16_t* YB = (bf16_t*)(ws + WS_YB);
    LAS bf16_t* in = (LAS bf16_t*)lds;
    LAS float* cv = (LAS float*)(lds + 65536);
    for (int i = tid; i < 62 * 64; i += NTHREADS) { const int r = i >> 6, ch = i & 63; const int t = t0 - 30 + r;
        u32x4 v = {0u, 0u, 0u, 0u}; if (t >= 0) v = *(const u32x4*)(GLU + (rbase + t) * 512 + 8 * ch);
        *(LAS u32x4*)(in + r * 512 + 8 * ch) = v; }
    __syncthreads();
    { const int c = tid; float w[31], x[62];
#pragma unroll
      for (int k = 0; k < 31; ++k) w[k] = par[P_CVW + k * 512 + c];
#pragma unroll
      for (int r = 0; r < 62; ++r) x[r] = bf1(in[r * 512 + c]);
      const float bias = par[P_CVB + c];
#pragma unroll
      for (int t = 0; t < 32; ++t) { float s = bias;
#pragma unroll
          for (int k = 0; k < 31; ++k) s += w[k] * x[t + k];
          cv[t * 512 + c] = s; } }
    __syncthreads();
    { const float* lng = par + P_CVLNG; const float* lnb = par + P_CVLNB;
      const f32x4 g0 = *(const f32x4*)(lng + 8 * lane), g1 = *(const f32x4*)(lng + 8 * lane + 4), b0 = *(const f32x4*)(lnb + 8 * lane), b1 = *(const f32x4*)(lnb + 8 * lane + 4);
      for (int t = wave; t < 32; t += NWAVES) {
          f32x4 x0 = *(const LAS f32x4*)(cv + t * 512 + 8 * lane), x1 = *(const LAS f32x4*)(cv + t * 512 + 8 * lane + 4);
          const float mean = wave_sum((x0[0] + x0[1]) + (x0[2] + x0[3]) + (x1[0] + x1[1]) + (x1[2] + x1[3])) * (1.0f / 512.0f);
          x0 -= mean; x1 -= mean;
          const float var = wave_sum((x0[0] * x0[0] + x0[1] * x0[1]) + (x0[2] * x0[2] + x0[3] * x0[3]) + (x1[0] * x1[0] + x1[1] * x1[1]) + (x1[2] * x1[2] + x1[3] * x1[3])) * (1.0f / 512.0f);
          const float rstd = __builtin_amdgcn_rsqf(var + EPS);
          x0 = x0 * rstd * g0 + b0; x1 = x1 * rstd * g1 + b1;
#pragma unroll
          for (int j = 0; j < 4; ++j) { x0[j] = x0[j] * sigmoidf_(x0[j]); x1[j] = x1[j] * sigmoidf_(x1[j]); }
          *(u32x4*)(YB + (rbase + t0 + t) * 512 + 8 * lane) = pack8(x0, x1); } }
    __syncthreads();
}
__device__ __forceinline__ void mixer_attn(unsigned char* ws, int l, LAS unsigned char* lds, int unit) {
    { size_t z_ = 0; asm volatile("" : "+s"(z_)); ws += z_; } int tid_ = threadIdx.x; asm volatile("" : "+v"(tid_));
    const float* par = (const float*)(ws + WS_PAR) + l * PAR_L;
    const int tid = tid_, lane = tid & 63, wave = __builtin_amdgcn_readfirstlane(tid >> 6), fr = lane & 15, fq = lane >> 4;
    const int kvh = unit & 1, blk = (unit >> 1) & 15, b = unit >> 5; const size_t rbase = (size_t)b * SEQ;
    bf16_t* Q = (bf16_t*)(ws + WS_Q); const bf16_t* K = (const bf16_t*)(ws + WS_K); const bf16_t* V = (const bf16_t*)(ws + WS_V);
    LAS bf16_t* Kl = (LAS bf16_t*)lds;
    LAS bf16_t* VT = (LAS bf16_t*)(lds + 36864);
    for (int i = tid; i < 256 * 8; i += NTHREADS) { const int r = i >> 3, ch = i & 7; const int t = (blk - 1) * 128 + r;
        u32x4 kv = {0u, 0u, 0u, 0u}, vv = {0u, 0u, 0u, 0u};
        if (t >= 0) { kv = *(const u32x4*)(K + (rbase + t) * 128 + kvh * 64 + 8 * ch); vv = *(const u32x4*)(V + (rbase + t) * 128 + kvh * 64 + 8 * ch); }
        *(LAS u32x4*)(Kl + r * 72 + 8 * ch) = kv;
        LAS bf16_t* d = VT + (8 * ch) * 264 + r;
        d[0] = (bf16_t)vv.x; d[264] = (bf16_t)(vv.x >> 16); d[2 * 264] = (bf16_t)vv.y; d[3 * 264] = (bf16_t)(vv.y >> 16);
        d[4 * 264] = (bf16_t)vv.z; d[5 * 264] = (bf16_t)(vv.z >> 16); d[6 * 264] = (bf16_t)vv.w; d[7 * 264] = (bf16_t)(vv.w >> 16); }
    __syncthreads();
    const int g = wave >> 1, head = kvh * 4 + g; const float sink = par[P_SINK + head];
    for (int it = 0; it < 2; ++it) {
        const int qs = 2 * (wave & 1) + it, qi0 = 32 * qs; const size_t qrow0 = rbase + blk * 128 + qi0;
        bf16x8 qf[2][2];
#pragma unroll
        for (int qt = 0; qt < 2; ++qt)
#pragma unroll
            for (int ks = 0; ks < 2; ++ks) qf[qt][ks] = *(const bf16x8*)(Q + (qrow0 + 16 * qt + fr) * 512 + head * 64 + 32 * ks + 8 * fq);
        f32x4 S[2][10];
#pragma unroll
        for (int qt = 0; qt < 2; ++qt)
#pragma unroll
            for (int kt = 0; kt < 10; ++kt) S[qt][kt] = (f32x4){0.f, 0.f, 0.f, 0.f};
#pragma unroll
        for (int kt = 0; kt < 10; ++kt)
#pragma unroll
            for (int ks = 0; ks < 2; ++ks) { const bf16x8 kf = *(const LAS bf16x8*)(Kl + (qi0 + 16 * kt + fr) * 72 + 32 * ks + 8 * fq);
#pragma unroll
                for (int qt = 0; qt < 2; ++qt) S[qt][kt] = __builtin_amdgcn_mfma_f32_16x16x32_bf16(kf, qf[qt][ks], S[qt][kt], 0, 0, 0); }
        bf16x8 pf[2][5];
#pragma unroll
        for (int qt = 0; qt < 2; ++qt) { const int qi = qi0 + 16 * qt + fr; float mx = sink;
#pragma unroll
            for (int kt = 0; kt < 10; ++kt)
#pragma unroll
                for (int j = 0; j < 4; ++j) { const int kb = qi0 + 16 * kt + 4 * fq + j; const bool valid = (kb > qi) && (kb <= qi + 128) && (blk > 0 || kb >= 128);
                    const float sv = valid ? S[qt][kt][j] : -INFINITY; S[qt][kt][j] = sv; mx = fmaxf(mx, sv); }
            mx = fmaxf(mx, __shfl_xor(mx, 16)); mx = fmaxf(mx, __shfl_xor(mx, 32));
            float sum = 0.f;
#pragma unroll
            for (int kt = 0; kt < 10; ++kt)
#pragma unroll
                for (int j = 0; j < 4; ++j) { const float p = __expf(S[qt][kt][j] - mx); S[qt][kt][j] = p; sum += p; }
            sum += __shfl_xor(sum, 16); sum += __shfl_xor(sum, 32);
            const float inv = 1.0f / (sum + __expf(sink - mx));
#pragma unroll
            for (int p = 0; p < 5; ++p) { const f32x4 a0 = S[qt][2 * p] * inv, a1 = S[qt][2 * p + 1] * inv; pf[qt][p] = __builtin_bit_cast(bf16x8, pack8(a0, a1)); }
        }
        f32x4 o[2][4];
#pragma unroll
        for (int qt = 0; qt < 2; ++qt)
#pragma unroll
            for (int dt = 0; dt < 4; ++dt) o[qt][dt] = (f32x4){0.f, 0.f, 0.f, 0.f};
#pragma unroll
        for (int p = 0; p < 5; ++p)
#pragma unroll
            for (int dt = 0; dt < 4; ++dt) { const LAS bf16_t* vp = VT + (16 * dt + fr) * 264 + qi0 + 32 * p + 4 * fq;
                const u32x2 lo = *(const LAS u32x2*)vp, hi = *(const LAS u32x2*)(vp + 16);
                const bf16x8 vf = __builtin_bit_cast(bf16x8, (u32x4){lo.x, lo.y, hi.x, hi.y});
#pragma unroll
                for (int qt = 0; qt < 2; ++qt) o[qt][dt] = __builtin_amdgcn_mfma_f32_16x16x32_bf16(vf, pf[qt][p], o[qt][dt], 0, 0, 0); }
#pragma unroll
        for (int qt = 0; qt < 2; ++qt)
#pragma unroll
            for (int dt = 0; dt < 4; ++dt) *(u32x2*)(Q + (qrow0 + 16 * qt + fr) * 512 + head * 64 + 16 * dt + 4 * fq) = (u32x2){cvt_pk_bf16(o[qt][dt][0], o[qt][dt][1]), cvt_pk_bf16(o[qt][dt][2], o[qt][dt][3])};
    }
    __syncthreads();
}
__device__ __forceinline__ void mixer_sc(unsigned char* ws, int l, int G) {
    { size_t z_ = 0; asm volatile("" : "+s"(z_)); ws += z_; } int tid_ = threadIdx.x; asm volatile("" : "+v"(tid_));
    bf16_t* BG = (bf16_t*)(ws + WS_BG); const bf16_t* CH = (const bf16_t*)(ws + WS_CH);
    const float* w = (const float*)(ws + WS_PAR) + l * PAR_L + P_SCW;
    for (int i = blockIdx.x * NTHREADS + tid_; i < (M / 8) * 64; i += G * NTHREADS) {
        const int row0 = 8 * (i >> 6), c = 8 * (i & 63), t0 = row0 & (SEQ - 1);
        u32x4 ch[10], bg[8];
#pragma unroll
        for (int r = 0; r < 10; ++r) { ch[r] = (u32x4){0u, 0u, 0u, 0u}; if (t0 - 2 + r >= 0) ch[r] = *(const u32x4*)(CH + (size_t)(row0 - 2 + r) * 512 + c); }
#pragma unroll
        for (int r = 0; r < 8; ++r) bg[r] = *(const u32x4*)(BG + (size_t)(row0 + r) * 512 + c);
        f32x4 wa[3], wb[3];
#pragma unroll
        for (int k = 0; k < 3; ++k) { wa[k] = *(const f32x4*)(w + k * 512 + c); wb[k] = *(const f32x4*)(w + k * 512 + c + 4); }
#pragma unroll
        for (int r = 0; r < 8; ++r) { f32x4 a0 = {0.f, 0.f, 0.f, 0.f}, a1 = a0;
#pragma unroll
            for (int k = 0; k < 3; ++k) { f32x4 x0, x1; unpack8(ch[r + k], x0, x1); a0 += x0 * wa[k]; a1 += x1 * wb[k]; }
            f32x4 g0, g1; unpack8(bg[r], g0, g1);
            *(u32x4*)(BG + (size_t)(row0 + r) * 512 + c) = pack8(g0 * a0, g1 * a1); }
    }
}

#define RLX_AGENT __ATOMIC_RELAXED, __HIP_MEMORY_SCOPE_AGENT
#define XB_TMO      128
#define XB_XCNT(j)  (256  + 64 * (j))
#define XB_XSUB(j)  (1280 + 64 * (j))
#define XB_XGEN(j)  (2304 + 64 * (j))
#define XB_TOP      3328
#define XB_TOPGEN   3392
#define XCD_BAR_WORDS 3456
#define XB_SPIN_CAP (1u << 18)

__device__ __forceinline__ unsigned xb_ld(unsigned* p)              { return __hip_atomic_load(p, __ATOMIC_RELAXED, __HIP_MEMORY_SCOPE_AGENT); }
__device__ __forceinline__ unsigned xb_add(unsigned* p, unsigned v) { return __hip_atomic_fetch_add(p, v, __ATOMIC_RELAXED, __HIP_MEMORY_SCOPE_AGENT); }
__device__ __forceinline__ unsigned xb_xcc_id() { return (unsigned)__builtin_amdgcn_s_getreg((3 << 11) | 20) & 0xFu; }
#define XB_SPIN(cond, bar) do { unsigned _sp = 0; while (cond) { __builtin_amdgcn_s_sleep(1); \
    if ((++_sp & 255u) == 0u) { if (xb_ld(&(bar)[XB_TMO])) break; if (_sp > XB_SPIN_CAP) { atomicAdd(&(bar)[XB_TMO], 1u); break; } } } } while (0)

struct XcdBarrier {
    unsigned* bar; unsigned x;
    volatile LAS unsigned* st;
};

__device__ __forceinline__ XcdBarrier xcd_barrier_post(unsigned* bar, volatile LAS unsigned* st) {
    XcdBarrier b; b.bar = bar; b.x = xb_xcc_id(); b.st = st;
    if (threadIdx.x == 0) (void)xb_add(&bar[XB_XCNT(b.x)], 1u);
    return b;
}
__device__ __forceinline__ void xcd_barrier_complete(unsigned* bar, unsigned x, unsigned& nloc, unsigned& nx) {
    const unsigned G = gridDim.x * gridDim.y * gridDim.z;
    unsigned sum, cnt, mine, sp = 0u;
    for (;;) {
        sum = 0u; cnt = 0u; mine = 0u;
#pragma unroll
        for (unsigned j = 0; j < 16; ++j) { const unsigned c = xb_ld(&bar[XB_XCNT(j)]); sum += c; cnt += (c > 0u) ? 1u : 0u; mine = (j == x) ? c : mine; }
        if (sum == G) break;
        __builtin_amdgcn_s_sleep(1);
        if ((++sp & 255u) == 0u) { if (xb_ld(&bar[XB_TMO])) break; if (sp > XB_SPIN_CAP) { atomicAdd(&bar[XB_TMO], 1u); break; } }
    }
    nloc = mine > 0u ? mine : 1u; nx = cnt > 0u ? cnt : 1u;
}

__device__ __forceinline__ void xcd_barrier(const XcdBarrier& b) {
    asm volatile("s_waitcnt vmcnt(0)" ::: "memory");
    __syncthreads();
    if (threadIdx.x == 0) {
        unsigned* bar = b.bar;
        __builtin_amdgcn_s_waitcnt(0);
        unsigned nloc = b.st[0], nx = b.st[1];
        if (nloc == 0u) { xcd_barrier_complete(bar, b.x, nloc, nx); b.st[0] = nloc; b.st[1] = nx; }
        const unsigned old = xb_add(&bar[XB_XSUB(b.x)], 1u);
        const unsigned gen = old / nloc;
        if (old + 1u == (gen + 1u) * nloc) {
            __builtin_amdgcn_fence(__ATOMIC_RELEASE, "agent");
            asm volatile("s_waitcnt vmcnt(0)" ::: "memory");
            const unsigned og = xb_add(&bar[XB_TOP], 1u);
            const unsigned tg = og / nx;
            if (og + 1u == (tg + 1u) * nx) xb_add(&bar[XB_TOPGEN], 1u);
            else XB_SPIN(xb_ld(&bar[XB_TOPGEN]) == tg, bar);
            __builtin_amdgcn_fence(__ATOMIC_ACQUIRE, "agent");
            xb_add(&bar[XB_XGEN(b.x)], 1u);
            asm volatile("s_waitcnt vmcnt(0)" ::: "memory");
        } else {
            XB_SPIN(xb_ld(&bar[XB_XGEN(b.x)]) == gen, bar);
            __builtin_amdgcn_fence(__ATOMIC_ACQUIRE, "agent");
            asm volatile("s_waitcnt vmcnt(0)" ::: "memory");
        }
    }
    __syncthreads();
}


__device__ __forceinline__ void stage_rs(LAS unsigned char* lds, const float* ssq, int pm) {
    int tid_ = threadIdx.x; asm volatile("" : "+v"(tid_));
    if (tid_ < 256 && pm >= 0) ((LAS float*)(lds + RSL_OFF))[tid_] = row_rs(ssq, pm * 256 + tid_);
    __syncthreads();
}
#define GRID_SYNC() do { XcdBarrier xb_; xb_.bar = (unsigned*)(ws + WS_BAR); xb_.x = xb_xcc_id(); xb_.st = (volatile LAS unsigned*)(lds + MISC_OFF); xcd_barrier(xb_); } while (0)
__global__ void __launch_bounds__(NTHREADS, 2) fwd_megakernel(Args a) {
    extern __shared__ __attribute__((aligned(16))) unsigned char lds_raw[];
    LAS unsigned char* lds = (LAS unsigned char*)lds_raw;
    cg::grid_group grid = cg::this_grid();
    const int G = gridDim.x, c = blockIdx.x;
    unsigned char* ws = a.ws;
    float* ssq = (float*)(ws + WS_SSQ);

    { volatile LAS unsigned* misc = (volatile LAS unsigned*)(lds + MISC_OFF); if (threadIdx.x < 16) misc[threadIdx.x] = 0u; }
    __syncthreads();
    if (blockIdx.x == 0 && threadIdx.x < 64) { unsigned* bw = (unsigned*)(ws + WS_BAR);
        for (int i = threadIdx.x; i < XCD_BAR_WORDS; i += 64) bw[i] = 0u; }
    grid.sync();
    (void)xcd_barrier_post((unsigned*)(ws + WS_BAR), (volatile LAS unsigned*)(lds + MISC_OFF));
    prologue(a, lds, G);
    GRID_SYNC();

    for (int l = 0; l < 2; ++l) {
        { size_t z_ = 0; asm volatile("" : "+s"(z_)); ws += z_; } ssq = (float*)(ws + WS_SSQ);
        const float* ssq_mix = ssq + (size_t)(2 * l) * M * 16;
        { pg8::SchedGrid S; S.nM = 64; S.nN = 17; S.nwg = 64 * 17; S.G = G; { int c_ = c; asm volatile("" : "+s"(c_)); S.c = c_; } S.A = (const char*)(ws + WS_XB); S.B = (const char*)(ws + WS_WIN + l * WIN_L); S.lda2 = 2048; S.ldb2 = 2048; S.nt = 16;
          int pm0 = -1; { pg8::Unit u0; if (S.next(0, u0)) pm0 = u0.pm; } stage_rs(lds, ssq_mix, pm0);
          EpiInProj E{ssq_mix, ws, (LAS const float*)(lds + RSL_OFF), pm0};
          pg8::gemm_phase<EpiInProj, pg8::SchedGrid, true>(lds, S, E);
          if (l == 0 && G == 256 && c >= 64) {
              const int wv = __builtin_amdgcn_readfirstlane((int)threadIdx.x >> 6); const WPtrs wp = *(const WPtrs*)(ws + WS_PTRS);
              convert_weights<16>(wp, ws, lds, ITEMS_EARLY, ITEMS_MID, (c - 64) * NWAVES + wv, 192 * NWAVES); }
        }
        GRID_SYNC(); { size_t z_ = 0; asm volatile("" : "+s"(z_)); ws += z_; }
        for (int u = c; u < 512; u += G) mixer_sg(ws, l, lds, u);
        for (int u = c; u < 512; u += G) mixer_conv(ws, l, lds, u);
        for (int u = c; u < 256; u += G) mixer_attn(ws, l, lds, u);
        mixer_sc(ws, l, G);
        GRID_SYNC(); { size_t z_ = 0; asm volatile("" : "+s"(z_)); ws += z_; } ssq = (float*)(ws + WS_SSQ);
        { pg8::SchedMerge S; S.G = G; { int c_ = c; asm volatile("" : "+s"(c_)); S.c = c_; } S.ws = (const char*)ws; S.WG = (const char*)(ws + WS_WIN + l * WIN_L) + (size_t)NLOG1 * 2048;
          S.WBR = (const char*)(ws + WS_WBR + l * WBR_L);
          S.swap = 1; int pm0 = -1; { pg8::Unit u0; if (S.next(0, u0)) pm0 = u0.pm; } stage_rs(lds, ssq_mix, pm0);
          EpiStashB ES{(bf16_t*)(ws + WS_MG)}; EpiGateAcc EA{ssq_mix, (bf16_t*)(ws + WS_MG), (bf16_t*)(ws + WS_TMP), (LAS const float*)(lds + RSL_OFF), pm0};
          EpiMerge2 E2{ES, EA};
          pg8::gemm_phase<EpiMerge2, pg8::SchedMerge, true>(lds, S, E2);
        }
        GRID_SYNC(); { size_t z_ = 0; asm volatile("" : "+s"(z_)); ws += z_; } ssq = (float*)(ws + WS_SSQ);
        { pg8::SchedGrid S; S.nM = 64; S.nN = 4; S.nwg = 256; S.G = G; { int c_ = c; asm volatile("" : "+s"(c_)); S.c = c_; } S.A = (const char*)(ws + WS_MG); S.B = (const char*)(ws + WS_WOUT + l * WOUT_L); S.lda2 = 2048; S.ldb2 = 2048; S.nt = 16;
          EpiResid E{(bf16_t*)(ws + WS_XB), ssq + (size_t)(2 * l + 1) * M * 16};
          pg8::gemm_phase<EpiResid, pg8::SchedGrid, false>(lds, S, E); }
        GRID_SYNC(); { size_t z_ = 0; asm volatile("" : "+s"(z_)); ws += z_; } ssq = (float*)(ws + WS_SSQ);
        { pg8::SchedGrid S; S.nM = 64; S.nN = 22; S.nwg = 64 * 22; S.G = G; { int c_ = c; asm volatile("" : "+s"(c_)); S.c = c_; } S.A = (const char*)(ws + WS_XB); S.B = (const char*)(ws + WS_WGU + l * WGU_L); S.lda2 = 2048; S.ldb2 = 2048; S.nt = 16;
          int pm0 = -1; { pg8::Unit u0; if (S.next(0, u0)) pm0 = u0.pm; } stage_rs(lds, ssq + (size_t)(2 * l + 1) * M * 16, pm0);
          EpiSwiGLU E{ssq + (size_t)(2 * l + 1) * M * 16, (bf16_t*)(ws + WS_ACT), ABL_FFN_SCALE(l), (LAS const float*)(lds + RSL_OFF), pm0};
          pg8::gemm_phase<EpiSwiGLU, pg8::SchedGrid, true>(lds, S, E);
          if (l == 0 && G == 256 && c >= 128) {
              const int wv = __builtin_amdgcn_readfirstlane((int)threadIdx.x >> 6); const WPtrs wp = *(const WPtrs*)(ws + WS_PTRS);
              convert_weights<16>(wp, ws, lds, ITEMS_MID, 2 * ITEMS_PER_LAYER, (c - 128) * NWAVES + wv, 128 * NWAVES); }
        }
        GRID_SYNC(); { size_t z_ = 0; asm volatile("" : "+s"(z_)); ws += z_; } ssq = (float*)(ws + WS_SSQ);
        { pg8::SchedGrid S; S.nM = 64; S.nN = 4; S.nwg = 256; S.G = G; { int c_ = c; asm volatile("" : "+s"(c_)); S.c = c_; } S.A = (const char*)(ws + WS_ACT); S.B = (const char*)(ws + WS_WDN + l * WDN_L); S.lda2 = DFF * 2; S.ldb2 = DFF * 2; S.nt = DFF / 64;
          EpiResid E{(bf16_t*)(ws + WS_XB), ssq + (size_t)(2 * l + 2) * M * 16};
          pg8::gemm_phase<EpiResid, pg8::SchedGrid, false>(lds, S, E); }
        GRID_SYNC();
    }
    { { size_t z_ = 0; asm volatile("" : "+s"(z_)); ws += z_; } int tid_ = threadIdx.x; asm volatile("" : "+v"(tid_));
      const int lane = tid_ & 63, gw = c * NWAVES + (tid_ >> 6), NGW = G * NWAVES; const float* gf = (const float*)(ws + WS_PAR) + P_FINAL; const float* sq = (const float*)(ws + WS_SSQ) + (size_t)4 * M * 16;
      const bf16_t* XBp = (const bf16_t*)(ws + WS_XB);
      for (int row = gw; row < M; row += 2 * NGW) { const int row2 = row + NGW;
          u32x4 ra_[2], rb_[2];
#pragma unroll
          for (int j = 0; j < 2; ++j) { ra_[j] = *(const u32x4*)(XBp + (size_t)row * D + 512 * j + 8 * lane); rb_[j] = *(const u32x4*)(XBp + (size_t)row2 * D + 512 * j + 8 * lane); }
          const float ra = row_rs(sq, row), rb = row_rs(sq, row2);
#pragma unroll
          for (int j = 0; j < 2; ++j) { const f32x4 g0 = *(const f32x4*)(gf + 512 * j + 8 * lane), g1 = *(const f32x4*)(gf + 512 * j + 8 * lane + 4);
              f32x4 x0, x1; unpack8(ra_[j], x0, x1); float* oa = a.out + (size_t)row * D + 512 * j + 8 * lane; *(f32x4*)oa = x0 * ra * g0; *(f32x4*)(oa + 4) = x1 * ra * g1;
              unpack8(rb_[j], x0, x1); float* ob = a.out + (size_t)row2 * D + 512 * j + 8 * lane; *(f32x4*)ob = x0 * rb * g0; *(f32x4*)(ob + 4) = x1 * rb * g1; } } }
}

extern "C" void kernel_launch(void* const* d_in, const int* in_sizes, int n_in, void* d_out, int out_size, void* d_ws, size_t ws_size, hipStream_t stream) {
    static int grid = 0;
    if (grid == 0) {
        if (n_in != 19 || out_size != M * D || ws_size < WS_END) { fprintf(stderr, "kernel_launch: unexpected shapes (n_in %d out %d ws %zu)\n", n_in, out_size, ws_size); grid = -1; return; }
        int dev = 0, cus = 0, per_cu = 0;
        if (hipGetDevice(&dev) != hipSuccess || hipDeviceGetAttribute(&cus, hipDeviceAttributeMultiprocessorCount, dev) != hipSuccess) { grid = -1; return; }
        if (hipFuncSetAttribute((const void*)fwd_megakernel, hipFuncAttributeMaxDynamicSharedMemorySize, LDS_BYTES) != hipSuccess) { fprintf(stderr, "kernel_launch: hipFuncSetAttribute failed\n"); grid = -1; return; }
        if (hipOccupancyMaxActiveBlocksPerMultiprocessor(&per_cu, (const void*)fwd_megakernel, NTHREADS, LDS_BYTES) != hipSuccess || per_cu < 1) { fprintf(stderr, "kernel_launch: occupancy query says %d\n", per_cu); per_cu = 1; }
        (void)hipGetLastError();
        grid = cus * 1;
    }
    if (grid < 0) return;
    Args a{};
    for (int i = 0; i < 19; ++i) a.in[i] = (const float*)d_in[i];
    a.out = (float*)d_out; a.ws = (unsigned char*)d_ws;
    void* args[] = {&a};
    hipError_t e = hipLaunchCooperativeKernel((const void*)fwd_megakernel, dim3(grid), dim3(NTHREADS), args, LDS_BYTES, stream);
    if (e != hipSuccess) fprintf(stderr, "cooperative launch failed: %s (grid %d)\n", hipGetErrorString(e), grid);
}
```

```cpp
#include <hip/hip_runtime.h>
#include <hip/hip_cooperative_groups.h>
#include <cstdio>
#include <cstdint>
namespace cg = cooperative_groups;

#define LAS __attribute__((address_space(3)))
typedef unsigned short bf16_t;
typedef short bf16x8 __attribute__((ext_vector_type(8)));
typedef float f32x4 __attribute__((ext_vector_type(4)));
typedef float f32x2 __attribute__((ext_vector_type(2)));
typedef unsigned u32x4 __attribute__((ext_vector_type(4)));
typedef unsigned u32x2 __attribute__((ext_vector_type(2)));

constexpr int M = 16384, D = 1024, SEQ = 2048, NBATCH = 8, DFF = 2816, PROJ = 8448, NLOG1 = 4352  ;
constexpr float EPS = 1e-6f;
constexpr int NTHREADS = 512, NWAVES = 8;
constexpr int LDS_BYTES = 147456;

constexpr size_t MiB = 1u << 20;
constexpr size_t WS_SSQ = 248 * (size_t)(1u << 20);
constexpr size_t WS_PAR = 512 * 1024;
constexpr int PAR_L = 24576, P_SGLNG = 0, P_SGLNB = 512, P_SGB = 1024, P_CVB = 1536, P_CVLNG = 2048, P_CVLNB = 2560, P_SCW = 3072, P_SINK = 4608, P_CVW = 4672, P_FINAL = 2 * PAR_L;
constexpr size_t WS_PTRS = 740 * 1024;
constexpr size_t WS_BAR = 768 * 1024;
constexpr int MISC_OFF = 147200;
constexpr size_t WS_ROPEC = 1 * MiB, WS_ROPES = 1 * MiB + 256 * 1024;
constexpr size_t WS_SGWT = 1 * MiB + 512 * 1024;
constexpr size_t WS_WIN = 2 * MiB, WIN_L = (size_t)PROJ * D * 2;
constexpr size_t WS_WBR = 35 * MiB, WBR_L = 4 * MiB;
constexpr size_t WS_WOUT = 43 * MiB, WOUT_L = 2 * MiB;
constexpr size_t WS_WGU = 47 * MiB, WGU_L = 11 * MiB;
constexpr size_t WS_WDN = 69 * MiB, WDN_L = (size_t)D * DFF * 2;
constexpr size_t WS_XB = 80 * MiB;
constexpr size_t WS_ZA = 112 * MiB;
constexpr size_t WS_MG = WS_ZA;
constexpr size_t WS_GLU = 144 * MiB;
constexpr size_t WS_CH = 160 * MiB;
constexpr size_t WS_TMP = WS_GLU;
constexpr size_t WS_Q = 176 * MiB;
constexpr size_t WS_BG = 192 * MiB;
constexpr size_t WS_K = 208 * MiB, WS_V = 212 * MiB;
constexpr size_t WS_YA = 216 * MiB, WS_YB = 232 * MiB;
constexpr size_t WS_ACT = 112 * MiB;
constexpr size_t WS_END = 254 * MiB;

__device__ const double INVF_REV[32] = {0.15915494309189535, 0.11934937021124886, 0.08949940160889101, 0.06711508300522726, 0.050329212104487035, 0.03774158471741977, 0.0283021958306234, 0.02122365276477766, 0.015915494309189534, 0.011934937021124886, 0.008949940160889102, 0.006711508300522725, 0.005032921210448704, 0.003774158471741977, 0.00283021958306234, 0.0021223652764777662, 0.0015915494309189536, 0.0011934937021124885, 0.0008949940160889102, 0.0006711508300522726, 0.0005032921210448703, 0.00037741584717419774, 0.00028302195830623395, 0.0002122365276477766, 0.00015915494309189535, 0.00011934937021124886, 8.949940160889102e-05, 6.711508300522725e-05, 5.0329212104487035e-05, 3.774158471741978e-05, 2.8302195830623396e-05, 2.122365276477766e-05};

__device__ __forceinline__ unsigned cvt_pk_bf16(float lo, float hi) { unsigned r; asm volatile("v_cvt_pk_bf16_f32 %0, %1, %2" : "=v"(r) : "v"(lo), "v"(hi)); return r; }
__device__ __forceinline__ float bf_lo(unsigned u) { return __builtin_bit_cast(float, u << 16); }
__device__ __forceinline__ float bf_hi(unsigned u) { return __builtin_bit_cast(float, u & 0xffff0000u); }
__device__ __forceinline__ float bf1(bf16_t h) { return __builtin_bit_cast(float, ((unsigned)h) << 16); }
__device__ __forceinline__ float sigmoidf_(float x) { return __builtin_amdgcn_rcpf(1.0f + __expf(-x)); }
template <int CTRL, int ROW_MASK> __device__ __forceinline__ float dpp_mov(float v) {
    return __builtin_bit_cast(float, __builtin_amdgcn_update_dpp(0, __builtin_bit_cast(int, v), CTRL, ROW_MASK, 0xf, true));
}
__device__ __forceinline__ float wave_sum(float v) {
    v += dpp_mov<0xB1, 0xf>(v);
    v += dpp_mov<0x4E, 0xf>(v);
    v += dpp_mov<0x141, 0xf>(v);
    v += dpp_mov<0x140, 0xf>(v);
    v += dpp_mov<0x142, 0xa>(v);
    v += dpp_mov<0x143, 0xc>(v);
    return __builtin_bit_cast(float, __builtin_amdgcn_readlane(__builtin_bit_cast(int, v), 63));
}
__device__ __forceinline__ f32x2 gelu_pk(f32x2 v) {
    const f32x2 av = __builtin_elementwise_abs(v), d = av * 0.2316418882f + 1.0f;
    f32x2 t; t.x = __builtin_amdgcn_rcpf(d.x); t.y = __builtin_amdgcn_rcpf(d.y);
    f32x2 q = t * 0.5307027145f + (-0.7265760135f); q = q * t + 0.7107068705f; q = q * t + (-0.142248368f); q = q * t + 0.127414796f; q = q * t;
    const f32x2 s = (v * v) * (-0.72134752044f);
    f32x2 e; e.x = __builtin_amdgcn_exp2f(s.x); e.y = __builtin_amdgcn_exp2f(s.y);
    const f32x2 m = v * (q * e), r = v - m;
    f32x2 o; o.x = v.x < 0.f ? m.x : r.x; o.y = v.y < 0.f ? m.y : r.y; return o;
}
__device__ __forceinline__ u32x4 pack8(f32x4 a, f32x4 b) { u32x4 w; w.x = cvt_pk_bf16(a[0], a[1]); w.y = cvt_pk_bf16(a[2], a[3]); w.z = cvt_pk_bf16(b[0], b[1]); w.w = cvt_pk_bf16(b[2], b[3]); return w; }
__device__ __forceinline__ void unpack8(u32x4 w, f32x4& a, f32x4& b) { a = (f32x4){bf_lo(w.x), bf_hi(w.x), bf_lo(w.y), bf_hi(w.y)}; b = (f32x4){bf_lo(w.z), bf_hi(w.z), bf_lo(w.w), bf_hi(w.w)}; }

namespace pg8 {
constexpr int BM = 256, BK = 64, HALF = 128, HTB = HALF * BK * 2, STAGE_BYTES = 8 * HTB, NXCD = 8, WGM = 8;
__host__ __device__ __forceinline__ int lds_byte(int r, int c) { const int st = (r >> 4) * 2 + (c >> 5), rr = r & 15, cc = c & 31, ob = rr * 64 + cc * 2; return st * 1024 + (ob ^ (((ob >> 9) & 1) << 5)); }
__host__ __device__ __forceinline__ void stage_rc(int b, int& R, int& C) { const int st = b / 1024, sb = b % 1024, swz = sb ^ (((sb >> 9) & 1) << 5); R = (st >> 1) * 16 + swz / 64; C = (st & 1) * 32 + (swz % 64) / 2; }
__host__ __device__ __forceinline__ int perm32(int rho) { const int n = rho >> 4, i = rho & 15; return 8 * (i >> 2) + 4 * n + (i & 3); }

struct Unit { const char* A; const char* B; int lda2, ldb2, nt, pm, pn, z; };

__device__ __forceinline__ void tile_of(int L, int nM, int nN, int& pm, int& pn) {
    const int nwg = nM * nN; int wgid = L; { const int q = nwg / NXCD, r = nwg % NXCD, xcd = wgid % NXCD, off = wgid / NXCD; wgid = (xcd < r ? xcd * (q + 1) : r * (q + 1) + (xcd - r) * q) + off; }
    const int nig = WGM * nN, gid = wgid / nig, fm = gid * WGM, gsz = (nM - fm) < WGM ? (nM - fm) : WGM;
    pm = fm + ((wgid % nig) % gsz); pn = (wgid % nig) / gsz;
}
struct SchedGrid {
    static constexpr bool VARLD = false;
    int nM, nN, nwg, G, c; const char* A; const char* B; int lda2, ldb2, nt;
    __device__ __forceinline__ bool next(int i, Unit& u) const {
        const long L = (long)i * G + c; if (L >= nwg) return false;
        tile_of((int)L, nM, nN, u.pm, u.pn); u.z = 0;
        u.A = A + (size_t)u.pm * 256 * lda2; u.B = B + (size_t)u.pn * 256 * ldb2; u.lda2 = lda2; u.ldb2 = ldb2; u.nt = nt; return true;
    }
};
struct SchedMerge {
    static constexpr bool VARLD = true;
    int G, c; const char* ws; const char* WG  ; const char* WBR; int swap;
    __device__ __forceinline__ bool next(int i, Unit& u) const {
        const int ti = i >> 3, sub = i & 7; const long L = (long)ti * G + c; if (L >= 256) return false;
        tile_of((int)L, 64, 4, u.pm, u.pn); u.z = sub; const int br = sub >> 1;
        if (((sub & 1) ^ swap) == 0) { u.A = ws + WS_XB + (size_t)u.pm * 256 * 2048; u.lda2 = 2048; u.B = WG + (size_t)(br * 1024 + u.pn * 256) * 2048; u.ldb2 = 2048; u.nt = 16; }
        else { const size_t yo = br == 0 ? WS_YA : br == 1 ? WS_YB : br == 2 ? WS_Q : WS_BG;
               u.A = ws + yo + (size_t)u.pm * 256 * 1024; u.lda2 = 1024; u.B = WBR + (size_t)br * (1024 * 512 * 2) + (size_t)u.pn * 256 * 1024; u.ldb2 = 1024; u.nt = 8; }
        return true;
    }
};

struct SchedOne {
    static constexpr bool VARLD = false;
    SchedMerge M; int i0;
    __device__ __forceinline__ bool next(int i, Unit& u) const { if (i != 0) return false; return M.next(i0, u); }
};
struct SchedOneG {
    static constexpr bool VARLD = false;
    SchedGrid S; int i0;
    __device__ __forceinline__ bool next(int i, Unit& u) const { if (i != 0) return false; return S.next(i0, u); }
};
template <class Epi, class Sched, bool ALIGN_EPI>
__device__ __forceinline__ void gemm_phase(LAS unsigned char* lds, const Sched& S, const Epi& E) {
    int tid_ = threadIdx.x; asm volatile("" : "+v"(tid_));
    const int tid = tid_, wid = __builtin_amdgcn_readfirstlane(tid >> 6), lane = tid & 63, wr = wid >> 2, wc = wid & 3, fr = lane & 15, fq = lane >> 4;
    unsigned rA[2], rB[2], cc2[2];
#pragma unroll
    for (int i = 0; i < 2; ++i) { int R, C; stage_rc(tid * 16 + i * 8192, R, C); rA[i] = (unsigned)R; rB[i] = (unsigned)((R & ~31) + perm32(R & 31)); cc2[i] = (unsigned)C * 2u; }
    const size_t kstep = (size_t)(BK * 2);
    const unsigned ldsw = (unsigned)wid * 1024u;
    const int aoff = lds_byte(wr * 64 + fr, fq * 8), boff = lds_byte(wc * 32 + fr, fq * 8);
#define PG8_SA(b, h) (((b) * 2 + (h)) * HTB)
#define PG8_SB(b, h) ((4 + (b) * 2 + (h)) * HTB)
#define PG8_STAGE(bufoff, gbase, voff) do { _Pragma("unroll") for (int _i = 0; _i < 2; ++_i) \
        __builtin_amdgcn_global_load_lds((const unsigned*)((const char*)(gbase) + (voff)[_i]), (LAS unsigned*)(lds + (bufoff) + ldsw + _i * 8192), 16, 0, 0); } while (0)
#define PG8_LDA(dst, b, h) do { _Pragma("unroll") for (int m = 0; m < 4; ++m) _Pragma("unroll") for (int k = 0; k < 2; ++k) dst[m][k] = *(const LAS bf16x8*)(lds + PG8_SA(b, h) + aoff + m * 2048 + k * 1024); } while (0)
#define PG8_LDB(dst, b, h) do { _Pragma("unroll") for (int n = 0; n < 2; ++n) _Pragma("unroll") for (int k = 0; k < 2; ++k) dst[n][k] = *(const LAS bf16x8*)(lds + PG8_SB(b, h) + boff + n * 2048 + k * 1024); } while (0)
#define PG8_MMA(ai, bj, At, Bt) do { __builtin_amdgcn_s_setprio(1); _Pragma("unroll") for (int m = 0; m < 4; ++m) _Pragma("unroll") for (int n = 0; n < 2; ++n) _Pragma("unroll") for (int k = 0; k < 2; ++k) \
        acc[ai][bj][m][n] = __builtin_amdgcn_mfma_f32_16x16x32_bf16(Bt[n][k], At[m][k], acc[ai][bj][m][n], 0, 0, 0); __builtin_amdgcn_s_setprio(0); } while (0)
#define PG8_WAIT_V(n) asm volatile("s_waitcnt vmcnt(" #n ")" ::: "memory")
#define PG8_WAIT_L(n) asm volatile("s_waitcnt lgkmcnt(" #n ")" ::: "memory")
#define PG8_BAR __builtin_amdgcn_s_barrier()
#define PG8_SCHED __builtin_amdgcn_sched_barrier(0)
    Unit cur, nxt; int ui = 0;
    if (!S.next(0, cur)) return;
    f32x4 acc[2][2][4][2];
#pragma unroll
    for (int a = 0; a < 2; ++a)
#pragma unroll
        for (int b = 0; b < 2; ++b)
#pragma unroll
            for (int m = 0; m < 4; ++m)
#pragma unroll
                for (int n = 0; n < 2; ++n) acc[a][b][m][n] = (f32x4){0.f, 0.f, 0.f, 0.f};
    bf16x8 At[4][2], B0[2][2], B1[2][2];
    unsigned voffA[2], voffB[2];
#pragma unroll
    for (int i = 0; i < 2; ++i) { voffA[i] = rA[i] * (unsigned)cur.lda2 + cc2[i]; voffB[i] = rB[i] * (unsigned)cur.ldb2 + cc2[i]; }
    const char* cA = cur.A; const char* cB = cur.B;
    unsigned hA = (unsigned)HALF * cur.lda2, hB = (unsigned)HALF * cur.ldb2;
    PG8_STAGE(PG8_SB(0, 0), cB, voffB); PG8_STAGE(PG8_SB(0, 1), cB + hB, voffB); PG8_STAGE(PG8_SA(0, 0), cA, voffA); PG8_STAGE(PG8_SA(0, 1), cA + hA, voffA);
    if (wr == 1) PG8_BAR;
    PG8_WAIT_V(2); PG8_BAR;
    PG8_STAGE(PG8_SB(1, 0), cB + kstep, voffB); PG8_STAGE(PG8_SA(1, 0), cA + kstep, voffA); PG8_STAGE(PG8_SB(1, 1), cB + hB + kstep, voffB);
    PG8_WAIT_V(6); PG8_BAR;
    for (;;) {
        const bool has_next = S.next(ui + 1, nxt);
        if (!has_next) nxt = cur;
        unsigned voffAn[2], voffBn[2];
#pragma unroll
        for (int i = 0; i < 2; ++i) { if constexpr (Sched::VARLD) { voffAn[i] = rA[i] * (unsigned)nxt.lda2 + cc2[i]; voffBn[i] = rB[i] * (unsigned)nxt.ldb2 + cc2[i]; } else { voffAn[i] = voffA[i]; voffBn[i] = voffB[i]; } }
        const char* nA = nxt.A; const char* nB = nxt.B;
        const unsigned hAn = Sched::VARLD ? (unsigned)HALF * nxt.lda2 : hA, hBn = Sched::VARLD ? (unsigned)HALF * nxt.ldb2 : hB;
        const int nt = cur.nt;
        for (int t = 0; t < nt; t += 2) {
            const bool last = (t == nt - 2);
            const char* a1 = cA + (size_t)(t + 1) * kstep;
            const char* a2 = last ? nA : cA + (size_t)(t + 2) * kstep; const char* b2 = last ? nB : cB + (size_t)(t + 2) * kstep;
            const char* a3 = a2 + kstep; const char* b3 = b2 + kstep;
            const unsigned hA2 = last ? hAn : hA, hB2 = last ? hBn : hB;
            unsigned vA2[2], vB2[2];
#pragma unroll
            for (int i = 0; i < 2; ++i) { vA2[i] = last ? voffAn[i] : voffA[i]; vB2[i] = last ? voffBn[i] : voffB[i]; }
            PG8_LDB(B0, 0, 0); PG8_LDB(B1, 0, 1); PG8_SCHED; PG8_LDA(At, 0, 0); PG8_STAGE(PG8_SA(1, 1), a1 + hA, voffA);
            PG8_WAIT_V(8); PG8_WAIT_L(0); PG8_BAR; PG8_MMA(0, 0, At, B0); PG8_MMA(0, 1, At, B1); PG8_BAR; PG8_SCHED;
            PG8_LDA(At, 0, 1); PG8_STAGE(PG8_SB(0, 0), b2, vB2); PG8_STAGE(PG8_SB(0, 1), b2 + hB2, vB2); PG8_STAGE(PG8_SA(0, 0), a2, vA2);
            PG8_WAIT_V(8); PG8_WAIT_L(0); PG8_BAR; PG8_MMA(1, 0, At, B0); PG8_MMA(1, 1, At, B1); PG8_BAR; PG8_SCHED;
            PG8_LDB(B0, 1, 0); PG8_LDB(B1, 1, 1); PG8_SCHED; PG8_LDA(At, 1, 0); PG8_STAGE(PG8_SA(0, 1), a2 + hA2, vA2);
            PG8_WAIT_V(8); PG8_WAIT_L(0); PG8_BAR; PG8_MMA(0, 0, At, B0); PG8_MMA(0, 1, At, B1); PG8_BAR; PG8_SCHED;
            PG8_LDA(At, 1, 1); PG8_STAGE(PG8_SB(1, 0), b3, vB2); PG8_STAGE(PG8_SB(1, 1), b3 + hB2, vB2); PG8_STAGE(PG8_SA(1, 0), a3, vA2);
            PG8_WAIT_V(8); PG8_WAIT_L(0); PG8_BAR; PG8_MMA(1, 0, At, B0); PG8_MMA(1, 1, At, B1); PG8_BAR; PG8_SCHED;
        }
        if constexpr (ALIGN_EPI) { if (wr == 0) PG8_BAR; }
        E(acc, cur, wr, wc, fr, fq);
        if (!has_next) break;
#pragma unroll
        for (int a = 0; a < 2; ++a)
#pragma unroll
            for (int b = 0; b < 2; ++b)
#pragma unroll
                for (int m = 0; m < 4; ++m)
#pragma unroll
                    for (int n = 0; n < 2; ++n) acc[a][b][m][n] = (f32x4){0.f, 0.f, 0.f, 0.f};
        cur = nxt; cA = nA; cB = nB; hA = hAn; hB = hBn; ++ui;
#pragma unroll
        for (int i = 0; i < 2; ++i) { voffA[i] = voffAn[i]; voffB[i] = voffBn[i]; }
        if constexpr (ALIGN_EPI) { if (wr == 1) PG8_BAR; }
    }
    PG8_WAIT_V(0);
    if constexpr (!ALIGN_EPI) { if (wr == 0) PG8_BAR; }
    PG8_BAR;
#undef PG8_SA
#undef PG8_SB
#undef PG8_STAGE
#undef PG8_LDA
#undef PG8_LDB
#undef PG8_MMA
#undef PG8_WAIT_V
#undef PG8_WAIT_L
#undef PG8_BAR
#undef PG8_SCHED
}
}

constexpr int RSL_OFF = 133120;
#define EPI_ROWLOOP _Pragma("unroll") for (int ai = 0; ai < 2; ++ai) _Pragma("unroll") for (int m = 0; m < 4; ++m)
#define EPI_RS(row) ((u.pm == pm0) ? rsl[(row) & 255] : row_rs(ssq, (row)))
__device__ __forceinline__ float row_rs(const float* ssq, int row) { const f32x4* p = (const f32x4*)(ssq + (size_t)row * 16); const f32x4 a = p[0], b = p[1], c = p[2], d = p[3];
    const float s = (((a[0] + a[1]) + (a[2] + a[3])) + ((b[0] + b[1]) + (b[2] + b[3]))) + (((c[0] + c[1]) + (c[2] + c[3])) + ((d[0] + d[1]) + (d[2] + d[3])));
    return __builtin_amdgcn_rsqf(s * (1.0f / D) + EPS); }

struct EpiInProj {
    const float* ssq; unsigned char* ws; LAS const float* rsl; int pm0;
    __device__ __forceinline__ void operator()(const f32x4 (&acc)[2][2][4][2], const pg8::Unit& u, int wr, int wc, int fr, int fq) const {
        bf16_t* const ZA = (bf16_t*)(ws + WS_ZA); bf16_t* const GLU = (bf16_t*)(ws + WS_GLU); bf16_t* const BG = (bf16_t*)(ws + WS_BG); bf16_t* const CH = (bf16_t*)(ws + WS_CH);
        const float* const ropeC = (const float*)(ws + WS_ROPEC); const float* const ropeS = (const float*)(ws + WS_ROPES);
        const int T = u.pn, row0 = u.pm * 256 + wr * 64 + fr, jcol = wc * 32 + 8 * fq;
        if (T < 4) {
            EPI_ROWLOOP { const int row = row0 + ai * 128 + m * 16; const float rs = EPI_RS(row);
#pragma unroll
                for (int bj = 0; bj < 2; ++bj) { f32x4 v0 = acc[ai][bj][m][0] * rs, v1 = acc[ai][bj][m][1] * rs;
                    f32x2 a = gelu_pk((f32x2){v0[0], v0[1]}), b = gelu_pk((f32x2){v0[2], v0[3]}), c = gelu_pk((f32x2){v1[0], v1[1]}), d = gelu_pk((f32x2){v1[2], v1[3]});
                    *(u32x4*)(ZA + (size_t)row * 1024 + 256 * T + 128 * bj + jcol) = pack8((f32x4){a.x, a.y, b.x, b.y}, (f32x4){c.x, c.y, d.x, d.y}); } }
        } else if (T < 8) {
            EPI_ROWLOOP { const int row = row0 + ai * 128 + m * 16; const float rs = EPI_RS(row); f32x4 o[2];
#pragma unroll
                for (int n = 0; n < 2; ++n) { const f32x4 a = acc[ai][0][m][n] * rs, g = acc[ai][1][m][n] * rs;
#pragma unroll
                    for (int j = 0; j < 4; ++j) o[n][j] = a[j] * sigmoidf_(g[j]); }
                *(u32x4*)(GLU + (size_t)row * 512 + 128 * (T - 4) + jcol) = pack8(o[0], o[1]); }
        } else if (T < 11) {
            const bool isq = T < 10; const bool rope = isq || wc < 2; const float sc = isq ? 0.125f : 1.0f;
            const size_t boff = isq ? WS_Q : (wc < 2 ? WS_K : WS_V); bf16_t* const base = (bf16_t*)(ws + boff);
            const int ld = isq ? 512 : 128, hcol = isq ? (4 * (T - 8) + wc) * 64 : (wc & 1) * 64;
            EPI_ROWLOOP { const int row = row0 + ai * 128 + m * 16; const float rs = EPI_RS(row) * sc; const int pos = row & (SEQ - 1); f32x4 o1[2], o2[2];
#pragma unroll
                for (int n = 0; n < 2; ++n) { const f32x4 x1 = acc[ai][0][m][n] * rs, x2 = acc[ai][1][m][n] * rs;
                    if (rope) { const f32x4 c = *(const f32x4*)(ropeC + pos * 32 + 8 * fq + 4 * n), s = *(const f32x4*)(ropeS + pos * 32 + 8 * fq + 4 * n);
                        o1[n] = x1 * c - x2 * s; o2[n] = x2 * c + x1 * s; } else { o1[n] = x1; o2[n] = x2; } }
                bf16_t* p = base + (size_t)row * ld + hcol + 8 * fq;
                *(u32x4*)p = pack8(o1[0], o1[1]); *(u32x4*)(p + 32) = pack8(o2[0], o2[1]); }
        } else if (T < 13) {
            EPI_ROWLOOP { const int row = row0 + ai * 128 + m * 16; const float rs = EPI_RS(row);
#pragma unroll
                for (int bj = 0; bj < 2; ++bj) *(u32x4*)(BG + (size_t)row * 512 + 256 * (T - 11) + 128 * bj + jcol) = pack8(acc[ai][bj][m][0] * rs, acc[ai][bj][m][1] * rs); }
        } else {
            EPI_ROWLOOP { const int row = row0 + ai * 128 + m * 16; const float rs = EPI_RS(row); const float rs2 = rs * rs;
                *(u32x4*)(CH + (size_t)row * 512 + 128 * (T - 13) + jcol) = pack8(acc[ai][0][m][0] * acc[ai][1][m][0] * rs2, acc[ai][0][m][1] * acc[ai][1][m][1] * rs2); }
        }
    }
};
struct EpiGate {
    const float* ssq; bf16_t* MG;
    __device__ __forceinline__ void operator()(const f32x4 (&acc)[2][2][4][2], const pg8::Unit& u, int wr, int wc, int fr, int fq) const {
        const int row0 = u.pm * 256 + wr * 64 + fr, col0 = u.pn * 256 + wc * 32 + 8 * fq;
        EPI_ROWLOOP { const int row = row0 + ai * 128 + m * 16; const float rs = row_rs(ssq, row);
#pragma unroll
            for (int bj = 0; bj < 2; ++bj) { f32x4 v0 = acc[ai][bj][m][0] * rs, v1 = acc[ai][bj][m][1] * rs;
#pragma unroll
                for (int j = 0; j < 4; ++j) { v0[j] = sigmoidf_(v0[j]); v1[j] = sigmoidf_(v1[j]); }
                *(u32x4*)(MG + (size_t)row * 1024 + col0 + 128 * bj) = pack8(v0, v1); } }
    }
};
struct EpiBranch {
    bf16_t* MG; bf16_t* TMP;
    __device__ __forceinline__ void operator()(const f32x4 (&acc)[2][2][4][2], const pg8::Unit& u, int wr, int wc, int fr, int fq) const {
        const int row0 = u.pm * 256 + wr * 64 + fr, col0 = u.pn * 256 + wc * 32 + 8 * fq, br = u.z >> 1;
        EPI_ROWLOOP { const int row = row0 + ai * 128 + m * 16;
#pragma unroll
            for (int bj = 0; bj < 2; ++bj) { const size_t off = (size_t)row * 1024 + col0 + 128 * bj;
                f32x4 g0, g1; unpack8(*(const u32x4*)(MG + off), g0, g1);
                f32x4 v0 = acc[ai][bj][m][0] * g0, v1 = acc[ai][bj][m][1] * g1;
                if (br > 0) { f32x4 t0, t1; unpack8(*(const u32x4*)(TMP + off), t0, t1); v0 += t0; v1 += t1; }
                if (br < 3) *(u32x4*)(TMP + off) = pack8(v0, v1); else *(u32x4*)(MG + off) = pack8(v0, v1); } }
    }
};
struct EpiStashB {
    bf16_t* MG;
    __device__ __forceinline__ void operator()(const f32x4 (&acc)[2][2][4][2], const pg8::Unit& u, int wr, int wc, int fr, int fq) const {
        const int row0 = u.pm * 256 + wr * 64 + fr, col0 = u.pn * 256 + wc * 32 + 8 * fq;
        EPI_ROWLOOP { const int row = row0 + ai * 128 + m * 16;
#pragma unroll
            for (int bj = 0; bj < 2; ++bj) *(u32x4*)(MG + (size_t)row * 1024 + col0 + 128 * bj) = pack8(acc[ai][bj][m][0], acc[ai][bj][m][1]); }
    }
};
struct EpiGateAcc {
    const float* ssq; bf16_t* MG; bf16_t* TMP; LAS const float* rsl; int pm0;
    __device__ __forceinline__ void operator()(const f32x4 (&acc)[2][2][4][2], const pg8::Unit& u, int wr, int wc, int fr, int fq) const {
        const int row0 = u.pm * 256 + wr * 64 + fr, col0 = u.pn * 256 + wc * 32 + 8 * fq, br = u.z >> 1;
        u32x4 sb[8][2], tb[8][2];
#define EGA_LOAD(it) do { const int row_ = row0 + ((it) >> 2) * 128 + ((it) & 3) * 16; _Pragma("unroll") for (int bj = 0; bj < 2; ++bj) { const size_t off_ = (size_t)row_ * 1024 + col0 + 128 * bj; \
            sb[it][bj] = *(const u32x4*)(MG + off_); if (br > 0) tb[it][bj] = *(const u32x4*)(TMP + off_); } } while (0)
        EGA_LOAD(0);
#pragma unroll
        for (int it = 0; it < 8; ++it) { const int ai = it >> 2, m = it & 3; const int row = row0 + ai * 128 + m * 16; const float rs = EPI_RS(row);
            if (it + 1 < 8) EGA_LOAD(it + 1);
#pragma unroll
            for (int bj = 0; bj < 2; ++bj) { const size_t off = (size_t)row * 1024 + col0 + 128 * bj;
                f32x4 b0, b1; unpack8(sb[it][bj], b0, b1);
                f32x4 v0 = acc[ai][bj][m][0] * rs, v1 = acc[ai][bj][m][1] * rs;
#pragma unroll
                for (int j = 0; j < 4; ++j) { v0[j] = sigmoidf_(v0[j]) * b0[j]; v1[j] = sigmoidf_(v1[j]) * b1[j]; }
                if (br > 0) { f32x4 t0, t1; unpack8(tb[it][bj], t0, t1); v0 += t0; v1 += t1; }
                if (br < 3) *(u32x4*)(TMP + off) = pack8(v0, v1); else *(u32x4*)(MG + off) = pack8(v0, v1); } }
#undef EGA_LOAD
    }
};
struct EpiMerge2 {
    EpiStashB ES; EpiGateAcc EA;
    __device__ __forceinline__ void operator()(const f32x4 (&acc)[2][2][4][2], const pg8::Unit& u, int wr, int wc, int fr, int fq) const {
        if ((u.z & 1) == 0) ES(acc, u, wr, wc, fr, fq); else EA(acc, u, wr, wc, fr, fq);
    }
};
struct EpiResid {
    bf16_t* XB; float* ssq_out;
    __device__ __forceinline__ void operator()(const f32x4 (&acc)[2][2][4][2], const pg8::Unit& u, int wr, int wc, int fr, int fq) const {
        const int row0 = u.pm * 256 + wr * 64 + fr, col0 = u.pn * 256 + wc * 32 + 8 * fq;
        u32x4 xb[8][2];
#define ER_LOAD(it) do { const int row_ = row0 + ((it) >> 2) * 128 + ((it) & 3) * 16; _Pragma("unroll") for (int bj = 0; bj < 2; ++bj) xb[it][bj] = *(const u32x4*)(XB + (size_t)row_ * 1024 + col0 + 128 * bj); } while (0)
        ER_LOAD(0); ER_LOAD(1);
#pragma unroll
        for (int it = 0; it < 8; ++it) { const int ai = it >> 2, m = it & 3; const int row = row0 + ai * 128 + m * 16; float ss = 0.f;
            if (it + 2 < 8) ER_LOAD(it + 2);
#pragma unroll
            for (int bj = 0; bj < 2; ++bj) { const size_t off = (size_t)row * 1024 + col0 + 128 * bj;
                f32x4 x0, x1; unpack8(xb[it][bj], x0, x1);
                const f32x4 v0 = x0 + acc[ai][bj][m][0], v1 = x1 + acc[ai][bj][m][1];
                *(u32x4*)(XB + off) = pack8(v0, v1);
                ss += (v0[0] * v0[0] + v0[1] * v0[1]) + (v0[2] * v0[2] + v0[3] * v0[3]) + (v1[0] * v1[0] + v1[1] * v1[1]) + (v1[2] * v1[2] + v1[3] * v1[3]); }
            ss += __shfl_xor(ss, 16); ss += __shfl_xor(ss, 32);
            if (fq == 0) ssq_out[(size_t)row * 16 + u.pn * 4 + wc] = ss; }
#undef ER_LOAD
    }
};
struct EpiSwiGLU {
    const float* ssq; bf16_t* ACT; float zero_scale; LAS const float* rsl; int pm0;
    __device__ __forceinline__ void operator()(const f32x4 (&acc)[2][2][4][2], const pg8::Unit& u, int wr, int wc, int fr, int fq) const {
        const int row0 = u.pm * 256 + wr * 64 + fr, col0 = u.pn * 128 + wc * 32 + 8 * fq;
        EPI_ROWLOOP { const int row = row0 + ai * 128 + m * 16; const float rs = EPI_RS(row); f32x4 o[2];
#pragma unroll
            for (int n = 0; n < 2; ++n) { const f32x4 g = acc[ai][0][m][n] * rs, up = acc[ai][1][m][n] * rs;
#pragma unroll
                for (int j = 0; j < 4; ++j) o[n][j] = g[j] * sigmoidf_(g[j]) * up[j] * zero_scale; }
            *(u32x4*)(ACT + (size_t)row * DFF + col0) = pack8(o[0], o[1]); }
    }
};

#define ABL_FFN_SCALE(l) 1.0f
struct Args { const float* in[19]; float* out; unsigned char* ws; };

__device__ __forceinline__ int win_src_col(int nlog) {
    const int T = nlog >> 8, o = nlog & 255, bj = o >> 7, j = o & 127;
    if (T < 4) return nlog;
    if (T < 8) return 1024 + bj * 512 + 128 * (T - 4) + j;
    if (T < 10) return 2048 + (4 * (T - 8) + (j >> 5)) * 64 + 32 * bj + (j & 31);
    if (T == 10) { const int h = j >> 5; return (h < 2 ? 2560 + h * 64 : 2688 + (h - 2) * 64) + 32 * bj + (j & 31); }
    if (T < 13) return 2816 + 256 * (T - 11) + o;
    if (T < 17) return 3328 + bj * 512 + 128 * (T - 13) + j;
    return nlog;
}
template <int NL> __device__ __forceinline__ void tr_item(const float* W, int Nsrc, int k0, int scolA, int scolB, const float* gain, bf16_t* WT, int K, int drow, LAS float* scr, int lane) {
    const int c4 = lane & 15; const int sc = ((c4 >> 3) ? scolB : scolA) + 4 * (c4 & 7);
#pragma unroll
    for (int h = 0; h < 16 / NL; ++h) { f32x4 v[NL];
#pragma unroll
        for (int i = 0; i < NL; ++i) v[i] = __builtin_nontemporal_load((const f32x4*)(W + (size_t)(k0 + 4 * (h * NL + i) + (lane >> 4)) * Nsrc + sc));
#pragma unroll
        for (int i = 0; i < NL; ++i) { const int row = 4 * (h * NL + i) + (lane >> 4); if (gain) v[i] = v[i] * gain[k0 + row];
            LAS float* d = scr + row * 65 + 4 * c4; d[0] = v[i][0]; d[1] = v[i][1]; d[2] = v[i][2]; d[3] = v[i][3]; } }
    asm volatile("s_waitcnt lgkmcnt(0)" ::: "memory");
    const int c = lane & 7;
#pragma unroll
    for (int jj = 0; jj < 8; ++jj) { const int n = (lane >> 3) + 8 * jj; const LAS float* s = scr + (8 * c) * 65 + n;
        u32x4 o; o.x = cvt_pk_bf16(s[0], s[65]); o.y = cvt_pk_bf16(s[2 * 65], s[3 * 65]); o.z = cvt_pk_bf16(s[4 * 65], s[5 * 65]); o.w = cvt_pk_bf16(s[6 * 65], s[7 * 65]);
        *(u32x4*)(WT + (size_t)(drow + n) * K + k0 + 8 * c) = o; }
    asm volatile("s_waitcnt lgkmcnt(0)" ::: "memory");
}
struct WPtrs { const float *w_in, *norm_mix, *w_branch, *w_out, *w_gate_up, *norm_ffn, *w_down; };
constexpr int ITEMS_PER_LAYER = 16 * 132 + 512 + 256 + 16 * 88 + 44 * 16;
constexpr int ITEMS_EARLY = 16 * 132 + 512 + 256, ITEMS_MID = ITEMS_PER_LAYER + 16 * 132;
template <int NL> __device__ __forceinline__ void convert_weights(const WPtrs& wp, unsigned char* ws, LAS unsigned char* lds, int lo, int hi, int w0, int nw) {
    int tid_ = threadIdx.x; asm volatile("" : "+v"(tid_));
    const int lane = tid_ & 63, wave = __builtin_amdgcn_readfirstlane(tid_ >> 6);
    LAS float* scr = (LAS float*)(lds + wave * 16640);
    constexpr int I_IN = 16 * 132, I_BR = 512, I_OUT = 256, I_GU = 16 * 88, I_L = ITEMS_PER_LAYER;
    for (int it = lo + w0; it < hi; it += nw) {
        const int l = it / I_L; int r = it % I_L;
        if (r < I_IN) { const int kb = r / 132, nb = r % 132, n0 = 64 * nb;
            tr_item<NL>(wp.w_in + (size_t)l * D * PROJ, PROJ, 64 * kb, win_src_col(n0), win_src_col(n0 + 32), wp.norm_mix + l * D, (bf16_t*)(ws + WS_WIN + l * WIN_L), D, n0, scr, lane); continue; } r -= I_IN;
        if (r < I_BR) { const int br = r >> 7, q = r & 127, kb = q >> 4, nb = q & 15;
            tr_item<NL>(wp.w_branch + (size_t)(l * 4 + br) * 512 * D, D, 64 * kb, 64 * nb, 64 * nb + 32, nullptr, (bf16_t*)(ws + WS_WBR + l * WBR_L) + (size_t)br * 1024 * 512, 512, 64 * nb, scr, lane); continue; } r -= I_BR;
        if (r < I_OUT) { const int kb = r >> 4, nb = r & 15;
            tr_item<NL>(wp.w_out + (size_t)l * D * D, D, 64 * kb, 64 * nb, 64 * nb + 32, nullptr, (bf16_t*)(ws + WS_WOUT + l * WOUT_L), D, 64 * nb, scr, lane); continue; } r -= I_OUT;
        if (r < I_GU) { const int kb = r / 88, nb = r % 88, n0 = 64 * nb, T = n0 >> 8, o = n0 & 255, sc = (o >> 7) * DFF + 128 * T + (o & 127);
            tr_item<NL>(wp.w_gate_up + (size_t)l * D * 2 * DFF, 2 * DFF, 64 * kb, sc, sc + 32, wp.norm_ffn + l * D, (bf16_t*)(ws + WS_WGU + l * WGU_L), D, n0, scr, lane); continue; } r -= I_GU;
        { const int kb = r >> 4, nb = r & 15;
            tr_item<NL>(wp.w_down + (size_t)l * DFF * D, D, 64 * kb, 64 * nb, 64 * nb + 32, nullptr, (bf16_t*)(ws + WS_WDN + l * WDN_L), DFF, 64 * nb, scr, lane); }
    }
}
__device__ __forceinline__ void prologue(const Args& a, LAS unsigned char* lds, int G) {
    int tid_ = threadIdx.x; asm volatile("" : "+v"(tid_));
    const int tid = tid_, lane = tid & 63, wave = __builtin_amdgcn_readfirstlane(tid >> 6);
    const int gw = blockIdx.x * NWAVES + wave, NGW = G * NWAVES;
    unsigned char* ws = a.ws;
    { const WPtrs wp{a.in[2], a.in[1], a.in[13], a.in[14], a.in[16], a.in[15], a.in[17]};
      if (blockIdx.x == 0 && tid == 0) *(WPtrs*)(ws + WS_PTRS) = wp;
      convert_weights<16>(wp, ws, lds, 0, G == 256 ? ITEMS_EARLY : 2 * ITEMS_PER_LAYER, gw, NGW); }
    float* ssq = (float*)(ws + WS_SSQ);
    for (int row = gw; row < M; row += NGW) {
        const f32x4* xr = (const f32x4*)(a.in[0] + (size_t)row * D) + lane; float s = 0.f; f32x4 v[4];
#pragma unroll
        for (int j = 0; j < 4; ++j) { v[j] = xr[64 * j]; s += (v[j][0] * v[j][0] + v[j][1] * v[j][1]) + (v[j][2] * v[j][2] + v[j][3] * v[j][3]); }
        s = wave_sum(s);
        u32x2* o = (u32x2*)((bf16_t*)(ws + WS_XB) + (size_t)row * D) + lane;
#pragma unroll
        for (int j = 0; j < 4; ++j) o[64 * j] = (u32x2){cvt_pk_bf16(v[j][0], v[j][1]), cvt_pk_bf16(v[j][2], v[j][3])};
        if (lane < 16) ssq[(size_t)row * 16 + lane] = lane == 0 ? s : 0.f;
    }
    { float* par = (float*)(ws + WS_PAR); const int gt = blockIdx.x * NTHREADS + tid, GT = G * NTHREADS;
#define CPY(dstoff, srcp, n) for (int i = gt; i < (n); i += GT) par[(dstoff) + i] = (srcp)[i]
      for (int l = 0; l < 2; ++l) { const int o = l * PAR_L;
          CPY(o + P_SGLNG, a.in[3] + l * 512, 512); CPY(o + P_SGLNB, a.in[4] + l * 512, 512); CPY(o + P_SGB, a.in[6] + l * 512, 512);
          CPY(o + P_CVB, a.in[8] + l * 512, 512); CPY(o + P_CVLNG, a.in[9] + l * 512, 512); CPY(o + P_CVLNB, a.in[10] + l * 512, 512);
          CPY(o + P_SCW, a.in[12] + l * 1536, 1536); CPY(o + P_SINK, a.in[11] + l * 8, 8); CPY(o + P_CVW, a.in[7] + l * 31 * 512, 31 * 512); }
      CPY(P_FINAL, a.in[18], 1024);
#undef CPY
    }
    for (int i = blockIdx.x * NTHREADS + tid; i < SEQ * 32; i += G * NTHREADS) { const int pos = i >> 5, f = i & 31;
        const double rev = (double)pos * INVF_REV[f]; const float fr = (float)(rev - floor(rev));
        ((float*)(ws + WS_ROPEC))[i] = __builtin_amdgcn_cosf(fr); ((float*)(ws + WS_ROPES))[i] = __builtin_amdgcn_sinf(fr); }
    for (int i = blockIdx.x * NTHREADS + tid; i < 2 * 4 * 128 * 128; i += G * NTHREADS) { const int s = i & 127, t = (i >> 7) & 127;
        ((bf16_t*)(ws + WS_SGWT))[i] = s <= t ? (bf16_t)(cvt_pk_bf16(a.in[5][i], 0.f) & 0xffffu) : (bf16_t)0; }
}

__device__ __forceinline__ void mixer_sg(unsigned char* ws, int l, LAS unsigned char* lds, int unit) {
    { size_t z_ = 0; asm volatile("" : "+s"(z_)); ws += z_; } int tid_ = threadIdx.x; asm volatile("" : "+v"(tid_));
    const float* par = (const float*)(ws + WS_PAR) + l * PAR_L;
    const int tid = tid_, lane = tid & 63, wave = __builtin_amdgcn_readfirstlane(tid >> 6);
    const int ck = unit >> 2, g = unit & 3, r0 = ck * 128;
    const bf16_t* ZA = (const bf16_t*)(ws + WS_ZA); bf16_t* YA = (bf16_t*)(ws + WS_YA);
    LAS bf16_t* vnT = (LAS bf16_t*)lds;
    const float* lng = par + P_SGLNG; const float* lnb = par + P_SGLNB;
    const f32x4 g0 = *(const f32x4*)(lng + 8 * lane), g1 = *(const f32x4*)(lng + 8 * lane + 4), b0 = *(const f32x4*)(lnb + 8 * lane), b1 = *(const f32x4*)(lnb + 8 * lane + 4);
    u32x4 raw[16];
#pragma unroll
    for (int i = 0; i < 16; ++i) raw[i] = *(const u32x4*)(ZA + (size_t)(r0 + wave + 8 * i) * 1024 + 512 + 8 * lane);
    const int fr = lane & 15, fq = lane >> 4, t0 = 16 * wave, nks = (wave >> 1) + 1;
    const bf16_t* W = (const bf16_t*)(ws + WS_SGWT) + (size_t)(l * 4 + g) * 16384 + (size_t)(t0 + fr) * 128 + 8 * fq;
    bf16x8 wf[4];
#pragma unroll
    for (int ks = 0; ks < 4; ++ks) wf[ks] = *(const bf16x8*)(W + 32 * (ks < nks ? ks : 0));
    const int tt = t0 + fr; const size_t orow = r0 + tt; const float bs = par[P_SGB + g * 128 + tt];
    u32x2 uu[8];
#pragma unroll
    for (int ct = 0; ct < 8; ++ct) uu[ct] = *(const u32x2*)(ZA + orow * 1024 + 128 * g + 16 * ct + 4 * fq);
#pragma unroll
    for (int i = 0; i < 16; ++i) { const int s = wave + 8 * i;
        f32x4 x0, x1; unpack8(raw[i], x0, x1);
        const float mean = wave_sum((x0[0] + x0[1]) + (x0[2] + x0[3]) + (x1[0] + x1[1]) + (x1[2] + x1[3])) * (1.0f / 512.0f);
        x0 -= mean; x1 -= mean;
        const float var = wave_sum((x0[0] * x0[0] + x0[1] * x0[1]) + (x0[2] * x0[2] + x0[3] * x0[3]) + (x1[0] * x1[0] + x1[1] * x1[1]) + (x1[2] * x1[2] + x1[3] * x1[3])) * (1.0f / 512.0f);
        const float rstd = __builtin_amdgcn_rsqf(var + EPS);
        if ((lane >> 4) == g) { const int c = 8 * (lane & 15); x0 = x0 * rstd * g0 + b0; x1 = x1 * rstd * g1 + b1;
            const unsigned p0 = cvt_pk_bf16(x0[0], x0[1]), p1 = cvt_pk_bf16(x0[2], x0[3]), p2 = cvt_pk_bf16(x1[0], x1[1]), p3 = cvt_pk_bf16(x1[2], x1[3]);
            LAS bf16_t* d = vnT + c * 136 + (s ^ (8 * (lane & 15)));
            d[0] = (bf16_t)p0; d[136] = (bf16_t)(p0 >> 16); d[2 * 136] = (bf16_t)p1; d[3 * 136] = (bf16_t)(p1 >> 16);
            d[4 * 136] = (bf16_t)p2; d[5 * 136] = (bf16_t)(p2 >> 16); d[6 * 136] = (bf16_t)p3; d[7 * 136] = (bf16_t)(p3 >> 16); }
    }
    __syncthreads();
    { f32x4 acc[8];
#pragma unroll
      for (int ct = 0; ct < 8; ++ct) acc[ct] = (f32x4){0.f, 0.f, 0.f, 0.f};
#pragma unroll
      for (int ks = 0; ks < 4; ++ks) if (ks < nks) {
#pragma unroll
          for (int ct = 0; ct < 8; ++ct) { const bf16x8 vf = *(const LAS bf16x8*)(vnT + (16 * ct + fr) * 136 + 8 * ((4 * ks + fq) ^ ((2 * ct + (fr >> 3)) & 15)));
              acc[ct] = __builtin_amdgcn_mfma_f32_16x16x32_bf16(vf, wf[ks], acc[ct], 0, 0, 0); }
      }
#pragma unroll
      for (int ct = 0; ct < 8; ++ct) { const int c = 128 * g + 16 * ct + 4 * fq;
          const float o0 = bf_lo(uu[ct].x) * (acc[ct][0] + bs), o1 = bf_hi(uu[ct].x) * (acc[ct][1] + bs), o2 = bf_lo(uu[ct].y) * (acc[ct][2] + bs), o3 = bf_hi(uu[ct].y) * (acc[ct][3] + bs);
          *(u32x2*)(YA + orow * 512 + c) = (u32x2){cvt_pk_bf16(o0, o1), cvt_pk_bf16(o2, o3)}; }
    }
    __syncthreads();
}
__device__ __forceinline__ void mixer_conv(unsigned char* ws, int l, LAS unsigned char* lds, int unit) {
    { size_t z_ = 0; asm volatile("" : "+s"(z_)); ws += z_; } int tid_ = threadIdx.x; asm volatile("" : "+v"(tid_));
    const float* par = (const float*)(ws + WS_PAR) + l * PAR_L;
    const int tid = tid_, lane = tid & 63, wave = tid >> 6;
    const int b = unit >> 6, tb = unit & 63, t0 = tb * 32; const size_t rbase = (size_t)b * SEQ;
    const bf16_t* GLU = (const bf16_t*)(ws + WS_GLU); bf16_t* YB = (bf16_t*)(ws + WS_YB);
    LAS bf16_t* in = (LAS bf16_t*)lds;
    LAS float* cv = (LAS float*)(lds + 65536);
    for (int i = tid; i < 62 * 64; i += NTHREADS) { const int r = i >> 6, ch = i & 63; const int t = t0 - 30 + r;
        u32x4 v = {0u, 0u, 0u, 0u}; if (t >= 0) v = *(const u32x4*)(GLU + (rbase + t) * 512 + 8 * ch);
        *(LAS u32x4*)(in + r * 512 + 8 * ch) = v; }
    __syncthreads();
    { const int c = tid; float w[31], x[62];
#pragma unroll
      for (int k = 0; k < 31; ++k) w[k] = par[P_CVW + k * 512 + c];
#pragma unroll
      for (int r = 0; r < 62; ++r) x[r] = bf1(in[r * 512 + c]);
      const float bias = par[P_CVB + c];
#pragma unroll
      for (int t = 0; t < 32; ++t) { float s = bias;
#pragma unroll
          for (int k = 0; k < 31; ++k) s += w[k] * x[t + k];
          cv[t * 512 + c] = s; } }
    __syncthreads();
    { const float* lng = par + P_CVLNG; const float* lnb = par + P_CVLNB;
      const f32x4 g0 = *(const f32x4*)(lng + 8 * lane), g1 = *(const f32x4*)(lng + 8 * lane + 4), b0 = *(const f32x4*)(lnb + 8 * lane), b1 = *(const f32x4*)(lnb + 8 * lane + 4);
      for (int t = wave; t < 32; t += NWAVES) {
          f32x4 x0 = *(const LAS f32x4*)(cv + t * 512 + 8 * lane), x1 = *(const LAS f32x4*)(cv + t * 512 + 8 * lane + 4);
          const float mean = wave_sum((x0[0] + x0[1]) + (x0[2] + x0[3]) + (x1[0] + x1[1]) + (x1[2] + x1[3])) * (1.0f / 512.0f);
          x0 -= mean; x1 -= mean;
          const float var = wave_sum((x0[0] * x0[0] + x0[1] * x0[1]) + (x0[2] * x0[2] + x0[3] * x0[3]) + (x1[0] * x1[0] + x1[1] * x1[1]) + (x1[2] * x1[2] + x1[3] * x1[3])) * (1.0f / 512.0f);
          const float rstd = __builtin_amdgcn_rsqf(var + EPS);
          x0 = x0 * rstd * g0 + b0; x1 = x1 * rstd * g1 + b1;
#pragma unroll
          for (int j = 0; j < 4; ++j) { x0[j] = x0[j] * sigmoidf_(x0[j]); x1[j] = x1[j] * sigmoidf_(x1[j]); }
          *(u32x4*)(YB + (rbase + t0 + t) * 512 + 8 * lane) = pack8(x0, x1); } }
    __syncthreads();
}
__device__ __forceinline__ void mixer_attn(unsigned char* ws, int l, LAS unsigned char* lds, int unit) {
    { size_t z_ = 0; asm volatile("" : "+s"(z_)); ws += z_; } int tid_ = threadIdx.x; asm volatile("" : "+v"(tid_));
    const float* par = (const float*)(ws + WS_PAR) + l * PAR_L;
    const int tid = tid_, lane = tid & 63, wave = __builtin_amdgcn_readfirstlane(tid >> 6), fr = lane & 15, fq = lane >> 4;
    const int kvh = unit & 1, blk = (unit >> 1) & 15, b = unit >> 5; const size_t rbase = (size_t)b * SEQ;
    bf16_t* Q = (bf16_t*)(ws + WS_Q); const bf16_t* K = (const bf16_t*)(ws + WS_K); const bf16_t* V = (const bf16_t*)(ws + WS_V);
    LAS bf16_t* Kl = (LAS bf16_t*)lds;
    LAS bf16_t* VT = (LAS bf16_t*)(lds + 36864);
    for (int i = tid; i < 256 * 8; i += NTHREADS) { const int r = i >> 3, ch = i & 7; const int t = (blk - 1) * 128 + r;
        u32x4 kv = {0u, 0u, 0u, 0u}, vv = {0u, 0u, 0u, 0u};
        if (t >= 0) { kv = *(const u32x4*)(K + (rbase + t) * 128 + kvh * 64 + 8 * ch); vv = *(const u32x4*)(V + (rbase + t) * 128 + kvh * 64 + 8 * ch); }
        *(LAS u32x4*)(Kl + r * 72 + 8 * ch) = kv;
        LAS bf16_t* d = VT + (8 * ch) * 264 + r;
        d[0] = (bf16_t)vv.x; d[264] = (bf16_t)(vv.x >> 16); d[2 * 264] = (bf16_t)vv.y; d[3 * 264] = (bf16_t)(vv.y >> 16);
        d[4 * 264] = (bf16_t)vv.z; d[5 * 264] = (bf16_t)(vv.z >> 16); d[6 * 264] = (bf16_t)vv.w; d[7 * 264] = (bf16_t)(vv.w >> 16); }
    __syncthreads();
    const int g = wave >> 1, head = kvh * 4 + g; const float sink = par[P_SINK + head];
    for (int it = 0; it < 2; ++it) {
        const int qs = 2 * (wave & 1) + it, qi0 = 32 * qs; const size_t qrow0 = rbase + blk * 128 + qi0;
        bf16x8 qf[2][2];
#pragma unroll
        for (int qt = 0; qt < 2; ++qt)
#pragma unroll
            for (int ks = 0; ks < 2; ++ks) qf[qt][ks] = *(const bf16x8*)(Q + (qrow0 + 16 * qt + fr) * 512 + head * 64 + 32 * ks + 8 * fq);
        f32x4 S[2][10];
#pragma unroll
        for (int qt = 0; qt < 2; ++qt)
#pragma unroll
            for (int kt = 0; kt < 10; ++kt) S[qt][kt] = (f32x4){0.f, 0.f, 0.f, 0.f};
#pragma unroll
        for (int kt = 0; kt < 10; ++kt)
#pragma unroll
            for (int ks = 0; ks < 2; ++ks) { const bf16x8 kf = *(const LAS bf16x8*)(Kl + (qi0 + 16 * kt + fr) * 72 + 32 * ks + 8 * fq);
#pragma unroll
                for (int qt = 0; qt < 2; ++qt) S[qt][kt] = __builtin_amdgcn_mfma_f32_16x16x32_bf16(kf, qf[qt][ks], S[qt][kt], 0, 0, 0); }
        bf16x8 pf[2][5];
#pragma unroll
        for (int qt = 0; qt < 2; ++qt) { const int qi = qi0 + 16 * qt + fr; float mx = sink;
#pragma unroll
            for (int kt = 0; kt < 10; ++kt)
#pragma unroll
                for (int j = 0; j < 4; ++j) { const int kb = qi0 + 16 * kt + 4 * fq + j; const bool valid = (kb > qi) && (kb <= qi + 128) && (blk > 0 || kb >= 128);
                    const float sv = valid ? S[qt][kt][j] : -INFINITY; S[qt][kt][j] = sv; mx = fmaxf(mx, sv); }
            mx = fmaxf(mx, __shfl_xor(mx, 16)); mx = fmaxf(mx, __shfl_xor(mx, 32));
            float sum = 0.f;
#pragma unroll
            for (int kt = 0; kt < 10; ++kt)
#pragma unroll
                for (int j = 0; j < 4; ++j) { const float p = __expf(S[qt][kt][j] - mx); S[qt][kt][j] = p; sum += p; }
            sum += __shfl_xor(sum, 16); sum += __shfl_xor(sum, 32);
            const float inv = 1.0f / (sum + __expf(sink - mx));
#pragma unroll
            for (int p = 0; p < 5; ++p) { const f32x4 a0 = S[qt][2 * p] * inv, a1 = S[qt][2 * p + 1] * inv; pf[qt][p] = __builtin_bit_cast(bf16x8, pack8(a0, a1)); }
        }
        f32x4 o[2][4];
#pragma unroll
        for (int qt = 0; qt < 2; ++qt)
#pragma unroll
            for (int dt = 0; dt < 4; ++dt) o[qt][dt] = (f32x4){0.f, 0.f, 0.f, 0.f};
#pragma unroll
        for (int p = 0; p < 5; ++p)
#pragma unroll
            for (int dt = 0; dt < 4; ++dt) { const LAS bf16_t* vp = VT + (16 * dt + fr) * 264 + qi0 + 32 * p + 4 * fq;
                const u32x2 lo = *(const LAS u32x2*)vp, hi = *(const LAS u32x2*)(vp + 16);
                const bf16x8 vf = __builtin_bit_cast(bf16x8, (u32x4){lo.x, lo.y, hi.x, hi.y});
#pragma unroll
                for (int qt = 0; qt < 2; ++qt) o[qt][dt] = __builtin_amdgcn_mfma_f32_16x16x32_bf16(vf, pf[qt][p], o[qt][dt], 0, 0, 0); }
#pragma unroll
        for (int qt = 0; qt < 2; ++qt)
#pragma unroll
            for (int dt = 0; dt < 4; ++dt) *(u32x2*)(Q + (qrow0 + 16 * qt + fr) * 512 + head * 64 + 16 * dt + 4 * fq) = (u32x2){cvt_pk_bf16(o[qt][dt][0], o[qt][dt][1]), cvt_pk_bf16(o[qt][dt][2], o[qt][dt][3])};
    }
    __syncthreads();
}
__device__ __forceinline__ void mixer_sc(unsigned char* ws, int l, int G) {
    { size_t z_ = 0; asm volatile("" : "+s"(z_)); ws += z_; } int tid_ = threadIdx.x; asm volatile("" : "+v"(tid_));
    bf16_t* BG = (bf16_t*)(ws + WS_BG); const bf16_t* CH = (const bf16_t*)(ws + WS_CH);
    const float* w = (const float*)(ws + WS_PAR) + l * PAR_L + P_SCW;
    for (int i = blockIdx.x * NTHREADS + tid_; i < (M / 8) * 64; i += G * NTHREADS) {
        const int row0 = 8 * (i >> 6), c = 8 * (i & 63), t0 = row0 & (SEQ - 1);
        u32x4 ch[10], bg[8];
#pragma unroll
        for (int r = 0; r < 10; ++r) { ch[r] = (u32x4){0u, 0u, 0u, 0u}; if (t0 - 2 + r >= 0) ch[r] = *(const u32x4*)(CH + (size_t)(row0 - 2 + r) * 512 + c); }
#pragma unroll
        for (int r = 0; r < 8; ++r) bg[r] = *(const u32x4*)(BG + (size_t)(row0 + r) * 512 + c);
        f32x4 wa[3], wb[3];
#pragma unroll
        for (int k = 0; k < 3; ++k) { wa[k] = *(const f32x4*)(w + k * 512 + c); wb[k] = *(const f32x4*)(w + k * 512 + c + 4); }
#pragma unroll
        for (int r = 0; r < 8; ++r) { f32x4 a0 = {0.f, 0.f, 0.f, 0.f}, a1 = a0;
#pragma unroll
            for (int k = 0; k < 3; ++k) { f32x4 x0, x1; unpack8(ch[r + k], x0, x1); a0 += x0 * wa[k]; a1 += x1 * wb[k]; }
            f32x4 g0, g1; unpack8(bg[r], g0, g1);
            *(u32x4*)(BG + (size_t)(row0 + r) * 512 + c) = pack8(g0 * a0, g1 * a1); }
    }
}

#define RLX_AGENT __ATOMIC_RELAXED, __HIP_MEMORY_SCOPE_AGENT
#define XB_TMO      128
#define XB_XCNT(j)  (256  + 64 * (j))
#define XB_XSUB(j)  (1280 + 64 * (j))
#define XB_XGEN(j)  (2304 + 64 * (j))
#define XB_TOP      3328
#define XB_TOPGEN   3392
#define XCD_BAR_WORDS 3456
#define XB_SPIN_CAP (1u << 18)

__device__ __forceinline__ unsigned xb_ld(unsigned* p)              { return __hip_atomic_load(p, __ATOMIC_RELAXED, __HIP_MEMORY_SCOPE_AGENT); }
__device__ __forceinline__ unsigned xb_add(unsigned* p, unsigned v) { return __hip_atomic_fetch_add(p, v, __ATOMIC_RELAXED, __HIP_MEMORY_SCOPE_AGENT); }
__device__ __forceinline__ unsigned xb_xcc_id() { return (unsigned)__builtin_amdgcn_s_getreg((3 << 11) | 20) & 0xFu; }
#define XB_SPIN(cond, bar) do { unsigned _sp = 0; while (cond) { __builtin_amdgcn_s_sleep(1); \
    if ((++_sp & 255u) == 0u) { if (xb_ld(&(bar)[XB_TMO])) break; if (_sp > XB_SPIN_CAP) { atomicAdd(&(bar)[XB_TMO], 1u); break; } } } } while (0)

struct XcdBarrier {
    unsigned* bar; unsigned x;
    volatile LAS unsigned* st;
};

__device__ __forceinline__ XcdBarrier xcd_barrier_post(unsigned* bar, volatile LAS unsigned* st) {
    XcdBarrier b; b.bar = bar; b.x = xb_xcc_id(); b.st = st;
    if (threadIdx.x == 0) (void)xb_add(&bar[XB_XCNT(b.x)], 1u);
    return b;
}
__device__ __forceinline__ void xcd_barrier_complete(unsigned* bar, unsigned x, unsigned& nloc, unsigned& nx) {
    const unsigned G = gridDim.x * gridDim.y * gridDim.z;
    unsigned sum, cnt, mine, sp = 0u;
    for (;;) {
        sum = 0u; cnt = 0u; mine = 0u;
#pragma unroll
        for (unsigned j = 0; j < 16; ++j) { const unsigned c = xb_ld(&bar[XB_XCNT(j)]); sum += c; cnt += (c > 0u) ? 1u : 0u; mine = (j == x) ? c : mine; }
        if (sum == G) break;
        __builtin_amdgcn_s_sleep(1);
        if ((++sp & 255u) == 0u) { if (xb_ld(&bar[XB_TMO])) break; if (sp > XB_SPIN_CAP) { atomicAdd(&bar[XB_TMO], 1u); break; } }
    }
    nloc = mine > 0u ? mine : 1u; nx = cnt > 0u ? cnt : 1u;
}

__device__ __forceinline__ void xcd_barrier(const XcdBarrier& b) {
    asm volatile("s_waitcnt vmcnt(0)" ::: "memory");
    __syncthreads();
    if (threadIdx.x == 0) {
        unsigned* bar = b.bar;
        __builtin_amdgcn_s_waitcnt(0);
        unsigned nloc = b.st[0], nx = b.st[1];
        if (nloc == 0u) { xcd_barrier_complete(bar, b.x, nloc, nx); b.st[0] = nloc; b.st[1] = nx; }
        const unsigned old = xb_add(&bar[XB_XSUB(b.x)], 1u);
        const unsigned gen = old / nloc;
        if (old + 1u == (gen + 1u) * nloc) {
            __builtin_amdgcn_fence(__ATOMIC_RELEASE, "agent");
            asm volatile("s_waitcnt vmcnt(0)" ::: "memory");
            const unsigned og = xb_add(&bar[XB_TOP], 1u);
            const unsigned tg = og / nx;
            if (og + 1u == (tg + 1u) * nx) xb_add(&bar[XB_TOPGEN], 1u);
            else XB_SPIN(xb_ld(&bar[XB_TOPGEN]) == tg, bar);
            __builtin_amdgcn_fence(__ATOMIC_ACQUIRE, "agent");
            xb_add(&bar[XB_XGEN(b.x)], 1u);
            asm volatile("s_waitcnt vmcnt(0)" ::: "memory");
        } else {
            XB_SPIN(xb_ld(&bar[XB_XGEN(b.x)]) == gen, bar);
            __builtin_amdgcn_fence(__ATOMIC_ACQUIRE, "agent");
            asm volatile("s_waitcnt vmcnt(0)" ::: "memory");
        }
    }
    __syncthreads();
}


__device__ __forceinline__ void stage_rs(LAS unsigned char* lds, const float* ssq, int pm) {
    int tid_ = threadIdx.x; asm volatile("" : "+v"(tid_));
    if (tid_ < 256 && pm >= 0) ((LAS float*)(lds + RSL_OFF))[tid_] = row_rs(ssq, pm * 256 + tid_);
    __syncthreads();
}
#define GRID_SYNC() do { XcdBarrier xb_; xb_.bar = (unsigned*)(ws + WS_BAR); xb_.x = xb_xcc_id(); xb_.st = (volatile LAS unsigned*)(lds + MISC_OFF); xcd_barrier(xb_); } while (0)
__global__ void __launch_bounds__(NTHREADS, 2) fwd_megakernel(Args a) {
    extern __shared__ __attribute__((aligned(16))) unsigned char lds_raw[];
    LAS unsigned char* lds = (LAS unsigned char*)lds_raw;
    cg::grid_group grid = cg::this_grid();
    const int G = gridDim.x, c = blockIdx.x;
    unsigned char* ws = a.ws;
    float* ssq = (float*)(ws + WS_SSQ);

    { volatile LAS unsigned* misc = (volatile LAS unsigned*)(lds + MISC_OFF); if (threadIdx.x < 16) misc[threadIdx.x] = 0u; }
    __syncthreads();
    if (blockIdx.x == 0 && threadIdx.x < 64) { unsigned* bw = (unsigned*)(ws + WS_BAR);
        for (int i = threadIdx.x; i < XCD_BAR_WORDS; i += 64) bw[i] = 0u; }
    grid.sync();
    (void)xcd_barrier_post((unsigned*)(ws + WS_BAR), (volatile LAS unsigned*)(lds + MISC_OFF));
    prologue(a, lds, G);
    GRID_SYNC();

    for (int l = 0; l < 2; ++l) {
        { size_t z_ = 0; asm volatile("" : "+s"(z_)); ws += z_; } ssq = (float*)(ws + WS_SSQ);
        const float* ssq_mix = ssq + (size_t)(2 * l) * M * 16;
        { pg8::SchedGrid S; S.nM = 64; S.nN = 17; S.nwg = 64 * 17; S.G = G; { int c_ = c; asm volatile("" : "+s"(c_)); S.c = c_; } S.A = (const char*)(ws + WS_XB); S.B = (const char*)(ws + WS_WIN + l * WIN_L); S.lda2 = 2048; S.ldb2 = 2048; S.nt = 16;
          int pm0 = -1; { pg8::Unit u0; if (S.next(0, u0)) pm0 = u0.pm; } stage_rs(lds, ssq_mix, pm0);
          EpiInProj E{ssq_mix, ws, (LAS const float*)(lds + RSL_OFF), pm0};
          pg8::gemm_phase<EpiInProj, pg8::SchedGrid, true>(lds, S, E);
          if (l == 0 && G == 256 && c >= 64) {
              const int wv = __builtin_amdgcn_readfirstlane((int)threadIdx.x >> 6); const WPtrs wp = *(const WPtrs*)(ws + WS_PTRS);
              convert_weights<16>(wp, ws, lds, ITEMS_EARLY, ITEMS_MID, (c - 64) * NWAVES + wv, 192 * NWAVES); }
        }
        GRID_SYNC(); { size_t z_ = 0; asm volatile("" : "+s"(z_)); ws += z_; }
        if (G == 256) {
            const int xcd = c & 7, j0 = c >> 3;
            for (int r = 0; r < 2; ++r) { const int j = j0 + 32 * r; mixer_sg(ws, l, lds, (xcd * 16 + (j >> 2)) * 4 + (j & 3)); }
            for (int r = 0; r < 2; ++r) mixer_conv(ws, l, lds, xcd * 64 + j0 + 32 * r);
            mixer_attn(ws, l, lds, xcd * 32 + j0);
        } else {
            for (int u = c; u < 512; u += G) mixer_sg(ws, l, lds, u);
            for (int u = c; u < 512; u += G) mixer_conv(ws, l, lds, u);
            for (int u = c; u < 256; u += G) mixer_attn(ws, l, lds, u);
        }
        mixer_sc(ws, l, G);
        GRID_SYNC(); { size_t z_ = 0; asm volatile("" : "+s"(z_)); ws += z_; } ssq = (float*)(ws + WS_SSQ);
        { pg8::SchedMerge S; S.G = G; { int c_ = c; asm volatile("" : "+s"(c_)); S.c = c_; } S.ws = (const char*)ws; S.WG = (const char*)(ws + WS_WIN + l * WIN_L) + (size_t)NLOG1 * 2048;
          S.WBR = (const char*)(ws + WS_WBR + l * WBR_L);
          S.swap = 1; int pm0 = -1; { pg8::Unit u0; if (S.next(0, u0)) pm0 = u0.pm; } stage_rs(lds, ssq_mix, pm0);
          EpiStashB ES{(bf16_t*)(ws + WS_MG)}; EpiGateAcc EA{ssq_mix, (bf16_t*)(ws + WS_MG), (bf16_t*)(ws + WS_TMP), (LAS const float*)(lds + RSL_OFF), pm0};
          EpiMerge2 E2{ES, EA};
          pg8::gemm_phase<EpiMerge2, pg8::SchedMerge, true>(lds, S, E2);
        }
        GRID_SYNC(); { size_t z_ = 0; asm volatile("" : "+s"(z_)); ws += z_; } ssq = (float*)(ws + WS_SSQ);
        { pg8::SchedGrid S; S.nM = 64; S.nN = 4; S.nwg = 256; S.G = G; { int c_ = c; asm volatile("" : "+s"(c_)); S.c = c_; } S.A = (const char*)(ws + WS_MG); S.B = (const char*)(ws + WS_WOUT + l * WOUT_L); S.lda2 = 2048; S.ldb2 = 2048; S.nt = 16;
          EpiResid E{(bf16_t*)(ws + WS_XB), ssq + (size_t)(2 * l + 1) * M * 16};
          pg8::gemm_phase<EpiResid, pg8::SchedGrid, false>(lds, S, E); }
        GRID_SYNC(); { size_t z_ = 0; asm volatile("" : "+s"(z_)); ws += z_; } ssq = (float*)(ws + WS_SSQ);
        { pg8::SchedGrid S; S.nM = 64; S.nN = 22; S.nwg = 64 * 22; S.G = G; { int c_ = c; asm volatile("" : "+s"(c_)); S.c = c_; } S.A = (const char*)(ws + WS_XB); S.B = (const char*)(ws + WS_WGU + l * WGU_L); S.lda2 = 2048; S.ldb2 = 2048; S.nt = 16;
          int pm0 = -1; { pg8::Unit u0; if (S.next(0, u0)) pm0 = u0.pm; } stage_rs(lds, ssq + (size_t)(2 * l + 1) * M * 16, pm0);
          EpiSwiGLU E{ssq + (size_t)(2 * l + 1) * M * 16, (bf16_t*)(ws + WS_ACT), ABL_FFN_SCALE(l), (LAS const float*)(lds + RSL_OFF), pm0};
          pg8::gemm_phase<EpiSwiGLU, pg8::SchedGrid, true>(lds, S, E);
          if (l == 0 && G == 256 && c >= 128) {
              const int wv = __builtin_amdgcn_readfirstlane((int)threadIdx.x >> 6); const WPtrs wp = *(const WPtrs*)(ws + WS_PTRS);
              convert_weights<16>(wp, ws, lds, ITEMS_MID, 2 * ITEMS_PER_LAYER, (c - 128) * NWAVES + wv, 128 * NWAVES); }
        }
        GRID_SYNC(); { size_t z_ = 0; asm volatile("" : "+s"(z_)); ws += z_; } ssq = (float*)(ws + WS_SSQ);
        { pg8::SchedGrid S; S.nM = 64; S.nN = 4; S.nwg = 256; S.G = G; { int c_ = c; asm volatile("" : "+s"(c_)); S.c = c_; } S.A = (const char*)(ws + WS_ACT); S.B = (const char*)(ws + WS_WDN + l * WDN_L); S.lda2 = DFF * 2; S.ldb2 = DFF * 2; S.nt = DFF / 64;
          EpiResid E{(bf16_t*)(ws + WS_XB), ssq + (size_t)(2 * l + 2) * M * 16};
          pg8::gemm_phase<EpiResid, pg8::SchedGrid, false>(lds, S, E); }
        GRID_SYNC();
    }
    { { size_t z_ = 0; asm volatile("" : "+s"(z_)); ws += z_; } int tid_ = threadIdx.x; asm volatile("" : "+v"(tid_));
      const int lane = tid_ & 63, gw = c * NWAVES + (tid_ >> 6), NGW = G * NWAVES; const float* gf = (const float*)(ws + WS_PAR) + P_FINAL; const float* sq = (const float*)(ws + WS_SSQ) + (size_t)4 * M * 16;
      const bf16_t* XBp = (const bf16_t*)(ws + WS_XB);
      for (int row = gw; row < M; row += 2 * NGW) { const int row2 = row + NGW;
          u32x4 ra_[2], rb_[2];
#pragma unroll
          for (int j = 0; j < 2; ++j) { ra_[j] = *(const u32x4*)(XBp + (size_t)row * D + 512 * j + 8 * lane); rb_[j] = *(const u32x4*)(XBp + (size_t)row2 * D + 512 * j + 8 * lane); }
          const float ra = row_rs(sq, row), rb = row_rs(sq, row2);
#pragma unroll
          for (int j = 0; j < 2; ++j) { const f32x4 g0 = *(const f32x4*)(gf + 512 * j + 8 * lane), g1 = *(const f32x4*)(gf + 512 * j + 8 * lane + 4);
              f32x4 x0, x1; unpack8(ra_[j], x0, x1); float* oa = a.out + (size_t)row * D + 512 * j + 8 * lane; *(f32x4*)oa = x0 * ra * g0; *(f32x4*)(oa + 4) = x1 * ra * g1;
              unpack8(rb_[j], x0, x1); float* ob = a.out + (size_t)row2 * D + 512 * j + 8 * lane; *(f32x4*)ob = x0 * rb * g0; *(f32x4*)(ob + 4) = x1 * rb * g1; } } }
}

extern "C" void kernel_launch(void* const* d_in, const int* in_sizes, int n_in, void* d_out, int out_size, void* d_ws, size_t ws_size, hipStream_t stream) {
    static int grid = 0;
    if (grid == 0) {
        if (n_in != 19 || out_size != M * D || ws_size < WS_END) { fprintf(stderr, "kernel_launch: unexpected shapes (n_in %d out %d ws %zu)\n", n_in, out_size, ws_size); grid = -1; return; }
        int dev = 0, cus = 0, per_cu = 0;
        if (hipGetDevice(&dev) != hipSuccess || hipDeviceGetAttribute(&cus, hipDeviceAttributeMultiprocessorCount, dev) != hipSuccess) { grid = -1; return; }
        if (hipFuncSetAttribute((const void*)fwd_megakernel, hipFuncAttributeMaxDynamicSharedMemorySize, LDS_BYTES) != hipSuccess) { fprintf(stderr, "kernel_launch: hipFuncSetAttribute failed\n"); grid = -1; return; }
        if (hipOccupancyMaxActiveBlocksPerMultiprocessor(&per_cu, (const void*)fwd_megakernel, NTHREADS, LDS_BYTES) != hipSuccess || per_cu < 1) { fprintf(stderr, "kernel_launch: occupancy query says %d\n", per_cu); per_cu = 1; }
        (void)hipGetLastError();
        grid = cus * 1;
    }
    if (grid < 0) return;
    Args a{};
    for (int i = 0; i < 19; ++i) a.in[i] = (const float*)d_in[i];
    a.out = (float*)d_out; a.ws = (unsigned char*)d_ws;
    void* args[] = {&a};
    hipError_t e = hipLaunchCooperativeKernel((const void*)fwd_megakernel, dim3(grid), dim3(NTHREADS), args, LDS_BYTES, stream);
    if (e != hipSuccess) fprintf(stderr, "cooperative launch failed: %s (grid %d)\n", hipGetErrorString(e), grid);
}
```
